# Optimizing an MI355X kernel written in HIP

```python
import jax, jax.numpy as jnp
from jax import lax
import numpy as np

D_MODEL = 2048
BATCH = 1
SEQ = 8192
DEPTH = 1

N_MLA_HEADS = D_MODEL // 256
MLA_NOPE_DIM = 128
ROPE_DIM = 64
MLA_QK_DIM = MLA_NOPE_DIM + ROPE_DIM
MLA_V_DIM = 128
Q_LORA = D_MODEL // 4
KV_LORA = D_MODEL // 8
ROPE_THETA = 10000.0
Q_BLOCK = 128
MLA_WIDTH = N_MLA_HEADS * MLA_V_DIM

N_MLSTM_HEADS = 4
MLSTM_HEAD_DIM = D_MODEL // 8
MLSTM_WIDTH = N_MLSTM_HEADS * MLSTM_HEAD_DIM
MLSTM_CHUNK = 128
CONV_WIDTH = 5
N_GATE_COLS = 4 * N_MLSTM_HEADS

D_MIX = MLA_WIDTH + MLSTM_WIDTH
D_FF = 4 * D_MODEL
IN_SIZES = (Q_LORA, KV_LORA, ROPE_DIM, MLSTM_WIDTH, MLSTM_WIDTH, MLSTM_WIDTH, MLSTM_WIDTH, N_GATE_COLS)
D_IN = sum(IN_SIZES)
IN_SPLIT_POINTS = tuple(int(v) for v in np.cumsum(IN_SIZES)[:-1])
EPS = 1e-6
M_INIT = -1e30

kernel_name = "hybrid_mla_mlstm_adaln_block"


def rmsnorm(x, g):
    xf = x.astype(jnp.float32)
    y = xf * lax.rsqrt(jnp.mean(xf * xf, axis=-1, keepdims=True) + EPS)
    return (y * g.astype(jnp.float32)).astype(x.dtype)


def modulate(h, shift, scale):
    return h * (1 + scale) + shift


def rope(xp, positions):
    half = ROPE_DIM // 2
    freqs = ROPE_THETA ** (-jnp.arange(half, dtype=jnp.float32) / half)
    ang = positions.astype(jnp.float32)[..., None] * freqs
    cos = jnp.cos(ang)[:, :, None, :]
    sin = jnp.sin(ang)[:, :, None, :]
    x1 = xp[..., :half].astype(jnp.float32)
    x2 = xp[..., half:].astype(jnp.float32)
    out = jnp.concatenate([x1 * cos - x2 * sin, x1 * sin + x2 * cos], axis=-1)
    return out.astype(xp.dtype)


def dense_attention_blocks(q, k, v):
    B, S, H, Dq = q.shape
    nb = S // Q_BLOCK
    qb = q.reshape(B, nb, Q_BLOCK, H, Dq).transpose(1, 0, 2, 3, 4)
    scale = Dq ** -0.5

    def one_block(qi):
        s = jnp.einsum('bqhd,bkhd->bhqk', qi, k).astype(jnp.float32) * scale
        p = jax.nn.softmax(s, axis=-1).astype(v.dtype)
        return jnp.einsum('bhqk,bkhd->bqhd', p, v)

    o = lax.map(one_block, qb)
    return o.transpose(1, 0, 2, 3, 4).reshape(B, S, H * v.shape[-1])


def mlstm_chunkwise(q, k, v, log_i, log_f):
    B, H, S, d = q.shape
    L = MLSTM_CHUNK
    nc = S // L
    chunk = lambda t: t.reshape(B, H, nc, L, *t.shape[3:]).swapaxes(0, 2).swapaxes(1, 2)
    qc, kc, vc = chunk(q), chunk(k), chunk(v)
    ic, fc = chunk(log_i), chunk(log_f)
    tril = jnp.tril(jnp.ones((L, L), dtype=bool))

    def step(carry, inp):
        C, n, m = carry
        qt, kt, vt, it, ft = inp
        b = jnp.cumsum(ft, axis=-1)
        log_inter = b + m[..., None]
        logD = jnp.where(tril, b[..., :, None] - b[..., None, :] + it[..., None, :], -jnp.inf)
        m_t = jnp.maximum(log_inter, jnp.max(logD, axis=-1))
        Dm = jnp.exp(logD - m_t[..., None])
        w_inter = jnp.exp(log_inter - m_t)
        scores = jnp.einsum('bhtd,bhsd->bhts', qt, kt) * Dm
        num = jnp.einsum('bhts,bhsd->bhtd', scores, vt) \
            + w_inter[..., None] * jnp.einsum('bhvk,bhtk->bhtv', C, qt)
        den = jnp.sum(scores, axis=-1) + w_inter * jnp.einsum('bhtk,bhk->bht', qt, n)
        h = num / jnp.maximum(jnp.abs(den), jnp.exp(-m_t))[..., None]
        bL = b[..., -1]
        log_w = bL[..., None] - b + it
        m_new = jnp.maximum(bL + m, jnp.max(log_w, axis=-1))
        decay = jnp.exp(bL + m - m_new)
        w = jnp.exp(log_w - m_new[..., None])
        C_new = decay[..., None, None] * C + jnp.einsum('bhs,bhsv,bhsk->bhvk', w, vt, kt)
        n_new = decay[..., None] * n + jnp.einsum('bhs,bhsk->bhk', w, kt)
        return (C_new, n_new, m_new), h

    init = (jnp.zeros((B, H, d, d), jnp.float32),
            jnp.zeros((B, H, d), jnp.float32),
            jnp.full((B, H), M_INIT, jnp.float32))
    _, hs = lax.scan(step, init, (qc, kc, vc, ic, fc))
    return hs.transpose(1, 2, 0, 3, 4).reshape(B, H, S, d)


def setup_inputs(seed: int = 0) -> dict:
    key = jax.random.key(seed)
    ks = jax.random.split(key, 24)
    f32 = jnp.float32
    nrm = lambda k, shape, fan_in, s=1.0: jax.random.normal(k, shape, f32) * (s * fan_in ** -0.5)
    gain = lambda k, shape: 1.0 + 0.05 * jax.random.normal(k, shape, f32)
    gate_base = jnp.concatenate([jnp.zeros((N_MLSTM_HEADS,), f32), jnp.linspace(3.0, 6.0, N_MLSTM_HEADS, dtype=f32),
                                 jnp.zeros((N_MLSTM_HEADS,), f32), jnp.linspace(3.0, 6.0, N_MLSTM_HEADS, dtype=f32)])
    return {
        "x": jax.random.normal(ks[0], (BATCH, SEQ, D_MODEL), f32),
        "c": jax.random.normal(ks[1], (BATCH, D_MODEL), f32),
        "positions": jnp.broadcast_to(jnp.arange(SEQ, dtype=jnp.int32), (BATCH, SEQ)),
        "w_ada": nrm(ks[2], (DEPTH, D_MODEL, 6 * D_MODEL), D_MODEL, 0.5),
        "b_ada": 0.02 * jax.random.normal(ks[3], (DEPTH, 6 * D_MODEL), f32),
        "norm_mix_g": gain(ks[4], (DEPTH, D_MODEL)),
        "w_in": nrm(ks[5], (DEPTH, D_MODEL, D_IN), D_MODEL),
        "b_gates": gate_base + 0.1 * jax.random.normal(ks[6], (DEPTH, N_GATE_COLS), f32),
        "conv_w": nrm(ks[7], (DEPTH, CONV_WIDTH, 2 * MLSTM_WIDTH), CONV_WIDTH),
        "conv_b": 0.02 * jax.random.normal(ks[8], (DEPTH, 2 * MLSTM_WIDTH), f32),
        "q_lora_g": gain(ks[9], (DEPTH, Q_LORA)),
        "w_uq": nrm(ks[10], (DEPTH, Q_LORA, N_MLA_HEADS * MLA_QK_DIM), Q_LORA),
        "kv_lora_g": gain(ks[11], (DEPTH, KV_LORA)),
        "w_ukv": nrm(ks[12], (DEPTH, KV_LORA, N_MLA_HEADS * (MLA_NOPE_DIM + MLA_V_DIM)), KV_LORA),
        "q_norm_g": gain(ks[13], (DEPTH, MLA_QK_DIM)),
        "k_norm_g": gain(ks[14], (DEPTH, MLA_QK_DIM)),
        "mlstm_norm_g": gain(ks[15], (DEPTH, N_MLSTM_HEADS, MLSTM_HEAD_DIM)),
        "w_out": nrm(ks[16], (DEPTH, D_MIX, D_MODEL), D_MIX),
        "norm_mlp_g": gain(ks[17], (DEPTH, D_MODEL)),
        "w_ff1": nrm(ks[18], (DEPTH, D_MODEL, D_FF), D_MODEL),
        "w_ff2": nrm(ks[19], (DEPTH, D_FF, D_MODEL), D_FF),
    }


def reference(x, c, positions, w_ada, b_ada, norm_mix_g, w_in, b_gates, conv_w, conv_b,
              q_lora_g, w_uq, kv_lora_g, w_ukv, q_norm_g, k_norm_g, mlstm_norm_g,
              w_out, norm_mlp_g, w_ff1, w_ff2):
    B, S, D = x.shape
    H, HM, DM = N_MLA_HEADS, N_MLSTM_HEADS, MLSTM_HEAD_DIM
    for l in range(DEPTH):
        mod = jax.nn.silu(c) @ w_ada[l] + b_ada[l]
        shift1, scale1, gate1, shift2, scale2, gate2 = jnp.split(mod[:, None, :], 6, axis=-1)

        h = modulate(rmsnorm(x, norm_mix_g[l]), shift1, scale1)
        proj = h @ w_in[l]
        c_q, c_kv, k_pe, q_m, k_m, v_m, o_m, g_m = jnp.split(proj, IN_SPLIT_POINTS, axis=-1)

        q = (rmsnorm(c_q, q_lora_g[l]) @ w_uq[l]).reshape(B, S, H, MLA_QK_DIM)
        kv = (rmsnorm(c_kv, kv_lora_g[l]) @ w_ukv[l]).reshape(B, S, H, MLA_NOPE_DIM + MLA_V_DIM)
        k_nope, v = kv[..., :MLA_NOPE_DIM], kv[..., MLA_NOPE_DIM:]
        k_full = jnp.concatenate([k_nope, jnp.broadcast_to(k_pe[:, :, None, :], (B, S, H, ROPE_DIM))], axis=-1)
        q = rmsnorm(q, q_norm_g[l])
        k_full = rmsnorm(k_full, k_norm_g[l])
        q = jnp.concatenate([q[..., :MLA_NOPE_DIM], rope(q[..., MLA_NOPE_DIM:], positions)], axis=-1)
        k_full = jnp.concatenate([k_full[..., :MLA_NOPE_DIM], rope(k_full[..., MLA_NOPE_DIM:], positions)], axis=-1)
        attn_out = dense_attention_blocks(q, k_full, v)

        qk = jnp.concatenate([q_m, k_m], axis=-1)
        qk = lax.conv_general_dilated(qk, conv_w[l][:, None, :].astype(qk.dtype), window_strides=(1,),
                                      padding='SAME', dimension_numbers=('NWC', 'WIO', 'NWC'),
                                      feature_group_count=2 * MLSTM_WIDTH)
        qk = jax.nn.silu(qk + conv_b[l])
        to_heads = lambda t: t.reshape(B, S, HM, DM).transpose(0, 2, 1, 3).astype(jnp.float32)
        qh = to_heads(qk[..., :MLSTM_WIDTH])
        kh = to_heads(qk[..., MLSTM_WIDTH:]) * (DM ** -0.5)
        vh = to_heads(v_m)
        gates = (g_m.astype(jnp.float32) + b_gates[l].astype(jnp.float32)).reshape(B, S, 4, HM)
        gates = gates.transpose(2, 0, 3, 1)
        i_fwd, f_fwd, i_bwd, f_bwd = gates[0], gates[1], gates[2], gates[3]
        h_fwd = mlstm_chunkwise(qh, kh, vh, i_fwd, jax.nn.log_sigmoid(f_fwd))
        flip = lambda t: jnp.flip(t, axis=2)
        h_bwd = flip(mlstm_chunkwise(flip(qh), flip(kh), flip(vh), flip(i_bwd), flip(jax.nn.log_sigmoid(f_bwd))))
        hm = (h_fwd + h_bwd).transpose(0, 2, 1, 3)
        hm = rmsnorm(hm, mlstm_norm_g[l]).astype(x.dtype)
        mlstm_out = (jax.nn.sigmoid(o_m).reshape(B, S, HM, DM) * hm).reshape(B, S, MLSTM_WIDTH)

        mixed = jnp.concatenate([attn_out.astype(x.dtype), mlstm_out], axis=-1) @ w_out[l]
        x = x + gate1 * mixed

        h2 = modulate(rmsnorm(x, norm_mlp_g[l]), shift2, scale2)
        y = jnp.square(jax.nn.relu(h2 @ w_ff1[l])) @ w_ff2[l]
        x = x + gate2 * y
    return x
```

```cpp
#include <hip/hip_runtime.h>
#include <hip/hip_cooperative_groups.h>
#include <cstdio>
#include <cstdint>
namespace cg = cooperative_groups;

#ifndef MK_MULTI
#define MK_MULTI 0
#endif

#define LAS __attribute__((address_space(3)))
typedef unsigned short bf16_t;
typedef short bf16x8 __attribute__((ext_vector_type(8)));
typedef short s16x4 __attribute__((ext_vector_type(4)));
typedef float f32x4 __attribute__((ext_vector_type(4)));
typedef float f32x2 __attribute__((ext_vector_type(2)));
typedef float f32x16 __attribute__((ext_vector_type(16)));
typedef unsigned u32x4 __attribute__((ext_vector_type(4)));
typedef unsigned u32x2 __attribute__((ext_vector_type(2)));

constexpr int SEQ = 8192, DM = 2048, DIN = 4944, DINP = 5120, DFF = 8192;
constexpr int NH = 8, DQK = 192, DV = 128, QLORA = 512, KVLORA = 256;
constexpr int HM = 4, DH = 256, LCH = 128, NCH = 64;
constexpr int OFF_CQ = 0, OFF_CKV = 512, OFF_KPE = 768, OFF_QM = 832, OFF_KM = 1856, OFF_VM = 2880, OFF_OM = 3904, OFF_GM = 4928;
constexpr float EPS = 1e-6f;
constexpr int NTHREADS = 512, NWAVES = 8;
constexpr int LDS_BYTES = 147456;

constexpr size_t MiB = 1u << 20;
constexpr size_t WS_MODP = 0;
constexpr size_t WS_MOD = 786432;
constexpr size_t WS_BC = 1 * MiB;
constexpr size_t WS_IG = WS_BC + 262144;
constexpr size_t WS_PM = WS_IG + 262144;
constexpr size_t WS_WL = WS_PM + 262144;
constexpr size_t WS_BL = 851968;
constexpr size_t WS_AC = 856064;
constexpr size_t WS_WIN = 2 * MiB, WS_WUQ = 22 * MiB, WS_WUKV = 24 * MiB, WS_WOUT = 26 * MiB;
constexpr size_t WS_CST = 34 * MiB;
constexpr size_t WS_W1 = 34 * MiB, WS_W2 = 66 * MiB;
constexpr size_t WS_H = 98 * MiB;
constexpr size_t WS_Q = 98 * MiB;
constexpr size_t WS_MIX = 130 * MiB;
constexpr size_t WS_PROJ = 162 * MiB;
constexpr size_t WS_CQN = 242 * MiB, WS_CKVN = 250 * MiB;
constexpr size_t WS_GATES = 254 * MiB;
constexpr size_t WS_NST = 255 * MiB;
constexpr size_t WS_ACT = 130 * MiB;
constexpr size_t WS_KV = 258 * MiB;
constexpr size_t WS_K = 290 * MiB;
constexpr size_t WS_QH = 314 * MiB, WS_KH = 330 * MiB, WS_KT = 346 * MiB, WS_VT = 362 * MiB;
constexpr size_t WS_END = 378 * MiB;

struct Params {
    const float* x; const float* c; const int* pos; const float* w_ada; const float* b_ada; const float* norm_mix_g; const float* w_in;
    const float* b_gates; const float* conv_w; const float* conv_b; const float* q_lora_g; const float* w_uq; const float* kv_lora_g;
    const float* w_ukv; const float* q_norm_g; const float* k_norm_g; const float* mlstm_norm_g; const float* w_out; const float* norm_mlp_g;
    const float* w_ff1; const float* w_ff2;
    float* out; unsigned char* ws; int ph_lo, ph_hi;
};

#define LAUNDER_V(x) asm volatile("" : "+v"(x))
#define LAUNDER_S(x) asm volatile("" : "+s"(x))
__device__ __forceinline__ int tid_opaque() { int t = threadIdx.x; LAUNDER_V(t); return t; }
__device__ __forceinline__ unsigned cvt_pk_bf16(float lo, float hi) { unsigned r; asm volatile("v_cvt_pk_bf16_f32 %0, %1, %2" : "=v"(r) : "v"(lo), "v"(hi)); return r; }
__device__ __forceinline__ float bf_lo(unsigned w) { return __uint_as_float(w << 16); }
__device__ __forceinline__ float bf_hi(unsigned w) { return __uint_as_float(w & 0xffff0000u); }
__device__ __forceinline__ float bf2f(bf16_t b) { return __uint_as_float(((unsigned)b) << 16); }
__device__ __forceinline__ bf16_t f2bf(float f) { return (bf16_t)(cvt_pk_bf16(f, 0.f) & 0xffffu); }
__device__ __forceinline__ float wave_sum(float v) {
#pragma unroll
    for (int o = 1; o < 64; o <<= 1) v += __shfl_xor(v, o);
    return v;
}
template <class T> __device__ __forceinline__ T ldgu(const void* ubase, unsigned voff) { return *(const T*)((const char*)ubase + voff); }
__device__ __forceinline__ float silu_f(float v) { return v / (1.f + __expf(-v)); }
__device__ __forceinline__ float sigmoid_f(float v) { return 1.f / (1.f + __expf(-v)); }
__device__ __forceinline__ void unpack8(u32x4 w, float* f) {
    f[0] = bf_lo(w.x); f[1] = bf_hi(w.x); f[2] = bf_lo(w.y); f[3] = bf_hi(w.y); f[4] = bf_lo(w.z); f[5] = bf_hi(w.z); f[6] = bf_lo(w.w); f[7] = bf_hi(w.w);
}
__device__ __forceinline__ u32x4 pack8(const float* f) {
    u32x4 w; w.x = cvt_pk_bf16(f[0], f[1]); w.y = cvt_pk_bf16(f[2], f[3]); w.z = cvt_pk_bf16(f[4], f[5]); w.w = cvt_pk_bf16(f[6], f[7]); return w;
}

namespace pg8 {
constexpr int BM = 256, BK = 64, HALF = 128, HTB = HALF * BK * 2, STAGE_BYTES = 8 * HTB, NXCD = 8, WGM = 8;
__host__ __device__ __forceinline__ int lds_byte(int r, int c) { const int st = (r >> 4) * 2 + (c >> 5), rr = r & 15, cc = c & 31, ob = rr * 64 + cc * 2; return st * 1024 + (ob ^ (((ob >> 9) & 1) << 5)); }
__host__ __device__ __forceinline__ void stage_rc(int b, int& R, int& C) { const int st = b / 1024, sb = b % 1024, swz = sb ^ (((sb >> 9) & 1) << 5); R = (st >> 1) * 16 + swz / 64; C = (st & 1) * 32 + (swz % 64) / 2; }
__host__ __device__ __forceinline__ int perm32(int rho) { const int n = rho >> 4, i = rho & 15; return 8 * (i >> 2) + 4 * n + (i & 3); }
struct Unit { int pm, pn; };
struct Gemm { const bf16_t* A; const bf16_t* Bt; int M, N, K; };
struct StaticOrder {
    int nM, nN, nwg, G, c;
    __host__ __device__ void init(int M, int N, int G_, int c_) { nM = M / BM; nN = N / BM; nwg = nM * nN; G = G_; c = c_; }
    __host__ __device__ bool next(int i, Unit& u) const {
        const long L = (long)i * G + c; if (L >= nwg) return false;
        int wgid = (int)L; { const int q = nwg / NXCD, r = nwg % NXCD, xcd = wgid % NXCD, off = wgid / NXCD; wgid = (xcd < r ? xcd * (q + 1) : r * (q + 1) + (xcd - r) * q) + off; }
        const int nig = WGM * nN, gid = wgid / nig, fm = gid * WGM, gsz = (nM - fm) < WGM ? (nM - fm) : WGM;
        u.pm = fm + ((wgid % nig) % gsz); u.pn = (wgid % nig) / gsz; return true;
    }
    __device__ __forceinline__ void a_ready(const Unit&) const {}
    __device__ __forceinline__ void done(const Unit&) const {}
};
template <class F> struct Epi8 {
    static constexpr bool PERM = true, AFTER_DRAIN = false; F f;
    __device__ __forceinline__ void operator()(const f32x4 (&acc)[2][2][4][2], const Unit& u, int wr, int wc, int fr, int fq) const {
        const int row0 = u.pm * BM + wr * 64 + fr, col0 = u.pn * BM + wc * 32 + 8 * fq;
#pragma unroll
        for (int ai = 0; ai < 2; ++ai)
#pragma unroll
            for (int m = 0; m < 4; ++m)
#pragma unroll
                for (int bj = 0; bj < 2; ++bj) f(row0 + ai * HALF + m * 16, col0 + bj * HALF, acc[ai][bj][m][0], acc[ai][bj][m][1]);
    }
};
template <class F> struct Epi4 {
    static constexpr bool PERM = false, AFTER_DRAIN = false; F f;
    __device__ __forceinline__ void operator()(const f32x4 (&acc)[2][2][4][2], const Unit& u, int wr, int wc, int fr, int fq) const {
        const int row0 = u.pm * BM + wr * 64 + fr, col0 = u.pn * BM + wc * 32 + 4 * fq;
#pragma unroll
        for (int ai = 0; ai < 2; ++ai)
#pragma unroll
            for (int m = 0; m < 4; ++m) {
#pragma unroll
                for (int bj = 0; bj < 2; ++bj)
#pragma unroll
                    for (int n = 0; n < 2; ++n) f(row0 + ai * HALF + m * 16, col0 + bj * HALF + n * 16, acc[ai][bj][m][n]);
                if (m & 1) asm volatile("" ::: "memory");
            }
    }
};

template <class Epi, class Sched, bool ALIGN_EPI = false, bool SP2 = false>
__device__ __forceinline__ void gemm_phase(LAS unsigned char* lds, const Gemm g, const Sched& S, const Epi& E) {
    const int tid = tid_opaque(), wid = __builtin_amdgcn_readfirstlane(tid >> 6), lane = tid & 63, wr = wid >> 2, wc = wid & 3, fr = lane & 15, fq = lane >> 4;
    const int K = g.K, nt = K / BK;
    unsigned voffA[2], voffB[2];
#pragma unroll
    for (int i = 0; i < 2; ++i) { int R, C; stage_rc(tid * 16 + i * 8192, R, C); const int Rb = Epi::PERM ? ((R & ~31) + perm32(R & 31)) : R;
        voffA[i] = (unsigned)(R * K + C) * 2u; voffB[i] = (unsigned)(Rb * K + C) * 2u; }
    const size_t kstep = (size_t)(BK * 2);
    const size_t hstep = (size_t)HALF * K * 2;
    const size_t tstep = 2 * hstep;
    const unsigned ldsw = (unsigned)wid * 1024u;
    const int aoff = lds_byte(wr * 64 + fr, fq * 8), boff = lds_byte(wc * 32 + fr, fq * 8);
#define PG8_SA(b, h) (((b) * 2 + (h)) * HTB)
#define PG8_SB(b, h) ((4 + (b) * 2 + (h)) * HTB)
#define PG8_STAGE(bufoff, gbase, voff) do { _Pragma("unroll") for (int _i = 0; _i < 2; ++_i) \
        __builtin_amdgcn_global_load_lds((const unsigned*)((const char*)(gbase) + (voff)[_i]), (LAS unsigned*)(lds + (bufoff) + ldsw + _i * 8192), 16, 0, 0); } while (0)
#define PG8_LDA(dst, b, h) do { _Pragma("unroll") for (int m = 0; m < 4; ++m) _Pragma("unroll") for (int k = 0; k < 2; ++k) dst[m][k] = *(const LAS bf16x8*)(lds + PG8_SA(b, h) + aoff + m * 2048 + k * 1024); } while (0)
#define PG8_LDB(dst, b, h) do { _Pragma("unroll") for (int n = 0; n < 2; ++n) _Pragma("unroll") for (int k = 0; k < 2; ++k) dst[n][k] = *(const LAS bf16x8*)(lds + PG8_SB(b, h) + boff + n * 2048 + k * 1024); } while (0)
#define PG8_MMA(ai, bj, At, Bt) do { __builtin_amdgcn_s_setprio(1); _Pragma("unroll") for (int m = 0; m < 4; ++m) _Pragma("unroll") for (int n = 0; n < 2; ++n) _Pragma("unroll") for (int k = 0; k < 2; ++k) \
        acc[ai][bj][m][n] = __builtin_amdgcn_mfma_f32_16x16x32_bf16(Bt[n][k], At[m][k], acc[ai][bj][m][n], 0, 0, 0); __builtin_amdgcn_s_setprio(0); } while (0)
#define PG8_WAIT_V(n) asm volatile("s_waitcnt vmcnt(" #n ")" ::: "memory")
#define PG8_WAIT_L(n) asm volatile("s_waitcnt lgkmcnt(" #n ")" ::: "memory")
#define PG8_BAR __builtin_amdgcn_s_barrier()
#define PG8_SCHED __builtin_amdgcn_sched_barrier(0)
    Unit cur, nxt; int ui = 0;
    if (!S.next(0, cur)) return;
    f32x4 acc[2][2][4][2];
#pragma unroll
    for (int a = 0; a < 2; ++a)
#pragma unroll
        for (int b = 0; b < 2; ++b)
#pragma unroll
            for (int m = 0; m < 4; ++m)
#pragma unroll
                for (int n = 0; n < 2; ++n) acc[a][b][m][n] = (f32x4){0.f, 0.f, 0.f, 0.f};
    bf16x8 At[4][2], B0[2][2], B1[2][2];
    const char* cA = (const char*)g.A + (size_t)cur.pm * tstep; const char* cB = (const char*)g.Bt + (size_t)cur.pn * tstep;
    S.a_ready(cur);
    if constexpr (SP2) {
        PG8_STAGE(PG8_SB(0, 0), cB, voffB); PG8_STAGE(PG8_SB(0, 1), cB + hstep, voffB); PG8_STAGE(PG8_SA(0, 0), cA, voffA); PG8_STAGE(PG8_SA(0, 1), cA + hstep, voffA);
        if (wr == 1) PG8_BAR;
        PG8_WAIT_V(2); PG8_BAR;
        PG8_STAGE(PG8_SB(1, 0), cB + kstep, voffB); PG8_STAGE(PG8_SA(1, 0), cA + kstep, voffA); PG8_STAGE(PG8_SB(1, 1), cB + hstep + kstep, voffB);
        PG8_WAIT_V(6); PG8_BAR;
    } else {
        PG8_STAGE(PG8_SB(0, 0), cB, voffB); PG8_STAGE(PG8_SA(0, 0), cA, voffA); PG8_STAGE(PG8_SB(0, 1), cB + hstep, voffB); PG8_STAGE(PG8_SA(0, 1), cA + hstep, voffA);
        if (wr == 1) PG8_BAR;
        PG8_WAIT_V(4); PG8_BAR;
        PG8_STAGE(PG8_SB(1, 0), cB + kstep, voffB); PG8_STAGE(PG8_SA(1, 0), cA + kstep, voffA); PG8_STAGE(PG8_SB(1, 1), cB + hstep + kstep, voffB);
        PG8_WAIT_V(6); PG8_BAR;
    }
    for (;;) {
        const bool has_next = S.next(ui + 1, nxt);
        const char* nA = has_next ? (const char*)g.A + (size_t)nxt.pm * tstep : cA; const char* nB = has_next ? (const char*)g.Bt + (size_t)nxt.pn * tstep : cB;
#pragma unroll 1
        for (int t = 0; t < nt; t += 2) {
            const bool last = (t == nt - 2);
            const char* a1 = cA + (size_t)(t + 1) * kstep;
            const char* a2 = last ? nA : cA + (size_t)(t + 2) * kstep; const char* b2 = last ? nB : cB + (size_t)(t + 2) * kstep;
            const char* a3 = a2 + kstep; const char* b3 = b2 + kstep;
            if (last && has_next) S.a_ready(nxt);
            if constexpr (SP2) {
            PG8_LDB(B0, 0, 0); PG8_LDB(B1, 0, 1); PG8_SCHED; PG8_LDA(At, 0, 0); PG8_STAGE(PG8_SA(1, 1), a1 + hstep, voffA);
            PG8_WAIT_V(8); PG8_WAIT_L(0); PG8_BAR; PG8_MMA(0, 0, At, B0); PG8_MMA(0, 1, At, B1); PG8_BAR; PG8_SCHED;
            PG8_LDA(At, 0, 1); PG8_STAGE(PG8_SB(0, 0), b2, voffB); PG8_STAGE(PG8_SB(0, 1), b2 + hstep, voffB); PG8_STAGE(PG8_SA(0, 0), a2, voffA);
            PG8_WAIT_V(8); PG8_WAIT_L(0); PG8_BAR; PG8_MMA(1, 0, At, B0); PG8_MMA(1, 1, At, B1); PG8_BAR; PG8_SCHED;
            PG8_LDB(B0, 1, 0); PG8_LDB(B1, 1, 1); PG8_SCHED; PG8_LDA(At, 1, 0); PG8_STAGE(PG8_SA(0, 1), a2 + hstep, voffA);
            PG8_WAIT_V(8); PG8_WAIT_L(0); PG8_BAR; PG8_MMA(0, 0, At, B0); PG8_MMA(0, 1, At, B1); PG8_BAR; PG8_SCHED;
            PG8_LDA(At, 1, 1); PG8_STAGE(PG8_SB(1, 0), b3, voffB); PG8_STAGE(PG8_SB(1, 1), b3 + hstep, voffB); PG8_STAGE(PG8_SA(1, 0), a3, voffA);
            PG8_WAIT_V(8); PG8_WAIT_L(0); PG8_BAR; PG8_MMA(1, 0, At, B0); PG8_MMA(1, 1, At, B1); PG8_BAR; PG8_SCHED;
            } else {
            PG8_LDB(B0, 0, 0); PG8_SCHED; PG8_LDA(At, 0, 0); PG8_STAGE(PG8_SA(1, 1), a1 + hstep, voffA);
            PG8_WAIT_L(8); PG8_BAR; PG8_WAIT_L(0); PG8_MMA(0, 0, At, B0); PG8_BAR; PG8_SCHED;
            PG8_LDB(B1, 0, 1); PG8_STAGE(PG8_SB(0, 0), b2, voffB);
            PG8_BAR; PG8_WAIT_L(0); PG8_MMA(0, 1, At, B1); PG8_BAR;
            PG8_LDA(At, 0, 1); PG8_STAGE(PG8_SA(0, 0), a2, voffA);
            PG8_BAR; PG8_WAIT_L(0); PG8_MMA(1, 0, At, B0); PG8_BAR; PG8_SCHED;
            PG8_STAGE(PG8_SB(0, 1), b2 + hstep, voffB);
            PG8_WAIT_V(6); PG8_BAR; PG8_MMA(1, 1, At, B1); PG8_BAR;
            PG8_LDB(B0, 1, 0); PG8_SCHED; PG8_LDA(At, 1, 0); PG8_STAGE(PG8_SA(0, 1), a2 + hstep, voffA);
            PG8_WAIT_L(8); PG8_BAR; PG8_WAIT_L(0); PG8_MMA(0, 0, At, B0); PG8_BAR; PG8_SCHED;
            PG8_LDB(B1, 1, 1); PG8_STAGE(PG8_SB(1, 0), b3, voffB);
            PG8_BAR; PG8_WAIT_L(0); PG8_MMA(0, 1, At, B1); PG8_BAR;
            PG8_LDA(At, 1, 1); PG8_STAGE(PG8_SA(1, 0), a3, voffA);
            PG8_BAR; PG8_WAIT_L(0); PG8_MMA(1, 0, At, B0); PG8_BAR; PG8_SCHED;
            PG8_STAGE(PG8_SB(1, 1), b3 + hstep, voffB);
            PG8_WAIT_V(6); PG8_BAR; PG8_MMA(1, 1, At, B1); PG8_BAR;
            }
        }
        if constexpr (ALIGN_EPI) { if (wr == 0) PG8_BAR; }
        if constexpr (!Epi::AFTER_DRAIN) { E(acc, cur, wr, wc, fr, fq); S.done(cur); }
        if (!has_next) break;
#pragma unroll
        for (int a = 0; a < 2; ++a)
#pragma unroll
            for (int b = 0; b < 2; ++b)
#pragma unroll
                for (int m = 0; m < 4; ++m)
#pragma unroll
                    for (int n = 0; n < 2; ++n) acc[a][b][m][n] = (f32x4){0.f, 0.f, 0.f, 0.f};
        cur = nxt; cA = nA; cB = nB; ++ui;
        if constexpr (ALIGN_EPI) { if (wr == 1) PG8_BAR; }
    }
    PG8_WAIT_V(0);
    if constexpr (!ALIGN_EPI) { if (wr == 0) PG8_BAR; }
    PG8_BAR;
#undef PG8_SA
#undef PG8_SB
#undef PG8_STAGE
#undef PG8_LDA
#undef PG8_LDB
#undef PG8_MMA
#undef PG8_WAIT_V
#undef PG8_WAIT_L
#undef PG8_BAR
#undef PG8_SCHED
}
}

namespace att {
constexpr int NW = 8, QBLK = 32, KVBLK = 64;
constexpr int LDQ = NH * DQK, LDK = NH * DQK, LDV = NH * 256, LDO = DM;
constexpr float SCALE = 0.07216878364870322f;
constexpr float THR = 8.f;
constexpr int SHM_K = KVBLK * DQK * 2, SHM_V = KVBLK * DV * 2;
constexpr int SHM_QL = 2 * SHM_V + 2 * SHM_K + NW * 64 * 4;
constexpr int SHM_ATTN = SHM_QL + NW * 4096;
#define KSWZ(row, colB) ((row) * 384 + ((colB) ^ ((((row) >> 1) & 7) << 4)))
#define SBAR() __builtin_amdgcn_sched_barrier(0)
__device__ __forceinline__ int crow(int r, int hi) { return (r & 3) + 8 * (r >> 2) + 4 * hi; }
__device__ __forceinline__ void partialSM(f32x16& p0, f32x16& p1, float& m_reg, float& mn, float& alpha) {
    constexpr float C = SCALE * 1.4426950408889634f;
    float pmax = p0[0];
#pragma unroll
    for (int r = 1; r < 16; ++r) pmax = fmaxf(pmax, p0[r]);
#pragma unroll
    for (int r = 0; r < 16; ++r) pmax = fmaxf(pmax, p1[r]);
    { auto rr = __builtin_amdgcn_permlane32_swap(__float_as_uint(pmax), __float_as_uint(pmax), false, false);
      pmax = fmaxf(__uint_as_float(rr[0]), __uint_as_float(rr[1])); }
    if (__builtin_expect(__all(pmax - m_reg <= THR / SCALE), 1)) { mn = m_reg; alpha = 1.f; }
    else { mn = fmaxf(m_reg, pmax); alpha = __builtin_amdgcn_exp2f((m_reg - mn) * C); m_reg = mn; }
    float mnC = -mn * C;
#pragma unroll
    for (int r = 0; r < 16; ++r) p0[r] = fmaf(p0[r], C, mnC);
#pragma unroll
    for (int r = 0; r < 16; ++r) p1[r] = fmaf(p1[r], C, mnC);
#pragma unroll
    for (int r = 0; r < 16; ++r) p0[r] = __builtin_amdgcn_exp2f(p0[r]);
}
__device__ __forceinline__ void finishSM(f32x16& p0, f32x16& p1, float alpha, float& l_reg, bf16x8& pa0, bf16x8& pa1, bf16x8& pa2, bf16x8& pa3) {
#pragma unroll
    for (int r = 0; r < 16; ++r) p1[r] = __builtin_amdgcn_exp2f(p1[r]);
    float ps = 0;
#pragma unroll
    for (int r = 0; r < 16; ++r) ps += p0[r];
#pragma unroll
    for (int r = 0; r < 16; ++r) ps += p1[r];
    { auto rr = __builtin_amdgcn_permlane32_swap(__float_as_uint(ps), __float_as_uint(ps), false, false);
      ps = __uint_as_float(rr[0]) + __uint_as_float(rr[1]); }
    l_reg = l_reg * alpha + ps;
#define PK4(P, BASE, OUT) do { unsigned a0 = cvt_pk_bf16(P[BASE + 0], P[BASE + 1]), a1 = cvt_pk_bf16(P[BASE + 2], P[BASE + 3]);   \
    unsigned b0 = cvt_pk_bf16(P[BASE + 4], P[BASE + 5]), b1 = cvt_pk_bf16(P[BASE + 6], P[BASE + 7]);                              \
    auto r0 = __builtin_amdgcn_permlane32_swap(a0, b0, false, false); auto r1 = __builtin_amdgcn_permlane32_swap(a1, b1, false, false); \
    u32x4 w = {r0[0], r1[0], r0[1], r1[1]}; OUT = *reinterpret_cast<bf16x8*>(&w); } while (0)
    PK4(p0, 0, pa0); PK4(p0, 8, pa1); PK4(p1, 0, pa2); PK4(p1, 8, pa3);
#undef PK4
}
__device__ __forceinline__ void qkt(f32x16& p0, f32x16& p1, const char* Ks, const bf16x8* qr, const char* ql, int r32, int hi) {
    p0 = f32x16{}; p1 = f32x16{};
#pragma unroll
    for (int d0 = 0; d0 < 12; ++d0) { const int cb = (d0 * 16 + hi * 8) * 2;
        bf16x8 b0 = *reinterpret_cast<const bf16x8*>(Ks + KSWZ(r32, cb));
        bf16x8 b1 = *reinterpret_cast<const bf16x8*>(Ks + KSWZ(32 + r32, cb));
        const bf16x8 q = d0 < 8 ? qr[d0 < 8 ? d0 : 0] : *reinterpret_cast<const bf16x8*>(ql + (d0 - 8) * 1024);
        p0 = __builtin_amdgcn_mfma_f32_32x32x16_bf16(b0, q, p0, 0, 0, 0);
        p1 = __builtin_amdgcn_mfma_f32_32x32x16_bf16(b1, q, p1, 0, 0, 0); }
}
__device__ __forceinline__ int v_st(int k, int c) { const int kk = (k & ~0xC) | ((k & 4) << 1) | ((k & 8) >> 1); return ((kk >> 3) * 4 + (c >> 5)) * 512 + ((kk & 7) * 32 + (c & 31)) * 2; }
__device__ __forceinline__ int v_rd_base(int lane) { return ((lane & 3) << 3) | (((lane >> 2) & 3) << 6) | (((lane >> 4) & 1) << 5) | (((lane >> 5) & 1) << 8); }
constexpr int v_rd_off(int d0, int ks, int half) { return d0 * 512 + ks * 4096 + half * 2048; }
template <int OFF> __device__ __forceinline__ s16x4 tr_read(int vb) {
    s16x4 r; asm volatile("ds_read_b64_tr_b16 %0, %1 offset:%2" : "=&v"(r) : "v"(vb), "i"(OFF) : "memory"); return r;
}
template <int D0> __device__ __forceinline__ void pv_one(f32x16& od, int vb, bf16x8 pa0, bf16x8 pa1, bf16x8 pa2, bf16x8 pa3) {
    const s16x4 l0 = tr_read<v_rd_off(D0, 0, 0)>(vb), h0 = tr_read<v_rd_off(D0, 0, 1)>(vb), l1 = tr_read<v_rd_off(D0, 1, 0)>(vb), h1 = tr_read<v_rd_off(D0, 1, 1)>(vb);
    const s16x4 l2 = tr_read<v_rd_off(D0, 2, 0)>(vb), h2 = tr_read<v_rd_off(D0, 2, 1)>(vb), l3 = tr_read<v_rd_off(D0, 3, 0)>(vb), h3 = tr_read<v_rd_off(D0, 3, 1)>(vb);
    asm volatile("s_waitcnt lgkmcnt(0)" ::: "memory"); SBAR();
#define PK(L, H) (bf16x8){L[0], L[1], L[2], L[3], H[0], H[1], H[2], H[3]}
    od = __builtin_amdgcn_mfma_f32_32x32x16_bf16(pa0, PK(l0, h0), od, 0, 0, 0);
    od = __builtin_amdgcn_mfma_f32_32x32x16_bf16(pa1, PK(l1, h1), od, 0, 0, 0);
    od = __builtin_amdgcn_mfma_f32_32x32x16_bf16(pa2, PK(l2, h2), od, 0, 0, 0);
    od = __builtin_amdgcn_mfma_f32_32x32x16_bf16(pa3, PK(l3, h3), od, 0, 0, 0);
#undef PK
}
__device__ __forceinline__ void pv_d0(f32x16* o, int vb, bf16x8 pa0, bf16x8 pa1, bf16x8 pa2, bf16x8 pa3) {
    pv_one<0>(o[0], vb, pa0, pa1, pa2, pa3); pv_one<1>(o[1], vb, pa0, pa1, pa2, pa3); pv_one<2>(o[2], vb, pa0, pa1, pa2, pa3); pv_one<3>(o[3], vb, pa0, pa1, pa2, pa3);
}
#ifndef ATT_SDEPTH
#define ATT_SDEPTH 1
#endif
constexpr int SDEPTH = ATT_SDEPTH;
__device__ __forceinline__ void attn_unit(const bf16_t* __restrict__ Qb, const bf16_t* __restrict__ Kh, const bf16_t* __restrict__ Vh, bf16_t* __restrict__ Ob, int seq, char* lds) {
    const int tid = tid_opaque(), wid = tid >> 6, lane = tid & 63, r32 = lane & 31, hi = lane >> 5;
    char* V_lds = lds; char* K_lds = lds + 2 * SHM_V;
    float* ws = (float*)(lds + 2 * SHM_V + 2 * SHM_K) + wid * 64; float* li_l = ws; float* al_l = ws + 32;
    float m_reg = -1e30f, l_reg = 0; f32x16 o[4] = {}; bf16x8 qr[8];
    const bf16_t* Qw = Qb + (long)(wid * QBLK + r32) * LDQ + hi * 8;
    char* ql = lds + SHM_QL + wid * 4096 + lane * 16;
#pragma unroll
    for (int d0 = 0; d0 < 8; ++d0) qr[d0] = *reinterpret_cast<const bf16x8*>(Qw + d0 * 16);
#pragma unroll
    for (int d0 = 8; d0 < 12; ++d0) *reinterpret_cast<bf16x8*>(ql + (d0 - 8) * 1024) = *reinterpret_cast<const bf16x8*>(Qw + d0 * 16);
    const int krow = tid >> 3, kc8 = tid & 7;
    const unsigned kgo = (unsigned)(krow * LDK + kc8 * 8) * 2u;
    const int kso = krow * 384 + ((kc8 * 16) ^ (((krow >> 1) & 7) << 4));
    const int sr = tid >> 4, sc = (tid & 15) * 8, vst0 = v_st(sr, sc);
    const unsigned vgo = (unsigned)(sr * LDV + sc) * 2u;
    const int vb0 = (int)(uintptr_t)V_lds + v_rd_base(lane);
    struct { bf16x8 k0, k1, k2, v0, v1; } sr_[SDEPTH];
#define SLOAD(i, kk0) do { const char* kp_ = (const char*)(Kh + (long)(kk0) * LDK); const char* vp_ = (const char*)(Vh + (long)(kk0) * LDV); \
    sr_[i].v0 = ldgu<bf16x8>(vp_, vgo); sr_[i].v1 = ldgu<bf16x8>(vp_ + 32 * LDV * 2, vgo); \
    sr_[i].k0 = ldgu<bf16x8>(kp_, kgo); sr_[i].k1 = ldgu<bf16x8>(kp_ + 128, kgo); sr_[i].k2 = ldgu<bf16x8>(kp_ + 256, kgo); } while (0)
#define SWRITE(b, i) do { *(bf16x8*)(V_lds + (b) * SHM_V + vst0) = sr_[i].v0; *(bf16x8*)(V_lds + (b) * SHM_V + 8192 + vst0) = sr_[i].v1; \
    *(bf16x8*)(K_lds + (b) * SHM_K + kso) = sr_[i].k0; *(bf16x8*)(K_lds + (b) * SHM_K + 128 + kso) = sr_[i].k1; *(bf16x8*)(K_lds + (b) * SHM_K + 256 + kso) = sr_[i].k2; } while (0)
#define SWAIT() do { if constexpr (SDEPTH == 2) asm volatile("s_waitcnt vmcnt(5)" ::: "memory"); else asm volatile("s_waitcnt vmcnt(0)" ::: "memory"); } while (0)
#define RESC(a) do { if (__any((a) < 1.f)) { if (hi == 0) al_l[r32] = (a); asm volatile("s_waitcnt lgkmcnt(0)" ::: "memory"); \
    _Pragma("unroll") for (int d = 0; d < 4; ++d) _Pragma("unroll") for (int r = 0; r < 16; ++r) o[d][r] *= al_l[crow(r, hi)]; } } while (0)
    f32x16 pA0, pA1, pB0, pB1; float mnA, mnB, alA, alB; bf16x8 pa0, pa1, pa2, pa3; const int NT = seq / KVBLK;
    constexpr int SE = 0, SO = SDEPTH - 1;
    SLOAD(SE, 0); asm volatile("s_waitcnt vmcnt(0)" ::: "memory"); SWRITE(0, SE); __syncthreads();
    qkt(pA0, pA1, K_lds, qr, ql, r32, hi); partialSM(pA0, pA1, m_reg, mnA, alA);
    SLOAD(SO, KVBLK); if constexpr (SDEPTH == 2) { if (2 < NT) SLOAD(SE, 2 * KVBLK); }
    SWAIT(); SWRITE(1, SO); __syncthreads();
    for (int j = 1; j + 1 < NT; j += 2) {
        SBAR(); qkt(pB0, pB1, K_lds + SHM_K, qr, ql, r32, hi);
        finishSM(pA0, pA1, alA, l_reg, pa0, pa1, pa2, pa3); SBAR();
        SLOAD(SO, (j + SDEPTH) * KVBLK); SBAR();
        pv_d0(o, vb0, pa0, pa1, pa2, pa3); partialSM(pB0, pB1, m_reg, mnB, alB);
        __syncthreads(); SWAIT(); SWRITE(0, SE);
        RESC(alB); __syncthreads();
        SBAR(); qkt(pA0, pA1, K_lds, qr, ql, r32, hi);
        finishSM(pB0, pB1, alB, l_reg, pa0, pa1, pa2, pa3); SBAR();
        if (SDEPTH == 1 || j + 3 < NT) SLOAD(SE, (j + 1 + SDEPTH) * KVBLK); SBAR();
        pv_d0(o, vb0 + SHM_V, pa0, pa1, pa2, pa3); partialSM(pA0, pA1, m_reg, mnA, alA);
        __syncthreads(); SWAIT(); SWRITE(1, SO);
        RESC(alA); __syncthreads();
    }
    SBAR(); qkt(pB0, pB1, K_lds + SHM_K, qr, ql, r32, hi);
    finishSM(pA0, pA1, alA, l_reg, pa0, pa1, pa2, pa3); SBAR();
    pv_d0(o, vb0, pa0, pa1, pa2, pa3); partialSM(pB0, pB1, m_reg, mnB, alB);
    __syncthreads(); RESC(alB);
    finishSM(pB0, pB1, alB, l_reg, pa0, pa1, pa2, pa3); SBAR();
    pv_d0(o, vb0 + SHM_V, pa0, pa1, pa2, pa3);
    if (hi == 0) li_l[r32] = l_reg; asm volatile("s_waitcnt lgkmcnt(0)" ::: "memory");
    float rli[16];
#pragma unroll
    for (int r = 0; r < 16; ++r) rli[r] = __builtin_amdgcn_rcpf(li_l[crow(r, hi)]);
    bf16_t* Ow = Ob + (long)(wid * QBLK) * LDO;
#pragma unroll
    for (int r = 0; r < 16; ++r) { const int orow = crow(r, hi);
#pragma unroll
        for (int d0 = 0; d0 < 4; ++d0) Ow[(long)orow * LDO + d0 * 32 + r32] = f2bf(o[d0][r] * rli[r]); }
    __syncthreads();
#undef SLOAD
#undef SWRITE
#undef SWAIT
#undef RESC
}
#undef SBAR
}

template <class RowMap>
__device__ __forceinline__ void transpose_item(const float* __restrict__ W, int K, int N, bf16_t* __restrict__ WT, float* scr, int kb, int nb, int lane, RowMap rm) {
    const int k0 = 64 * kb, n0 = 32 * nb; const int nn = n0 + (lane & 31); const bool ok = nn < N;
#pragma unroll 8
    for (int i = 0; i < 32; ++i) { const int kk = 2 * i + (lane >> 5); scr[kk * 33 + (lane & 31)] = ok ? W[(size_t)(k0 + kk) * N + nn] : 0.f; }
    asm volatile("s_waitcnt lgkmcnt(0)" ::: "memory");
    const int c = lane & 7;
#pragma unroll
    for (int j = 0; j < 4; ++j) { const int nl = (lane >> 3) + 8 * j; const int n = n0 + nl; const float* s = scr + (8 * c) * 33 + nl;
        u32x4 o; o.x = cvt_pk_bf16(s[0 * 33], s[1 * 33]); o.y = cvt_pk_bf16(s[2 * 33], s[3 * 33]); o.z = cvt_pk_bf16(s[4 * 33], s[5 * 33]); o.w = cvt_pk_bf16(s[6 * 33], s[7 * 33]);
        if (n < N) *(u32x4*)(WT + (size_t)rm(n) * K + k0 + 8 * c) = o; }
    asm volatile("s_waitcnt lgkmcnt(0)" ::: "memory");
}
struct RowId { __device__ __forceinline__ int operator()(int n) const { return n; } };
struct RowUq { __device__ __forceinline__ int operator()(int n) const { return (n / DQK) * 256 + (n % DQK); } };

__device__ __forceinline__ void phase0(const Params& P, char* lds, int G) {
    const int tid = tid_opaque(), lane = tid & 63, wave = tid >> 6;
    const int gw = blockIdx.x * NWAVES + wave, NGW = G * NWAVES;
    float* modp = (float*)(P.ws + WS_MODP);
    for (int task = gw; task < 768; task += NGW) {
        const int ks = task / 48, cb = task % 48;
        const float s0 = silu_f(P.c[ks * 128 + lane]), s1 = silu_f(P.c[ks * 128 + 64 + lane]);
        f32x4 acc = {0.f, 0.f, 0.f, 0.f};
        const float* wp = P.w_ada + (size_t)(ks * 128) * (6 * DM) + cb * 256 + lane * 4;
#pragma unroll 8
        for (int kk = 0; kk < 128; ++kk) { const float sv = __shfl(kk < 64 ? s0 : s1, kk & 63); const f32x4 w = *(const f32x4*)(wp + (size_t)kk * (6 * DM)); acc += w * sv; }
        *(f32x4*)(modp + (size_t)ks * (6 * DM) + cb * 256 + lane * 4) = acc;
    }
    float* scr = (float*)(lds + wave * 16384);
    constexpr int I_IN = 32 * 155, I_UQ = 8 * 48, I_UKV = 4 * 64, I_OUT = 32 * 64, NIT = I_IN + I_UQ + I_UKV + I_OUT;
    for (int it = gw; it < NIT; it += NGW) {
        int r = it;
        if (r < I_IN) { transpose_item(P.w_in, DM, DIN, (bf16_t*)(P.ws + WS_WIN), scr, r / 155, r % 155, lane, RowId()); continue; } r -= I_IN;
        if (r < I_UQ) { transpose_item(P.w_uq, QLORA, NH * DQK, (bf16_t*)(P.ws + WS_WUQ), scr, r / 48, r % 48, lane, RowUq()); continue; } r -= I_UQ;
        if (r < I_UKV) { transpose_item(P.w_ukv, KVLORA, NH * 256, (bf16_t*)(P.ws + WS_WUKV), scr, r / 64, r % 64, lane, RowId()); continue; } r -= I_UKV;
        transpose_item(P.w_out, DM, DM, (bf16_t*)(P.ws + WS_WOUT), scr, r / 64, r % 64, lane, RowId());
    }
}
__device__ __forceinline__ void norm_mod_rows(const float* __restrict__ src, const float* __restrict__ g, const float* sh, const float* sc, bf16_t* __restrict__ dst, int G) {
    const int tid = tid_opaque(), lane = tid & 63, wave = tid >> 6;
    const int gw = blockIdx.x * NWAVES + wave, NGW = G * NWAVES;
    for (int row = gw; row < SEQ; row += NGW) {
        const f32x4* xr = (const f32x4*)(src + (size_t)row * DM) + lane;
        f32x4 v[8]; float ss = 0.f;
#pragma unroll
        for (int j = 0; j < 8; ++j) { v[j] = xr[64 * j]; ss += (v[j].x * v[j].x + v[j].y * v[j].y) + (v[j].z * v[j].z + v[j].w * v[j].w); }
        const float rstd = rsqrtf(wave_sum(ss) * (1.f / DM) + EPS);
        u32x2* o8 = (u32x2*)(dst + (size_t)row * DM) + lane;
#pragma unroll
        for (int j = 0; j < 8; ++j) { const int col = lane * 4 + 256 * j; const f32x4 gg = *(const f32x4*)(g + col); const f32x4 s1 = *(const f32x4*)(sc + col), s0 = *(const f32x4*)(sh + col);
            f32x4 y = v[j] * rstd * gg; y = y * (s1 + 1.f) + s0;
            u32x2 w; w.x = cvt_pk_bf16(y.x, y.y); w.y = cvt_pk_bf16(y.z, y.w); o8[64 * j] = w; }
    }
}
__device__ __forceinline__ void phase1a(const Params& P, char* lds, int G) {
    const int tid = tid_opaque();
    const float* modp = (const float*)(P.ws + WS_MODP); float* mod = (float*)(P.ws + WS_MOD);
    float* sh = (float*)lds; float* sc = sh + DM;
    for (int n = tid; n < 2 * DM; n += NTHREADS) { float a = P.b_ada[n];
#pragma unroll
        for (int ks = 0; ks < 16; ++ks) a += modp[(size_t)ks * (6 * DM) + n];
        sh[n] = a; }
    if (blockIdx.x < 16) { const int n = 2 * DM + blockIdx.x * NTHREADS + tid; float a = P.b_ada[n];
#pragma unroll
        for (int ks = 0; ks < 16; ++ks) a += modp[(size_t)ks * (6 * DM) + n];
        mod[n] = a; }
    __syncthreads();
    norm_mod_rows(P.x, P.norm_mix_g, sh, sc, (bf16_t*)(P.ws + WS_H), G);
    __syncthreads();
}
__device__ __forceinline__ void phase6b(const Params& P, char* lds, int G) {
    const int tid = tid_opaque(), lane = tid & 63, wave = tid >> 6;
    const int gw = blockIdx.x * NWAVES + wave, NGW = G * NWAVES;
    const float* mod = (const float*)(P.ws + WS_MOD);
    float* sh = (float*)lds; float* sc = sh + DM;
    for (int n = tid; n < 2 * DM; n += NTHREADS) sh[n] = mod[3 * DM + n];
    __syncthreads();
    norm_mod_rows(P.out, P.norm_mlp_g, sh, sc, (bf16_t*)(P.ws + WS_H), G);
    __syncthreads();
    float* scr = (float*)(lds + wave * 16384);
    constexpr int I_1 = 32 * 256, I_2 = 128 * 64;
    for (int it = gw; it < I_1 + I_2; it += NGW) {
        if (it < I_1) transpose_item(P.w_ff1, DM, DFF, (bf16_t*)(P.ws + WS_W1), scr, it / 256, it % 256, lane, RowId());
        else { const int r = it - I_1; transpose_item(P.w_ff2, DFF, DM, (bf16_t*)(P.ws + WS_W2), scr, r / 64, r % 64, lane, RowId()); }
    }
}

__device__ __forceinline__ void phase2(const Params& P, char* lds, int G) {
    const int tid = tid_opaque(), lane = tid & 63, wave = tid >> 6;
    const int gw = blockIdx.x * NWAVES + wave, NGW = G * NWAVES;
    const bf16_t* proj = (const bf16_t*)(P.ws + WS_PROJ);
    { bf16_t* cqn = (bf16_t*)(P.ws + WS_CQN); bf16_t* ckvn = (bf16_t*)(P.ws + WS_CKVN);
      float gq[8], gk[8];
#pragma unroll
      for (int e = 0; e < 8; ++e) { gq[e] = P.q_lora_g[lane * 8 + e]; gk[e] = P.kv_lora_g[(lane & 31) * 8 + e]; }
      for (int row = gw; row < SEQ; row += NGW) {
        const u32x4 wq = *(const u32x4*)(proj + (size_t)row * DINP + OFF_CQ + lane * 8);
        const u32x4 wk = *(const u32x4*)(proj + (size_t)row * DINP + OFF_CKV + (lane & 31) * 8);
        float fq[8], fk[8]; unpack8(wq, fq); unpack8(wk, fk);
        float sq = 0.f, sk = 0.f;
#pragma unroll
        for (int e = 0; e < 8; ++e) { sq += fq[e] * fq[e]; sk += fk[e] * fk[e]; }
        if (lane >= 32) sk = 0.f;
        const float rq = rsqrtf(wave_sum(sq) * (1.f / QLORA) + EPS), rk = rsqrtf(wave_sum(sk) * (1.f / KVLORA) + EPS);
#pragma unroll
        for (int e = 0; e < 8; ++e) { fq[e] = fq[e] * rq * gq[e]; fk[e] = fk[e] * rk * gk[e]; }
        *(u32x4*)(cqn + (size_t)row * QLORA + lane * 8) = pack8(fq);
        if (lane < 32) *(u32x4*)(ckvn + (size_t)row * KVLORA + lane * 8) = pack8(fk);
      } }
    { bf16_t* QH = (bf16_t*)(P.ws + WS_QH); bf16_t* KH = (bf16_t*)(P.ws + WS_KH); bf16_t* KT = (bf16_t*)(P.ws + WS_KT); bf16_t* VT = (bf16_t*)(P.ws + WS_VT);
      const int tg = tid >> 5, cgp = tid & 31, chl = cgp * 8;
      for (int item = blockIdx.x; item < 3 * HM * NCH; item += G) {
        const int kind = item / (HM * NCH), h = (item / NCH) % HM, c = item % NCH;
        const int t0 = LCH * c + 8 * tg;
        float outv[8][8];
        if (kind < 2) {
            const int col = OFF_QM + kind * 1024 + h * DH + chl;
            float cw[5][8], cb[8];
#pragma unroll
            for (int e = 0; e < 8; ++e) cb[e] = P.conv_b[kind * 1024 + h * DH + chl + e];
#pragma unroll
            for (int j = 0; j < 5; ++j)
#pragma unroll
                for (int e = 0; e < 8; ++e) cw[j][e] = P.conv_w[j * 2048 + kind * 1024 + h * DH + chl + e];
#pragma unroll
            for (int tt = 0; tt < 8; ++tt)
#pragma unroll
                for (int e = 0; e < 8; ++e) outv[tt][e] = cb[e];
#pragma unroll
            for (int rr = 0; rr < 12; ++rr) {
                const int t = t0 - 2 + rr; float in[8];
                if (t >= 0 && t < SEQ) { const u32x4 w = *(const u32x4*)(proj + (size_t)t * DINP + col); unpack8(w, in); }
                else {
#pragma unroll
                    for (int e = 0; e < 8; ++e) in[e] = 0.f; }
#pragma unroll
                for (int j = 0; j < 5; ++j) { const int tt = rr - j;
                    if (tt >= 0 && tt < 8) {
#pragma unroll
                        for (int e = 0; e < 8; ++e) outv[tt][e] += cw[j][e] * in[e]; } }
            }
            const float osc = kind == 1 ? 0.0625f : 1.f;
#pragma unroll
            for (int tt = 0; tt < 8; ++tt)
#pragma unroll
                for (int e = 0; e < 8; ++e) outv[tt][e] = silu_f(outv[tt][e]) * osc;
            bf16_t* dst = (kind == 0 ? QH : KH) + ((size_t)h * SEQ + t0) * DH + chl;
#pragma unroll
            for (int tt = 0; tt < 8; ++tt) *(u32x4*)(dst + (size_t)tt * DH) = pack8(outv[tt]);
        } else {
#pragma unroll
            for (int tt = 0; tt < 8; ++tt) { const u32x4 w = *(const u32x4*)(proj + (size_t)(t0 + tt) * DINP + OFF_VM + h * DH + chl); unpack8(w, outv[tt]); }
        }
        if (kind >= 1) {
            bf16_t* dst = (kind == 1 ? KT : VT) + ((size_t)(h * NCH + c) * DH + chl) * LCH + 8 * tg;
#pragma unroll
            for (int e = 0; e < 8; ++e) { u32x4 w; w.x = cvt_pk_bf16(outv[0][e], outv[1][e]); w.y = cvt_pk_bf16(outv[2][e], outv[3][e]); w.z = cvt_pk_bf16(outv[4][e], outv[5][e]); w.w = cvt_pk_bf16(outv[6][e], outv[7][e]);
                *(u32x4*)(dst + (size_t)e * LCH) = w; }
        }
      } }
    { const float* gates = (const float*)(P.ws + WS_GATES);
      float* BC = (float*)(P.ws + WS_BC); float* IG = (float*)(P.ws + WS_IG); float* PM = (float*)(P.ws + WS_PM); float* WL = (float*)(P.ws + WS_WL);
      float* BL = (float*)(P.ws + WS_BL); float* AC = (float*)(P.ws + WS_AC);
      for (int task = gw; task < 2 * HM * NCH; task += NGW) {
        const int dir = task / (HM * NCH), h = (task / NCH) % HM, c = task % NCH;
        const float bi = P.b_gates[dir * 8 + h], bfg = P.b_gates[dir * 8 + 4 + h];
        const int u0 = 2 * lane, u1 = 2 * lane + 1;
        const int t0 = LCH * c + (dir ? 127 - u0 : u0), t1 = LCH * c + (dir ? 127 - u1 : u1);
        const float i0 = gates[(size_t)t0 * 16 + dir * 8 + h] + bi, i1 = gates[(size_t)t1 * 16 + dir * 8 + h] + bi;
        const float f0 = gates[(size_t)t0 * 16 + dir * 8 + 4 + h] + bfg, f1 = gates[(size_t)t1 * 16 + dir * 8 + 4 + h] + bfg;
        const float l0 = fminf(f0, 0.f) - log1pf(expf(-fabsf(f0))), l1 = fminf(f1, 0.f) - log1pf(expf(-fabsf(f1)));
        float inc = l0 + l1;
#pragma unroll
        for (int o = 1; o < 64; o <<= 1) { const float t = __shfl_up(inc, o); if (lane >= o) inc += t; }
        const float b1 = inc, b0 = inc - l1;
        const float d0 = i0 - b0, d1 = i1 - b1;
        float pmx = fmaxf(d0, d1);
#pragma unroll
        for (int o = 1; o < 64; o <<= 1) { const float t = __shfl_up(pmx, o); if (lane >= o) pmx = fmaxf(pmx, t); }
        float prev = __shfl_up(pmx, 1); if (lane == 0) prev = -INFINITY;
        const float pm0 = fmaxf(prev, d0), pm1 = pmx;
        const float bL = __shfl(b1, 63), pmL = __shfl(pmx, 63);
        const size_t base = (size_t)(dir * HM + h) * SEQ;
        BC[base + t0] = b0; BC[base + t1] = b1; IG[base + t0] = i0; IG[base + t1] = i1;
        PM[base + t0] = b0 + pm0; PM[base + t1] = b1 + pm1;
        WL[base + t0] = bL - b0 + i0; WL[base + t1] = bL - b1 + i1;
        if (lane == 63) { BL[(dir * HM + h) * NCH + c] = bL; AC[(dir * HM + h) * NCH + c] = bL + pmL; }
      } }
}

__device__ __forceinline__ void m2_block(const Params& P, char* lds, int blk) {
    const int tid = tid_opaque(), lane = tid & 63, wid = tid >> 6, r = lane & 15, g = lane >> 4;
    const int dir = blk >> 7, h = (blk >> 5) & 3, vs = (blk >> 2) & 7, ksl = blk & 3;
    const int vi = wid >> 2, ki = wid & 3, v0 = 32 * vs + 16 * vi, k0 = 64 * ksl + 16 * ki;
    const int dh = dir * HM + h;
    const float* BL = (const float*)(P.ws + WS_BL) + dh * NCH; const float* AC = (const float*)(P.ws + WS_AC) + dh * NCH;
    const float* WL = (const float*)(P.ws + WS_WL) + (size_t)dh * SEQ;
    const bf16_t* KT = (const bf16_t*)(P.ws + WS_KT); const bf16_t* VT = (const bf16_t*)(P.ws + WS_VT);
    bf16_t* CST = (bf16_t*)(P.ws + WS_CST); float* NST = (float*)(P.ws + WS_NST);
    float* s_mA = (float*)lds; float* s_dec = s_mA + NCH;
    if (tid == 0) { float m = -1e30f;
#pragma unroll 1
        for (int st = 0; st < NCH; ++st) { const int c = dir ? NCH - 1 - st : st; const float bL = BL[c], a = AC[c]; const float mn = fmaxf(bL + m, a);
            s_dec[c] = __expf(bL + m - mn); s_mA[c] = mn; m = mn; } }
    __syncthreads();
    const bool do_n = (vs == 0 && vi == 0);
    f32x4 acc = {0.f, 0.f, 0.f, 0.f}; float nacc = 0.f;
    for (int st = 0; st < NCH; ++st) {
        const int c = dir ? NCH - 1 - st : st;
        const size_t hc = (size_t)h * NCH + c;
        u32x4 av[4], bv[4]; f32x4 wl[4][2];
#pragma unroll
        for (int ks = 0; ks < 4; ++ks) { const int s0 = 32 * ks + 8 * g;
            av[ks] = *(const u32x4*)(VT + (hc * DH + v0 + r) * LCH + s0); bv[ks] = *(const u32x4*)(KT + (hc * DH + k0 + r) * LCH + s0);
            wl[ks][0] = *(const f32x4*)(WL + LCH * c + s0); wl[ks][1] = *(const f32x4*)(WL + LCH * c + s0 + 4); }
        { bf16_t* cp = CST + ((size_t)dh * NCH + c) * (DH * DH) + (size_t)(v0 + 4 * g) * DH + k0 + r;
#pragma unroll
          for (int i = 0; i < 4; ++i) cp[(size_t)i * DH] = f2bf(acc[i]);
          if (do_n && g == 0) NST[((size_t)dh * NCH + c) * DH + k0 + r] = nacc; }
        const float dec = s_dec[c], mA = s_mA[c];
        acc = acc * dec; nacc *= dec;
        float nsum = 0.f;
#pragma unroll
        for (int ks = 0; ks < 4; ++ks) {
            float w[8], a[8], b[8];
#pragma unroll
            for (int j = 0; j < 4; ++j) { w[j] = __expf(wl[ks][0][j] - mA); w[4 + j] = __expf(wl[ks][1][j] - mA); }
            unpack8(av[ks], a); unpack8(bv[ks], b);
#pragma unroll
            for (int j = 0; j < 8; ++j) { a[j] *= w[j]; nsum += w[j] * b[j]; }
            const u32x4 aw = pack8(a);
            acc = __builtin_amdgcn_mfma_f32_16x16x32_bf16(*(const bf16x8*)&aw, *(const bf16x8*)&bv[ks], acc, 0, 0, 0);
        }
        nsum += __shfl_xor(nsum, 16); nsum += __shfl_xor(nsum, 32);
        nacc += nsum;
    }
    __syncthreads();
}

constexpr int M3_LV = 1024, M3_LVS = 272, M3_LC = M3_LV + 256 * M3_LVS, M3_LCS = 528;
static_assert(M3_LC + 128 * M3_LCS <= LDS_BYTES, "M3 LDS");
__device__ __forceinline__ void m3_unit(const Params& P, char* lds, int h, int c) {
    const int tid = tid_opaque(), lane = tid & 63, wid = __builtin_amdgcn_readfirstlane(tid >> 6), r = lane & 15, g = lane >> 4;
    const int T0 = LCH * c, tl = 16 * wid + r;
    const char* QHc = (const char*)(P.ws + WS_QH) + ((size_t)h * SEQ + T0 + 16 * wid) * (DH * 2);
    const char* KHc = (const char*)(P.ws + WS_KH) + ((size_t)h * SEQ + T0) * (DH * 2);
    const char* VTc = (const char*)(P.ws + WS_VT) + ((size_t)h * NCH + c) * (DH * LCH * 2);
    const unsigned o512 = (unsigned)(r * 512 + g * 16);
    float* s_mb = (float*)lds; char* LV = lds + M3_LV; char* LC = lds + M3_LC;
    { u32x4 v[8];
#pragma unroll
      for (int n = 0; n < 8; ++n) v[n] = ldgu<u32x4>(VTc + n * 8192, (unsigned)tid * 16u);
#pragma unroll
      for (int n = 0; n < 8; ++n) *(u32x4*)(LV + ((tid >> 4) + 32 * n) * M3_LVS + (tid & 15) * 16) = v[n]; }
    if (tid == 0 || tid == 64) { const int dir = tid >> 6; const float* BL = (const float*)(P.ws + WS_BL) + (dir * HM + h) * NCH; const float* AC = (const float*)(P.ws + WS_AC) + (dir * HM + h) * NCH;
        float m = -1e30f;
#pragma unroll 1
        for (int st = 0; st < NCH; ++st) { const int cc = dir ? NCH - 1 - st : st; s_mb[dir * NCH + cc] = m; m = fmaxf(BL[cc] + m, AC[cc]); } }
    __syncthreads();
    f32x4 st[8];
    { bf16x8 qf[8];
#pragma unroll
      for (int kd = 0; kd < 8; ++kd) qf[kd] = ldgu<bf16x8>(QHc + 64 * kd, o512);
#pragma unroll
      for (int j = 0; j < 8; ++j) { st[j] = (f32x4){0.f, 0.f, 0.f, 0.f};
#pragma unroll
        for (int kd = 0; kd < 8; ++kd) { const bf16x8 kf = ldgu<bf16x8>(KHc + (16 * j) * 512 + 64 * kd, o512);
            st[j] = __builtin_amdgcn_mfma_f32_16x16x32_bf16(kf, qf[kd], st[j], 0, 0, 0); }
        asm volatile("" ::: "memory"); } }
    f32x4 acc[16];
#pragma unroll
    for (int vt = 0; vt < 16; ++vt) acc[vt] = (f32x4){0.f, 0.f, 0.f, 0.f};
    const char* lvr = LV + r * M3_LVS + g * 8;
    const char* lcr = LC + r * M3_LCS + g * 16;
    char* lcw = LC + (tid >> 5) * M3_LCS + (tid & 31) * 16;
#pragma unroll 1
    for (int dir = 0; dir < 2; ++dir) {
        const int dh = dir * HM + h;
        const char* BCc = (const char*)(P.ws + WS_BC) + ((size_t)dh * SEQ + T0) * 4; const char* IGc = (const char*)(P.ws + WS_IG) + ((size_t)dh * SEQ + T0) * 4;
        const char* PMc = (const char*)(P.ws + WS_PM) + ((size_t)dh * SEQ + T0) * 4;
        const char* Cc = (const char*)(P.ws + WS_CST) + ((size_t)dh * NCH + c) * (DH * DH * 2);
        const char* Nc = (const char*)(P.ws + WS_NST) + ((size_t)dh * NCH + c) * (DH * 4);
        const int fx = dir * 127, tlx = tl ^ fx;
        const float mB = s_mb[dir * NCH + c];
        const float bt = ldgu<float>(BCc, (unsigned)tl * 4u), pm = ldgu<float>(PMc, (unsigned)tl * 4u);
        const float mt = fmaxf(bt + mB, pm); const float alpha = bt - mt; const float winter = __expf(bt + mB - mt);
        float den = 0.f;
#pragma unroll
        for (int j = 0; j < 8; ++j) { const int sb = 16 * j + 4 * g;
            const f32x4 ig = ldgu<f32x4>(IGc + 64 * j, (unsigned)g * 16u), bc = ldgu<f32x4>(BCc + 64 * j, (unsigned)g * 16u);
#pragma unroll
            for (int i = 0; i < 4; ++i) { const int sl = sb + i; const bool ok = ((sl ^ fx) <= tlx);
                const float e = ok ? __expf(alpha + ig[i] - bc[i]) : 0.f; den += st[j][i] * e; }
            if (j & 1) asm volatile("" ::: "memory"); }
        den += __shfl_xor(den, 16); den += __shfl_xor(den, 32);
        float qn = 0.f;
#pragma unroll
        for (int kd = 0; kd < 8; ++kd) { const f32x4 n0 = ldgu<f32x4>(Nc + 128 * kd, (unsigned)g * 32u), n1 = ldgu<f32x4>(Nc + 128 * kd + 16, (unsigned)g * 32u);
            const u32x4 qt = ldgu<u32x4>(QHc + 64 * kd, o512); float q[8]; unpack8(qt, q);
            qn += q[0] * n0[0] + q[1] * n0[1] + q[2] * n0[2] + q[3] * n0[3] + q[4] * n1[0] + q[5] * n1[1] + q[6] * n1[2] + q[7] * n1[3];
            if (kd & 1) asm volatile("" ::: "memory"); }
        qn += __shfl_xor(qn, 16); qn += __shfl_xor(qn, 32);
        const float dtot = den + winter * qn;
        const float hdiv = 1.f / fmaxf(fabsf(dtot), __expf(-mt));
        int tlx2 = tlx; LAUNDER_V(tlx2);
#pragma unroll
        for (int ks = 0; ks < 4; ++ks) {
            float e8[8];
#pragma unroll
            for (int hh = 0; hh < 2; ++hh) { const int j = 2 * ks + hh, sb = 16 * j + 4 * g;
                const f32x4 ig = ldgu<f32x4>(IGc + 64 * j, (unsigned)g * 16u), bc = ldgu<f32x4>(BCc + 64 * j, (unsigned)g * 16u);
#pragma unroll
                for (int i = 0; i < 4; ++i) { const int sl = sb + i; const bool ok = ((sl ^ fx) <= tlx2);
                    const float e = ok ? __expf(alpha + ig[i] - bc[i]) : 0.f; e8[4 * hh + i] = st[j][i] * e * hdiv; } }
            const u32x4 pw = pack8(e8); const bf16x8 pa = *(const bf16x8*)&pw;
#pragma unroll
            for (int vt = 0; vt < 16; ++vt) {
                const u32x2 lo = *(const u32x2*)(lvr + vt * (16 * M3_LVS) + ks * 64), hi2 = *(const u32x2*)(lvr + vt * (16 * M3_LVS) + ks * 64 + 32);
                u32x4 w; w.x = lo.x; w.y = lo.y; w.z = hi2.x; w.w = hi2.y;
                acc[vt] = __builtin_amdgcn_mfma_f32_16x16x32_bf16(pa, *(const bf16x8*)&w, acc[vt], 0, 0, 0); }
        }
        const float qsc = winter * hdiv;
#pragma unroll
        for (int half = 0; half < 2; ++half) {
            __syncthreads();
            { u32x4 v[8];
#pragma unroll
              for (int n = 0; n < 8; ++n) v[n] = ldgu<u32x4>(Cc + half * 65536 + n * 8192, (unsigned)tid * 16u);
#pragma unroll
              for (int n = 0; n < 8; ++n) *(u32x4*)(lcw + n * (16 * M3_LCS)) = v[n]; }
            __syncthreads();
#pragma unroll
            for (int kd = 0; kd < 8; ++kd) { const u32x4 qt = ldgu<u32x4>(QHc + 64 * kd, o512); float q[8]; unpack8(qt, q);
#pragma unroll
                for (int e = 0; e < 8; ++e) q[e] *= qsc;
                const u32x4 qw = pack8(q); const bf16x8 qs = *(const bf16x8*)&qw;
#pragma unroll
                for (int v8 = 0; v8 < 8; ++v8) { const bf16x8 cf = *(const bf16x8*)(lcr + v8 * (16 * M3_LCS) + kd * 64);
                    acc[half * 8 + v8] = __builtin_amdgcn_mfma_f32_16x16x32_bf16(qs, cf, acc[half * 8 + v8], 0, 0, 0); }
            }
        }
    }
    float ss[4] = {0.f, 0.f, 0.f, 0.f};
#pragma unroll
    for (int vt = 0; vt < 16; ++vt)
#pragma unroll
        for (int i = 0; i < 4; ++i) ss[i] += acc[vt][i] * acc[vt][i];
#pragma unroll
    for (int i = 0; i < 4; ++i) { ss[i] += __shfl_xor(ss[i], 1); ss[i] += __shfl_xor(ss[i], 2); ss[i] += __shfl_xor(ss[i], 4); ss[i] += __shfl_xor(ss[i], 8); ss[i] = rsqrtf(ss[i] * (1.f / DH) + EPS); }
    const char* pr0 = (const char*)(P.ws + WS_PROJ) + ((size_t)(T0 + 16 * wid) * DINP + OFF_OM + h * DH) * 2;
    char* mx0 = (char*)(P.ws + WS_MIX) + ((size_t)(T0 + 16 * wid) * DM + 1024 + h * DH) * 2;
    const char* gmp = (const char*)(P.mlstm_norm_g + h * DH);
    const unsigned opr = (unsigned)(4 * g * DINP * 2 + r * 2), omx = (unsigned)(4 * g * DM * 2 + r * 2);
#pragma unroll
    for (int vt = 0; vt < 16; ++vt) { const float gm = ldgu<float>(gmp + 64 * vt, (unsigned)r * 4u);
#pragma unroll
        for (int i = 0; i < 4; ++i) { const float om = bf2f(ldgu<bf16_t>(pr0 + i * (DINP * 2) + 32 * vt, opr));
            *(bf16_t*)(mx0 + i * (DM * 2) + 32 * vt + omx) = f2bf(acc[vt][i] * ss[i] * gm * sigmoid_f(om)); }
        if ((vt & 3) == 3) asm volatile("" ::: "memory"); }
    __syncthreads();
}

__device__ __forceinline__ void phase4(const Params& P, int G) {
    const int tid = tid_opaque(), lane = tid & 63, wave = tid >> 6;
    const int gw = blockIdx.x * NWAVES + wave, NGW = G * NWAVES;
    bf16_t* Q = (bf16_t*)(P.ws + WS_Q); bf16_t* K = (bf16_t*)(P.ws + WS_K); const bf16_t* KRAW = (const bf16_t*)(P.ws + WS_KV); const bf16_t* proj = (const bf16_t*)(P.ws + WS_PROJ);
    const int l31 = lane & 31;
    const float gqa = P.q_norm_g[lane], gqb = P.q_norm_g[64 + lane], gqc = P.q_norm_g[128 + l31], gqd = P.q_norm_g[160 + l31];
    const float gka = P.k_norm_g[lane], gkb = P.k_norm_g[64 + lane], gkc = P.k_norm_g[128 + l31], gkd = P.k_norm_g[160 + l31];
    const float freq = powf(10000.0f, -(float)l31 / 32.0f);
    for (int t = gw; t < SEQ; t += NGW) {
        const float ang = (float)P.pos[t] * freq; float sn, cs; sincosf(ang, &sn, &cs);
        const float pc = bf2f(proj[(size_t)t * DINP + OFF_KPE + l31]), pd = bf2f(proj[(size_t)t * DINP + OFF_KPE + 32 + l31]);
#pragma unroll 2
        for (int h = 0; h < NH; ++h) {
            bf16_t* qp = Q + (size_t)t * (NH * DQK) + h * DQK;
            { float a = bf2f(qp[lane]), b = bf2f(qp[64 + lane]), c = bf2f(qp[128 + l31]), d = bf2f(qp[160 + l31]);
              float ss = a * a + b * b + (lane < 32 ? c * c + d * d : 0.f);
              const float rs = rsqrtf(wave_sum(ss) * (1.f / DQK) + EPS);
              a *= rs * gqa; b *= rs * gqb; c *= rs * gqc; d *= rs * gqd;
              qp[lane] = f2bf(a); qp[64 + lane] = f2bf(b);
              if (lane < 32) { qp[128 + lane] = f2bf(c * cs - d * sn); qp[160 + lane] = f2bf(c * sn + d * cs); } }
            { const bf16_t* kp = KRAW + (size_t)t * (NH * 256) + h * 256; bf16_t* ko = K + (size_t)t * (NH * DQK) + h * DQK;
              float a = bf2f(kp[lane]), b = bf2f(kp[64 + lane]), c = pc, d = pd;
              float ss = a * a + b * b + (lane < 32 ? c * c + d * d : 0.f);
              const float rs = rsqrtf(wave_sum(ss) * (1.f / DQK) + EPS);
              a *= rs * gka; b *= rs * gkb; c *= rs * gkc; d *= rs * gkd;
              ko[lane] = f2bf(a); ko[64 + lane] = f2bf(b);
              if (lane < 32) { ko[128 + lane] = f2bf(c * cs - d * sn); ko[160 + lane] = f2bf(c * sn + d * cs); } }
        }
    }
}

struct StoreProj { bf16_t* proj; float* gates;
    __device__ __forceinline__ void operator()(int row, int col, f32x4 v0, f32x4 v1) const {
        u32x4 w; w.x = cvt_pk_bf16(v0[0], v0[1]); w.y = cvt_pk_bf16(v0[2], v0[3]); w.z = cvt_pk_bf16(v1[0], v1[1]); w.w = cvt_pk_bf16(v1[2], v1[3]);
        *(u32x4*)(proj + (size_t)row * DINP + col) = w;
        if (col >= OFF_GM && col < OFF_GM + 16) { float* gp = gates + (size_t)row * 16 + (col - OFF_GM); *(f32x4*)gp = v0; *(f32x4*)(gp + 4) = v1; } } };
struct StoreQ { bf16_t* q;
    __device__ __forceinline__ void operator()(int row, int col, f32x4 v0, f32x4 v1) const {
        const int h = col >> 8, ct = col & 255;
        if (ct < DQK) { u32x4 w; w.x = cvt_pk_bf16(v0[0], v0[1]); w.y = cvt_pk_bf16(v0[2], v0[3]); w.z = cvt_pk_bf16(v1[0], v1[1]); w.w = cvt_pk_bf16(v1[2], v1[3]);
            *(u32x4*)(q + (size_t)row * (NH * DQK) + h * DQK + ct) = w; } } };
struct StoreKV { bf16_t* kv;
    __device__ __forceinline__ void operator()(int row, int col, f32x4 v0, f32x4 v1) const {
        u32x4 w; w.x = cvt_pk_bf16(v0[0], v0[1]); w.y = cvt_pk_bf16(v0[2], v0[3]); w.z = cvt_pk_bf16(v1[0], v1[1]); w.w = cvt_pk_bf16(v1[2], v1[3]);
        *(u32x4*)(kv + (size_t)row * (NH * 256) + col) = w; } };
struct StoreX1 { const float* x; const float* gate; float* out;
    __device__ __forceinline__ void operator()(int row, int col, f32x4 v) const {
        const size_t off = (size_t)row * DM + col; const f32x4 xv = *(const f32x4*)(x + off); const f32x4 gv = *(const f32x4*)(gate + col);
        *(f32x4*)(out + off) = xv + gv * v; } };
struct StoreAct { bf16_t* act;
    __device__ __forceinline__ void operator()(int row, int col, f32x4 v0, f32x4 v1) const {
        float f[8] = {v0[0], v0[1], v0[2], v0[3], v1[0], v1[1], v1[2], v1[3]};
#pragma unroll
        for (int e = 0; e < 8; ++e) { const float rl = fmaxf(f[e], 0.f); f[e] = rl * rl; }
        *(u32x4*)(act + (size_t)row * DFF + col) = pack8(f); } };

constexpr int NPH = 11;
#ifdef ONLY_PH
#define PH_ON(n) ((n) == ONLY_PH)
#else
#define PH_ON(n) 1
#endif
#define CAS __attribute__((address_space(4)))
__device__ __forceinline__ Params load_params(const CAS Params* kp) {
#if defined(__HIP_DEVICE_COMPILE__)
    unsigned long long kv = (unsigned long long)kp; asm volatile("" : "+s"(kv)); return *(const CAS Params*)kv;
#else
    return Params{};
#endif
}
__global__ void __launch_bounds__(NTHREADS, 2) fwd_kernel(Params Pk) {
    extern __shared__ __attribute__((aligned(16))) char lds[];
    const CAS Params* kp = (const CAS Params*)__builtin_amdgcn_kernarg_segment_ptr();
    const int G0 = gridDim.x; const int bx0 = blockIdx.x;
    const int vcu0 = (G0 % 8 == 0) ? (bx0 % 8) * (G0 / 8) + bx0 / 8 : bx0;
    LAS unsigned char* ldsl = (LAS unsigned char*)lds;
    const int ph_lo = Pk.ph_lo, ph_hi = Pk.ph_hi;
    for (int ph = ph_lo; ph < ph_hi; ++ph) {
        int G = G0, bx = bx0, vcu = vcu0; asm volatile("" : "+s"(G), "+s"(bx), "+s"(vcu));
        switch (ph) {
        case 0: if (PH_ON(0)) { const Params P = load_params(kp); phase0(P, lds, G); } break;
        case 1: if (PH_ON(1)) { const Params P = load_params(kp); phase1a(P, lds, G); } break;
        case 2: if (PH_ON(2)) { const Params P = load_params(kp); unsigned char* ws = P.ws;
                  pg8::Gemm g{(const bf16_t*)(ws + WS_H), (const bf16_t*)(ws + WS_WIN), SEQ, DINP, DM}; pg8::StaticOrder S; S.init(SEQ, DINP, G, bx);
                  pg8::Epi8<StoreProj> E{{(bf16_t*)(ws + WS_PROJ), (float*)(ws + WS_GATES)}};
                  pg8::gemm_phase<pg8::Epi8<StoreProj>, pg8::StaticOrder, true, true>(ldsl, g, S, E); } break;
        case 3: if (PH_ON(3)) { const Params P = load_params(kp); phase2(P, lds, G); } break;
        case 4: if (PH_ON(4)) {
#ifndef NO_G4
#ifndef NO_G4A
                  { const Params P = load_params(kp); unsigned char* ws = P.ws;
                    pg8::Gemm g{(const bf16_t*)(ws + WS_CQN), (const bf16_t*)(ws + WS_WUQ), SEQ, NH * 256, QLORA}; pg8::StaticOrder S; S.init(SEQ, NH * 256, G, bx);
                    pg8::Epi8<StoreQ> E{{(bf16_t*)(ws + WS_Q)}};
                    pg8::gemm_phase<pg8::Epi8<StoreQ>, pg8::StaticOrder, true, true>(ldsl, g, S, E); }
#endif
#ifndef NO_G4B
                  { const Params P = load_params(kp); unsigned char* ws = P.ws;
                    pg8::Gemm g{(const bf16_t*)(ws + WS_CKVN), (const bf16_t*)(ws + WS_WUKV), SEQ, NH * 256, KVLORA}; pg8::StaticOrder S; S.init(SEQ, NH * 256, G, bx);
                    pg8::Epi8<StoreKV> E{{(bf16_t*)(ws + WS_KV)}};
                    pg8::gemm_phase<pg8::Epi8<StoreKV>, pg8::StaticOrder, true, true>(ldsl, g, S, E); }
#endif
#endif
#ifndef NO_M2
                  { const Params P = load_params(kp); for (int b = bx; b < 256; b += G) m2_block(P, lds, b); }
#endif
                  } break;
        case 5: if (PH_ON(5)) { const Params P = load_params(kp); phase4(P, G); } break;
        case 6: if (PH_ON(6)) {
#ifndef NO_ATT
                  { const Params P = load_params(kp); unsigned char* ws = P.ws;
                  for (int u = vcu; u < NH * (SEQ / 256); u += G) { const int h = u >> 5, qb = u & 31;
                      att::attn_unit((const bf16_t*)(ws + WS_Q) + (size_t)(qb * 256) * att::LDQ + h * DQK, (const bf16_t*)(ws + WS_K) + h * DQK, (const bf16_t*)(ws + WS_KV) + h * 256 + 128,
                                     (bf16_t*)(ws + WS_MIX) + (size_t)(qb * 256) * DM + h * DV, SEQ, lds); } }
#endif
#ifndef NO_M3
                  { const Params P = load_params(kp); for (int u = vcu; u < HM * NCH; u += G) m3_unit(P, lds, u >> 6, u & 63); }
#endif
                  } break;
        case 7: if (PH_ON(7)) { const Params P = load_params(kp); unsigned char* ws = P.ws;
                  pg8::Gemm g{(const bf16_t*)(ws + WS_MIX), (const bf16_t*)(ws + WS_WOUT), SEQ, DM, DM}; pg8::StaticOrder S; S.init(SEQ, DM, G, bx);
                  pg8::Epi4<StoreX1> E{{P.x, (const float*)(ws + WS_MOD) + 2 * DM, P.out}};
                  pg8::gemm_phase<pg8::Epi4<StoreX1>, pg8::StaticOrder, true, true>(ldsl, g, S, E); } break;
        case 8: if (PH_ON(8)) { const Params P = load_params(kp); phase6b(P, lds, G); } break;
        case 9: if (PH_ON(9)) { const Params P = load_params(kp); unsigned char* ws = P.ws;
                  pg8::Gemm g{(const bf16_t*)(ws + WS_H), (const bf16_t*)(ws + WS_W1), SEQ, DFF, DM}; pg8::StaticOrder S; S.init(SEQ, DFF, G, bx);
                  pg8::Epi8<StoreAct> E{{(bf16_t*)(ws + WS_ACT)}};
                  pg8::gemm_phase<pg8::Epi8<StoreAct>, pg8::StaticOrder, true, true>(ldsl, g, S, E); } break;
        case 10: if (PH_ON(10)) { const Params P = load_params(kp); unsigned char* ws = P.ws;
                  pg8::Gemm g{(const bf16_t*)(ws + WS_ACT), (const bf16_t*)(ws + WS_W2), SEQ, DM, DFF}; pg8::StaticOrder S; S.init(SEQ, DM, G, bx);
                  pg8::Epi4<StoreX1> E{{P.out, (const float*)(ws + WS_MOD) + 5 * DM, P.out}};
                  pg8::gemm_phase<pg8::Epi4<StoreX1>, pg8::StaticOrder, true, true>(ldsl, g, S, E); } break;
        default: break;
        }
        if (ph + 1 < ph_hi) { cg::this_grid().sync(); }
    }
}

extern "C" void kernel_launch(void* const* d_in, const int* in_sizes, int n_in, void* d_out, int out_size, void* d_ws, size_t ws_size, hipStream_t stream) {
    static int grid = 0;
    if (grid == 0) {
        if (n_in != 21 || out_size != SEQ * DM || ws_size < WS_END) { fprintf(stderr, "kernel_launch: unexpected shapes n_in %d out %d ws %zu\n", n_in, out_size, ws_size); grid = -1; return; }
        int dev = 0, cus = 0, per_cu = 0;
        if (hipGetDevice(&dev) != hipSuccess || hipDeviceGetAttribute(&cus, hipDeviceAttributeMultiprocessorCount, dev) != hipSuccess) { grid = -1; return; }
        if (hipFuncSetAttribute((const void*)fwd_kernel, hipFuncAttributeMaxDynamicSharedMemorySize, LDS_BYTES) != hipSuccess) { fprintf(stderr, "kernel_launch: hipFuncSetAttribute failed\n"); grid = -1; return; }
        if (hipOccupancyMaxActiveBlocksPerMultiprocessor(&per_cu, (const void*)fwd_kernel, NTHREADS, LDS_BYTES) != hipSuccess || per_cu < 1) { fprintf(stderr, "kernel_launch: occupancy query says %d\n", per_cu); per_cu = 1; }
        (void)hipGetLastError();
        grid = cus * 1;
    }
    if (grid < 0) return;
    Params p{};
    p.x = (const float*)d_in[0]; p.c = (const float*)d_in[1]; p.pos = (const int*)d_in[2]; p.w_ada = (const float*)d_in[3]; p.b_ada = (const float*)d_in[4];
    p.norm_mix_g = (const float*)d_in[5]; p.w_in = (const float*)d_in[6]; p.b_gates = (const float*)d_in[7]; p.conv_w = (const float*)d_in[8]; p.conv_b = (const float*)d_in[9];
    p.q_lora_g = (const float*)d_in[10]; p.w_uq = (const float*)d_in[11]; p.kv_lora_g = (const float*)d_in[12]; p.w_ukv = (const float*)d_in[13]; p.q_norm_g = (const float*)d_in[14];
    p.k_norm_g = (const float*)d_in[15]; p.mlstm_norm_g = (const float*)d_in[16]; p.w_out = (const float*)d_in[17]; p.norm_mlp_g = (const float*)d_in[18];
    p.w_ff1 = (const float*)d_in[19]; p.w_ff2 = (const float*)d_in[20];
    p.out = (float*)d_out; p.ws = (unsigned char*)d_ws;
#if MK_MULTI
    for (int ph = 0; ph < NPH; ++ph) { p.ph_lo = ph; p.ph_hi = ph + 1; hipLaunchKernelGGL(fwd_kernel, dim3(grid), dim3(NTHREADS), LDS_BYTES, stream, p); }
#else
    p.ph_lo = 0; p.ph_hi = NPH;
    void* args[] = {&p};
    hipError_t e = hipLaunchCooperativeKernel((const void*)fwd_kernel, dim3(grid), dim3(NTHREADS), args, LDS_BYTES, stream);
    if (e != hipSuccess) fprintf(stderr, "kernel_launch: cooperative launch failed: %s (grid %d)\n", hipGetErrorString(e), grid);
#endif
}
```

```cpp
#include <hip/hip_runtime.h>
#include <hip/hip_cooperative_groups.h>
#include <cstdio>
#include <cstdint>
namespace cg = cooperative_groups;

#ifndef MK_MULTI
#define MK_MULTI 0
#endif

#define LAS __attribute__((address_space(3)))
typedef unsigned short bf16_t;
typedef short bf16x8 __attribute__((ext_vector_type(8)));
typedef short s16x4 __attribute__((ext_vector_type(4)));
typedef float f32x4 __attribute__((ext_vector_type(4)));
typedef float f32x2 __attribute__((ext_vector_type(2)));
typedef float f32x16 __attribute__((ext_vector_type(16)));
typedef unsigned u32x4 __attribute__((ext_vector_type(4)));
typedef unsigned u32x2 __attribute__((ext_vector_type(2)));

constexpr int SEQ = 8192, DM = 2048, DIN = 4944, DINP = 5120, DFF = 8192;
constexpr int NH = 8, DQK = 192, DV = 128, QLORA = 512, KVLORA = 256;
constexpr int HM = 4, DH = 256, LCH = 128, NCH = 64;
constexpr int OFF_CQ = 0, OFF_CKV = 512, OFF_KPE = 768, OFF_QM = 832, OFF_KM = 1856, OFF_VM = 2880, OFF_OM = 3904, OFF_GM = 4928;
constexpr float EPS = 1e-6f;
constexpr int NTHREADS = 512, NWAVES = 8;
constexpr int LDS_BYTES = 147456;

constexpr size_t MiB = 1u << 20;
constexpr size_t WS_MODP = 0;
constexpr size_t WS_MOD = 786432;
constexpr size_t WS_BC = 1 * MiB;
constexpr size_t WS_IG = WS_BC + 262144;
constexpr size_t WS_PM = WS_IG + 262144;
constexpr size_t WS_WL = WS_PM + 262144;
constexpr size_t WS_BL = 851968;
constexpr size_t WS_AC = 856064;
constexpr size_t WS_WIN = 2 * MiB, WS_WUQ = 22 * MiB, WS_WUKV = 24 * MiB, WS_WOUT = 26 * MiB;
constexpr size_t WS_CST = 34 * MiB;
constexpr size_t WS_W1 = 34 * MiB, WS_W2 = 66 * MiB;
constexpr size_t WS_H = 98 * MiB;
constexpr size_t WS_Q = 98 * MiB;
constexpr size_t WS_MIX = 130 * MiB;
constexpr size_t WS_PROJ = 162 * MiB;
constexpr size_t WS_CQN = 242 * MiB, WS_CKVN = 250 * MiB;
constexpr size_t WS_GATES = 254 * MiB;
constexpr size_t WS_NST = 255 * MiB;
constexpr size_t WS_ACT = 130 * MiB;
constexpr size_t WS_KV = 258 * MiB;
constexpr size_t WS_K = 290 * MiB;
constexpr size_t WS_QH = 314 * MiB, WS_KH = 330 * MiB, WS_KT = 346 * MiB, WS_VT = 362 * MiB;
constexpr size_t WS_ROPE = 378 * MiB;
constexpr size_t WS_END = 380 * MiB;

struct Params {
    const float* x; const float* c; const int* pos; const float* w_ada; const float* b_ada; const float* norm_mix_g; const float* w_in;
    const float* b_gates; const float* conv_w; const float* conv_b; const float* q_lora_g; const float* w_uq; const float* kv_lora_g;
    const float* w_ukv; const float* q_norm_g; const float* k_norm_g; const float* mlstm_norm_g; const float* w_out; const float* norm_mlp_g;
    const float* w_ff1; const float* w_ff2;
    float* out; unsigned char* ws; int ph_lo, ph_hi;
};

#define LAUNDER_V(x) asm volatile("" : "+v"(x))
#define LAUNDER_S(x) asm volatile("" : "+s"(x))
__device__ __forceinline__ int tid_opaque() { int t = threadIdx.x; LAUNDER_V(t); return t; }
__device__ __forceinline__ unsigned cvt_pk_bf16(float lo, float hi) { unsigned r; asm volatile("v_cvt_pk_bf16_f32 %0, %1, %2" : "=v"(r) : "v"(lo), "v"(hi)); return r; }
__device__ __forceinline__ float bf_lo(unsigned w) { return __uint_as_float(w << 16); }
__device__ __forceinline__ float bf_hi(unsigned w) { return __uint_as_float(w & 0xffff0000u); }
__device__ __forceinline__ float bf2f(bf16_t b) { return __uint_as_float(((unsigned)b) << 16); }
__device__ __forceinline__ bf16_t f2bf(float f) { return (bf16_t)(cvt_pk_bf16(f, 0.f) & 0xffffu); }
__device__ __forceinline__ float wave_sum(float v) {
#pragma unroll
    for (int o = 1; o < 64; o <<= 1) v += __shfl_xor(v, o);
    return v;
}
template <class T> __device__ __forceinline__ T ldgu(const void* ubase, unsigned voff) { return *(const T*)((const char*)ubase + voff); }
__device__ __forceinline__ float silu_f(float v) { return v / (1.f + __expf(-v)); }
__device__ __forceinline__ float sigmoid_f(float v) { return 1.f / (1.f + __expf(-v)); }
__device__ __forceinline__ void unpack8(u32x4 w, float* f) {
    f[0] = bf_lo(w.x); f[1] = bf_hi(w.x); f[2] = bf_lo(w.y); f[3] = bf_hi(w.y); f[4] = bf_lo(w.z); f[5] = bf_hi(w.z); f[6] = bf_lo(w.w); f[7] = bf_hi(w.w);
}
__device__ __forceinline__ u32x4 pack8(const float* f) {
    u32x4 w; w.x = cvt_pk_bf16(f[0], f[1]); w.y = cvt_pk_bf16(f[2], f[3]); w.z = cvt_pk_bf16(f[4], f[5]); w.w = cvt_pk_bf16(f[6], f[7]); return w;
}

namespace pg8 {
constexpr int BM = 256, BK = 64, HALF = 128, HTB = HALF * BK * 2, STAGE_BYTES = 8 * HTB, NXCD = 8, WGM = 8;
__host__ __device__ __forceinline__ int lds_byte(int r, int c) { const int st = (r >> 4) * 2 + (c >> 5), rr = r & 15, cc = c & 31, ob = rr * 64 + cc * 2; return st * 1024 + (ob ^ (((ob >> 9) & 1) << 5)); }
__host__ __device__ __forceinline__ void stage_rc(int b, int& R, int& C) { const int st = b / 1024, sb = b % 1024, swz = sb ^ (((sb >> 9) & 1) << 5); R = (st >> 1) * 16 + swz / 64; C = (st & 1) * 32 + (swz % 64) / 2; }
__host__ __device__ __forceinline__ int perm32(int rho) { const int n = rho >> 4, i = rho & 15; return 8 * (i >> 2) + 4 * n + (i & 3); }
struct Unit { int pm, pn; };
struct Gemm { const bf16_t* A; const bf16_t* Bt; int M, N, K; };
struct StaticOrder {
    int nM, nN, nwg, G, c;
    __host__ __device__ void init(int M, int N, int G_, int c_) { nM = M / BM; nN = N / BM; nwg = nM * nN; G = G_; c = c_; }
    __host__ __device__ bool next(int i, Unit& u) const {
        const long L = (long)i * G + c; if (L >= nwg) return false;
        int wgid = (int)L; { const int q = nwg / NXCD, r = nwg % NXCD, xcd = wgid % NXCD, off = wgid / NXCD; wgid = (xcd < r ? xcd * (q + 1) : r * (q + 1) + (xcd - r) * q) + off; }
        const int nig = WGM * nN, gid = wgid / nig, fm = gid * WGM, gsz = (nM - fm) < WGM ? (nM - fm) : WGM;
        u.pm = fm + ((wgid % nig) % gsz); u.pn = (wgid % nig) / gsz; return true;
    }
    __device__ __forceinline__ void a_ready(const Unit&) const {}
    __device__ __forceinline__ void done(const Unit&) const {}
};
template <class F> struct Epi8 {
    static constexpr bool PERM = true, AFTER_DRAIN = false; F f;
    __device__ __forceinline__ void operator()(const f32x4 (&acc)[2][2][4][2], const Unit& u, int wr, int wc, int fr, int fq) const {
        const int row0 = u.pm * BM + wr * 64 + fr, col0 = u.pn * BM + wc * 32 + 8 * fq;
#pragma unroll
        for (int ai = 0; ai < 2; ++ai)
#pragma unroll
            for (int m = 0; m < 4; ++m)
#pragma unroll
                for (int bj = 0; bj < 2; ++bj) f(row0 + ai * HALF + m * 16, col0 + bj * HALF, acc[ai][bj][m][0], acc[ai][bj][m][1]);
    }
};
template <class F> struct Epi4 {
    static constexpr bool PERM = false, AFTER_DRAIN = false; F f;
    __device__ __forceinline__ void operator()(const f32x4 (&acc)[2][2][4][2], const Unit& u, int wr, int wc, int fr, int fq) const {
        const int row0 = u.pm * BM + wr * 64 + fr, col0 = u.pn * BM + wc * 32 + 4 * fq;
#pragma unroll
        for (int ai = 0; ai < 2; ++ai)
#pragma unroll
            for (int m = 0; m < 4; ++m) {
#pragma unroll
                for (int bj = 0; bj < 2; ++bj)
#pragma unroll
                    for (int n = 0; n < 2; ++n) f(row0 + ai * HALF + m * 16, col0 + bj * HALF + n * 16, acc[ai][bj][m][n]);
                if (m & 1) asm volatile("" ::: "memory");
            }
    }
};

template <class Epi, class Sched, bool ALIGN_EPI = false, bool SP2 = false>
__device__ __forceinline__ void gemm_phase(LAS unsigned char* lds, const Gemm g, const Sched& S, const Epi& E) {
    const int tid = tid_opaque(), wid = __builtin_amdgcn_readfirstlane(tid >> 6), lane = tid & 63, wr = wid >> 2, wc = wid & 3, fr = lane & 15, fq = lane >> 4;
    const int K = g.K, nt = K / BK;
    unsigned voffA[2], voffB[2];
#pragma unroll
    for (int i = 0; i < 2; ++i) { int R, C; stage_rc(tid * 16 + i * 8192, R, C); const int Rb = Epi::PERM ? ((R & ~31) + perm32(R & 31)) : R;
        voffA[i] = (unsigned)(R * K + C) * 2u; voffB[i] = (unsigned)(Rb * K + C) * 2u; }
    const size_t kstep = (size_t)(BK * 2);
    const size_t hstep = (size_t)HALF * K * 2;
    const size_t tstep = 2 * hstep;
    const unsigned ldsw = (unsigned)wid * 1024u;
    const int aoff = lds_byte(wr * 64 + fr, fq * 8), boff = lds_byte(wc * 32 + fr, fq * 8);
#define PG8_SA(b, h) (((b) * 2 + (h)) * HTB)
#define PG8_SB(b, h) ((4 + (b) * 2 + (h)) * HTB)
#define PG8_STAGE(bufoff, gbase, voff) do { _Pragma("unroll") for (int _i = 0; _i < 2; ++_i) \
        __builtin_amdgcn_global_load_lds((const unsigned*)((const char*)(gbase) + (voff)[_i]), (LAS unsigned*)(lds + (bufoff) + ldsw + _i * 8192), 16, 0, 0); } while (0)
#define PG8_LDA(dst, b, h) do { _Pragma("unroll") for (int m = 0; m < 4; ++m) _Pragma("unroll") for (int k = 0; k < 2; ++k) dst[m][k] = *(const LAS bf16x8*)(lds + PG8_SA(b, h) + aoff + m * 2048 + k * 1024); } while (0)
#define PG8_LDB(dst, b, h) do { _Pragma("unroll") for (int n = 0; n < 2; ++n) _Pragma("unroll") for (int k = 0; k < 2; ++k) dst[n][k] = *(const LAS bf16x8*)(lds + PG8_SB(b, h) + boff + n * 2048 + k * 1024); } while (0)
#define PG8_MMA(ai, bj, At, Bt) do { __builtin_amdgcn_s_setprio(1); _Pragma("unroll") for (int m = 0; m < 4; ++m) _Pragma("unroll") for (int n = 0; n < 2; ++n) _Pragma("unroll") for (int k = 0; k < 2; ++k) \
        acc[ai][bj][m][n] = __builtin_amdgcn_mfma_f32_16x16x32_bf16(Bt[n][k], At[m][k], acc[ai][bj][m][n], 0, 0, 0); __builtin_amdgcn_s_setprio(0); } while (0)
#define PG8_WAIT_V(n) asm volatile("s_waitcnt vmcnt(" #n ")" ::: "memory")
#define PG8_WAIT_L(n) asm volatile("s_waitcnt lgkmcnt(" #n ")" ::: "memory")
#define PG8_BAR __builtin_amdgcn_s_barrier()
#define PG8_SCHED __builtin_amdgcn_sched_barrier(0)
    Unit cur, nxt; int ui = 0;
    if (!S.next(0, cur)) return;
    f32x4 acc[2][2][4][2];
#pragma unroll
    for (int a = 0; a < 2; ++a)
#pragma unroll
        for (int b = 0; b < 2; ++b)
#pragma unroll
            for (int m = 0; m < 4; ++m)
#pragma unroll
                for (int n = 0; n < 2; ++n) acc[a][b][m][n] = (f32x4){0.f, 0.f, 0.f, 0.f};
    bf16x8 At[4][2], B0[2][2], B1[2][2];
    const char* cA = (const char*)g.A + (size_t)cur.pm * tstep; const char* cB = (const char*)g.Bt + (size_t)cur.pn * tstep;
    S.a_ready(cur);
    if constexpr (SP2) {
        PG8_STAGE(PG8_SB(0, 0), cB, voffB); PG8_STAGE(PG8_SB(0, 1), cB + hstep, voffB); PG8_STAGE(PG8_SA(0, 0), cA, voffA); PG8_STAGE(PG8_SA(0, 1), cA + hstep, voffA);
        if (wr == 1) PG8_BAR;
        PG8_WAIT_V(2); PG8_BAR;
        PG8_STAGE(PG8_SB(1, 0), cB + kstep, voffB); PG8_STAGE(PG8_SA(1, 0), cA + kstep, voffA); PG8_STAGE(PG8_SB(1, 1), cB + hstep + kstep, voffB);
        PG8_WAIT_V(6); PG8_BAR;
    } else {
        PG8_STAGE(PG8_SB(0, 0), cB, voffB); PG8_STAGE(PG8_SA(0, 0), cA, voffA); PG8_STAGE(PG8_SB(0, 1), cB + hstep, voffB); PG8_STAGE(PG8_SA(0, 1), cA + hstep, voffA);
        if (wr == 1) PG8_BAR;
        PG8_WAIT_V(4); PG8_BAR;
        PG8_STAGE(PG8_SB(1, 0), cB + kstep, voffB); PG8_STAGE(PG8_SA(1, 0), cA + kstep, voffA); PG8_STAGE(PG8_SB(1, 1), cB + hstep + kstep, voffB);
        PG8_WAIT_V(6); PG8_BAR;
    }
    for (;;) {
        const bool has_next = S.next(ui + 1, nxt);
        const char* nA = has_next ? (const char*)g.A + (size_t)nxt.pm * tstep : cA; const char* nB = has_next ? (const char*)g.Bt + (size_t)nxt.pn * tstep : cB;
#pragma unroll 1
        for (int t = 0; t < nt; t += 2) {
            const bool last = (t == nt - 2);
            const char* a1 = cA + (size_t)(t + 1) * kstep;
            const char* a2 = last ? nA : cA + (size_t)(t + 2) * kstep; const char* b2 = last ? nB : cB + (size_t)(t + 2) * kstep;
            const char* a3 = a2 + kstep; const char* b3 = b2 + kstep;
            if (last && has_next) S.a_ready(nxt);
            if constexpr (SP2) {
            PG8_LDB(B0, 0, 0); PG8_LDB(B1, 0, 1); PG8_SCHED; PG8_LDA(At, 0, 0); PG8_STAGE(PG8_SA(1, 1), a1 + hstep, voffA);
            PG8_WAIT_V(8); PG8_WAIT_L(0); PG8_BAR; PG8_MMA(0, 0, At, B0); PG8_MMA(0, 1, At, B1); PG8_BAR; PG8_SCHED;
            PG8_LDA(At, 0, 1); PG8_STAGE(PG8_SB(0, 0), b2, voffB); PG8_STAGE(PG8_SB(0, 1), b2 + hstep, voffB); PG8_STAGE(PG8_SA(0, 0), a2, voffA);
            PG8_WAIT_V(8); PG8_WAIT_L(0); PG8_BAR; PG8_MMA(1, 0, At, B0); PG8_MMA(1, 1, At, B1); PG8_BAR; PG8_SCHED;
            PG8_LDB(B0, 1, 0); PG8_LDB(B1, 1, 1); PG8_SCHED; PG8_LDA(At, 1, 0); PG8_STAGE(PG8_SA(0, 1), a2 + hstep, voffA);
            PG8_WAIT_V(8); PG8_WAIT_L(0); PG8_BAR; PG8_MMA(0, 0, At, B0); PG8_MMA(0, 1, At, B1); PG8_BAR; PG8_SCHED;
            PG8_LDA(At, 1, 1); PG8_STAGE(PG8_SB(1, 0), b3, voffB); PG8_STAGE(PG8_SB(1, 1), b3 + hstep, voffB); PG8_STAGE(PG8_SA(1, 0), a3, voffA);
            PG8_WAIT_V(8); PG8_WAIT_L(0); PG8_BAR; PG8_MMA(1, 0, At, B0); PG8_MMA(1, 1, At, B1); PG8_BAR; PG8_SCHED;
            } else {
            PG8_LDB(B0, 0, 0); PG8_SCHED; PG8_LDA(At, 0, 0); PG8_STAGE(PG8_SA(1, 1), a1 + hstep, voffA);
            PG8_WAIT_L(8); PG8_BAR; PG8_WAIT_L(0); PG8_MMA(0, 0, At, B0); PG8_BAR; PG8_SCHED;
            PG8_LDB(B1, 0, 1); PG8_STAGE(PG8_SB(0, 0), b2, voffB);
            PG8_BAR; PG8_WAIT_L(0); PG8_MMA(0, 1, At, B1); PG8_BAR;
            PG8_LDA(At, 0, 1); PG8_STAGE(PG8_SA(0, 0), a2, voffA);
            PG8_BAR; PG8_WAIT_L(0); PG8_MMA(1, 0, At, B0); PG8_BAR; PG8_SCHED;
            PG8_STAGE(PG8_SB(0, 1), b2 + hstep, voffB);
            PG8_WAIT_V(6); PG8_BAR; PG8_MMA(1, 1, At, B1); PG8_BAR;
            PG8_LDB(B0, 1, 0); PG8_SCHED; PG8_LDA(At, 1, 0); PG8_STAGE(PG8_SA(0, 1), a2 + hstep, voffA);
            PG8_WAIT_L(8); PG8_BAR; PG8_WAIT_L(0); PG8_MMA(0, 0, At, B0); PG8_BAR; PG8_SCHED;
            PG8_LDB(B1, 1, 1); PG8_STAGE(PG8_SB(1, 0), b3, voffB);
            PG8_BAR; PG8_WAIT_L(0); PG8_MMA(0, 1, At, B1); PG8_BAR;
            PG8_LDA(At, 1, 1); PG8_STAGE(PG8_SA(1, 0), a3, voffA);
            PG8_BAR; PG8_WAIT_L(0); PG8_MMA(1, 0, At, B0); PG8_BAR; PG8_SCHED;
            PG8_STAGE(PG8_SB(1, 1), b3 + hstep, voffB);
            PG8_WAIT_V(6); PG8_BAR; PG8_MMA(1, 1, At, B1); PG8_BAR;
            }
        }
        if constexpr (ALIGN_EPI) { if (wr == 0) PG8_BAR; }
        if constexpr (!Epi::AFTER_DRAIN) { E(acc, cur, wr, wc, fr, fq); S.done(cur); }
        if (!has_next) break;
#pragma unroll
        for (int a = 0; a < 2; ++a)
#pragma unroll
            for (int b = 0; b < 2; ++b)
#pragma unroll
                for (int m = 0; m < 4; ++m)
#pragma unroll
                    for (int n = 0; n < 2; ++n) acc[a][b][m][n] = (f32x4){0.f, 0.f, 0.f, 0.f};
        cur = nxt; cA = nA; cB = nB; ++ui;
        if constexpr (ALIGN_EPI) { if (wr == 1) PG8_BAR; }
    }
    PG8_WAIT_V(0);
    if constexpr (!ALIGN_EPI) { if (wr == 0) PG8_BAR; }
    PG8_BAR;
#undef PG8_SA
#undef PG8_SB
#undef PG8_STAGE
#undef PG8_LDA
#undef PG8_LDB
#undef PG8_MMA
#undef PG8_WAIT_V
#undef PG8_WAIT_L
#undef PG8_BAR
#undef PG8_SCHED
}
}

namespace att {
constexpr int NW = 8, QBLK = 32, KVBLK = 64;
constexpr int LDQ = NH * DQK, LDK = NH * DQK, LDV = NH * 256, LDO = DM;
constexpr float SCALE = 0.07216878364870322f;
constexpr float THR = 8.f;
constexpr int SHM_K = KVBLK * DQK * 2, SHM_V = KVBLK * DV * 2;
constexpr int SHM_QL = 2 * SHM_V + 2 * SHM_K + NW * 64 * 4;
constexpr int SHM_ATTN = SHM_QL + NW * 4096;
#define KSWZ(row, colB) ((row) * 384 + ((colB) ^ ((((row) >> 1) & 7) << 4)))
#define SBAR() __builtin_amdgcn_sched_barrier(0)
__device__ __forceinline__ int crow(int r, int hi) { return (r & 3) + 8 * (r >> 2) + 4 * hi; }
__device__ __forceinline__ void partialSM(f32x16& p0, f32x16& p1, float& m_reg, float& mn, float& alpha) {
    constexpr float C = SCALE * 1.4426950408889634f;
    float pmax = p0[0];
#pragma unroll
    for (int r = 1; r < 16; ++r) pmax = fmaxf(pmax, p0[r]);
#pragma unroll
    for (int r = 0; r < 16; ++r) pmax = fmaxf(pmax, p1[r]);
    { auto rr = __builtin_amdgcn_permlane32_swap(__float_as_uint(pmax), __float_as_uint(pmax), false, false);
      pmax = fmaxf(__uint_as_float(rr[0]), __uint_as_float(rr[1])); }
    if (__builtin_expect(__all(pmax - m_reg <= THR / SCALE), 1)) { mn = m_reg; alpha = 1.f; }
    else { mn = fmaxf(m_reg, pmax); alpha = __builtin_amdgcn_exp2f((m_reg - mn) * C); m_reg = mn; }
    float mnC = -mn * C;
#pragma unroll
    for (int r = 0; r < 16; ++r) p0[r] = fmaf(p0[r], C, mnC);
#pragma unroll
    for (int r = 0; r < 16; ++r) p1[r] = fmaf(p1[r], C, mnC);
#pragma unroll
    for (int r = 0; r < 16; ++r) p0[r] = __builtin_amdgcn_exp2f(p0[r]);
}
__device__ __forceinline__ void finishSM(f32x16& p0, f32x16& p1, float alpha, float& l_reg, bf16x8& pa0, bf16x8& pa1, bf16x8& pa2, bf16x8& pa3) {
#pragma unroll
    for (int r = 0; r < 16; ++r) p1[r] = __builtin_amdgcn_exp2f(p1[r]);
    float ps = 0;
#pragma unroll
    for (int r = 0; r < 16; ++r) ps += p0[r];
#pragma unroll
    for (int r = 0; r < 16; ++r) ps += p1[r];
    { auto rr = __builtin_amdgcn_permlane32_swap(__float_as_uint(ps), __float_as_uint(ps), false, false);
      ps = __uint_as_float(rr[0]) + __uint_as_float(rr[1]); }
    l_reg = l_reg * alpha + ps;
#define PK4(P, BASE, OUT) do { unsigned a0 = cvt_pk_bf16(P[BASE + 0], P[BASE + 1]), a1 = cvt_pk_bf16(P[BASE + 2], P[BASE + 3]);   \
    unsigned b0 = cvt_pk_bf16(P[BASE + 4], P[BASE + 5]), b1 = cvt_pk_bf16(P[BASE + 6], P[BASE + 7]);                              \
    auto r0 = __builtin_amdgcn_permlane32_swap(a0, b0, false, false); auto r1 = __builtin_amdgcn_permlane32_swap(a1, b1, false, false); \
    u32x4 w = {r0[0], r1[0], r0[1], r1[1]}; OUT = *reinterpret_cast<bf16x8*>(&w); } while (0)
    PK4(p0, 0, pa0); PK4(p0, 8, pa1); PK4(p1, 0, pa2); PK4(p1, 8, pa3);
#undef PK4
}
__device__ __forceinline__ void qkt(f32x16& p0, f32x16& p1, const char* Ks, const bf16x8* qr, const char* ql, int r32, int hi) {
    p0 = f32x16{}; p1 = f32x16{};
#pragma unroll
    for (int d0 = 0; d0 < 12; ++d0) { const int cb = (d0 * 16 + hi * 8) * 2;
        bf16x8 b0 = *reinterpret_cast<const bf16x8*>(Ks + KSWZ(r32, cb));
        bf16x8 b1 = *reinterpret_cast<const bf16x8*>(Ks + KSWZ(32 + r32, cb));
        const bf16x8 q = d0 < 8 ? qr[d0 < 8 ? d0 : 0] : *reinterpret_cast<const bf16x8*>(ql + (d0 - 8) * 1024);
        p0 = __builtin_amdgcn_mfma_f32_32x32x16_bf16(b0, q, p0, 0, 0, 0);
        p1 = __builtin_amdgcn_mfma_f32_32x32x16_bf16(b1, q, p1, 0, 0, 0); }
}
__device__ __forceinline__ int v_st(int k, int c) { const int kk = (k & ~0xC) | ((k & 4) << 1) | ((k & 8) >> 1); return ((kk >> 3) * 4 + (c >> 5)) * 512 + ((kk & 7) * 32 + (c & 31)) * 2; }
__device__ __forceinline__ int v_rd_base(int lane) { return ((lane & 3) << 3) | (((lane >> 2) & 3) << 6) | (((lane >> 4) & 1) << 5) | (((lane >> 5) & 1) << 8); }
constexpr int v_rd_off(int d0, int ks, int half) { return d0 * 512 + ks * 4096 + half * 2048; }
template <int OFF> __device__ __forceinline__ s16x4 tr_read(int vb) {
    s16x4 r; asm volatile("ds_read_b64_tr_b16 %0, %1 offset:%2" : "=&v"(r) : "v"(vb), "i"(OFF) : "memory"); return r;
}
template <int D0> __device__ __forceinline__ void pv_one(f32x16& od, int vb, bf16x8 pa0, bf16x8 pa1, bf16x8 pa2, bf16x8 pa3) {
    const s16x4 l0 = tr_read<v_rd_off(D0, 0, 0)>(vb), h0 = tr_read<v_rd_off(D0, 0, 1)>(vb), l1 = tr_read<v_rd_off(D0, 1, 0)>(vb), h1 = tr_read<v_rd_off(D0, 1, 1)>(vb);
    const s16x4 l2 = tr_read<v_rd_off(D0, 2, 0)>(vb), h2 = tr_read<v_rd_off(D0, 2, 1)>(vb), l3 = tr_read<v_rd_off(D0, 3, 0)>(vb), h3 = tr_read<v_rd_off(D0, 3, 1)>(vb);
    asm volatile("s_waitcnt lgkmcnt(0)" ::: "memory"); SBAR();
#define PK(L, H) (bf16x8){L[0], L[1], L[2], L[3], H[0], H[1], H[2], H[3]}
    od = __builtin_amdgcn_mfma_f32_32x32x16_bf16(pa0, PK(l0, h0), od, 0, 0, 0);
    od = __builtin_amdgcn_mfma_f32_32x32x16_bf16(pa1, PK(l1, h1), od, 0, 0, 0);
    od = __builtin_amdgcn_mfma_f32_32x32x16_bf16(pa2, PK(l2, h2), od, 0, 0, 0);
    od = __builtin_amdgcn_mfma_f32_32x32x16_bf16(pa3, PK(l3, h3), od, 0, 0, 0);
#undef PK
}
__device__ __forceinline__ void pv_d0(f32x16* o, int vb, bf16x8 pa0, bf16x8 pa1, bf16x8 pa2, bf16x8 pa3) {
    pv_one<0>(o[0], vb, pa0, pa1, pa2, pa3); pv_one<1>(o[1], vb, pa0, pa1, pa2, pa3); pv_one<2>(o[2], vb, pa0, pa1, pa2, pa3); pv_one<3>(o[3], vb, pa0, pa1, pa2, pa3);
}
#ifndef ATT_SDEPTH
#define ATT_SDEPTH 1
#endif
constexpr int SDEPTH = ATT_SDEPTH;
__device__ __forceinline__ void attn_unit(const bf16_t* __restrict__ Qb, const bf16_t* __restrict__ Kh, const bf16_t* __restrict__ Vh, bf16_t* __restrict__ Ob, int seq, char* lds) {
    const int tid = tid_opaque(), wid = tid >> 6, lane = tid & 63, r32 = lane & 31, hi = lane >> 5;
    char* V_lds = lds; char* K_lds = lds + 2 * SHM_V;
    float* ws = (float*)(lds + 2 * SHM_V + 2 * SHM_K) + wid * 64; float* li_l = ws; float* al_l = ws + 32;
    float m_reg = -1e30f, l_reg = 0; f32x16 o[4] = {}; bf16x8 qr[8];
    const bf16_t* Qw = Qb + (long)(wid * QBLK + r32) * LDQ + hi * 8;
    char* ql = lds + SHM_QL + wid * 4096 + lane * 16;
#pragma unroll
    for (int d0 = 0; d0 < 8; ++d0) qr[d0] = *reinterpret_cast<const bf16x8*>(Qw + d0 * 16);
#pragma unroll
    for (int d0 = 8; d0 < 12; ++d0) *reinterpret_cast<bf16x8*>(ql + (d0 - 8) * 1024) = *reinterpret_cast<const bf16x8*>(Qw + d0 * 16);
    const int krow = tid >> 3, kc8 = tid & 7;
    const unsigned kgo = (unsigned)(krow * LDK + kc8 * 8) * 2u;
    const int kso = krow * 384 + ((kc8 * 16) ^ (((krow >> 1) & 7) << 4));
    const int sr = tid >> 4, sc = (tid & 15) * 8, vst0 = v_st(sr, sc);
    const unsigned vgo = (unsigned)(sr * LDV + sc) * 2u;
    const int vb0 = (int)(uintptr_t)V_lds + v_rd_base(lane);
    struct { bf16x8 k0, k1, k2, v0, v1; } sr_[SDEPTH];
#define SLOAD(i, kk0) do { const char* kp_ = (const char*)(Kh + (long)(kk0) * LDK); const char* vp_ = (const char*)(Vh + (long)(kk0) * LDV); \
    sr_[i].v0 = ldgu<bf16x8>(vp_, vgo); sr_[i].v1 = ldgu<bf16x8>(vp_ + 32 * LDV * 2, vgo); \
    sr_[i].k0 = ldgu<bf16x8>(kp_, kgo); sr_[i].k1 = ldgu<bf16x8>(kp_ + 128, kgo); sr_[i].k2 = ldgu<bf16x8>(kp_ + 256, kgo); } while (0)
#define SWRITE(b, i) do { *(bf16x8*)(V_lds + (b) * SHM_V + vst0) = sr_[i].v0; *(bf16x8*)(V_lds + (b) * SHM_V + 8192 + vst0) = sr_[i].v1; \
    *(bf16x8*)(K_lds + (b) * SHM_K + kso) = sr_[i].k0; *(bf16x8*)(K_lds + (b) * SHM_K + 128 + kso) = sr_[i].k1; *(bf16x8*)(K_lds + (b) * SHM_K + 256 + kso) = sr_[i].k2; } while (0)
#define SWAIT() do { if constexpr (SDEPTH == 2) asm volatile("s_waitcnt vmcnt(5)" ::: "memory"); else asm volatile("s_waitcnt vmcnt(0)" ::: "memory"); } while (0)
#define RESC(a) do { if (__any((a) < 1.f)) { if (hi == 0) al_l[r32] = (a); asm volatile("s_waitcnt lgkmcnt(0)" ::: "memory"); \
    _Pragma("unroll") for (int d = 0; d < 4; ++d) _Pragma("unroll") for (int r = 0; r < 16; ++r) o[d][r] *= al_l[crow(r, hi)]; } } while (0)
    f32x16 pA0, pA1, pB0, pB1; float mnA, mnB, alA, alB; bf16x8 pa0, pa1, pa2, pa3; const int NT = seq / KVBLK;
    constexpr int SE = 0, SO = SDEPTH - 1;
    SLOAD(SE, 0); asm volatile("s_waitcnt vmcnt(0)" ::: "memory"); SWRITE(0, SE); __syncthreads();
    qkt(pA0, pA1, K_lds, qr, ql, r32, hi); partialSM(pA0, pA1, m_reg, mnA, alA);
    SLOAD(SO, KVBLK); if constexpr (SDEPTH == 2) { if (2 < NT) SLOAD(SE, 2 * KVBLK); }
    SWAIT(); SWRITE(1, SO); __syncthreads();
    for (int j = 1; j + 1 < NT; j += 2) {
        SBAR(); qkt(pB0, pB1, K_lds + SHM_K, qr, ql, r32, hi);
        finishSM(pA0, pA1, alA, l_reg, pa0, pa1, pa2, pa3); SBAR();
        SLOAD(SO, (j + SDEPTH) * KVBLK); SBAR();
        pv_d0(o, vb0, pa0, pa1, pa2, pa3); partialSM(pB0, pB1, m_reg, mnB, alB);
        __syncthreads(); SWAIT(); SWRITE(0, SE);
        RESC(alB); __syncthreads();
        SBAR(); qkt(pA0, pA1, K_lds, qr, ql, r32, hi);
        finishSM(pB0, pB1, alB, l_reg, pa0, pa1, pa2, pa3); SBAR();
        if (SDEPTH == 1 || j + 3 < NT) SLOAD(SE, (j + 1 + SDEPTH) * KVBLK); SBAR();
        pv_d0(o, vb0 + SHM_V, pa0, pa1, pa2, pa3); partialSM(pA0, pA1, m_reg, mnA, alA);
        __syncthreads(); SWAIT(); SWRITE(1, SO);
        RESC(alA); __syncthreads();
    }
    SBAR(); qkt(pB0, pB1, K_lds + SHM_K, qr, ql, r32, hi);
    finishSM(pA0, pA1, alA, l_reg, pa0, pa1, pa2, pa3); SBAR();
    pv_d0(o, vb0, pa0, pa1, pa2, pa3); partialSM(pB0, pB1, m_reg, mnB, alB);
    __syncthreads(); RESC(alB);
    finishSM(pB0, pB1, alB, l_reg, pa0, pa1, pa2, pa3); SBAR();
    pv_d0(o, vb0 + SHM_V, pa0, pa1, pa2, pa3);
    if (hi == 0) li_l[r32] = l_reg; asm volatile("s_waitcnt lgkmcnt(0)" ::: "memory");
    float rli[16];
#pragma unroll
    for (int r = 0; r < 16; ++r) rli[r] = __builtin_amdgcn_rcpf(li_l[crow(r, hi)]);
    bf16_t* Ow = Ob + (long)(wid * QBLK) * LDO;
#pragma unroll
    for (int r = 0; r < 16; ++r) { const int orow = crow(r, hi);
#pragma unroll
        for (int d0 = 0; d0 < 4; ++d0) Ow[(long)orow * LDO + d0 * 32 + r32] = f2bf(o[d0][r] * rli[r]); }
    __syncthreads();
#undef SLOAD
#undef SWRITE
#undef SWAIT
#undef RESC
}
#undef SBAR
}

template <class RowMap>
__device__ __forceinline__ void transpose_tile(const float* __restrict__ W, int K, int N, bf16_t* __restrict__ WT, float* scr, int kb, int nb, int lane, RowMap rm) {
    const int k0 = 64 * kb, n0 = 64 * nb; const int nq = 4 * (lane & 15), kr = lane >> 4; const bool ok = (n0 + nq) < N;
    const float* wp = W + (size_t)(k0 + kr) * N + n0 + nq;
#pragma unroll 4
    for (int i = 0; i < 16; ++i) { f32x4 v = {0.f, 0.f, 0.f, 0.f}; if (ok) v = *(const f32x4*)(wp + (size_t)(4 * i) * N);
        float* d = scr + nq * 65 + 4 * i + kr; d[0] = v[0]; d[65] = v[1]; d[130] = v[2]; d[195] = v[3]; }
    asm volatile("s_waitcnt lgkmcnt(0)" ::: "memory");
    const int c = lane & 7;
#pragma unroll
    for (int j = 0; j < 8; ++j) { const int nl = (lane >> 3) + 8 * j; const int n = n0 + nl; const float* sp = scr + nl * 65 + 8 * c;
        u32x4 o; o.x = cvt_pk_bf16(sp[0], sp[1]); o.y = cvt_pk_bf16(sp[2], sp[3]); o.z = cvt_pk_bf16(sp[4], sp[5]); o.w = cvt_pk_bf16(sp[6], sp[7]);
        if (n < N) *(u32x4*)(WT + (size_t)rm(n) * K + k0 + 8 * c) = o; }
    asm volatile("s_waitcnt lgkmcnt(0)" ::: "memory");
}
struct RowId { __device__ __forceinline__ int operator()(int n) const { return n; } };
struct RowUq { __device__ __forceinline__ int operator()(int n) const { return (n / DQK) * 256 + (n % DQK); } };

__device__ __forceinline__ void phase0(const Params& P, char* lds, int G) {
    const int tid = tid_opaque(), lane = tid & 63, wave = tid >> 6;
    const int gw = blockIdx.x * NWAVES + wave, NGW = G * NWAVES;
    float* modp = (float*)(P.ws + WS_MODP);
    for (int task = gw; task < 768; task += NGW) {
        const int ks = task / 48, cb = task % 48;
        const float s0 = silu_f(P.c[ks * 128 + lane]), s1 = silu_f(P.c[ks * 128 + 64 + lane]);
        f32x4 acc = {0.f, 0.f, 0.f, 0.f};
        const float* wp = P.w_ada + (size_t)(ks * 128) * (6 * DM) + cb * 256 + lane * 4;
#pragma unroll 8
        for (int kk = 0; kk < 128; ++kk) { const float sv = __shfl(kk < 64 ? s0 : s1, kk & 63); const f32x4 w = *(const f32x4*)(wp + (size_t)kk * (6 * DM)); acc += w * sv; }
        *(f32x4*)(modp + (size_t)ks * (6 * DM) + cb * 256 + lane * 4) = acc;
    }
    { f32x2* rt = (f32x2*)(P.ws + WS_ROPE); const int i = lane & 31; const float freq = powf(10000.0f, -(float)i / 32.0f);
      for (int t = 2 * gw + (lane >> 5); t < SEQ; t += 2 * NGW) { float sn, cs; sincosf((float)P.pos[t] * freq, &sn, &cs); rt[(size_t)t * 32 + i] = (f32x2){cs, sn}; } }
    float* scr = (float*)(lds + wave * 17408);
    constexpr int I_IN = 32 * 78, I_UQ = 8 * 24, I_UKV = 4 * 32, I_OUT = 32 * 32, NIT = I_IN + I_UQ + I_UKV + I_OUT;
    for (int it = gw; it < NIT; it += NGW) {
        int r = it;
        if (r < I_IN) { transpose_tile(P.w_in, DM, DIN, (bf16_t*)(P.ws + WS_WIN), scr, r / 78, r % 78, lane, RowId()); continue; } r -= I_IN;
        if (r < I_UQ) { transpose_tile(P.w_uq, QLORA, NH * DQK, (bf16_t*)(P.ws + WS_WUQ), scr, r / 24, r % 24, lane, RowUq()); continue; } r -= I_UQ;
        if (r < I_UKV) { transpose_tile(P.w_ukv, KVLORA, NH * 256, (bf16_t*)(P.ws + WS_WUKV), scr, r / 32, r % 32, lane, RowId()); continue; } r -= I_UKV;
        transpose_tile(P.w_out, DM, DM, (bf16_t*)(P.ws + WS_WOUT), scr, r / 32, r % 32, lane, RowId());
    }
}
__device__ __forceinline__ void norm_mod_rows(const float* __restrict__ src, const float* __restrict__ g, const float* sh, const float* sc, bf16_t* __restrict__ dst, int G) {
    const int tid = tid_opaque(), lane = tid & 63, wave = tid >> 6;
    const int gw = blockIdx.x * NWAVES + wave, NGW = G * NWAVES;
    for (int row = gw; row < SEQ; row += NGW) {
        const f32x4* xr = (const f32x4*)(src + (size_t)row * DM) + lane;
        f32x4 v[8]; float ss = 0.f;
#pragma unroll
        for (int j = 0; j < 8; ++j) { v[j] = xr[64 * j]; ss += (v[j].x * v[j].x + v[j].y * v[j].y) + (v[j].z * v[j].z + v[j].w * v[j].w); }
        const float rstd = rsqrtf(wave_sum(ss) * (1.f / DM) + EPS);
        u32x2* o8 = (u32x2*)(dst + (size_t)row * DM) + lane;
#pragma unroll
        for (int j = 0; j < 8; ++j) { const int col = lane * 4 + 256 * j; const f32x4 gg = *(const f32x4*)(g + col); const f32x4 s1 = *(const f32x4*)(sc + col), s0 = *(const f32x4*)(sh + col);
            f32x4 y = v[j] * rstd * gg; y = y * (s1 + 1.f) + s0;
            u32x2 w; w.x = cvt_pk_bf16(y.x, y.y); w.y = cvt_pk_bf16(y.z, y.w); o8[64 * j] = w; }
    }
}
__device__ __forceinline__ void phase1a(const Params& P, char* lds, int G) {
    const int tid = tid_opaque();
    const float* modp = (const float*)(P.ws + WS_MODP); float* mod = (float*)(P.ws + WS_MOD);
    float* sh = (float*)lds; float* sc = sh + DM;
    for (int n = tid; n < 2 * DM; n += NTHREADS) { float a = P.b_ada[n];
#pragma unroll
        for (int ks = 0; ks < 16; ++ks) a += modp[(size_t)ks * (6 * DM) + n];
        sh[n] = a; }
    if (blockIdx.x < 16) { const int n = 2 * DM + blockIdx.x * NTHREADS + tid; float a = P.b_ada[n];
#pragma unroll
        for (int ks = 0; ks < 16; ++ks) a += modp[(size_t)ks * (6 * DM) + n];
        mod[n] = a; }
    __syncthreads();
    norm_mod_rows(P.x, P.norm_mix_g, sh, sc, (bf16_t*)(P.ws + WS_H), G);
    __syncthreads();
}
__device__ __forceinline__ void phase6b(const Params& P, char* lds, int G) {
    const int tid = tid_opaque(), lane = tid & 63, wave = tid >> 6;
    const int gw = blockIdx.x * NWAVES + wave, NGW = G * NWAVES;
    const float* mod = (const float*)(P.ws + WS_MOD);
    float* sh = (float*)lds; float* sc = sh + DM;
    for (int n = tid; n < 2 * DM; n += NTHREADS) sh[n] = mod[3 * DM + n];
    __syncthreads();
    norm_mod_rows(P.out, P.norm_mlp_g, sh, sc, (bf16_t*)(P.ws + WS_H), G);
    __syncthreads();
    float* scr = (float*)(lds + wave * 17408);
    constexpr int I_1 = 32 * 128, I_2 = 128 * 32;
    for (int it = gw; it < I_1 + I_2; it += NGW) {
        if (it < I_1) transpose_tile(P.w_ff1, DM, DFF, (bf16_t*)(P.ws + WS_W1), scr, it / 128, it % 128, lane, RowId());
        else { const int r = it - I_1; transpose_tile(P.w_ff2, DFF, DM, (bf16_t*)(P.ws + WS_W2), scr, r / 32, r % 32, lane, RowId()); }
    }
}

__device__ __forceinline__ void phase2(const Params& P, char* lds, int G) {
    const int tid = tid_opaque(), lane = tid & 63, wave = tid >> 6;
    const int gw = blockIdx.x * NWAVES + wave, NGW = G * NWAVES;
    const bf16_t* proj = (const bf16_t*)(P.ws + WS_PROJ);
    { bf16_t* cqn = (bf16_t*)(P.ws + WS_CQN); bf16_t* ckvn = (bf16_t*)(P.ws + WS_CKVN);
      float gq[8], gk[8];
#pragma unroll
      for (int e = 0; e < 8; ++e) { gq[e] = P.q_lora_g[lane * 8 + e]; gk[e] = P.kv_lora_g[(lane & 31) * 8 + e]; }
      for (int row = gw; row < SEQ; row += NGW) {
        const u32x4 wq = *(const u32x4*)(proj + (size_t)row * DINP + OFF_CQ + lane * 8);
        const u32x4 wk = *(const u32x4*)(proj + (size_t)row * DINP + OFF_CKV + (lane & 31) * 8);
        float fq[8], fk[8]; unpack8(wq, fq); unpack8(wk, fk);
        float sq = 0.f, sk = 0.f;
#pragma unroll
        for (int e = 0; e < 8; ++e) { sq += fq[e] * fq[e]; sk += fk[e] * fk[e]; }
        if (lane >= 32) sk = 0.f;
        const float rq = rsqrtf(wave_sum(sq) * (1.f / QLORA) + EPS), rk = rsqrtf(wave_sum(sk) * (1.f / KVLORA) + EPS);
#pragma unroll
        for (int e = 0; e < 8; ++e) { fq[e] = fq[e] * rq * gq[e]; fk[e] = fk[e] * rk * gk[e]; }
        *(u32x4*)(cqn + (size_t)row * QLORA + lane * 8) = pack8(fq);
        if (lane < 32) *(u32x4*)(ckvn + (size_t)row * KVLORA + lane * 8) = pack8(fk);
      } }
    { bf16_t* QH = (bf16_t*)(P.ws + WS_QH); bf16_t* KH = (bf16_t*)(P.ws + WS_KH); bf16_t* KT = (bf16_t*)(P.ws + WS_KT); bf16_t* VT = (bf16_t*)(P.ws + WS_VT);
      const int tg = tid >> 5, cgp = tid & 31, chl = cgp * 8;
      for (int item = blockIdx.x; item < 3 * HM * NCH; item += G) {
        const int kind = item / (HM * NCH), h = (item / NCH) % HM, c = item % NCH;
        const int t0 = LCH * c + 8 * tg;
        float outv[8][8];
        if (kind < 2) {
            const int col = OFF_QM + kind * 1024 + h * DH + chl;
            float cw[5][8], cb[8];
#pragma unroll
            for (int e = 0; e < 8; ++e) cb[e] = P.conv_b[kind * 1024 + h * DH + chl + e];
#pragma unroll
            for (int j = 0; j < 5; ++j)
#pragma unroll
                for (int e = 0; e < 8; ++e) cw[j][e] = P.conv_w[j * 2048 + kind * 1024 + h * DH + chl + e];
#pragma unroll
            for (int tt = 0; tt < 8; ++tt)
#pragma unroll
                for (int e = 0; e < 8; ++e) outv[tt][e] = cb[e];
#pragma unroll
            for (int rr = 0; rr < 12; ++rr) {
                const int t = t0 - 2 + rr; float in[8];
                if (t >= 0 && t < SEQ) { const u32x4 w = *(const u32x4*)(proj + (size_t)t * DINP + col); unpack8(w, in); }
                else {
#pragma unroll
                    for (int e = 0; e < 8; ++e) in[e] = 0.f; }
#pragma unroll
                for (int j = 0; j < 5; ++j) { const int tt = rr - j;
                    if (tt >= 0 && tt < 8) {
#pragma unroll
                        for (int e = 0; e < 8; ++e) outv[tt][e] += cw[j][e] * in[e]; } }
            }
            const float osc = kind == 1 ? 0.0625f : 1.f;
#pragma unroll
            for (int tt = 0; tt < 8; ++tt)
#pragma unroll
                for (int e = 0; e < 8; ++e) outv[tt][e] = silu_f(outv[tt][e]) * osc;
            bf16_t* dst = (kind == 0 ? QH : KH) + ((size_t)h * SEQ + t0) * DH + chl;
#pragma unroll
            for (int tt = 0; tt < 8; ++tt) *(u32x4*)(dst + (size_t)tt * DH) = pack8(outv[tt]);
        } else {
#pragma unroll
            for (int tt = 0; tt < 8; ++tt) { const u32x4 w = *(const u32x4*)(proj + (size_t)(t0 + tt) * DINP + OFF_VM + h * DH + chl); unpack8(w, outv[tt]); }
        }
        if (kind >= 1) {
            bf16_t* dst = (kind == 1 ? KT : VT) + ((size_t)(h * NCH + c) * DH + chl) * LCH + 8 * tg;
#pragma unroll
            for (int e = 0; e < 8; ++e) { u32x4 w; w.x = cvt_pk_bf16(outv[0][e], outv[1][e]); w.y = cvt_pk_bf16(outv[2][e], outv[3][e]); w.z = cvt_pk_bf16(outv[4][e], outv[5][e]); w.w = cvt_pk_bf16(outv[6][e], outv[7][e]);
                *(u32x4*)(dst + (size_t)e * LCH) = w; }
        }
      } }
    { const float* gates = (const float*)(P.ws + WS_GATES);
      float* BC = (float*)(P.ws + WS_BC); float* IG = (float*)(P.ws + WS_IG); float* PM = (float*)(P.ws + WS_PM); float* WL = (float*)(P.ws + WS_WL);
      float* BL = (float*)(P.ws + WS_BL); float* AC = (float*)(P.ws + WS_AC);
      for (int task = gw; task < 2 * HM * NCH; task += NGW) {
        const int dir = task / (HM * NCH), h = (task / NCH) % HM, c = task % NCH;
        const float bi = P.b_gates[dir * 8 + h], bfg = P.b_gates[dir * 8 + 4 + h];
        const int u0 = 2 * lane, u1 = 2 * lane + 1;
        const int t0 = LCH * c + (dir ? 127 - u0 : u0), t1 = LCH * c + (dir ? 127 - u1 : u1);
        const float i0 = gates[(size_t)t0 * 16 + dir * 8 + h] + bi, i1 = gates[(size_t)t1 * 16 + dir * 8 + h] + bi;
        const float f0 = gates[(size_t)t0 * 16 + dir * 8 + 4 + h] + bfg, f1 = gates[(size_t)t1 * 16 + dir * 8 + 4 + h] + bfg;
        const float l0 = fminf(f0, 0.f) - log1pf(expf(-fabsf(f0))), l1 = fminf(f1, 0.f) - log1pf(expf(-fabsf(f1)));
        float inc = l0 + l1;
#pragma unroll
        for (int o = 1; o < 64; o <<= 1) { const float t = __shfl_up(inc, o); if (lane >= o) inc += t; }
        const float b1 = inc, b0 = inc - l1;
        const float d0 = i0 - b0, d1 = i1 - b1;
        float pmx = fmaxf(d0, d1);
#pragma unroll
        for (int o = 1; o < 64; o <<= 1) { const float t = __shfl_up(pmx, o); if (lane >= o) pmx = fmaxf(pmx, t); }
        float prev = __shfl_up(pmx, 1); if (lane == 0) prev = -INFINITY;
        const float pm0 = fmaxf(prev, d0), pm1 = pmx;
        const float bL = __shfl(b1, 63), pmL = __shfl(pmx, 63);
        const size_t base = (size_t)(dir * HM + h) * SEQ;
        BC[base + t0] = b0; BC[base + t1] = b1; IG[base + t0] = i0; IG[base + t1] = i1;
        PM[base + t0] = b0 + pm0; PM[base + t1] = b1 + pm1;
        WL[base + t0] = bL - b0 + i0; WL[base + t1] = bL - b1 + i1;
        if (lane == 63) { BL[(dir * HM + h) * NCH + c] = bL; AC[(dir * HM + h) * NCH + c] = bL + pmL; }
      } }
}

constexpr int M2_W = 1024, M2_T0 = M2_W + SEQ * 4, M2_TB = 96 * 256;
static_assert(M2_T0 + 2 * M2_TB <= LDS_BYTES, "M2 LDS");
__device__ __forceinline__ void m2_block(const Params& P, char* lds, int blk) {
    const int tid = tid_opaque(), lane = tid & 63, wid = tid >> 6, r = lane & 15, g = lane >> 4;
    const int dir = blk >> 7, h = (blk >> 5) & 3, vs = (blk >> 2) & 7, ksl = blk & 3;
    const int vi = wid >> 2, ki = wid & 3, v0 = 32 * vs + 16 * vi, k0 = 64 * ksl + 16 * ki;
    const int dh = dir * HM + h;
    const float* BL = (const float*)(P.ws + WS_BL) + dh * NCH; const float* AC = (const float*)(P.ws + WS_AC) + dh * NCH;
    const float* WL = (const float*)(P.ws + WS_WL) + (size_t)dh * SEQ;
    bf16_t* CST = (bf16_t*)(P.ws + WS_CST); float* NST = (float*)(P.ws + WS_NST);
    float* s_mA = (float*)lds; float* s_dec = s_mA + NCH; float* s_w = (float*)(lds + M2_W);
    if (tid == 0) { float m = -1e30f;
#pragma unroll 1
        for (int st = 0; st < NCH; ++st) { const int c = dir ? NCH - 1 - st : st; const float bL = BL[c], a = AC[c]; const float mn = fmaxf(bL + m, a);
            s_dec[c] = __expf(bL + m - mn); s_mA[c] = mn; m = mn; } }
    __syncthreads();
    for (int t = tid; t < SEQ; t += NTHREADS) s_w[t] = __expf(WL[t] - s_mA[t >> 7]);
    const int srow = tid >> 4, sslot = tid & 15;
    const char* gV = (const char*)(P.ws + WS_VT) + ((size_t)h * NCH * DH + 32 * vs + srow) * (LCH * 2) + sslot * 16;
    const char* gK = (const char*)(P.ws + WS_KT) + ((size_t)h * NCH * DH + 64 * ksl + srow) * (LCH * 2) + sslot * 16;
    const int lw = srow * 256 + ((sslot ^ (srow & 15)) << 4);
    const int la = (16 * vi + r) * 256, lb = (32 + 16 * ki + r) * 256;
    char* tb = lds + M2_T0;
    u32x4 ring[8][3];
#define M2_LOAD(slot, stp) do { const int c_ = dir ? NCH - 1 - (stp) : (stp); const size_t co_ = (size_t)c_ * (DH * LCH * 2); \
        ring[slot][0] = *(const u32x4*)(gV + co_); ring[slot][1] = *(const u32x4*)(gK + co_); ring[slot][2] = *(const u32x4*)(gK + co_ + 32 * LCH * 2); } while (0)
#define M2_WRITE(slot, buf) do { char* d_ = tb + (buf) * M2_TB + lw; *(u32x4*)d_ = ring[slot][0]; *(u32x4*)(d_ + 8192) = ring[slot][1]; *(u32x4*)(d_ + 16384) = ring[slot][2]; } while (0)
#pragma unroll
    for (int d = 0; d < 8; ++d) M2_LOAD(d, d);
    M2_WRITE(0, 0);
    const bool do_n = (vs == 0 && vi == 0);
    f32x4 acc = {0.f, 0.f, 0.f, 0.f}; float nacc = 0.f;
#pragma unroll 1
    for (int st8 = 0; st8 < NCH; st8 += 8) {
#pragma unroll
        for (int u = 0; u < 8; ++u) {
            const int st = st8 + u;
            const int c = dir ? NCH - 1 - st : st;
            asm volatile("s_waitcnt lgkmcnt(0)" ::: "memory"); __builtin_amdgcn_s_barrier(); asm volatile("" ::: "memory");
            if (st + 1 < NCH) M2_WRITE((u + 1) & 7, (u + 1) & 1);
            if (st + 8 < NCH) M2_LOAD(u, st + 8);
            { bf16_t* cp = CST + ((size_t)dh * NCH + c) * (DH * DH) + (size_t)(v0 + 4 * g) * DH + k0 + r;
#pragma unroll
              for (int i = 0; i < 4; ++i) cp[(size_t)i * DH] = f2bf(acc[i]);
              if (do_n && g == 0) NST[((size_t)dh * NCH + c) * DH + k0 + r] = nacc; }
            const float dec = s_dec[c];
            acc = acc * dec; nacc *= dec;
            float nsum = 0.f;
            const char* tbuf = tb + (u & 1) * M2_TB;
#pragma unroll
            for (int ks = 0; ks < 4; ++ks) {
                const int sl = ((4 * ks + g) ^ r) << 4;
                const u32x4 av = *(const u32x4*)(tbuf + la + sl), bv = *(const u32x4*)(tbuf + lb + sl);
                const f32x4 w0 = *(const f32x4*)(s_w + LCH * c + 32 * ks + 8 * g), w1 = *(const f32x4*)(s_w + LCH * c + 32 * ks + 8 * g + 4);
                float a[8], b[8]; unpack8(av, a); unpack8(bv, b);
#pragma unroll
                for (int j = 0; j < 4; ++j) { a[j] *= w0[j]; a[4 + j] *= w1[j]; nsum += w0[j] * b[j] + w1[j] * b[4 + j]; }
                const u32x4 aw = pack8(a);
                acc = __builtin_amdgcn_mfma_f32_16x16x32_bf16(*(const bf16x8*)&aw, *(const bf16x8*)&bv, acc, 0, 0, 0);
            }
            nsum += __shfl_xor(nsum, 16); nsum += __shfl_xor(nsum, 32);
            nacc += nsum;
        }
    }
#undef M2_LOAD
#undef M2_WRITE
    __syncthreads();
}

constexpr int M3_LV = 1024, M3_LVS = 272, M3_LC = M3_LV + 256 * M3_LVS, M3_LCS = 528;
static_assert(M3_LC + 128 * M3_LCS <= LDS_BYTES, "M3 LDS");
__device__ __forceinline__ void m3_unit(const Params& P, char* lds, int h, int c) {
    const int tid = tid_opaque(), lane = tid & 63, wid = __builtin_amdgcn_readfirstlane(tid >> 6), r = lane & 15, g = lane >> 4;
    const int T0 = LCH * c, tl = 16 * wid + r;
    const char* QHc = (const char*)(P.ws + WS_QH) + ((size_t)h * SEQ + T0 + 16 * wid) * (DH * 2);
    const char* KHc = (const char*)(P.ws + WS_KH) + ((size_t)h * SEQ + T0) * (DH * 2);
    const char* VTc = (const char*)(P.ws + WS_VT) + ((size_t)h * NCH + c) * (DH * LCH * 2);
    const unsigned o512 = (unsigned)(r * 512 + g * 16);
    float* s_mb = (float*)lds; char* LV = lds + M3_LV; char* LC = lds + M3_LC;
    { u32x4 v[8];
#pragma unroll
      for (int n = 0; n < 8; ++n) v[n] = ldgu<u32x4>(VTc + n * 8192, (unsigned)tid * 16u);
#pragma unroll
      for (int n = 0; n < 8; ++n) *(u32x4*)(LV + ((tid >> 4) + 32 * n) * M3_LVS + (tid & 15) * 16) = v[n]; }
    if (tid == 0 || tid == 64) { const int dir = tid >> 6; const float* BL = (const float*)(P.ws + WS_BL) + (dir * HM + h) * NCH; const float* AC = (const float*)(P.ws + WS_AC) + (dir * HM + h) * NCH;
        float m = -1e30f;
#pragma unroll 1
        for (int st = 0; st < NCH; ++st) { const int cc = dir ? NCH - 1 - st : st; s_mb[dir * NCH + cc] = m; m = fmaxf(BL[cc] + m, AC[cc]); } }
    __syncthreads();
    f32x4 st[8];
    { bf16x8 qf[8];
#pragma unroll
      for (int kd = 0; kd < 8; ++kd) qf[kd] = ldgu<bf16x8>(QHc + 64 * kd, o512);
#pragma unroll
      for (int j = 0; j < 8; ++j) { st[j] = (f32x4){0.f, 0.f, 0.f, 0.f};
#pragma unroll
        for (int kd = 0; kd < 8; ++kd) { const bf16x8 kf = ldgu<bf16x8>(KHc + (16 * j) * 512 + 64 * kd, o512);
            st[j] = __builtin_amdgcn_mfma_f32_16x16x32_bf16(kf, qf[kd], st[j], 0, 0, 0); }
        asm volatile("" ::: "memory"); } }
    f32x4 acc[16];
#pragma unroll
    for (int vt = 0; vt < 16; ++vt) acc[vt] = (f32x4){0.f, 0.f, 0.f, 0.f};
    const char* lvr = LV + r * M3_LVS + g * 8;
    const char* lcr = LC + r * M3_LCS + g * 16;
    char* lcw = LC + (tid >> 5) * M3_LCS + (tid & 31) * 16;
#pragma unroll 1
    for (int dir = 0; dir < 2; ++dir) {
        const int dh = dir * HM + h;
        const char* BCc = (const char*)(P.ws + WS_BC) + ((size_t)dh * SEQ + T0) * 4; const char* IGc = (const char*)(P.ws + WS_IG) + ((size_t)dh * SEQ + T0) * 4;
        const char* PMc = (const char*)(P.ws + WS_PM) + ((size_t)dh * SEQ + T0) * 4;
        const char* Cc = (const char*)(P.ws + WS_CST) + ((size_t)dh * NCH + c) * (DH * DH * 2);
        const char* Nc = (const char*)(P.ws + WS_NST) + ((size_t)dh * NCH + c) * (DH * 4);
        const int fx = dir * 127, tlx = tl ^ fx;
        const float mB = s_mb[dir * NCH + c];
        const float bt = ldgu<float>(BCc, (unsigned)tl * 4u), pm = ldgu<float>(PMc, (unsigned)tl * 4u);
        const float mt = fmaxf(bt + mB, pm); const float alpha = bt - mt; const float winter = __expf(bt + mB - mt);
        float den = 0.f;
#pragma unroll
        for (int j = 0; j < 8; ++j) { const int sb = 16 * j + 4 * g;
            const f32x4 ig = ldgu<f32x4>(IGc + 64 * j, (unsigned)g * 16u), bc = ldgu<f32x4>(BCc + 64 * j, (unsigned)g * 16u);
#pragma unroll
            for (int i = 0; i < 4; ++i) { const int sl = sb + i; const bool ok = ((sl ^ fx) <= tlx);
                const float e = ok ? __expf(alpha + ig[i] - bc[i]) : 0.f; den += st[j][i] * e; }
            if (j & 1) asm volatile("" ::: "memory"); }
        den += __shfl_xor(den, 16); den += __shfl_xor(den, 32);
        float qn = 0.f;
#pragma unroll
        for (int kd = 0; kd < 8; ++kd) { const f32x4 n0 = ldgu<f32x4>(Nc + 128 * kd, (unsigned)g * 32u), n1 = ldgu<f32x4>(Nc + 128 * kd + 16, (unsigned)g * 32u);
            const u32x4 qt = ldgu<u32x4>(QHc + 64 * kd, o512); float q[8]; unpack8(qt, q);
            qn += q[0] * n0[0] + q[1] * n0[1] + q[2] * n0[2] + q[3] * n0[3] + q[4] * n1[0] + q[5] * n1[1] + q[6] * n1[2] + q[7] * n1[3];
            if (kd & 1) asm volatile("" ::: "memory"); }
        qn += __shfl_xor(qn, 16); qn += __shfl_xor(qn, 32);
        const float dtot = den + winter * qn;
        const float hdiv = 1.f / fmaxf(fabsf(dtot), __expf(-mt));
        int tlx2 = tlx; LAUNDER_V(tlx2);
#pragma unroll
        for (int ks = 0; ks < 4; ++ks) {
            float e8[8];
#pragma unroll
            for (int hh = 0; hh < 2; ++hh) { const int j = 2 * ks + hh, sb = 16 * j + 4 * g;
                const f32x4 ig = ldgu<f32x4>(IGc + 64 * j, (unsigned)g * 16u), bc = ldgu<f32x4>(BCc + 64 * j, (unsigned)g * 16u);
#pragma unroll
                for (int i = 0; i < 4; ++i) { const int sl = sb + i; const bool ok = ((sl ^ fx) <= tlx2);
                    const float e = ok ? __expf(alpha + ig[i] - bc[i]) : 0.f; e8[4 * hh + i] = st[j][i] * e * hdiv; } }
            const u32x4 pw = pack8(e8); const bf16x8 pa = *(const bf16x8*)&pw;
#pragma unroll
            for (int vt = 0; vt < 16; ++vt) {
                const u32x2 lo = *(const u32x2*)(lvr + vt * (16 * M3_LVS) + ks * 64), hi2 = *(const u32x2*)(lvr + vt * (16 * M3_LVS) + ks * 64 + 32);
                u32x4 w; w.x = lo.x; w.y = lo.y; w.z = hi2.x; w.w = hi2.y;
                acc[vt] = __builtin_amdgcn_mfma_f32_16x16x32_bf16(pa, *(const bf16x8*)&w, acc[vt], 0, 0, 0); }
        }
        const float qsc = winter * hdiv;
#pragma unroll
        for (int half = 0; half < 2; ++half) {
            __syncthreads();
            { u32x4 v[8];
#pragma unroll
              for (int n = 0; n < 8; ++n) v[n] = ldgu<u32x4>(Cc + half * 65536 + n * 8192, (unsigned)tid * 16u);
#pragma unroll
              for (int n = 0; n < 8; ++n) *(u32x4*)(lcw + n * (16 * M3_LCS)) = v[n]; }
            __syncthreads();
#pragma unroll
            for (int kd = 0; kd < 8; ++kd) { const u32x4 qt = ldgu<u32x4>(QHc + 64 * kd, o512); float q[8]; unpack8(qt, q);
#pragma unroll
                for (int e = 0; e < 8; ++e) q[e] *= qsc;
                const u32x4 qw = pack8(q); const bf16x8 qs = *(const bf16x8*)&qw;
#pragma unroll
                for (int v8 = 0; v8 < 8; ++v8) { const bf16x8 cf = *(const bf16x8*)(lcr + v8 * (16 * M3_LCS) + kd * 64);
                    acc[half * 8 + v8] = __builtin_amdgcn_mfma_f32_16x16x32_bf16(qs, cf, acc[half * 8 + v8], 0, 0, 0); }
            }
        }
    }
    float ss[4] = {0.f, 0.f, 0.f, 0.f};
#pragma unroll
    for (int vt = 0; vt < 16; ++vt)
#pragma unroll
        for (int i = 0; i < 4; ++i) ss[i] += acc[vt][i] * acc[vt][i];
#pragma unroll
    for (int i = 0; i < 4; ++i) { ss[i] += __shfl_xor(ss[i], 1); ss[i] += __shfl_xor(ss[i], 2); ss[i] += __shfl_xor(ss[i], 4); ss[i] += __shfl_xor(ss[i], 8); ss[i] = rsqrtf(ss[i] * (1.f / DH) + EPS); }
    const char* pr0 = (const char*)(P.ws + WS_PROJ) + ((size_t)(T0 + 16 * wid) * DINP + OFF_OM + h * DH) * 2;
    char* mx0 = (char*)(P.ws + WS_MIX) + ((size_t)(T0 + 16 * wid) * DM + 1024 + h * DH) * 2;
    const char* gmp = (const char*)(P.mlstm_norm_g + h * DH);
    const unsigned opr = (unsigned)(4 * g * DINP * 2 + r * 2), omx = (unsigned)(4 * g * DM * 2 + r * 2);
#pragma unroll
    for (int vt = 0; vt < 16; ++vt) { const float gm = ldgu<float>(gmp + 64 * vt, (unsigned)r * 4u);
#pragma unroll
        for (int i = 0; i < 4; ++i) { const float om = bf2f(ldgu<bf16_t>(pr0 + i * (DINP * 2) + 32 * vt, opr));
            *(bf16_t*)(mx0 + i * (DM * 2) + 32 * vt + omx) = f2bf(acc[vt][i] * ss[i] * gm * sigmoid_f(om)); }
        if ((vt & 3) == 3) asm volatile("" ::: "memory"); }
    __syncthreads();
}

__device__ __forceinline__ void phase4(const Params& P, int G) {
    const int tid = tid_opaque(), lane = tid & 63, wave = tid >> 6;
    const int gw = blockIdx.x * NWAVES + wave, NGW = G * NWAVES;
    bf16_t* Q = (bf16_t*)(P.ws + WS_Q); bf16_t* K = (bf16_t*)(P.ws + WS_K); const bf16_t* KV = (const bf16_t*)(P.ws + WS_KV); const bf16_t* proj = (const bf16_t*)(P.ws + WS_PROJ);
    const f32x4* rt = (const f32x4*)(P.ws + WS_ROPE);
    const int i = lane & 7, hh = lane >> 3; const bool lo = i < 4;
    float gq[3][8], gk[3][8];
#pragma unroll
    for (int j = 0; j < 3; ++j)
#pragma unroll
        for (int e = 0; e < 8; ++e) { gq[j][e] = P.q_norm_g[8 * (i + 8 * j) + e]; gk[j][e] = P.k_norm_g[8 * (i + 8 * j) + e]; }
    for (int t = gw; t < SEQ; t += NGW) {
        float cs[8], sn[8];
#pragma unroll
        for (int e2 = 0; e2 < 4; ++e2) { const f32x4 v = rt[(size_t)t * 16 + 4 * (i & 3) + e2]; cs[2 * e2] = v[0]; sn[2 * e2] = v[1]; cs[2 * e2 + 1] = v[2]; sn[2 * e2 + 1] = v[3]; }
#pragma unroll
        for (int which = 0; which < 2; ++which) {
            u32x4 w0, w1, w2; bf16_t* dst;
            if (which == 0) { bf16_t* qp = Q + (size_t)t * (NH * DQK) + hh * DQK + 8 * i; w0 = *(const u32x4*)qp; w1 = *(const u32x4*)(qp + 64); w2 = *(const u32x4*)(qp + 128); dst = qp; }
            else { const bf16_t* kp = KV + (size_t)t * (NH * 256) + hh * 256 + 8 * i; w0 = *(const u32x4*)kp; w1 = *(const u32x4*)(kp + 64);
                   w2 = *(const u32x4*)(proj + (size_t)t * DINP + OFF_KPE + 8 * i); dst = K + (size_t)t * (NH * DQK) + hh * DQK + 8 * i; }
            float a0[8], a1[8], a2[8]; unpack8(w0, a0); unpack8(w1, a1); unpack8(w2, a2);
            float ss = 0.f;
#pragma unroll
            for (int e = 0; e < 8; ++e) ss += a0[e] * a0[e] + a1[e] * a1[e] + a2[e] * a2[e];
            ss += __shfl_xor(ss, 1); ss += __shfl_xor(ss, 2); ss += __shfl_xor(ss, 4);
            const float rs = rsqrtf(ss * (1.f / DQK) + EPS);
#pragma unroll
            for (int e = 0; e < 8; ++e) { const float g0 = which ? gk[0][e] : gq[0][e], g1 = which ? gk[1][e] : gq[1][e], g2 = which ? gk[2][e] : gq[2][e];
                a0[e] *= rs * g0; a1[e] *= rs * g1; a2[e] *= rs * g2; }
            float o2[8];
#pragma unroll
            for (int e = 0; e < 8; ++e) { const float pr = __shfl_xor(a2[e], 4);
                o2[e] = lo ? (a2[e] * cs[e] - pr * sn[e]) : (pr * sn[e] + a2[e] * cs[e]); }
            *(u32x4*)dst = pack8(a0); *(u32x4*)(dst + 64) = pack8(a1); *(u32x4*)(dst + 128) = pack8(o2);
        }
    }
}

struct StoreProj { bf16_t* proj; float* gates;
    __device__ __forceinline__ void operator()(int row, int col, f32x4 v0, f32x4 v1) const {
        u32x4 w; w.x = cvt_pk_bf16(v0[0], v0[1]); w.y = cvt_pk_bf16(v0[2], v0[3]); w.z = cvt_pk_bf16(v1[0], v1[1]); w.w = cvt_pk_bf16(v1[2], v1[3]);
        *(u32x4*)(proj + (size_t)row * DINP + col) = w;
        if (col >= OFF_GM && col < OFF_GM + 16) { float* gp = gates + (size_t)row * 16 + (col - OFF_GM); *(f32x4*)gp = v0; *(f32x4*)(gp + 4) = v1; } } };
struct StoreQ { bf16_t* q;
    __device__ __forceinline__ void operator()(int row, int col, f32x4 v0, f32x4 v1) const {
        const int h = col >> 8, ct = col & 255;
        if (ct < DQK) { u32x4 w; w.x = cvt_pk_bf16(v0[0], v0[1]); w.y = cvt_pk_bf16(v0[2], v0[3]); w.z = cvt_pk_bf16(v1[0], v1[1]); w.w = cvt_pk_bf16(v1[2], v1[3]);
            *(u32x4*)(q + (size_t)row * (NH * DQK) + h * DQK + ct) = w; } } };
struct StoreKV { bf16_t* kv;
    __device__ __forceinline__ void operator()(int row, int col, f32x4 v0, f32x4 v1) const {
        u32x4 w; w.x = cvt_pk_bf16(v0[0], v0[1]); w.y = cvt_pk_bf16(v0[2], v0[3]); w.z = cvt_pk_bf16(v1[0], v1[1]); w.w = cvt_pk_bf16(v1[2], v1[3]);
        *(u32x4*)(kv + (size_t)row * (NH * 256) + col) = w; } };
struct StoreX1 { const float* x; const float* gate; float* out;
    __device__ __forceinline__ void operator()(int row, int col, f32x4 v) const {
        const size_t off = (size_t)row * DM + col; const f32x4 xv = *(const f32x4*)(x + off); const f32x4 gv = *(const f32x4*)(gate + col);
        *(f32x4*)(out + off) = xv + gv * v; } };
struct StoreAct { bf16_t* act;
    __device__ __forceinline__ void operator()(int row, int col, f32x4 v0, f32x4 v1) const {
        float f[8] = {v0[0], v0[1], v0[2], v0[3], v1[0], v1[1], v1[2], v1[3]};
#pragma unroll
        for (int e = 0; e < 8; ++e) { const float rl = fmaxf(f[e], 0.f); f[e] = rl * rl; }
        *(u32x4*)(act + (size_t)row * DFF + col) = pack8(f); } };

constexpr int NPH = 11;
#ifdef ONLY_PH
#define PH_ON(n) ((n) == ONLY_PH)
#else
#define PH_ON(n) 1
#endif
#define CAS __attribute__((address_space(4)))
__device__ __forceinline__ Params load_params(const CAS Params* kp) {
#if defined(__HIP_DEVICE_COMPILE__)
    unsigned long long kv = (unsigned long long)kp; asm volatile("" : "+s"(kv)); return *(const CAS Params*)kv;
#else
    return Params{};
#endif
}
__global__ void __launch_bounds__(NTHREADS, 2) fwd_kernel(Params Pk) {
    extern __shared__ __attribute__((aligned(16))) char lds[];
    const CAS Params* kp = (const CAS Params*)__builtin_amdgcn_kernarg_segment_ptr();
    const int G0 = gridDim.x; const int bx0 = blockIdx.x;
    const int vcu0 = (G0 % 8 == 0) ? (bx0 % 8) * (G0 / 8) + bx0 / 8 : bx0;
    LAS unsigned char* ldsl = (LAS unsigned char*)lds;
    const int ph_lo = Pk.ph_lo, ph_hi = Pk.ph_hi;
#ifndef DUP_PH
#define DUP_PH (-1)
#endif
#ifndef DUP_SUB
#define DUP_SUB 0
#endif
    for (int ph = ph_lo; ph < ph_hi; ++ph) {
      for (int rep = 0; rep < ((ph == DUP_PH) ? 2 : 1); ++rep) {
        int G = G0, bx = bx0, vcu = vcu0; asm volatile("" : "+s"(G), "+s"(bx), "+s"(vcu));
        switch (ph) {
        case 0: if (PH_ON(0)) { const Params P = load_params(kp); phase0(P, lds, G); } break;
        case 1: if (PH_ON(1)) { const Params P = load_params(kp); phase1a(P, lds, G); } break;
        case 2: if (PH_ON(2)) { const Params P = load_params(kp); unsigned char* ws = P.ws;
                  pg8::Gemm g{(const bf16_t*)(ws + WS_H), (const bf16_t*)(ws + WS_WIN), SEQ, DINP, DM}; pg8::StaticOrder S; S.init(SEQ, DINP, G, bx);
                  pg8::Epi8<StoreProj> E{{(bf16_t*)(ws + WS_PROJ), (float*)(ws + WS_GATES)}};
                  pg8::gemm_phase<pg8::Epi8<StoreProj>, pg8::StaticOrder, true, true>(ldsl, g, S, E); } break;
        case 3: if (PH_ON(3)) { const Params P = load_params(kp); phase2(P, lds, G); } break;
        case 4: if (PH_ON(4)) {
#ifndef NO_G4
#ifndef NO_G4A
                  if (rep == 0 || DUP_SUB == 0 || DUP_SUB == 1) { const Params P = load_params(kp); unsigned char* ws = P.ws;
                    pg8::Gemm g{(const bf16_t*)(ws + WS_CQN), (const bf16_t*)(ws + WS_WUQ), SEQ, NH * 256, QLORA}; pg8::StaticOrder S; S.init(SEQ, NH * 256, G, bx);
                    pg8::Epi8<StoreQ> E{{(bf16_t*)(ws + WS_Q)}};
                    pg8::gemm_phase<pg8::Epi8<StoreQ>, pg8::StaticOrder, true, true>(ldsl, g, S, E); }
#endif
#ifndef NO_G4B
                  if (rep == 0 || DUP_SUB == 0 || DUP_SUB == 2) { const Params P = load_params(kp); unsigned char* ws = P.ws;
                    pg8::Gemm g{(const bf16_t*)(ws + WS_CKVN), (const bf16_t*)(ws + WS_WUKV), SEQ, NH * 256, KVLORA}; pg8::StaticOrder S; S.init(SEQ, NH * 256, G, bx);
                    pg8::Epi8<StoreKV> E{{(bf16_t*)(ws + WS_KV)}};
                    pg8::gemm_phase<pg8::Epi8<StoreKV>, pg8::StaticOrder, true, true>(ldsl, g, S, E); }
#endif
#endif
#ifndef NO_M2
                  if (rep == 0 || DUP_SUB == 0 || DUP_SUB == 3) { const Params P = load_params(kp); for (int b = bx; b < 256; b += G) m2_block(P, lds, b); }
#endif
                  } break;
        case 5: if (PH_ON(5)) { const Params P = load_params(kp); phase4(P, G); } break;
        case 6: if (PH_ON(6)) {
#ifndef NO_ATT
                  if (rep == 0 || DUP_SUB == 0 || DUP_SUB == 1) { const Params P = load_params(kp); unsigned char* ws = P.ws;
                  for (int u = vcu; u < NH * (SEQ / 256); u += G) { const int h = u >> 5, qb = u & 31;
                      att::attn_unit((const bf16_t*)(ws + WS_Q) + (size_t)(qb * 256) * att::LDQ + h * DQK, (const bf16_t*)(ws + WS_K) + h * DQK, (const bf16_t*)(ws + WS_KV) + h * 256 + 128,
                                     (bf16_t*)(ws + WS_MIX) + (size_t)(qb * 256) * DM + h * DV, SEQ, lds); } }
#endif
#ifndef NO_M3
                  if (rep == 0 || DUP_SUB == 0 || DUP_SUB == 2) { const Params P = load_params(kp); for (int u = vcu; u < HM * NCH; u += G) m3_unit(P, lds, u >> 6, u & 63); }
#endif
                  } break;
        case 7: if (PH_ON(7)) { const Params P = load_params(kp); unsigned char* ws = P.ws;
                  pg8::Gemm g{(const bf16_t*)(ws + WS_MIX), (const bf16_t*)(ws + WS_WOUT), SEQ, DM, DM}; pg8::StaticOrder S; S.init(SEQ, DM, G, bx);
                  pg8::Epi4<StoreX1> E{{P.x, (const float*)(ws + WS_MOD) + 2 * DM, P.out}};
                  pg8::gemm_phase<pg8::Epi4<StoreX1>, pg8::StaticOrder, true, true>(ldsl, g, S, E); } break;
        case 8: if (PH_ON(8)) { const Params P = load_params(kp); phase6b(P, lds, G); } break;
        case 9: if (PH_ON(9)) { const Params P = load_params(kp); unsigned char* ws = P.ws;
                  pg8::Gemm g{(const bf16_t*)(ws + WS_H), (const bf16_t*)(ws + WS_W1), SEQ, DFF, DM}; pg8::StaticOrder S; S.init(SEQ, DFF, G, bx);
                  pg8::Epi8<StoreAct> E{{(bf16_t*)(ws + WS_ACT)}};
                  pg8::gemm_phase<pg8::Epi8<StoreAct>, pg8::StaticOrder, true, true>(ldsl, g, S, E); } break;
        case 10: if (PH_ON(10)) { const Params P = load_params(kp); unsigned char* ws = P.ws;
                  pg8::Gemm g{(const bf16_t*)(ws + WS_ACT), (const bf16_t*)(ws + WS_W2), SEQ, DM, DFF}; pg8::StaticOrder S; S.init(SEQ, DM, G, bx);
                  pg8::Epi4<StoreX1> E{{P.out, (const float*)(ws + WS_MOD) + 5 * DM, P.out}};
                  pg8::gemm_phase<pg8::Epi4<StoreX1>, pg8::StaticOrder, true, true>(ldsl, g, S, E); } break;
        default: break;
        }
        if (ph + 1 < ph_hi || rep == 0 && ph == DUP_PH) { cg::this_grid().sync(); }
      }
    }
}

extern "C" void kernel_launch(void* const* d_in, const int* in_sizes, int n_in, void* d_out, int out_size, void* d_ws, size_t ws_size, hipStream_t stream) {
    static int grid = 0;
    if (grid == 0) {
        if (n_in != 21 || out_size != SEQ * DM || ws_size < WS_END) { fprintf(stderr, "kernel_launch: unexpected shapes n_in %d out %d ws %zu\n", n_in, out_size, ws_size); grid = -1; return; }
        int dev = 0, cus = 0, per_cu = 0;
        if (hipGetDevice(&dev) != hipSuccess || hipDeviceGetAttribute(&cus, hipDeviceAttributeMultiprocessorCount, dev) != hipSuccess) { grid = -1; return; }
        if (hipFuncSetAttribute((const void*)fwd_kernel, hipFuncAttributeMaxDynamicSharedMemorySize, LDS_BYTES) != hipSuccess) { fprintf(stderr, "kernel_launch: hipFuncSetAttribute failed\n"); grid = -1; return; }
        if (hipOccupancyMaxActiveBlocksPerMultiprocessor(&per_cu, (const void*)fwd_kernel, NTHREADS, LDS_BYTES) != hipSuccess || per_cu < 1) { fprintf(stderr, "kernel_launch: occupancy query says %d\n", per_cu); per_cu = 1; }
        (void)hipGetLastError();
        grid = cus * 1;
    }
    if (grid < 0) return;
    Params p{};
    p.x = (const float*)d_in[0]; p.c = (const float*)d_in[1]; p.pos = (const int*)d_in[2]; p.w_ada = (const float*)d_in[3]; p.b_ada = (const float*)d_in[4];
    p.norm_mix_g = (const float*)d_in[5]; p.w_in = (const float*)d_in[6]; p.b_gates = (const float*)d_in[7]; p.conv_w = (const float*)d_in[8]; p.conv_b = (const float*)d_in[9];
    p.q_lora_g = (const float*)d_in[10]; p.w_uq = (const float*)d_in[11]; p.kv_lora_g = (const float*)d_in[12]; p.w_ukv = (const float*)d_in[13]; p.q_norm_g = (const float*)d_in[14];
    p.k_norm_g = (const float*)d_in[15]; p.mlstm_norm_g = (const float*)d_in[16]; p.w_out = (const float*)d_in[17]; p.norm_mlp_g = (const float*)d_in[18];
    p.w_ff1 = (const float*)d_in[19]; p.w_ff2 = (const float*)d_in[20];
    p.out = (float*)d_out; p.ws = (unsigned char*)d_ws;
#if MK_MULTI
    for (int ph = 0; ph < NPH; ++ph) { p.ph_lo = ph; p.ph_hi = ph + 1; hipLaunchKernelGGL(fwd_kernel, dim3(grid), dim3(NTHREADS), LDS_BYTES, stream, p); }
#else
    p.ph_lo = 0; p.ph_hi = NPH;
    void* args[] = {&p};
    hipError_t e = hipLaunchCooperativeKernel((const void*)fwd_kernel, dim3(grid), dim3(NTHREADS), args, LDS_BYTES, stream);
    if (e != hipSuccess) fprintf(stderr, "kernel_launch: cooperative launch failed: %s (grid %d)\n", hipGetErrorString(e), grid);
#endif
}
```

```cpp
#include <hip/hip_runtime.h>
#include <hip/hip_cooperative_groups.h>
#include <cstdio>
#include <cstdint>
namespace cg = cooperative_groups;

#ifndef MK_MULTI
#define MK_MULTI 0
#endif

#define LAS __attribute__((address_space(3)))
typedef unsigned short bf16_t;
typedef short bf16x8 __attribute__((ext_vector_type(8)));
typedef short s16x4 __attribute__((ext_vector_type(4)));
typedef float f32x4 __attribute__((ext_vector_type(4)));
typedef float f32x2 __attribute__((ext_vector_type(2)));
typedef float f32x16 __attribute__((ext_vector_type(16)));
typedef unsigned u32x4 __attribute__((ext_vector_type(4)));
typedef unsigned u32x2 __attribute__((ext_vector_type(2)));

constexpr int SEQ = 8192, DM = 2048, DIN = 4944, DINP = 5120, DFF = 8192;
constexpr int NH = 8, DQK = 192, DV = 128, QLORA = 512, KVLORA = 256;
constexpr int HM = 4, DH = 256, LCH = 128, NCH = 64;
constexpr int OFF_CQ = 0, OFF_CKV = 512, OFF_KPE = 768, OFF_QM = 832, OFF_KM = 1856, OFF_VM = 2880, OFF_OM = 3904, OFF_GM = 4928;
constexpr float EPS = 1e-6f;
constexpr int NTHREADS = 512, NWAVES = 8;
constexpr int LDS_BYTES = 147456;
constexpr int LDS_BARST = LDS_BYTES - 64;

constexpr size_t MiB = 1u << 20;
constexpr size_t WS_MODP = 0;
constexpr size_t WS_MOD = 786432;
constexpr size_t WS_BC = 1 * MiB;
constexpr size_t WS_IG = WS_BC + 262144;
constexpr size_t WS_PM = WS_IG + 262144;
constexpr size_t WS_WL = WS_PM + 262144;
constexpr size_t WS_BAR = 868352;
constexpr size_t WS_BL = 851968;
constexpr size_t WS_AC = 856064;
constexpr size_t WS_WIN = 2 * MiB, WS_WUQ = 22 * MiB, WS_WUKV = 24 * MiB, WS_WOUT = 26 * MiB;
constexpr size_t WS_CST = 34 * MiB;
constexpr size_t WS_W1 = 34 * MiB, WS_W2 = 66 * MiB;
constexpr size_t WS_H = 98 * MiB;
constexpr size_t WS_Q = 98 * MiB;
constexpr size_t WS_MIX = 130 * MiB;
constexpr size_t WS_PROJ = 162 * MiB;
constexpr size_t WS_CQN = 242 * MiB, WS_CKVN = 250 * MiB;
constexpr size_t WS_GATES = 254 * MiB;
constexpr size_t WS_NST = 255 * MiB;
constexpr size_t WS_ACT = 130 * MiB;
constexpr size_t WS_KV = 258 * MiB;
constexpr size_t WS_K = 290 * MiB;
constexpr size_t WS_QH = 314 * MiB, WS_KH = 330 * MiB, WS_KT = 346 * MiB, WS_VT = 362 * MiB;
constexpr size_t WS_ROPE = 378 * MiB;
constexpr size_t WS_END = 380 * MiB;

struct Params {
    const float* x; const float* c; const int* pos; const float* w_ada; const float* b_ada; const float* norm_mix_g; const float* w_in;
    const float* b_gates; const float* conv_w; const float* conv_b; const float* q_lora_g; const float* w_uq; const float* kv_lora_g;
    const float* w_ukv; const float* q_norm_g; const float* k_norm_g; const float* mlstm_norm_g; const float* w_out; const float* norm_mlp_g;
    const float* w_ff1; const float* w_ff2;
    float* out; unsigned char* ws; int ph_lo, ph_hi;
};

#define LAUNDER_V(x) asm volatile("" : "+v"(x))
#define LAUNDER_S(x) asm volatile("" : "+s"(x))
__device__ __forceinline__ int tid_opaque() { int t = threadIdx.x; LAUNDER_V(t); return t; }
__device__ __forceinline__ unsigned cvt_pk_bf16(float lo, float hi) { unsigned r; asm volatile("v_cvt_pk_bf16_f32 %0, %1, %2" : "=v"(r) : "v"(lo), "v"(hi)); return r; }
__device__ __forceinline__ float bf_lo(unsigned w) { return __uint_as_float(w << 16); }
__device__ __forceinline__ float bf_hi(unsigned w) { return __uint_as_float(w & 0xffff0000u); }
__device__ __forceinline__ float bf2f(bf16_t b) { return __uint_as_float(((unsigned)b) << 16); }
__device__ __forceinline__ bf16_t f2bf(float f) { return (bf16_t)(cvt_pk_bf16(f, 0.f) & 0xffffu); }
__device__ __forceinline__ float wave_sum(float v) {
#pragma unroll
    for (int o = 1; o < 64; o <<= 1) v += __shfl_xor(v, o);
    return v;
}
template <class T> __device__ __forceinline__ T ldgu(const void* ubase, unsigned voff) { return *(const T*)((const char*)ubase + voff); }
__device__ __forceinline__ float silu_f(float v) { return v / (1.f + __expf(-v)); }
__device__ __forceinline__ float sigmoid_f(float v) { return 1.f / (1.f + __expf(-v)); }
__device__ __forceinline__ void unpack8(u32x4 w, float* f) {
    f[0] = bf_lo(w.x); f[1] = bf_hi(w.x); f[2] = bf_lo(w.y); f[3] = bf_hi(w.y); f[4] = bf_lo(w.z); f[5] = bf_hi(w.z); f[6] = bf_lo(w.w); f[7] = bf_hi(w.w);
}
__device__ __forceinline__ u32x4 pack8(const float* f) {
    u32x4 w; w.x = cvt_pk_bf16(f[0], f[1]); w.y = cvt_pk_bf16(f[2], f[3]); w.z = cvt_pk_bf16(f[4], f[5]); w.w = cvt_pk_bf16(f[6], f[7]); return w;
}

namespace pg8 {
constexpr int BM = 256, BK = 64, HALF = 128, HTB = HALF * BK * 2, STAGE_BYTES = 8 * HTB, NXCD = 8, WGM = 8;
__host__ __device__ __forceinline__ int lds_byte(int r, int c) { const int st = (r >> 4) * 2 + (c >> 5), rr = r & 15, cc = c & 31, ob = rr * 64 + cc * 2; return st * 1024 + (ob ^ (((ob >> 9) & 1) << 5)); }
__host__ __device__ __forceinline__ void stage_rc(int b, int& R, int& C) { const int st = b / 1024, sb = b % 1024, swz = sb ^ (((sb >> 9) & 1) << 5); R = (st >> 1) * 16 + swz / 64; C = (st & 1) * 32 + (swz % 64) / 2; }
__host__ __device__ __forceinline__ int perm32(int rho) { const int n = rho >> 4, i = rho & 15; return 8 * (i >> 2) + 4 * n + (i & 3); }
struct Unit { int pm, pn; };
struct Gemm { const bf16_t* A; const bf16_t* Bt; int M, N, K; };
struct StaticOrder {
    int nM, nN, nwg, G, c;
    __host__ __device__ void init(int M, int N, int G_, int c_) { nM = M / BM; nN = N / BM; nwg = nM * nN; G = G_; c = c_; }
    __host__ __device__ bool next(int i, Unit& u) const {
        const long L = (long)i * G + c; if (L >= nwg) return false;
        int wgid = (int)L; { const int q = nwg / NXCD, r = nwg % NXCD, xcd = wgid % NXCD, off = wgid / NXCD; wgid = (xcd < r ? xcd * (q + 1) : r * (q + 1) + (xcd - r) * q) + off; }
        const int nig = WGM * nN, gid = wgid / nig, fm = gid * WGM, gsz = (nM - fm) < WGM ? (nM - fm) : WGM;
        u.pm = fm + ((wgid % nig) % gsz); u.pn = (wgid % nig) / gsz; return true;
    }
    __device__ __forceinline__ void a_ready(const Unit&) const {}
    __device__ __forceinline__ void done(const Unit&) const {}
};
template <class F> struct Epi8 {
    static constexpr bool PERM = true, AFTER_DRAIN = false; F f;
    __device__ __forceinline__ void operator()(const f32x4 (&acc)[2][2][4][2], const Unit& u, int wr, int wc, int fr, int fq) const {
        const int row0 = u.pm * BM + wr * 64 + fr, col0 = u.pn * BM + wc * 32 + 8 * fq;
#pragma unroll
        for (int ai = 0; ai < 2; ++ai)
#pragma unroll
            for (int m = 0; m < 4; ++m)
#pragma unroll
                for (int bj = 0; bj < 2; ++bj) f(row0 + ai * HALF + m * 16, col0 + bj * HALF, acc[ai][bj][m][0], acc[ai][bj][m][1]);
    }
};
template <class F> struct Epi4 {
    static constexpr bool PERM = false, AFTER_DRAIN = false; F f;
    __device__ __forceinline__ void operator()(const f32x4 (&acc)[2][2][4][2], const Unit& u, int wr, int wc, int fr, int fq) const {
        const int row0 = u.pm * BM + wr * 64 + fr, col0 = u.pn * BM + wc * 32 + 4 * fq;
#pragma unroll
        for (int ai = 0; ai < 2; ++ai)
#pragma unroll
            for (int m = 0; m < 4; ++m) {
#pragma unroll
                for (int bj = 0; bj < 2; ++bj)
#pragma unroll
                    for (int n = 0; n < 2; ++n) f(row0 + ai * HALF + m * 16, col0 + bj * HALF + n * 16, acc[ai][bj][m][n]);
                if (m & 1) asm volatile("" ::: "memory");
            }
    }
};

template <class Epi, class Sched, bool ALIGN_EPI = false, bool SP2 = false>
__device__ __forceinline__ void gemm_phase(LAS unsigned char* lds, const Gemm g, const Sched& S, const Epi& E) {
    const int tid = tid_opaque(), wid = __builtin_amdgcn_readfirstlane(tid >> 6), lane = tid & 63, wr = wid >> 2, wc = wid & 3, fr = lane & 15, fq = lane >> 4;
    const int K = g.K, nt = K / BK;
    unsigned voffA[2], voffB[2];
#pragma unroll
    for (int i = 0; i < 2; ++i) { int R, C; stage_rc(tid * 16 + i * 8192, R, C); const int Rb = Epi::PERM ? ((R & ~31) + perm32(R & 31)) : R;
        voffA[i] = (unsigned)(R * K + C) * 2u; voffB[i] = (unsigned)(Rb * K + C) * 2u; }
    const size_t kstep = (size_t)(BK * 2);
    const size_t hstep = (size_t)HALF * K * 2;
    const size_t tstep = 2 * hstep;
    const unsigned ldsw = (unsigned)wid * 1024u;
    const int aoff = lds_byte(wr * 64 + fr, fq * 8), boff = lds_byte(wc * 32 + fr, fq * 8);
#define PG8_SA(b, h) (((b) * 2 + (h)) * HTB)
#define PG8_SB(b, h) ((4 + (b) * 2 + (h)) * HTB)
#define PG8_STAGE(bufoff, gbase, voff) do { _Pragma("unroll") for (int _i = 0; _i < 2; ++_i) \
        __builtin_amdgcn_global_load_lds((const unsigned*)((const char*)(gbase) + (voff)[_i]), (LAS unsigned*)(lds + (bufoff) + ldsw + _i * 8192), 16, 0, 0); } while (0)
#define PG8_LDA(dst, b, h) do { _Pragma("unroll") for (int m = 0; m < 4; ++m) _Pragma("unroll") for (int k = 0; k < 2; ++k) dst[m][k] = *(const LAS bf16x8*)(lds + PG8_SA(b, h) + aoff + m * 2048 + k * 1024); } while (0)
#define PG8_LDB(dst, b, h) do { _Pragma("unroll") for (int n = 0; n < 2; ++n) _Pragma("unroll") for (int k = 0; k < 2; ++k) dst[n][k] = *(const LAS bf16x8*)(lds + PG8_SB(b, h) + boff + n * 2048 + k * 1024); } while (0)
#define PG8_MMA(ai, bj, At, Bt) do { __builtin_amdgcn_s_setprio(1); _Pragma("unroll") for (int m = 0; m < 4; ++m) _Pragma("unroll") for (int n = 0; n < 2; ++n) _Pragma("unroll") for (int k = 0; k < 2; ++k) \
        acc[ai][bj][m][n] = __builtin_amdgcn_mfma_f32_16x16x32_bf16(Bt[n][k], At[m][k], acc[ai][bj][m][n], 0, 0, 0); __builtin_amdgcn_s_setprio(0); } while (0)
#define PG8_WAIT_V(n) asm volatile("s_waitcnt vmcnt(" #n ")" ::: "memory")
#define PG8_WAIT_L(n) asm volatile("s_waitcnt lgkmcnt(" #n ")" ::: "memory")
#define PG8_BAR __builtin_amdgcn_s_barrier()
#define PG8_SCHED __builtin_amdgcn_sched_barrier(0)
    Unit cur, nxt; int ui = 0;
    if (!S.next(0, cur)) return;
    f32x4 acc[2][2][4][2];
#pragma unroll
    for (int a = 0; a < 2; ++a)
#pragma unroll
        for (int b = 0; b < 2; ++b)
#pragma unroll
            for (int m = 0; m < 4; ++m)
#pragma unroll
                for (int n = 0; n < 2; ++n) acc[a][b][m][n] = (f32x4){0.f, 0.f, 0.f, 0.f};
    bf16x8 At[4][2], B0[2][2], B1[2][2];
    const char* cA = (const char*)g.A + (size_t)cur.pm * tstep; const char* cB = (const char*)g.Bt + (size_t)cur.pn * tstep;
    S.a_ready(cur);
    if constexpr (SP2) {
        PG8_STAGE(PG8_SB(0, 0), cB, voffB); PG8_STAGE(PG8_SB(0, 1), cB + hstep, voffB); PG8_STAGE(PG8_SA(0, 0), cA, voffA); PG8_STAGE(PG8_SA(0, 1), cA + hstep, voffA);
        if (wr == 1) PG8_BAR;
        PG8_WAIT_V(2); PG8_BAR;
        PG8_STAGE(PG8_SB(1, 0), cB + kstep, voffB); PG8_STAGE(PG8_SA(1, 0), cA + kstep, voffA); PG8_STAGE(PG8_SB(1, 1), cB + hstep + kstep, voffB);
        PG8_WAIT_V(6); PG8_BAR;
    } else {
        PG8_STAGE(PG8_SB(0, 0), cB, voffB); PG8_STAGE(PG8_SA(0, 0), cA, voffA); PG8_STAGE(PG8_SB(0, 1), cB + hstep, voffB); PG8_STAGE(PG8_SA(0, 1), cA + hstep, voffA);
        if (wr == 1) PG8_BAR;
        PG8_WAIT_V(4); PG8_BAR;
        PG8_STAGE(PG8_SB(1, 0), cB + kstep, voffB); PG8_STAGE(PG8_SA(1, 0), cA + kstep, voffA); PG8_STAGE(PG8_SB(1, 1), cB + hstep + kstep, voffB);
        PG8_WAIT_V(6); PG8_BAR;
    }
    for (;;) {
        const bool has_next = S.next(ui + 1, nxt);
        const char* nA = has_next ? (const char*)g.A + (size_t)nxt.pm * tstep : cA; const char* nB = has_next ? (const char*)g.Bt + (size_t)nxt.pn * tstep : cB;
#pragma unroll 1
        for (int t = 0; t < nt; t += 2) {
            const bool last = (t == nt - 2);
            const char* a1 = cA + (size_t)(t + 1) * kstep;
            const char* a2 = last ? nA : cA + (size_t)(t + 2) * kstep; const char* b2 = last ? nB : cB + (size_t)(t + 2) * kstep;
            const char* a3 = a2 + kstep; const char* b3 = b2 + kstep;
            if (last && has_next) S.a_ready(nxt);
            if constexpr (SP2) {
            PG8_LDB(B0, 0, 0); PG8_LDB(B1, 0, 1); PG8_SCHED; PG8_LDA(At, 0, 0); PG8_STAGE(PG8_SA(1, 1), a1 + hstep, voffA);
            PG8_WAIT_V(8); PG8_WAIT_L(0); PG8_BAR; PG8_MMA(0, 0, At, B0); PG8_MMA(0, 1, At, B1); PG8_BAR; PG8_SCHED;
            PG8_LDA(At, 0, 1); PG8_STAGE(PG8_SB(0, 0), b2, voffB); PG8_STAGE(PG8_SB(0, 1), b2 + hstep, voffB); PG8_STAGE(PG8_SA(0, 0), a2, voffA);
            PG8_WAIT_V(8); PG8_WAIT_L(0); PG8_BAR; PG8_MMA(1, 0, At, B0); PG8_MMA(1, 1, At, B1); PG8_BAR; PG8_SCHED;
            PG8_LDB(B0, 1, 0); PG8_LDB(B1, 1, 1); PG8_SCHED; PG8_LDA(At, 1, 0); PG8_STAGE(PG8_SA(0, 1), a2 + hstep, voffA);
            PG8_WAIT_V(8); PG8_WAIT_L(0); PG8_BAR; PG8_MMA(0, 0, At, B0); PG8_MMA(0, 1, At, B1); PG8_BAR; PG8_SCHED;
            PG8_LDA(At, 1, 1); PG8_STAGE(PG8_SB(1, 0), b3, voffB); PG8_STAGE(PG8_SB(1, 1), b3 + hstep, voffB); PG8_STAGE(PG8_SA(1, 0), a3, voffA);
            PG8_WAIT_V(8); PG8_WAIT_L(0); PG8_BAR; PG8_MMA(1, 0, At, B0); PG8_MMA(1, 1, At, B1); PG8_BAR; PG8_SCHED;
            } else {
            PG8_LDB(B0, 0, 0); PG8_SCHED; PG8_LDA(At, 0, 0); PG8_STAGE(PG8_SA(1, 1), a1 + hstep, voffA);
            PG8_WAIT_L(8); PG8_BAR; PG8_WAIT_L(0); PG8_MMA(0, 0, At, B0); PG8_BAR; PG8_SCHED;
            PG8_LDB(B1, 0, 1); PG8_STAGE(PG8_SB(0, 0), b2, voffB);
            PG8_BAR; PG8_WAIT_L(0); PG8_MMA(0, 1, At, B1); PG8_BAR;
            PG8_LDA(At, 0, 1); PG8_STAGE(PG8_SA(0, 0), a2, voffA);
            PG8_BAR; PG8_WAIT_L(0); PG8_MMA(1, 0, At, B0); PG8_BAR; PG8_SCHED;
            PG8_STAGE(PG8_SB(0, 1), b2 + hstep, voffB);
            PG8_WAIT_V(6); PG8_BAR; PG8_MMA(1, 1, At, B1); PG8_BAR;
            PG8_LDB(B0, 1, 0); PG8_SCHED; PG8_LDA(At, 1, 0); PG8_STAGE(PG8_SA(0, 1), a2 + hstep, voffA);
            PG8_WAIT_L(8); PG8_BAR; PG8_WAIT_L(0); PG8_MMA(0, 0, At, B0); PG8_BAR; PG8_SCHED;
            PG8_LDB(B1, 1, 1); PG8_STAGE(PG8_SB(1, 0), b3, voffB);
            PG8_BAR; PG8_WAIT_L(0); PG8_MMA(0, 1, At, B1); PG8_BAR;
            PG8_LDA(At, 1, 1); PG8_STAGE(PG8_SA(1, 0), a3, voffA);
            PG8_BAR; PG8_WAIT_L(0); PG8_MMA(1, 0, At, B0); PG8_BAR; PG8_SCHED;
            PG8_STAGE(PG8_SB(1, 1), b3 + hstep, voffB);
            PG8_WAIT_V(6); PG8_BAR; PG8_MMA(1, 1, At, B1); PG8_BAR;
            }
        }
        if constexpr (ALIGN_EPI) { if (wr == 0) PG8_BAR; }
        if constexpr (!Epi::AFTER_DRAIN) { E(acc, cur, wr, wc, fr, fq); S.done(cur); }
        if (!has_next) break;
#pragma unroll
        for (int a = 0; a < 2; ++a)
#pragma unroll
            for (int b = 0; b < 2; ++b)
#pragma unroll
                for (int m = 0; m < 4; ++m)
#pragma unroll
                    for (int n = 0; n < 2; ++n) acc[a][b][m][n] = (f32x4){0.f, 0.f, 0.f, 0.f};
        cur = nxt; cA = nA; cB = nB; ++ui;
        if constexpr (ALIGN_EPI) { if (wr == 1) PG8_BAR; }
    }
    PG8_WAIT_V(0);
    if constexpr (!ALIGN_EPI) { if (wr == 0) PG8_BAR; }
    PG8_BAR;
#undef PG8_SA
#undef PG8_SB
#undef PG8_STAGE
#undef PG8_LDA
#undef PG8_LDB
#undef PG8_MMA
#undef PG8_WAIT_V
#undef PG8_WAIT_L
#undef PG8_BAR
#undef PG8_SCHED
}
}

namespace att {
constexpr int NW = 8, QBLK = 32, KVBLK = 64;
constexpr int LDQ = NH * DQK, LDK = NH * DQK, LDV = NH * 256, LDO = DM;
constexpr float SCALE = 0.07216878364870322f;
constexpr float THR = 8.f;
constexpr int SHM_K = KVBLK * DQK * 2, SHM_V = KVBLK * DV * 2;
constexpr int SHM_QL = 2 * SHM_V + 2 * SHM_K + NW * 64 * 4;
constexpr int SHM_ATTN = SHM_QL + NW * 4096;
#define KSWZ(row, colB) ((row) * 384 + ((colB) ^ ((((row) >> 1) & 7) << 4)))
#define SBAR() __builtin_amdgcn_sched_barrier(0)
__device__ __forceinline__ int crow(int r, int hi) { return (r & 3) + 8 * (r >> 2) + 4 * hi; }
__device__ __forceinline__ void partialSM(f32x16& p0, f32x16& p1, float& m_reg, float& mn, float& alpha) {
    constexpr float C = SCALE * 1.4426950408889634f;
    float pmax = p0[0];
#pragma unroll
    for (int r = 1; r < 16; ++r) pmax = fmaxf(pmax, p0[r]);
#pragma unroll
    for (int r = 0; r < 16; ++r) pmax = fmaxf(pmax, p1[r]);
    { auto rr = __builtin_amdgcn_permlane32_swap(__float_as_uint(pmax), __float_as_uint(pmax), false, false);
      pmax = fmaxf(__uint_as_float(rr[0]), __uint_as_float(rr[1])); }
    if (__builtin_expect(__all(pmax - m_reg <= THR / SCALE), 1)) { mn = m_reg; alpha = 1.f; }
    else { mn = fmaxf(m_reg, pmax); alpha = __builtin_amdgcn_exp2f((m_reg - mn) * C); m_reg = mn; }
    float mnC = -mn * C;
#pragma unroll
    for (int r = 0; r < 16; ++r) p0[r] = fmaf(p0[r], C, mnC);
#pragma unroll
    for (int r = 0; r < 16; ++r) p1[r] = fmaf(p1[r], C, mnC);
#pragma unroll
    for (int r = 0; r < 16; ++r) p0[r] = __builtin_amdgcn_exp2f(p0[r]);
}
__device__ __forceinline__ void finishSM(f32x16& p0, f32x16& p1, float alpha, float& l_reg, bf16x8& pa0, bf16x8& pa1, bf16x8& pa2, bf16x8& pa3) {
#pragma unroll
    for (int r = 0; r < 16; ++r) p1[r] = __builtin_amdgcn_exp2f(p1[r]);
    float ps = 0;
#pragma unroll
    for (int r = 0; r < 16; ++r) ps += p0[r];
#pragma unroll
    for (int r = 0; r < 16; ++r) ps += p1[r];
    { auto rr = __builtin_amdgcn_permlane32_swap(__float_as_uint(ps), __float_as_uint(ps), false, false);
      ps = __uint_as_float(rr[0]) + __uint_as_float(rr[1]); }
    l_reg = l_reg * alpha + ps;
#define PK4(P, BASE, OUT) do { unsigned a0 = cvt_pk_bf16(P[BASE + 0], P[BASE + 1]), a1 = cvt_pk_bf16(P[BASE + 2], P[BASE + 3]);   \
    unsigned b0 = cvt_pk_bf16(P[BASE + 4], P[BASE + 5]), b1 = cvt_pk_bf16(P[BASE + 6], P[BASE + 7]);                              \
    auto r0 = __builtin_amdgcn_permlane32_swap(a0, b0, false, false); auto r1 = __builtin_amdgcn_permlane32_swap(a1, b1, false, false); \
    u32x4 w = {r0[0], r1[0], r0[1], r1[1]}; OUT = *reinterpret_cast<bf16x8*>(&w); } while (0)
    PK4(p0, 0, pa0); PK4(p0, 8, pa1); PK4(p1, 0, pa2); PK4(p1, 8, pa3);
#undef PK4
}
__device__ __forceinline__ void qkt(f32x16& p0, f32x16& p1, const char* Ks, const bf16x8* qr, const char* ql, int r32, int hi) {
    p0 = f32x16{}; p1 = f32x16{};
#pragma unroll
    for (int d0 = 0; d0 < 12; ++d0) { const int cb = (d0 * 16 + hi * 8) * 2;
        bf16x8 b0 = *reinterpret_cast<const bf16x8*>(Ks + KSWZ(r32, cb));
        bf16x8 b1 = *reinterpret_cast<const bf16x8*>(Ks + KSWZ(32 + r32, cb));
        const bf16x8 q = d0 < 8 ? qr[d0 < 8 ? d0 : 0] : *reinterpret_cast<const bf16x8*>(ql + (d0 - 8) * 1024);
        p0 = __builtin_amdgcn_mfma_f32_32x32x16_bf16(b0, q, p0, 0, 0, 0);
        p1 = __builtin_amdgcn_mfma_f32_32x32x16_bf16(b1, q, p1, 0, 0, 0); }
}
__device__ __forceinline__ int v_st(int k, int c) { const int kk = (k & ~0xC) | ((k & 4) << 1) | ((k & 8) >> 1); return ((kk >> 3) * 4 + (c >> 5)) * 512 + ((kk & 7) * 32 + (c & 31)) * 2; }
__device__ __forceinline__ int v_rd_base(int lane) { return ((lane & 3) << 3) | (((lane >> 2) & 3) << 6) | (((lane >> 4) & 1) << 5) | (((lane >> 5) & 1) << 8); }
constexpr int v_rd_off(int d0, int ks, int half) { return d0 * 512 + ks * 4096 + half * 2048; }
template <int OFF> __device__ __forceinline__ s16x4 tr_read(int vb) {
    s16x4 r; asm volatile("ds_read_b64_tr_b16 %0, %1 offset:%2" : "=&v"(r) : "v"(vb), "i"(OFF) : "memory"); return r;
}
template <int D0> __device__ __forceinline__ void pv_one(f32x16& od, int vb, bf16x8 pa0, bf16x8 pa1, bf16x8 pa2, bf16x8 pa3) {
    const s16x4 l0 = tr_read<v_rd_off(D0, 0, 0)>(vb), h0 = tr_read<v_rd_off(D0, 0, 1)>(vb), l1 = tr_read<v_rd_off(D0, 1, 0)>(vb), h1 = tr_read<v_rd_off(D0, 1, 1)>(vb);
    const s16x4 l2 = tr_read<v_rd_off(D0, 2, 0)>(vb), h2 = tr_read<v_rd_off(D0, 2, 1)>(vb), l3 = tr_read<v_rd_off(D0, 3, 0)>(vb), h3 = tr_read<v_rd_off(D0, 3, 1)>(vb);
    asm volatile("s_waitcnt lgkmcnt(0)" ::: "memory"); SBAR();
#define PK(L, H) (bf16x8){L[0], L[1], L[2], L[3], H[0], H[1], H[2], H[3]}
    od = __builtin_amdgcn_mfma_f32_32x32x16_bf16(pa0, PK(l0, h0), od, 0, 0, 0);
    od = __builtin_amdgcn_mfma_f32_32x32x16_bf16(pa1, PK(l1, h1), od, 0, 0, 0);
    od = __builtin_amdgcn_mfma_f32_32x32x16_bf16(pa2, PK(l2, h2), od, 0, 0, 0);
    od = __builtin_amdgcn_mfma_f32_32x32x16_bf16(pa3, PK(l3, h3), od, 0, 0, 0);
#undef PK
}
__device__ __forceinline__ void pv_d0(f32x16* o, int vb, bf16x8 pa0, bf16x8 pa1, bf16x8 pa2, bf16x8 pa3) {
    pv_one<0>(o[0], vb, pa0, pa1, pa2, pa3); pv_one<1>(o[1], vb, pa0, pa1, pa2, pa3); pv_one<2>(o[2], vb, pa0, pa1, pa2, pa3); pv_one<3>(o[3], vb, pa0, pa1, pa2, pa3);
}
#ifndef ATT_SDEPTH
#define ATT_SDEPTH 1
#endif
constexpr int SDEPTH = ATT_SDEPTH;
__device__ __forceinline__ void attn_unit(const bf16_t* __restrict__ Qb, const bf16_t* __restrict__ Kh, const bf16_t* __restrict__ Vh, bf16_t* __restrict__ Ob, int seq, char* lds) {
    const int tid = tid_opaque(), wid = tid >> 6, lane = tid & 63, r32 = lane & 31, hi = lane >> 5;
    char* V_lds = lds; char* K_lds = lds + 2 * SHM_V;
    float* ws = (float*)(lds + 2 * SHM_V + 2 * SHM_K) + wid * 64; float* li_l = ws; float* al_l = ws + 32;
    float m_reg = -1e30f, l_reg = 0; f32x16 o[4] = {}; bf16x8 qr[8];
    const bf16_t* Qw = Qb + (long)(wid * QBLK + r32) * LDQ + hi * 8;
    char* ql = lds + SHM_QL + wid * 4096 + lane * 16;
#pragma unroll
    for (int d0 = 0; d0 < 8; ++d0) qr[d0] = *reinterpret_cast<const bf16x8*>(Qw + d0 * 16);
#pragma unroll
    for (int d0 = 8; d0 < 12; ++d0) *reinterpret_cast<bf16x8*>(ql + (d0 - 8) * 1024) = *reinterpret_cast<const bf16x8*>(Qw + d0 * 16);
    const int krow = tid >> 3, kc8 = tid & 7;
    const unsigned kgo = (unsigned)(krow * LDK + kc8 * 8) * 2u;
    const int kso = krow * 384 + ((kc8 * 16) ^ (((krow >> 1) & 7) << 4));
    const int sr = tid >> 4, sc = (tid & 15) * 8, vst0 = v_st(sr, sc);
    const unsigned vgo = (unsigned)(sr * LDV + sc) * 2u;
    const int vb0 = (int)(uintptr_t)V_lds + v_rd_base(lane);
    struct { bf16x8 k0, k1, k2, v0, v1; } sr_[SDEPTH];
#define SLOAD(i, kk0) do { const char* kp_ = (const char*)(Kh + (long)(kk0) * LDK); const char* vp_ = (const char*)(Vh + (long)(kk0) * LDV); \
    sr_[i].v0 = ldgu<bf16x8>(vp_, vgo); sr_[i].v1 = ldgu<bf16x8>(vp_ + 32 * LDV * 2, vgo); \
    sr_[i].k0 = ldgu<bf16x8>(kp_, kgo); sr_[i].k1 = ldgu<bf16x8>(kp_ + 128, kgo); sr_[i].k2 = ldgu<bf16x8>(kp_ + 256, kgo); } while (0)
#define SWRITE(b, i) do { *(bf16x8*)(V_lds + (b) * SHM_V + vst0) = sr_[i].v0; *(bf16x8*)(V_lds + (b) * SHM_V + 8192 + vst0) = sr_[i].v1; \
    *(bf16x8*)(K_lds + (b) * SHM_K + kso) = sr_[i].k0; *(bf16x8*)(K_lds + (b) * SHM_K + 128 + kso) = sr_[i].k1; *(bf16x8*)(K_lds + (b) * SHM_K + 256 + kso) = sr_[i].k2; } while (0)
#define SWAIT() do { if constexpr (SDEPTH == 2) asm volatile("s_waitcnt vmcnt(5)" ::: "memory"); else asm volatile("s_waitcnt vmcnt(0)" ::: "memory"); } while (0)
#define RESC(a) do { if (__any((a) < 1.f)) { if (hi == 0) al_l[r32] = (a); asm volatile("s_waitcnt lgkmcnt(0)" ::: "memory"); \
    _Pragma("unroll") for (int d = 0; d < 4; ++d) _Pragma("unroll") for (int r = 0; r < 16; ++r) o[d][r] *= al_l[crow(r, hi)]; } } while (0)
    f32x16 pA0, pA1, pB0, pB1; float mnA, mnB, alA, alB; bf16x8 pa0, pa1, pa2, pa3; const int NT = seq / KVBLK;
    constexpr int SE = 0, SO = SDEPTH - 1;
    SLOAD(SE, 0); asm volatile("s_waitcnt vmcnt(0)" ::: "memory"); SWRITE(0, SE); __syncthreads();
    qkt(pA0, pA1, K_lds, qr, ql, r32, hi); partialSM(pA0, pA1, m_reg, mnA, alA);
    SLOAD(SO, KVBLK); if constexpr (SDEPTH == 2) { if (2 < NT) SLOAD(SE, 2 * KVBLK); }
    SWAIT(); SWRITE(1, SO); __syncthreads();
    for (int j = 1; j + 1 < NT; j += 2) {
        SBAR(); qkt(pB0, pB1, K_lds + SHM_K, qr, ql, r32, hi);
        finishSM(pA0, pA1, alA, l_reg, pa0, pa1, pa2, pa3); SBAR();
        SLOAD(SO, (j + SDEPTH) * KVBLK); SBAR();
        pv_d0(o, vb0, pa0, pa1, pa2, pa3); partialSM(pB0, pB1, m_reg, mnB, alB);
        __syncthreads(); SWAIT(); SWRITE(0, SE);
        RESC(alB); __syncthreads();
        SBAR(); qkt(pA0, pA1, K_lds, qr, ql, r32, hi);
        finishSM(pB0, pB1, alB, l_reg, pa0, pa1, pa2, pa3); SBAR();
        if (SDEPTH == 1 || j + 3 < NT) SLOAD(SE, (j + 1 + SDEPTH) * KVBLK); SBAR();
        pv_d0(o, vb0 + SHM_V, pa0, pa1, pa2, pa3); partialSM(pA0, pA1, m_reg, mnA, alA);
        __syncthreads(); SWAIT(); SWRITE(1, SO);
        RESC(alA); __syncthreads();
    }
    SBAR(); qkt(pB0, pB1, K_lds + SHM_K, qr, ql, r32, hi);
    finishSM(pA0, pA1, alA, l_reg, pa0, pa1, pa2, pa3); SBAR();
    pv_d0(o, vb0, pa0, pa1, pa2, pa3); partialSM(pB0, pB1, m_reg, mnB, alB);
    __syncthreads(); RESC(alB);
    finishSM(pB0, pB1, alB, l_reg, pa0, pa1, pa2, pa3); SBAR();
    pv_d0(o, vb0 + SHM_V, pa0, pa1, pa2, pa3);
    if (hi == 0) li_l[r32] = l_reg; asm volatile("s_waitcnt lgkmcnt(0)" ::: "memory");
    float rli[16];
#pragma unroll
    for (int r = 0; r < 16; ++r) rli[r] = __builtin_amdgcn_rcpf(li_l[crow(r, hi)]);
    bf16_t* Ow = Ob + (long)(wid * QBLK) * LDO;
#pragma unroll
    for (int r = 0; r < 16; ++r) { const int orow = crow(r, hi);
#pragma unroll
        for (int d0 = 0; d0 < 4; ++d0) Ow[(long)orow * LDO + d0 * 32 + r32] = f2bf(o[d0][r] * rli[r]); }
    __syncthreads();
#undef SLOAD
#undef SWRITE
#undef SWAIT
#undef RESC
}
#undef SBAR
}

template <class RowMap>
__device__ __forceinline__ void transpose_tile(const float* __restrict__ W, int K, int N, bf16_t* __restrict__ WT, float* scr, int kb, int nb, int lane, RowMap rm) {
    const int k0 = 64 * kb, n0 = 64 * nb; const int nq = 4 * (lane & 15), kr = lane >> 4; const bool ok = (n0 + nq) < N;
    const float* wp = W + (size_t)(k0 + kr) * N + n0 + nq;
#pragma unroll 4
    for (int i = 0; i < 16; ++i) { f32x4 v = {0.f, 0.f, 0.f, 0.f}; if (ok) v = *(const f32x4*)(wp + (size_t)(4 * i) * N);
        float* d = scr + nq * 65 + 4 * i + kr; d[0] = v[0]; d[65] = v[1]; d[130] = v[2]; d[195] = v[3]; }
    asm volatile("s_waitcnt lgkmcnt(0)" ::: "memory");
    const int c = lane & 7;
#pragma unroll
    for (int j = 0; j < 8; ++j) { const int nl = (lane >> 3) + 8 * j; const int n = n0 + nl; const float* sp = scr + nl * 65 + 8 * c;
        u32x4 o; o.x = cvt_pk_bf16(sp[0], sp[1]); o.y = cvt_pk_bf16(sp[2], sp[3]); o.z = cvt_pk_bf16(sp[4], sp[5]); o.w = cvt_pk_bf16(sp[6], sp[7]);
        if (n < N) *(u32x4*)(WT + (size_t)rm(n) * K + k0 + 8 * c) = o; }
    asm volatile("s_waitcnt lgkmcnt(0)" ::: "memory");
}
struct RowId { __device__ __forceinline__ int operator()(int n) const { return n; } };
struct RowUq { __device__ __forceinline__ int operator()(int n) const { return (n / DQK) * 256 + (n % DQK); } };

__device__ __forceinline__ void phase0(const Params& P, char* lds, int G) {
    const int tid = tid_opaque(), lane = tid & 63, wave = tid >> 6;
    const int gw = blockIdx.x * NWAVES + wave, NGW = G * NWAVES;
    float* modp = (float*)(P.ws + WS_MODP);
    for (int task = gw; task < 768; task += NGW) {
        const int ks = task / 48, cb = task % 48;
        const float s0 = silu_f(P.c[ks * 128 + lane]), s1 = silu_f(P.c[ks * 128 + 64 + lane]);
        f32x4 acc = {0.f, 0.f, 0.f, 0.f};
        const float* wp = P.w_ada + (size_t)(ks * 128) * (6 * DM) + cb * 256 + lane * 4;
#pragma unroll 8
        for (int kk = 0; kk < 128; ++kk) { const float sv = __shfl(kk < 64 ? s0 : s1, kk & 63); const f32x4 w = *(const f32x4*)(wp + (size_t)kk * (6 * DM)); acc += w * sv; }
        *(f32x4*)(modp + (size_t)ks * (6 * DM) + cb * 256 + lane * 4) = acc;
    }
    { f32x2* rt = (f32x2*)(P.ws + WS_ROPE); const int i = lane & 31; const float freq = powf(10000.0f, -(float)i / 32.0f);
      for (int t = 2 * gw + (lane >> 5); t < SEQ; t += 2 * NGW) { float sn, cs; sincosf((float)P.pos[t] * freq, &sn, &cs); rt[(size_t)t * 32 + i] = (f32x2){cs, sn}; } }
    float* scr = (float*)(lds + wave * 17408);
    constexpr int I_IN = 32 * 78, I_UQ = 8 * 24, I_UKV = 4 * 32, I_OUT = 32 * 32, NIT = I_IN + I_UQ + I_UKV + I_OUT;
    for (int it = gw; it < NIT; it += NGW) {
        int r = it;
        if (r < I_IN) { transpose_tile(P.w_in, DM, DIN, (bf16_t*)(P.ws + WS_WIN), scr, r / 78, r % 78, lane, RowId()); continue; } r -= I_IN;
        if (r < I_UQ) { transpose_tile(P.w_uq, QLORA, NH * DQK, (bf16_t*)(P.ws + WS_WUQ), scr, r / 24, r % 24, lane, RowUq()); continue; } r -= I_UQ;
        if (r < I_UKV) { transpose_tile(P.w_ukv, KVLORA, NH * 256, (bf16_t*)(P.ws + WS_WUKV), scr, r / 32, r % 32, lane, RowId()); continue; } r -= I_UKV;
        transpose_tile(P.w_out, DM, DM, (bf16_t*)(P.ws + WS_WOUT), scr, r / 32, r % 32, lane, RowId());
    }
}
__device__ __forceinline__ void norm_mod_rows(const float* __restrict__ src, const float* __restrict__ g, const float* sh, const float* sc, bf16_t* __restrict__ dst, int G) {
    const int tid = tid_opaque(), lane = tid & 63, wave = tid >> 6;
    const int gw = blockIdx.x * NWAVES + wave, NGW = G * NWAVES;
    for (int row = gw; row < SEQ; row += NGW) {
        const f32x4* xr = (const f32x4*)(src + (size_t)row * DM) + lane;
        f32x4 v[8]; float ss = 0.f;
#pragma unroll
        for (int j = 0; j < 8; ++j) { v[j] = xr[64 * j]; ss += (v[j].x * v[j].x + v[j].y * v[j].y) + (v[j].z * v[j].z + v[j].w * v[j].w); }
        const float rstd = rsqrtf(wave_sum(ss) * (1.f / DM) + EPS);
        u32x2* o8 = (u32x2*)(dst + (size_t)row * DM) + lane;
#pragma unroll
        for (int j = 0; j < 8; ++j) { const int col = lane * 4 + 256 * j; const f32x4 gg = *(const f32x4*)(g + col); const f32x4 s1 = *(const f32x4*)(sc + col), s0 = *(const f32x4*)(sh + col);
            f32x4 y = v[j] * rstd * gg; y = y * (s1 + 1.f) + s0;
            u32x2 w; w.x = cvt_pk_bf16(y.x, y.y); w.y = cvt_pk_bf16(y.z, y.w); o8[64 * j] = w; }
    }
}
__device__ __forceinline__ void phase1a(const Params& P, char* lds, int G) {
    const int tid = tid_opaque();
    const float* modp = (const float*)(P.ws + WS_MODP); float* mod = (float*)(P.ws + WS_MOD);
    float* sh = (float*)lds; float* sc = sh + DM;
    for (int n = tid; n < 2 * DM; n += NTHREADS) { float a = P.b_ada[n];
#pragma unroll
        for (int ks = 0; ks < 16; ++ks) a += modp[(size_t)ks * (6 * DM) + n];
        sh[n] = a; }
    if (blockIdx.x < 16) { const int n = 2 * DM + blockIdx.x * NTHREADS + tid; float a = P.b_ada[n];
#pragma unroll
        for (int ks = 0; ks < 16; ++ks) a += modp[(size_t)ks * (6 * DM) + n];
        mod[n] = a; }
    __syncthreads();
    norm_mod_rows(P.x, P.norm_mix_g, sh, sc, (bf16_t*)(P.ws + WS_H), G);
    __syncthreads();
}
__device__ __forceinline__ void phase6b(const Params& P, char* lds, int G) {
    const int tid = tid_opaque(), lane = tid & 63, wave = tid >> 6;
    const int gw = blockIdx.x * NWAVES + wave, NGW = G * NWAVES;
    const float* mod = (const float*)(P.ws + WS_MOD);
    float* sh = (float*)lds; float* sc = sh + DM;
    for (int n = tid; n < 2 * DM; n += NTHREADS) sh[n] = mod[3 * DM + n];
    __syncthreads();
    norm_mod_rows(P.out, P.norm_mlp_g, sh, sc, (bf16_t*)(P.ws + WS_H), G);
    __syncthreads();
    float* scr = (float*)(lds + wave * 17408);
    constexpr int I_1 = 32 * 128, I_2 = 128 * 32;
    for (int it = gw; it < I_1 + I_2; it += NGW) {
        if (it < I_1) transpose_tile(P.w_ff1, DM, DFF, (bf16_t*)(P.ws + WS_W1), scr, it / 128, it % 128, lane, RowId());
        else { const int r = it - I_1; transpose_tile(P.w_ff2, DFF, DM, (bf16_t*)(P.ws + WS_W2), scr, r / 32, r % 32, lane, RowId()); }
    }
}

__device__ __forceinline__ void phase2(const Params& P, char* lds, int G) {
    const int tid = tid_opaque(), lane = tid & 63, wave = tid >> 6;
    const int gw = blockIdx.x * NWAVES + wave, NGW = G * NWAVES;
    const bf16_t* proj = (const bf16_t*)(P.ws + WS_PROJ);
    { bf16_t* cqn = (bf16_t*)(P.ws + WS_CQN); bf16_t* ckvn = (bf16_t*)(P.ws + WS_CKVN);
      float gq[8], gk[8];
#pragma unroll
      for (int e = 0; e < 8; ++e) { gq[e] = P.q_lora_g[lane * 8 + e]; gk[e] = P.kv_lora_g[(lane & 31) * 8 + e]; }
      for (int row = gw; row < SEQ; row += NGW) {
        const u32x4 wq = *(const u32x4*)(proj + (size_t)row * DINP + OFF_CQ + lane * 8);
        const u32x4 wk = *(const u32x4*)(proj + (size_t)row * DINP + OFF_CKV + (lane & 31) * 8);
        float fq[8], fk[8]; unpack8(wq, fq); unpack8(wk, fk);
        float sq = 0.f, sk = 0.f;
#pragma unroll
        for (int e = 0; e < 8; ++e) { sq += fq[e] * fq[e]; sk += fk[e] * fk[e]; }
        if (lane >= 32) sk = 0.f;
        const float rq = rsqrtf(wave_sum(sq) * (1.f / QLORA) + EPS), rk = rsqrtf(wave_sum(sk) * (1.f / KVLORA) + EPS);
#pragma unroll
        for (int e = 0; e < 8; ++e) { fq[e] = fq[e] * rq * gq[e]; fk[e] = fk[e] * rk * gk[e]; }
        *(u32x4*)(cqn + (size_t)row * QLORA + lane * 8) = pack8(fq);
        if (lane < 32) *(u32x4*)(ckvn + (size_t)row * KVLORA + lane * 8) = pack8(fk);
      } }
    { bf16_t* QH = (bf16_t*)(P.ws + WS_QH); bf16_t* KH = (bf16_t*)(P.ws + WS_KH); bf16_t* KT = (bf16_t*)(P.ws + WS_KT); bf16_t* VT = (bf16_t*)(P.ws + WS_VT);
      const int tg = tid >> 5, cgp = tid & 31, chl = cgp * 8;
      for (int item = blockIdx.x; item < 3 * HM * NCH; item += G) {
        const int kind = item / (HM * NCH), h = (item / NCH) % HM, c = item % NCH;
        const int t0 = LCH * c + 8 * tg;
        float outv[8][8];
        if (kind < 2) {
            const int col = OFF_QM + kind * 1024 + h * DH + chl;
            float cw[5][8], cb[8];
#pragma unroll
            for (int e = 0; e < 8; ++e) cb[e] = P.conv_b[kind * 1024 + h * DH + chl + e];
#pragma unroll
            for (int j = 0; j < 5; ++j)
#pragma unroll
                for (int e = 0; e < 8; ++e) cw[j][e] = P.conv_w[j * 2048 + kind * 1024 + h * DH + chl + e];
#pragma unroll
            for (int tt = 0; tt < 8; ++tt)
#pragma unroll
                for (int e = 0; e < 8; ++e) outv[tt][e] = cb[e];
#pragma unroll
            for (int rr = 0; rr < 12; ++rr) {
                const int t = t0 - 2 + rr; float in[8];
                if (t >= 0 && t < SEQ) { const u32x4 w = *(const u32x4*)(proj + (size_t)t * DINP + col); unpack8(w, in); }
                else {
#pragma unroll
                    for (int e = 0; e < 8; ++e) in[e] = 0.f; }
#pragma unroll
                for (int j = 0; j < 5; ++j) { const int tt = rr - j;
                    if (tt >= 0 && tt < 8) {
#pragma unroll
                        for (int e = 0; e < 8; ++e) outv[tt][e] += cw[j][e] * in[e]; } }
            }
            const float osc = kind == 1 ? 0.0625f : 1.f;
#pragma unroll
            for (int tt = 0; tt < 8; ++tt)
#pragma unroll
                for (int e = 0; e < 8; ++e) outv[tt][e] = silu_f(outv[tt][e]) * osc;
            bf16_t* dst = (kind == 0 ? QH : KH) + ((size_t)h * SEQ + t0) * DH + chl;
#pragma unroll
            for (int tt = 0; tt < 8; ++tt) *(u32x4*)(dst + (size_t)tt * DH) = pack8(outv[tt]);
        } else {
#pragma unroll
            for (int tt = 0; tt < 8; ++tt) { const u32x4 w = *(const u32x4*)(proj + (size_t)(t0 + tt) * DINP + OFF_VM + h * DH + chl); unpack8(w, outv[tt]); }
        }
        if (kind >= 1) {
            bf16_t* dst = (kind == 1 ? KT : VT) + ((size_t)(h * NCH + c) * DH + chl) * LCH + 8 * tg;
#pragma unroll
            for (int e = 0; e < 8; ++e) { u32x4 w; w.x = cvt_pk_bf16(outv[0][e], outv[1][e]); w.y = cvt_pk_bf16(outv[2][e], outv[3][e]); w.z = cvt_pk_bf16(outv[4][e], outv[5][e]); w.w = cvt_pk_bf16(outv[6][e], outv[7][e]);
                *(u32x4*)(dst + (size_t)e * LCH) = w; }
        }
      } }
    { const float* gates = (const float*)(P.ws + WS_GATES);
      float* BC = (float*)(P.ws + WS_BC); float* IG = (float*)(P.ws + WS_IG); float* PM = (float*)(P.ws + WS_PM); float* WL = (float*)(P.ws + WS_WL);
      float* BL = (float*)(P.ws + WS_BL); float* AC = (float*)(P.ws + WS_AC);
      for (int task = gw; task < 2 * HM * NCH; task += NGW) {
        const int dir = task / (HM * NCH), h = (task / NCH) % HM, c = task % NCH;
        const float bi = P.b_gates[dir * 8 + h], bfg = P.b_gates[dir * 8 + 4 + h];
        const int u0 = 2 * lane, u1 = 2 * lane + 1;
        const int t0 = LCH * c + (dir ? 127 - u0 : u0), t1 = LCH * c + (dir ? 127 - u1 : u1);
        const float i0 = gates[(size_t)t0 * 16 + dir * 8 + h] + bi, i1 = gates[(size_t)t1 * 16 + dir * 8 + h] + bi;
        const float f0 = gates[(size_t)t0 * 16 + dir * 8 + 4 + h] + bfg, f1 = gates[(size_t)t1 * 16 + dir * 8 + 4 + h] + bfg;
        const float l0 = fminf(f0, 0.f) - log1pf(expf(-fabsf(f0))), l1 = fminf(f1, 0.f) - log1pf(expf(-fabsf(f1)));
        float inc = l0 + l1;
#pragma unroll
        for (int o = 1; o < 64; o <<= 1) { const float t = __shfl_up(inc, o); if (lane >= o) inc += t; }
        const float b1 = inc, b0 = inc - l1;
        const float d0 = i0 - b0, d1 = i1 - b1;
        float pmx = fmaxf(d0, d1);
#pragma unroll
        for (int o = 1; o < 64; o <<= 1) { const float t = __shfl_up(pmx, o); if (lane >= o) pmx = fmaxf(pmx, t); }
        float prev = __shfl_up(pmx, 1); if (lane == 0) prev = -INFINITY;
        const float pm0 = fmaxf(prev, d0), pm1 = pmx;
        const float bL = __shfl(b1, 63), pmL = __shfl(pmx, 63);
        const size_t base = (size_t)(dir * HM + h) * SEQ;
        BC[base + t0] = b0; BC[base + t1] = b1; IG[base + t0] = i0; IG[base + t1] = i1;
        PM[base + t0] = b0 + pm0; PM[base + t1] = b1 + pm1;
        WL[base + t0] = bL - b0 + i0; WL[base + t1] = bL - b1 + i1;
        if (lane == 63) { BL[(dir * HM + h) * NCH + c] = bL; AC[(dir * HM + h) * NCH + c] = bL + pmL; }
      } }
}

constexpr int M2_W = 1024, M2_T0 = M2_W + SEQ * 4, M2_TB = 96 * 256;
static_assert(M2_T0 + 2 * M2_TB <= LDS_BYTES, "M2 LDS");
__device__ __forceinline__ void m2_block(const Params& P, char* lds, int blk) {
    const int tid = tid_opaque(), lane = tid & 63, wid = tid >> 6, r = lane & 15, g = lane >> 4;
    const int dir = blk >> 7, h = (blk >> 5) & 3, vs = (blk >> 2) & 7, ksl = blk & 3;
    const int vi = wid >> 2, ki = wid & 3, v0 = 32 * vs + 16 * vi, k0 = 64 * ksl + 16 * ki;
    const int dh = dir * HM + h;
    const float* BL = (const float*)(P.ws + WS_BL) + dh * NCH; const float* AC = (const float*)(P.ws + WS_AC) + dh * NCH;
    const float* WL = (const float*)(P.ws + WS_WL) + (size_t)dh * SEQ;
    bf16_t* CST = (bf16_t*)(P.ws + WS_CST); float* NST = (float*)(P.ws + WS_NST);
    float* s_mA = (float*)lds; float* s_dec = s_mA + NCH; float* s_w = (float*)(lds + M2_W);
    if (tid == 0) { float m = -1e30f;
#pragma unroll 1
        for (int st = 0; st < NCH; ++st) { const int c = dir ? NCH - 1 - st : st; const float bL = BL[c], a = AC[c]; const float mn = fmaxf(bL + m, a);
            s_dec[c] = __expf(bL + m - mn); s_mA[c] = mn; m = mn; } }
    __syncthreads();
    for (int t = tid; t < SEQ; t += NTHREADS) s_w[t] = __expf(WL[t] - s_mA[t >> 7]);
    const int srow = tid >> 4, sslot = tid & 15;
    const char* gV = (const char*)(P.ws + WS_VT) + ((size_t)h * NCH * DH + 32 * vs + srow) * (LCH * 2) + sslot * 16;
    const char* gK = (const char*)(P.ws + WS_KT) + ((size_t)h * NCH * DH + 64 * ksl + srow) * (LCH * 2) + sslot * 16;
    const int lw = srow * 256 + ((sslot ^ (srow & 15)) << 4);
    const int la = (16 * vi + r) * 256, lb = (32 + 16 * ki + r) * 256;
    char* tb = lds + M2_T0;
    u32x4 ring[8][3];
#define M2_LOAD(slot, stp) do { const int c_ = dir ? NCH - 1 - (stp) : (stp); const size_t co_ = (size_t)c_ * (DH * LCH * 2); \
        ring[slot][0] = *(const u32x4*)(gV + co_); ring[slot][1] = *(const u32x4*)(gK + co_); ring[slot][2] = *(const u32x4*)(gK + co_ + 32 * LCH * 2); } while (0)
#define M2_WRITE(slot, buf) do { char* d_ = tb + (buf) * M2_TB + lw; *(u32x4*)d_ = ring[slot][0]; *(u32x4*)(d_ + 8192) = ring[slot][1]; *(u32x4*)(d_ + 16384) = ring[slot][2]; } while (0)
#pragma unroll
    for (int d = 0; d < 8; ++d) M2_LOAD(d, d);
    M2_WRITE(0, 0);
    const bool do_n = (vs == 0 && vi == 0);
    f32x4 acc = {0.f, 0.f, 0.f, 0.f}; float nacc = 0.f;
#pragma unroll 1
    for (int st8 = 0; st8 < NCH; st8 += 8) {
#pragma unroll
        for (int u = 0; u < 8; ++u) {
            const int st = st8 + u;
            const int c = dir ? NCH - 1 - st : st;
            asm volatile("s_waitcnt lgkmcnt(0)" ::: "memory"); __builtin_amdgcn_s_barrier(); asm volatile("" ::: "memory");
            if (st + 1 < NCH) M2_WRITE((u + 1) & 7, (u + 1) & 1);
            if (st + 8 < NCH) M2_LOAD(u, st + 8);
            { bf16_t* cp = CST + ((size_t)dh * NCH + c) * (DH * DH) + (size_t)(v0 + 4 * g) * DH + k0 + r;
#pragma unroll
              for (int i = 0; i < 4; ++i) cp[(size_t)i * DH] = f2bf(acc[i]);
              if (do_n && g == 0) NST[((size_t)dh * NCH + c) * DH + k0 + r] = nacc; }
            const float dec = s_dec[c];
            acc = acc * dec; nacc *= dec;
            float nsum = 0.f;
            const char* tbuf = tb + (u & 1) * M2_TB;
#pragma unroll
            for (int ks = 0; ks < 4; ++ks) {
                const int sl = ((4 * ks + g) ^ r) << 4;
                const u32x4 av = *(const u32x4*)(tbuf + la + sl), bv = *(const u32x4*)(tbuf + lb + sl);
                const f32x4 w0 = *(const f32x4*)(s_w + LCH * c + 32 * ks + 8 * g), w1 = *(const f32x4*)(s_w + LCH * c + 32 * ks + 8 * g + 4);
                float a[8], b[8]; unpack8(av, a); unpack8(bv, b);
#pragma unroll
                for (int j = 0; j < 4; ++j) { a[j] *= w0[j]; a[4 + j] *= w1[j]; nsum += w0[j] * b[j] + w1[j] * b[4 + j]; }
                const u32x4 aw = pack8(a);
                acc = __builtin_amdgcn_mfma_f32_16x16x32_bf16(*(const bf16x8*)&aw, *(const bf16x8*)&bv, acc, 0, 0, 0);
            }
            nsum += __shfl_xor(nsum, 16); nsum += __shfl_xor(nsum, 32);
            nacc += nsum;
        }
    }
#undef M2_LOAD
#undef M2_WRITE
    __syncthreads();
}

constexpr int M3_LV = 1024, M3_LVS = 272, M3_LC = M3_LV + 256 * M3_LVS, M3_LCS = 528;
static_assert(M3_LC + 128 * M3_LCS <= LDS_BYTES, "M3 LDS");
__device__ __forceinline__ void m3_unit(const Params& P, char* lds, int h, int c) {
    const int tid = tid_opaque(), lane = tid & 63, wid = __builtin_amdgcn_readfirstlane(tid >> 6), r = lane & 15, g = lane >> 4;
    const int T0 = LCH * c, tl = 16 * wid + r;
    const char* QHc = (const char*)(P.ws + WS_QH) + ((size_t)h * SEQ + T0 + 16 * wid) * (DH * 2);
    const char* KHc = (const char*)(P.ws + WS_KH) + ((size_t)h * SEQ + T0) * (DH * 2);
    const char* VTc = (const char*)(P.ws + WS_VT) + ((size_t)h * NCH + c) * (DH * LCH * 2);
    const unsigned o512 = (unsigned)(r * 512 + g * 16);
    float* s_mb = (float*)lds; char* LV = lds + M3_LV; char* LC = lds + M3_LC;
    { u32x4 v[8];
#pragma unroll
      for (int n = 0; n < 8; ++n) v[n] = ldgu<u32x4>(VTc + n * 8192, (unsigned)tid * 16u);
#pragma unroll
      for (int n = 0; n < 8; ++n) *(u32x4*)(LV + ((tid >> 4) + 32 * n) * M3_LVS + (tid & 15) * 16) = v[n]; }
    if (tid == 0 || tid == 64) { const int dir = tid >> 6; const float* BL = (const float*)(P.ws + WS_BL) + (dir * HM + h) * NCH; const float* AC = (const float*)(P.ws + WS_AC) + (dir * HM + h) * NCH;
        float m = -1e30f;
#pragma unroll 1
        for (int st = 0; st < NCH; ++st) { const int cc = dir ? NCH - 1 - st : st; s_mb[dir * NCH + cc] = m; m = fmaxf(BL[cc] + m, AC[cc]); } }
    __syncthreads();
    f32x4 st[8];
    { bf16x8 qf[8];
#pragma unroll
      for (int kd = 0; kd < 8; ++kd) qf[kd] = ldgu<bf16x8>(QHc + 64 * kd, o512);
#pragma unroll
      for (int j = 0; j < 8; ++j) { st[j] = (f32x4){0.f, 0.f, 0.f, 0.f};
#pragma unroll
        for (int kd = 0; kd < 8; ++kd) { const bf16x8 kf = ldgu<bf16x8>(KHc + (16 * j) * 512 + 64 * kd, o512);
            st[j] = __builtin_amdgcn_mfma_f32_16x16x32_bf16(kf, qf[kd], st[j], 0, 0, 0); }
        asm volatile("" ::: "memory"); } }
    f32x4 acc[16];
#pragma unroll
    for (int vt = 0; vt < 16; ++vt) acc[vt] = (f32x4){0.f, 0.f, 0.f, 0.f};
    const char* lvr = LV + r * M3_LVS + g * 8;
    const char* lcr = LC + r * M3_LCS + g * 16;
    char* lcw = LC + (tid >> 5) * M3_LCS + (tid & 31) * 16;
#pragma unroll 1
    for (int dir = 0; dir < 2; ++dir) {
        const int dh = dir * HM + h;
        const char* BCc = (const char*)(P.ws + WS_BC) + ((size_t)dh * SEQ + T0) * 4; const char* IGc = (const char*)(P.ws + WS_IG) + ((size_t)dh * SEQ + T0) * 4;
        const char* PMc = (const char*)(P.ws + WS_PM) + ((size_t)dh * SEQ + T0) * 4;
        const char* Cc = (const char*)(P.ws + WS_CST) + ((size_t)dh * NCH + c) * (DH * DH * 2);
        const char* Nc = (const char*)(P.ws + WS_NST) + ((size_t)dh * NCH + c) * (DH * 4);
        const int fx = dir * 127, tlx = tl ^ fx;
        const float mB = s_mb[dir * NCH + c];
        const float bt = ldgu<float>(BCc, (unsigned)tl * 4u), pm = ldgu<float>(PMc, (unsigned)tl * 4u);
        const float mt = fmaxf(bt + mB, pm); const float alpha = bt - mt; const float winter = __expf(bt + mB - mt);
        float den = 0.f;
#pragma unroll
        for (int j = 0; j < 8; ++j) { const int sb = 16 * j + 4 * g;
            const f32x4 ig = ldgu<f32x4>(IGc + 64 * j, (unsigned)g * 16u), bc = ldgu<f32x4>(BCc + 64 * j, (unsigned)g * 16u);
#pragma unroll
            for (int i = 0; i < 4; ++i) { const int sl = sb + i; const bool ok = ((sl ^ fx) <= tlx);
                const float e = ok ? __expf(alpha + ig[i] - bc[i]) : 0.f; den += st[j][i] * e; }
            if (j & 1) asm volatile("" ::: "memory"); }
        den += __shfl_xor(den, 16); den += __shfl_xor(den, 32);
        float qn = 0.f;
#pragma unroll
        for (int kd = 0; kd < 8; ++kd) { const f32x4 n0 = ldgu<f32x4>(Nc + 128 * kd, (unsigned)g * 32u), n1 = ldgu<f32x4>(Nc + 128 * kd + 16, (unsigned)g * 32u);
            const u32x4 qt = ldgu<u32x4>(QHc + 64 * kd, o512); float q[8]; unpack8(qt, q);
            qn += q[0] * n0[0] + q[1] * n0[1] + q[2] * n0[2] + q[3] * n0[3] + q[4] * n1[0] + q[5] * n1[1] + q[6] * n1[2] + q[7] * n1[3];
            if (kd & 1) asm volatile("" ::: "memory"); }
        qn += __shfl_xor(qn, 16); qn += __shfl_xor(qn, 32);
        const float dtot = den + winter * qn;
        const float hdiv = 1.f / fmaxf(fabsf(dtot), __expf(-mt));
        int tlx2 = tlx; LAUNDER_V(tlx2);
#pragma unroll
        for (int ks = 0; ks < 4; ++ks) {
            float e8[8];
#pragma unroll
            for (int hh = 0; hh < 2; ++hh) { const int j = 2 * ks + hh, sb = 16 * j + 4 * g;
                const f32x4 ig = ldgu<f32x4>(IGc + 64 * j, (unsigned)g * 16u), bc = ldgu<f32x4>(BCc + 64 * j, (unsigned)g * 16u);
#pragma unroll
                for (int i = 0; i < 4; ++i) { const int sl = sb + i; const bool ok = ((sl ^ fx) <= tlx2);
                    const float e = ok ? __expf(alpha + ig[i] - bc[i]) : 0.f; e8[4 * hh + i] = st[j][i] * e * hdiv; } }
            const u32x4 pw = pack8(e8); const bf16x8 pa = *(const bf16x8*)&pw;
#pragma unroll
            for (int vt = 0; vt < 16; ++vt) {
                const u32x2 lo = *(const u32x2*)(lvr + vt * (16 * M3_LVS) + ks * 64), hi2 = *(const u32x2*)(lvr + vt * (16 * M3_LVS) + ks * 64 + 32);
                u32x4 w; w.x = lo.x; w.y = lo.y; w.z = hi2.x; w.w = hi2.y;
                acc[vt] = __builtin_amdgcn_mfma_f32_16x16x32_bf16(pa, *(const bf16x8*)&w, acc[vt], 0, 0, 0); }
        }
        const float qsc = winter * hdiv;
#pragma unroll
        for (int half = 0; half < 2; ++half) {
            __syncthreads();
            { u32x4 v[8];
#pragma unroll
              for (int n = 0; n < 8; ++n) v[n] = ldgu<u32x4>(Cc + half * 65536 + n * 8192, (unsigned)tid * 16u);
#pragma unroll
              for (int n = 0; n < 8; ++n) *(u32x4*)(lcw + n * (16 * M3_LCS)) = v[n]; }
            __syncthreads();
#pragma unroll
            for (int kd = 0; kd < 8; ++kd) { const u32x4 qt = ldgu<u32x4>(QHc + 64 * kd, o512); float q[8]; unpack8(qt, q);
#pragma unroll
                for (int e = 0; e < 8; ++e) q[e] *= qsc;
                const u32x4 qw = pack8(q); const bf16x8 qs = *(const bf16x8*)&qw;
#pragma unroll
                for (int v8 = 0; v8 < 8; ++v8) { const bf16x8 cf = *(const bf16x8*)(lcr + v8 * (16 * M3_LCS) + kd * 64);
                    acc[half * 8 + v8] = __builtin_amdgcn_mfma_f32_16x16x32_bf16(qs, cf, acc[half * 8 + v8], 0, 0, 0); }
            }
        }
    }
    float ss[4] = {0.f, 0.f, 0.f, 0.f};
#pragma unroll
    for (int vt = 0; vt < 16; ++vt)
#pragma unroll
        for (int i = 0; i < 4; ++i) ss[i] += acc[vt][i] * acc[vt][i];
#pragma unroll
    for (int i = 0; i < 4; ++i) { ss[i] += __shfl_xor(ss[i], 1); ss[i] += __shfl_xor(ss[i], 2); ss[i] += __shfl_xor(ss[i], 4); ss[i] += __shfl_xor(ss[i], 8); ss[i] = rsqrtf(ss[i] * (1.f / DH) + EPS); }
    const char* pr0 = (const char*)(P.ws + WS_PROJ) + ((size_t)(T0 + 16 * wid) * DINP + OFF_OM + h * DH) * 2;
    char* mx0 = (char*)(P.ws + WS_MIX) + ((size_t)(T0 + 16 * wid) * DM + 1024 + h * DH) * 2;
    const char* gmp = (const char*)(P.mlstm_norm_g + h * DH);
    const unsigned opr = (unsigned)(4 * g * DINP * 2 + r * 2), omx = (unsigned)(4 * g * DM * 2 + r * 2);
#pragma unroll
    for (int vt = 0; vt < 16; ++vt) { const float gm = ldgu<float>(gmp + 64 * vt, (unsigned)r * 4u);
#pragma unroll
        for (int i = 0; i < 4; ++i) { const float om = bf2f(ldgu<bf16_t>(pr0 + i * (DINP * 2) + 32 * vt, opr));
            *(bf16_t*)(mx0 + i * (DM * 2) + 32 * vt + omx) = f2bf(acc[vt][i] * ss[i] * gm * sigmoid_f(om)); }
        if ((vt & 3) == 3) asm volatile("" ::: "memory"); }
    __syncthreads();
}

__device__ __forceinline__ void phase4(const Params& P, int G) {
    const int tid = tid_opaque(), lane = tid & 63, wave = tid >> 6;
    const int gw = blockIdx.x * NWAVES + wave, NGW = G * NWAVES;
    bf16_t* Q = (bf16_t*)(P.ws + WS_Q); bf16_t* K = (bf16_t*)(P.ws + WS_K); const bf16_t* KV = (const bf16_t*)(P.ws + WS_KV); const bf16_t* proj = (const bf16_t*)(P.ws + WS_PROJ);
    const f32x4* rt = (const f32x4*)(P.ws + WS_ROPE);
    const int i = lane & 7, hh = lane >> 3; const bool lo = i < 4;
    float gq[3][8], gk[3][8];
#pragma unroll
    for (int j = 0; j < 3; ++j)
#pragma unroll
        for (int e = 0; e < 8; ++e) { gq[j][e] = P.q_norm_g[8 * (i + 8 * j) + e]; gk[j][e] = P.k_norm_g[8 * (i + 8 * j) + e]; }
    for (int t = gw; t < SEQ; t += NGW) {
        float cs[8], sn[8];
#pragma unroll
        for (int e2 = 0; e2 < 4; ++e2) { const f32x4 v = rt[(size_t)t * 16 + 4 * (i & 3) + e2]; cs[2 * e2] = v[0]; sn[2 * e2] = v[1]; cs[2 * e2 + 1] = v[2]; sn[2 * e2 + 1] = v[3]; }
#pragma unroll
        for (int which = 0; which < 2; ++which) {
            u32x4 w0, w1, w2; bf16_t* dst;
            if (which == 0) { bf16_t* qp = Q + (size_t)t * (NH * DQK) + hh * DQK + 8 * i; w0 = *(const u32x4*)qp; w1 = *(const u32x4*)(qp + 64); w2 = *(const u32x4*)(qp + 128); dst = qp; }
            else { const bf16_t* kp = KV + (size_t)t * (NH * 256) + hh * 256 + 8 * i; w0 = *(const u32x4*)kp; w1 = *(const u32x4*)(kp + 64);
                   w2 = *(const u32x4*)(proj + (size_t)t * DINP + OFF_KPE + 8 * i); dst = K + (size_t)t * (NH * DQK) + hh * DQK + 8 * i; }
            float a0[8], a1[8], a2[8]; unpack8(w0, a0); unpack8(w1, a1); unpack8(w2, a2);
            float ss = 0.f;
#pragma unroll
            for (int e = 0; e < 8; ++e) ss += a0[e] * a0[e] + a1[e] * a1[e] + a2[e] * a2[e];
            ss += __shfl_xor(ss, 1); ss += __shfl_xor(ss, 2); ss += __shfl_xor(ss, 4);
            const float rs = rsqrtf(ss * (1.f / DQK) + EPS);
#pragma unroll
            for (int e = 0; e < 8; ++e) { const float g0 = which ? gk[0][e] : gq[0][e], g1 = which ? gk[1][e] : gq[1][e], g2 = which ? gk[2][e] : gq[2][e];
                a0[e] *= rs * g0; a1[e] *= rs * g1; a2[e] *= rs * g2; }
            float o2[8];
#pragma unroll
            for (int e = 0; e < 8; ++e) { const float pr = __shfl_xor(a2[e], 4);
                o2[e] = lo ? (a2[e] * cs[e] - pr * sn[e]) : (pr * sn[e] + a2[e] * cs[e]); }
            *(u32x4*)dst = pack8(a0); *(u32x4*)(dst + 64) = pack8(a1); *(u32x4*)(dst + 128) = pack8(o2);
        }
    }
}

struct StoreProj { bf16_t* proj; float* gates;
    __device__ __forceinline__ void operator()(int row, int col, f32x4 v0, f32x4 v1) const {
        u32x4 w; w.x = cvt_pk_bf16(v0[0], v0[1]); w.y = cvt_pk_bf16(v0[2], v0[3]); w.z = cvt_pk_bf16(v1[0], v1[1]); w.w = cvt_pk_bf16(v1[2], v1[3]);
        *(u32x4*)(proj + (size_t)row * DINP + col) = w;
        if (col >= OFF_GM && col < OFF_GM + 16) { float* gp = gates + (size_t)row * 16 + (col - OFF_GM); *(f32x4*)gp = v0; *(f32x4*)(gp + 4) = v1; } } };
struct StoreQ { bf16_t* q;
    __device__ __forceinline__ void operator()(int row, int col, f32x4 v0, f32x4 v1) const {
        const int h = col >> 8, ct = col & 255;
        if (ct < DQK) { u32x4 w; w.x = cvt_pk_bf16(v0[0], v0[1]); w.y = cvt_pk_bf16(v0[2], v0[3]); w.z = cvt_pk_bf16(v1[0], v1[1]); w.w = cvt_pk_bf16(v1[2], v1[3]);
            *(u32x4*)(q + (size_t)row * (NH * DQK) + h * DQK + ct) = w; } } };
struct StoreKV { bf16_t* kv;
    __device__ __forceinline__ void operator()(int row, int col, f32x4 v0, f32x4 v1) const {
        u32x4 w; w.x = cvt_pk_bf16(v0[0], v0[1]); w.y = cvt_pk_bf16(v0[2], v0[3]); w.z = cvt_pk_bf16(v1[0], v1[1]); w.w = cvt_pk_bf16(v1[2], v1[3]);
        *(u32x4*)(kv + (size_t)row * (NH * 256) + col) = w; } };
struct StoreX1 { const float* x; const float* gate; float* out;
    __device__ __forceinline__ void operator()(int row, int col, f32x4 v) const {
        const size_t off = (size_t)row * DM + col; const f32x4 xv = *(const f32x4*)(x + off); const f32x4 gv = *(const f32x4*)(gate + col);
        *(f32x4*)(out + off) = xv + gv * v; } };
struct StoreAct { bf16_t* act;
    __device__ __forceinline__ void operator()(int row, int col, f32x4 v0, f32x4 v1) const {
        float f[8] = {v0[0], v0[1], v0[2], v0[3], v1[0], v1[1], v1[2], v1[3]};
#pragma unroll
        for (int e = 0; e < 8; ++e) { const float rl = fmaxf(f[e], 0.f); f[e] = rl * rl; }
        *(u32x4*)(act + (size_t)row * DFF + col) = pack8(f); } };

#define XB_TMO      128
#define XB_XCNT(j)  (256  + 64 * (j))
#define XB_XSUB(j)  (1280 + 64 * (j))
#define XB_XGEN(j)  (2304 + 64 * (j))
#define XB_TOP      3328
#define XB_TOPGEN   3392
#define XCD_BAR_WORDS 3456
#define XB_SPIN_CAP (1u << 18)

__device__ __forceinline__ unsigned xb_ld(unsigned* p)              { return __hip_atomic_load(p, __ATOMIC_RELAXED, __HIP_MEMORY_SCOPE_AGENT); }
__device__ __forceinline__ unsigned xb_add(unsigned* p, unsigned v) { return __hip_atomic_fetch_add(p, v, __ATOMIC_RELAXED, __HIP_MEMORY_SCOPE_AGENT); }
__device__ __forceinline__ unsigned xb_xcc_id() { return (unsigned)__builtin_amdgcn_s_getreg((3 << 11) | 20) & 0xFu; }
#define XB_SPIN(cond, bar) do { unsigned _sp = 0; while (cond) { __builtin_amdgcn_s_sleep(1); \
    if ((++_sp & 255u) == 0u) { if (xb_ld(&(bar)[XB_TMO])) break; if (_sp > XB_SPIN_CAP) { atomicAdd(&(bar)[XB_TMO], 1u); break; } } } } while (0)

struct XcdBarrier {
    unsigned* bar; unsigned x;
    volatile LAS unsigned* st;
};

__device__ __forceinline__ XcdBarrier xcd_barrier_post(unsigned* bar, volatile LAS unsigned* st) {
    XcdBarrier b; b.bar = bar; b.x = xb_xcc_id(); b.st = st;
    if (threadIdx.x == 0) (void)xb_add(&bar[XB_XCNT(b.x)], 1u);
    return b;
}
__device__ __forceinline__ void xcd_barrier_complete(unsigned* bar, unsigned x, unsigned& nloc, unsigned& nx) {
    const unsigned G = gridDim.x * gridDim.y * gridDim.z;
    unsigned sum, cnt, mine, sp = 0u;
    for (;;) {
        sum = 0u; cnt = 0u; mine = 0u;
#pragma unroll
        for (unsigned j = 0; j < 16; ++j) { const unsigned c = xb_ld(&bar[XB_XCNT(j)]); sum += c; cnt += (c > 0u) ? 1u : 0u; mine = (j == x) ? c : mine; }
        if (sum == G) break;
        __builtin_amdgcn_s_sleep(1);
        if ((++sp & 255u) == 0u) { if (xb_ld(&bar[XB_TMO])) break; if (sp > XB_SPIN_CAP) { atomicAdd(&bar[XB_TMO], 1u); break; } }
    }
    nloc = mine > 0u ? mine : 1u; nx = cnt > 0u ? cnt : 1u;
}

__device__ __forceinline__ void xcd_barrier(const XcdBarrier& b) {
    asm volatile("s_waitcnt vmcnt(0)" ::: "memory");
    __syncthreads();
    if (threadIdx.x == 0) {
        unsigned* bar = b.bar;
        __builtin_amdgcn_s_waitcnt(0);
        unsigned nloc = b.st[0], nx = b.st[1];
        if (nloc == 0u) { xcd_barrier_complete(bar, b.x, nloc, nx); b.st[0] = nloc; b.st[1] = nx; }
        const unsigned old = xb_add(&bar[XB_XSUB(b.x)], 1u);
        const unsigned gen = old / nloc;
        if (old + 1u == (gen + 1u) * nloc) {
            __builtin_amdgcn_fence(__ATOMIC_RELEASE, "agent");
            asm volatile("s_waitcnt vmcnt(0)" ::: "memory");
            const unsigned og = xb_add(&bar[XB_TOP], 1u);
            const unsigned tg = og / nx;
            if (og + 1u == (tg + 1u) * nx) xb_add(&bar[XB_TOPGEN], 1u);
            else XB_SPIN(xb_ld(&bar[XB_TOPGEN]) == tg, bar);
            __builtin_amdgcn_fence(__ATOMIC_ACQUIRE, "agent");
            xb_add(&bar[XB_XGEN(b.x)], 1u);
            asm volatile("s_waitcnt vmcnt(0)" ::: "memory");
        } else {
            XB_SPIN(xb_ld(&bar[XB_XGEN(b.x)]) == gen, bar);
            __builtin_amdgcn_fence(__ATOMIC_ACQUIRE, "agent");
            asm volatile("s_waitcnt vmcnt(0)" ::: "memory");
        }
    }
    __syncthreads();
}


constexpr int NPH = 11;
#ifdef ONLY_PH
#define PH_ON(n) ((n) == ONLY_PH)
#else
#define PH_ON(n) 1
#endif
#define CAS __attribute__((address_space(4)))
__device__ __forceinline__ Params load_params(const CAS Params* kp) {
#if defined(__HIP_DEVICE_COMPILE__)
    unsigned long long kv = (unsigned long long)kp; asm volatile("" : "+s"(kv)); return *(const CAS Params*)kv;
#else
    return Params{};
#endif
}
__global__ void __launch_bounds__(NTHREADS, 2) fwd_kernel(Params Pk) {
    extern __shared__ __attribute__((aligned(16))) char lds[];
    const CAS Params* kp = (const CAS Params*)__builtin_amdgcn_kernarg_segment_ptr();
    const int G0 = gridDim.x; const int bx0 = blockIdx.x;
    const int vcu0 = (G0 % 8 == 0) ? (bx0 % 8) * (G0 / 8) + bx0 / 8 : bx0;
    LAS unsigned char* ldsl = (LAS unsigned char*)lds;
    const int ph_lo = Pk.ph_lo, ph_hi = Pk.ph_hi;
    if (threadIdx.x < 16) ((volatile LAS unsigned*)(ldsl + LDS_BARST))[threadIdx.x] = 0u;
    __syncthreads();
    XcdBarrier xbar = xcd_barrier_post((unsigned*)(Pk.ws + WS_BAR), (volatile LAS unsigned*)(ldsl + LDS_BARST));
#ifndef PROBE_PH
#define PROBE_PH (-1)
#endif
    unsigned long long probe_dt = 0;
#ifndef DUP_PH
#define DUP_PH (-1)
#endif
#ifndef DUP_SUB
#define DUP_SUB 0
#endif
    for (int ph = ph_lo; ph < ph_hi; ++ph) {
      for (int rep = 0; rep < ((ph == DUP_PH) ? 2 : 1); ++rep) {
        int G = G0, bx = bx0, vcu = vcu0; asm volatile("" : "+s"(G), "+s"(bx), "+s"(vcu));
        unsigned long long probe_t0 = 0; if (PROBE_PH >= 0 && ph == PROBE_PH) probe_t0 = __builtin_amdgcn_s_memrealtime();
        switch (ph) {
        case 0: if (PH_ON(0)) { const Params P = load_params(kp); phase0(P, lds, G); } break;
        case 1: if (PH_ON(1)) { const Params P = load_params(kp); phase1a(P, lds, G); } break;
        case 2: if (PH_ON(2)) { const Params P = load_params(kp); unsigned char* ws = P.ws;
                  pg8::Gemm g{(const bf16_t*)(ws + WS_H), (const bf16_t*)(ws + WS_WIN), SEQ, DINP, DM}; pg8::StaticOrder S; S.init(SEQ, DINP, G, bx);
                  pg8::Epi8<StoreProj> E{{(bf16_t*)(ws + WS_PROJ), (float*)(ws + WS_GATES)}};
                  pg8::gemm_phase<pg8::Epi8<StoreProj>, pg8::StaticOrder, true, true>(ldsl, g, S, E); } break;
        case 3: if (PH_ON(3)) { const Params P = load_params(kp); phase2(P, lds, G); } break;
        case 4: if (PH_ON(4)) {
#ifndef NO_G4
#ifndef NO_G4A
                  if (rep == 0 || DUP_SUB == 0 || DUP_SUB == 1) { const Params P = load_params(kp); unsigned char* ws = P.ws;
                    pg8::Gemm g{(const bf16_t*)(ws + WS_CQN), (const bf16_t*)(ws + WS_WUQ), SEQ, NH * 256, QLORA}; pg8::StaticOrder S; S.init(SEQ, NH * 256, G, bx);
                    pg8::Epi8<StoreQ> E{{(bf16_t*)(ws + WS_Q)}};
                    pg8::gemm_phase<pg8::Epi8<StoreQ>, pg8::StaticOrder, true, true>(ldsl, g, S, E); }
#endif
#ifndef NO_G4B
                  if (rep == 0 || DUP_SUB == 0 || DUP_SUB == 2) { const Params P = load_params(kp); unsigned char* ws = P.ws;
                    pg8::Gemm g{(const bf16_t*)(ws + WS_CKVN), (const bf16_t*)(ws + WS_WUKV), SEQ, NH * 256, KVLORA}; pg8::StaticOrder S; S.init(SEQ, NH * 256, G, bx);
                    pg8::Epi8<StoreKV> E{{(bf16_t*)(ws + WS_KV)}};
                    pg8::gemm_phase<pg8::Epi8<StoreKV>, pg8::StaticOrder, true, true>(ldsl, g, S, E); }
#endif
#endif
#ifndef NO_M2
                  if (rep == 0 || DUP_SUB == 0 || DUP_SUB == 3) { const Params P = load_params(kp); for (int b = bx; b < 256; b += G) m2_block(P, lds, b); }
#endif
                  } break;
        case 5: if (PH_ON(5)) { const Params P = load_params(kp); phase4(P, G); } break;
        case 6: if (PH_ON(6)) {
#ifndef NO_ATT
                  if (rep == 0 || DUP_SUB == 0 || DUP_SUB == 1) { const Params P = load_params(kp); unsigned char* ws = P.ws;
                  for (int u = vcu; u < NH * (SEQ / 256); u += G) { const int h = u >> 5, qb = u & 31;
                      att::attn_unit((const bf16_t*)(ws + WS_Q) + (size_t)(qb * 256) * att::LDQ + h * DQK, (const bf16_t*)(ws + WS_K) + h * DQK, (const bf16_t*)(ws + WS_KV) + h * 256 + 128,
                                     (bf16_t*)(ws + WS_MIX) + (size_t)(qb * 256) * DM + h * DV, SEQ, lds); } }
#endif
#ifndef NO_M3
                  if (rep == 0 || DUP_SUB == 0 || DUP_SUB == 2) { const Params P = load_params(kp); for (int u = vcu; u < HM * NCH; u += G) m3_unit(P, lds, u >> 6, u & 63); }
#endif
                  } break;
        case 7: if (PH_ON(7)) { const Params P = load_params(kp); unsigned char* ws = P.ws;
                  pg8::Gemm g{(const bf16_t*)(ws + WS_MIX), (const bf16_t*)(ws + WS_WOUT), SEQ, DM, DM}; pg8::StaticOrder S; S.init(SEQ, DM, G, bx);
                  pg8::Epi4<StoreX1> E{{P.x, (const float*)(ws + WS_MOD) + 2 * DM, P.out}};
                  pg8::gemm_phase<pg8::Epi4<StoreX1>, pg8::StaticOrder, true, true>(ldsl, g, S, E); } break;
        case 8: if (PH_ON(8)) { const Params P = load_params(kp); phase6b(P, lds, G); } break;
        case 9: if (PH_ON(9)) { const Params P = load_params(kp); unsigned char* ws = P.ws;
                  pg8::Gemm g{(const bf16_t*)(ws + WS_H), (const bf16_t*)(ws + WS_W1), SEQ, DFF, DM}; pg8::StaticOrder S; S.init(SEQ, DFF, G, bx);
                  pg8::Epi8<StoreAct> E{{(bf16_t*)(ws + WS_ACT)}};
                  pg8::gemm_phase<pg8::Epi8<StoreAct>, pg8::StaticOrder, true, true>(ldsl, g, S, E); } break;
        case 10: if (PH_ON(10)) { const Params P = load_params(kp); unsigned char* ws = P.ws;
                  pg8::Gemm g{(const bf16_t*)(ws + WS_ACT), (const bf16_t*)(ws + WS_W2), SEQ, DM, DFF}; pg8::StaticOrder S; S.init(SEQ, DM, G, bx);
                  pg8::Epi4<StoreX1> E{{P.out, (const float*)(ws + WS_MOD) + 5 * DM, P.out}};
                  pg8::gemm_phase<pg8::Epi4<StoreX1>, pg8::StaticOrder, true, true>(ldsl, g, S, E); } break;
        default: break;
        }
        if (ph + 1 < ph_hi || rep == 0 && ph == DUP_PH) { xcd_barrier(xbar); }
        if (PROBE_PH >= 0 && ph == PROBE_PH) { __syncthreads(); probe_dt = __builtin_amdgcn_s_memrealtime() - probe_t0; }
      }
    }
    if (PROBE_PH >= 0 && blockIdx.x == 0) { const unsigned long long te = __builtin_amdgcn_s_memrealtime();
        while (__builtin_amdgcn_s_memrealtime() - te < probe_dt) __builtin_amdgcn_s_sleep(8); }
}

extern "C" void kernel_launch(void* const* d_in, const int* in_sizes, int n_in, void* d_out, int out_size, void* d_ws, size_t ws_size, hipStream_t stream) {
    static int grid = 0;
    if (grid == 0) {
        if (n_in != 21 || out_size != SEQ * DM || ws_size < WS_END) { fprintf(stderr, "kernel_launch: unexpected shapes n_in %d out %d ws %zu\n", n_in, out_size, ws_size); grid = -1; return; }
        int dev = 0, cus = 0, per_cu = 0;
        if (hipGetDevice(&dev) != hipSuccess || hipDeviceGetAttribute(&cus, hipDeviceAttributeMultiprocessorCount, dev) != hipSuccess) { grid = -1; return; }
        if (hipFuncSetAttribute((const void*)fwd_kernel, hipFuncAttributeMaxDynamicSharedMemorySize, LDS_BYTES) != hipSuccess) { fprintf(stderr, "kernel_launch: hipFuncSetAttribute failed\n"); grid = -1; return; }
        if (hipOccupancyMaxActiveBlocksPerMultiprocessor(&per_cu, (const void*)fwd_kernel, NTHREADS, LDS_BYTES) != hipSuccess || per_cu < 1) { fprintf(stderr, "kernel_launch: occupancy query says %d\n", per_cu); per_cu = 1; }
        (void)hipGetLastError();
        grid = cus * 1;
    }
    if (grid < 0) return;
    Params p{};
    p.x = (const float*)d_in[0]; p.c = (const float*)d_in[1]; p.pos = (const int*)d_in[2]; p.w_ada = (const float*)d_in[3]; p.b_ada = (const float*)d_in[4];
    p.norm_mix_g = (const float*)d_in[5]; p.w_in = (const float*)d_in[6]; p.b_gates = (const float*)d_in[7]; p.conv_w = (const float*)d_in[8]; p.conv_b = (const float*)d_in[9];
    p.q_lora_g = (const float*)d_in[10]; p.w_uq = (const float*)d_in[11]; p.kv_lora_g = (const float*)d_in[12]; p.w_ukv = (const float*)d_in[13]; p.q_norm_g = (const float*)d_in[14];
    p.k_norm_g = (const float*)d_in[15]; p.mlstm_norm_g = (const float*)d_in[16]; p.w_out = (const float*)d_in[17]; p.norm_mlp_g = (const float*)d_in[18];
    p.w_ff1 = (const float*)d_in[19]; p.w_ff2 = (const float*)d_in[20];
    p.out = (float*)d_out; p.ws = (unsigned char*)d_ws;
#if MK_MULTI
    for (int ph = 0; ph < NPH; ++ph) { p.ph_lo = ph; p.ph_hi = ph + 1; hipLaunchKernelGGL(fwd_kernel, dim3(grid), dim3(NTHREADS), LDS_BYTES, stream, p); }
#else
    p.ph_lo = 0; p.ph_hi = NPH;
    (void)hipMemsetAsync((char*)d_ws + WS_BAR, 0, 16384, stream);
    void* args[] = {&p};
    hipError_t e = hipLaunchCooperativeKernel((const void*)fwd_kernel, dim3(grid), dim3(NTHREADS), args, LDS_BYTES, stream);
    if (e != hipSuccess) fprintf(stderr, "kernel_launch: cooperative launch failed: %s (grid %d)\n", hipGetErrorString(e), grid);
#endif
}
```

```cpp
#include <hip/hip_runtime.h>
#include <hip/hip_cooperative_groups.h>
#include <cstdio>
#include <cstdint>
namespace cg = cooperative_groups;

#ifndef MK_MULTI
#define MK_MULTI 0
#endif

#define LAS __attribute__((address_space(3)))
typedef unsigned short bf16_t;
typedef short bf16x8 __attribute__((ext_vector_type(8)));
typedef short s16x4 __attribute__((ext_vector_type(4)));
typedef float f32x4 __attribute__((ext_vector_type(4)));
typedef float f32x2 __attribute__((ext_vector_type(2)));
typedef float f32x16 __attribute__((ext_vector_type(16)));
typedef unsigned u32x4 __attribute__((ext_vector_type(4)));
typedef unsigned u32x2 __attribute__((ext_vector_type(2)));

constexpr int SEQ = 8192, DM = 2048, DIN = 4944, DINP = 5120, DFF = 8192;
constexpr int NH = 8, DQK = 192, DV = 128, QLORA = 512, KVLORA = 256;
constexpr int HM = 4, DH = 256, LCH = 128, NCH = 64;
constexpr int OFF_CQ = 0, OFF_CKV = 512, OFF_KPE = 768, OFF_QM = 832, OFF_KM = 1856, OFF_VM = 2880, OFF_OM = 3904, OFF_GM = 4928;
constexpr float EPS = 1e-6f;
constexpr int NTHREADS = 512, NWAVES = 8;
constexpr int LDS_BYTES = 147456;
constexpr int LDS_BARST = LDS_BYTES - 64;

constexpr size_t MiB = 1u << 20;
constexpr size_t WS_MODP = 384 * MiB - 2 * MiB;
constexpr size_t WS_MOD = 786432;
constexpr size_t WS_BC = 1 * MiB;
constexpr size_t WS_IG = WS_BC + 262144;
constexpr size_t WS_PM = WS_IG + 262144;
constexpr size_t WS_WL = WS_PM + 262144;
constexpr size_t WS_BAR = 868352;
constexpr size_t WS_CNT = WS_BAR + 16384;
constexpr size_t WS_MB = 860160;
constexpr size_t WS_BL = 851968;
constexpr size_t WS_AC = 856064;
constexpr size_t WS_WIN = 2 * MiB, WS_WUQ = 22 * MiB, WS_WUKV = 24 * MiB, WS_WOUT = 26 * MiB;
constexpr size_t WS_CST = 34 * MiB;
constexpr size_t WS_W1 = 34 * MiB, WS_W2 = 66 * MiB;
constexpr size_t WS_H = 98 * MiB;
constexpr size_t WS_Q = 98 * MiB;
constexpr size_t WS_MIX = 130 * MiB;
constexpr size_t WS_PROJ = 162 * MiB;
constexpr size_t WS_CQN = 242 * MiB, WS_CKVN = 250 * MiB;
constexpr size_t WS_GATES = 254 * MiB;
constexpr size_t WS_NST = 255 * MiB;
constexpr size_t WS_ACT = 130 * MiB;
constexpr size_t WS_KV = 258 * MiB;
constexpr size_t WS_K = 290 * MiB;
constexpr size_t WS_QH = 314 * MiB, WS_KH = 330 * MiB, WS_KT = 346 * MiB, WS_VT = 362 * MiB;
constexpr size_t WS_ROPE = 378 * MiB;
constexpr size_t WS_END = 384 * MiB;

struct Params {
    const float* x; const float* c; const int* pos; const float* w_ada; const float* b_ada; const float* norm_mix_g; const float* w_in;
    const float* b_gates; const float* conv_w; const float* conv_b; const float* q_lora_g; const float* w_uq; const float* kv_lora_g;
    const float* w_ukv; const float* q_norm_g; const float* k_norm_g; const float* mlstm_norm_g; const float* w_out; const float* norm_mlp_g;
    const float* w_ff1; const float* w_ff2;
    float* out; unsigned char* ws; int ph_lo, ph_hi;
};

#define LAUNDER_V(x) asm volatile("" : "+v"(x))
#define LAUNDER_S(x) asm volatile("" : "+s"(x))
__device__ __forceinline__ int tid_opaque() { int t = threadIdx.x; LAUNDER_V(t); return t; }
__device__ __forceinline__ unsigned cvt_pk_bf16(float lo, float hi) { unsigned r; asm volatile("v_cvt_pk_bf16_f32 %0, %1, %2" : "=v"(r) : "v"(lo), "v"(hi)); return r; }
__device__ __forceinline__ float bf_lo(unsigned w) { return __uint_as_float(w << 16); }
__device__ __forceinline__ float bf_hi(unsigned w) { return __uint_as_float(w & 0xffff0000u); }
__device__ __forceinline__ float bf2f(bf16_t b) { return __uint_as_float(((unsigned)b) << 16); }
__device__ __forceinline__ bf16_t f2bf(float f) { return (bf16_t)(cvt_pk_bf16(f, 0.f) & 0xffffu); }
__device__ __forceinline__ float wave_sum(float v) {
#pragma unroll
    for (int o = 1; o < 64; o <<= 1) v += __shfl_xor(v, o);
    return v;
}
template <class T> __device__ __forceinline__ T ldgu(const void* ubase, unsigned voff) { return *(const T*)((const char*)ubase + voff); }
__device__ __forceinline__ float silu_f(float v) { return v / (1.f + __expf(-v)); }
__device__ __forceinline__ float sigmoid_f(float v) { return 1.f / (1.f + __expf(-v)); }
__device__ __forceinline__ void unpack8(u32x4 w, float* f) {
    f[0] = bf_lo(w.x); f[1] = bf_hi(w.x); f[2] = bf_lo(w.y); f[3] = bf_hi(w.y); f[4] = bf_lo(w.z); f[5] = bf_hi(w.z); f[6] = bf_lo(w.w); f[7] = bf_hi(w.w);
}
__device__ __forceinline__ u32x4 pack8(const float* f) {
    u32x4 w; w.x = cvt_pk_bf16(f[0], f[1]); w.y = cvt_pk_bf16(f[2], f[3]); w.z = cvt_pk_bf16(f[4], f[5]); w.w = cvt_pk_bf16(f[6], f[7]); return w;
}

namespace pg8 {
constexpr int BM = 256, BK = 64, HALF = 128, HTB = HALF * BK * 2, STAGE_BYTES = 8 * HTB, NXCD = 8, WGM = 8;
__host__ __device__ __forceinline__ int lds_byte(int r, int c) { const int st = (r >> 4) * 2 + (c >> 5), rr = r & 15, cc = c & 31, ob = rr * 64 + cc * 2; return st * 1024 + (ob ^ (((ob >> 9) & 1) << 5)); }
__host__ __device__ __forceinline__ void stage_rc(int b, int& R, int& C) { const int st = b / 1024, sb = b % 1024, swz = sb ^ (((sb >> 9) & 1) << 5); R = (st >> 1) * 16 + swz / 64; C = (st & 1) * 32 + (swz % 64) / 2; }
__host__ __device__ __forceinline__ int perm32(int rho) { const int n = rho >> 4, i = rho & 15; return 8 * (i >> 2) + 4 * n + (i & 3); }
struct Unit { int pm, pn; };
struct Gemm { const bf16_t* A; const bf16_t* Bt; int M, N, K; };
struct StaticOrder {
    int nM, nN, nwg, G, c;
    __host__ __device__ void init(int M, int N, int G_, int c_) { nM = M / BM; nN = N / BM; nwg = nM * nN; G = G_; c = c_; }
    __host__ __device__ bool next(int i, Unit& u) const {
        const long L = (long)i * G + c; if (L >= nwg) return false;
        int wgid = (int)L; { const int q = nwg / NXCD, r = nwg % NXCD, xcd = wgid % NXCD, off = wgid / NXCD; wgid = (xcd < r ? xcd * (q + 1) : r * (q + 1) + (xcd - r) * q) + off; }
        const int nig = WGM * nN, gid = wgid / nig, fm = gid * WGM, gsz = (nM - fm) < WGM ? (nM - fm) : WGM;
        u.pm = fm + ((wgid % nig) % gsz); u.pn = (wgid % nig) / gsz; return true;
    }
    __device__ __forceinline__ void a_ready(const Unit&) const {}
    __device__ __forceinline__ void done(const Unit&) const {}
};
template <class F> struct Epi8 {
    static constexpr bool PERM = true, AFTER_DRAIN = false; F f;
    __device__ __forceinline__ void operator()(const f32x4 (&acc)[2][2][4][2], const Unit& u, int wr, int wc, int fr, int fq) const {
        const int row0 = u.pm * BM + wr * 64 + fr, col0 = u.pn * BM + wc * 32 + 8 * fq;
#pragma unroll
        for (int ai = 0; ai < 2; ++ai)
#pragma unroll
            for (int m = 0; m < 4; ++m)
#pragma unroll
                for (int bj = 0; bj < 2; ++bj) f(row0 + ai * HALF + m * 16, col0 + bj * HALF, acc[ai][bj][m][0], acc[ai][bj][m][1]);
    }
};
template <class F> struct Epi4 {
    static constexpr bool PERM = false, AFTER_DRAIN = false; F f;
    __device__ __forceinline__ void operator()(const f32x4 (&acc)[2][2][4][2], const Unit& u, int wr, int wc, int fr, int fq) const {
        const int row0 = u.pm * BM + wr * 64 + fr, col0 = u.pn * BM + wc * 32 + 4 * fq;
#pragma unroll
        for (int ai = 0; ai < 2; ++ai)
#pragma unroll
            for (int m = 0; m < 4; ++m) {
#pragma unroll
                for (int bj = 0; bj < 2; ++bj)
#pragma unroll
                    for (int n = 0; n < 2; ++n) f(row0 + ai * HALF + m * 16, col0 + bj * HALF + n * 16, acc[ai][bj][m][n]);
                if (m & 1) asm volatile("" ::: "memory");
            }
    }
};

template <class Epi, class Sched, bool ALIGN_EPI = false, bool SP2 = false>
__device__ __forceinline__ void gemm_phase(LAS unsigned char* lds, const Gemm g, const Sched& S, const Epi& E) {
    const int tid = tid_opaque(), wid = __builtin_amdgcn_readfirstlane(tid >> 6), lane = tid & 63, wr = wid >> 2, wc = wid & 3, fr = lane & 15, fq = lane >> 4;
    const int K = g.K, nt = K / BK;
    unsigned voffA[2], voffB[2];
#pragma unroll
    for (int i = 0; i < 2; ++i) { int R, C; stage_rc(tid * 16 + i * 8192, R, C); const int Rb = Epi::PERM ? ((R & ~31) + perm32(R & 31)) : R;
        voffA[i] = (unsigned)(R * K + C) * 2u; voffB[i] = (unsigned)(Rb * K + C) * 2u; }
    const size_t kstep = (size_t)(BK * 2);
    const size_t hstep = (size_t)HALF * K * 2;
    const size_t tstep = 2 * hstep;
    const unsigned ldsw = (unsigned)wid * 1024u;
    const int aoff = lds_byte(wr * 64 + fr, fq * 8), boff = lds_byte(wc * 32 + fr, fq * 8);
#define PG8_SA(b, h) (((b) * 2 + (h)) * HTB)
#define PG8_SB(b, h) ((4 + (b) * 2 + (h)) * HTB)
#define PG8_STAGE(bufoff, gbase, voff) do { _Pragma("unroll") for (int _i = 0; _i < 2; ++_i) \
        __builtin_amdgcn_global_load_lds((const unsigned*)((const char*)(gbase) + (voff)[_i]), (LAS unsigned*)(lds + (bufoff) + ldsw + _i * 8192), 16, 0, 0); } while (0)
#define PG8_LDA(dst, b, h) do { _Pragma("unroll") for (int m = 0; m < 4; ++m) _Pragma("unroll") for (int k = 0; k < 2; ++k) dst[m][k] = *(const LAS bf16x8*)(lds + PG8_SA(b, h) + aoff + m * 2048 + k * 1024); } while (0)
#define PG8_LDB(dst, b, h) do { _Pragma("unroll") for (int n = 0; n < 2; ++n) _Pragma("unroll") for (int k = 0; k < 2; ++k) dst[n][k] = *(const LAS bf16x8*)(lds + PG8_SB(b, h) + boff + n * 2048 + k * 1024); } while (0)
#define PG8_MMA(ai, bj, At, Bt) do { __builtin_amdgcn_s_setprio(1); _Pragma("unroll") for (int m = 0; m < 4; ++m) _Pragma("unroll") for (int n = 0; n < 2; ++n) _Pragma("unroll") for (int k = 0; k < 2; ++k) \
        acc[ai][bj][m][n] = __builtin_amdgcn_mfma_f32_16x16x32_bf16(Bt[n][k], At[m][k], acc[ai][bj][m][n], 0, 0, 0); __builtin_amdgcn_s_setprio(0); } while (0)
#define PG8_WAIT_V(n) asm volatile("s_waitcnt vmcnt(" #n ")" ::: "memory")
#define PG8_WAIT_L(n) asm volatile("s_waitcnt lgkmcnt(" #n ")" ::: "memory")
#define PG8_BAR __builtin_amdgcn_s_barrier()
#define PG8_SCHED __builtin_amdgcn_sched_barrier(0)
    Unit cur, nxt; int ui = 0;
    if (!S.next(0, cur)) return;
    f32x4 acc[2][2][4][2];
#pragma unroll
    for (int a = 0; a < 2; ++a)
#pragma unroll
        for (int b = 0; b < 2; ++b)
#pragma unroll
            for (int m = 0; m < 4; ++m)
#pragma unroll
                for (int n = 0; n < 2; ++n) acc[a][b][m][n] = (f32x4){0.f, 0.f, 0.f, 0.f};
    bf16x8 At[4][2], B0[2][2], B1[2][2];
    const char* cA = (const char*)g.A + (size_t)cur.pm * tstep; const char* cB = (const char*)g.Bt + (size_t)cur.pn * tstep;
    S.a_ready(cur);
    if constexpr (SP2) {
        PG8_STAGE(PG8_SB(0, 0), cB, voffB); PG8_STAGE(PG8_SB(0, 1), cB + hstep, voffB); PG8_STAGE(PG8_SA(0, 0), cA, voffA); PG8_STAGE(PG8_SA(0, 1), cA + hstep, voffA);
        if (wr == 1) PG8_BAR;
        PG8_WAIT_V(2); PG8_BAR;
        PG8_STAGE(PG8_SB(1, 0), cB + kstep, voffB); PG8_STAGE(PG8_SA(1, 0), cA + kstep, voffA); PG8_STAGE(PG8_SB(1, 1), cB + hstep + kstep, voffB);
        PG8_WAIT_V(6); PG8_BAR;
    } else {
        PG8_STAGE(PG8_SB(0, 0), cB, voffB); PG8_STAGE(PG8_SA(0, 0), cA, voffA); PG8_STAGE(PG8_SB(0, 1), cB + hstep, voffB); PG8_STAGE(PG8_SA(0, 1), cA + hstep, voffA);
        if (wr == 1) PG8_BAR;
        PG8_WAIT_V(4); PG8_BAR;
        PG8_STAGE(PG8_SB(1, 0), cB + kstep, voffB); PG8_STAGE(PG8_SA(1, 0), cA + kstep, voffA); PG8_STAGE(PG8_SB(1, 1), cB + hstep + kstep, voffB);
        PG8_WAIT_V(6); PG8_BAR;
    }
    for (;;) {
        const bool has_next = S.next(ui + 1, nxt);
        const char* nA = has_next ? (const char*)g.A + (size_t)nxt.pm * tstep : cA; const char* nB = has_next ? (const char*)g.Bt + (size_t)nxt.pn * tstep : cB;
#pragma unroll 1
        for (int t = 0; t < nt; t += 2) {
            const bool last = (t == nt - 2);
            const char* a1 = cA + (size_t)(t + 1) * kstep;
            const char* a2 = last ? nA : cA + (size_t)(t + 2) * kstep; const char* b2 = last ? nB : cB + (size_t)(t + 2) * kstep;
            const char* a3 = a2 + kstep; const char* b3 = b2 + kstep;
            if (last && has_next) S.a_ready(nxt);
            if constexpr (SP2) {
            PG8_LDB(B0, 0, 0); PG8_LDB(B1, 0, 1); PG8_SCHED; PG8_LDA(At, 0, 0); PG8_STAGE(PG8_SA(1, 1), a1 + hstep, voffA);
            PG8_WAIT_V(8); PG8_WAIT_L(0); PG8_BAR; PG8_MMA(0, 0, At, B0); PG8_MMA(0, 1, At, B1); PG8_BAR; PG8_SCHED;
            PG8_LDA(At, 0, 1); PG8_STAGE(PG8_SB(0, 0), b2, voffB); PG8_STAGE(PG8_SB(0, 1), b2 + hstep, voffB); PG8_STAGE(PG8_SA(0, 0), a2, voffA);
            PG8_WAIT_V(8); PG8_WAIT_L(0); PG8_BAR; PG8_MMA(1, 0, At, B0); PG8_MMA(1, 1, At, B1); PG8_BAR; PG8_SCHED;
            PG8_LDB(B0, 1, 0); PG8_LDB(B1, 1, 1); PG8_SCHED; PG8_LDA(At, 1, 0); PG8_STAGE(PG8_SA(0, 1), a2 + hstep, voffA);
            PG8_WAIT_V(8); PG8_WAIT_L(0); PG8_BAR; PG8_MMA(0, 0, At, B0); PG8_MMA(0, 1, At, B1); PG8_BAR; PG8_SCHED;
            PG8_LDA(At, 1, 1); PG8_STAGE(PG8_SB(1, 0), b3, voffB); PG8_STAGE(PG8_SB(1, 1), b3 + hstep, voffB); PG8_STAGE(PG8_SA(1, 0), a3, voffA);
            PG8_WAIT_V(8); PG8_WAIT_L(0); PG8_BAR; PG8_MMA(1, 0, At, B0); PG8_MMA(1, 1, At, B1); PG8_BAR; PG8_SCHED;
            } else {
            PG8_LDB(B0, 0, 0); PG8_SCHED; PG8_LDA(At, 0, 0); PG8_STAGE(PG8_SA(1, 1), a1 + hstep, voffA);
            PG8_WAIT_L(8); PG8_BAR; PG8_WAIT_L(0); PG8_MMA(0, 0, At, B0); PG8_BAR; PG8_SCHED;
            PG8_LDB(B1, 0, 1); PG8_STAGE(PG8_SB(0, 0), b2, voffB);
            PG8_BAR; PG8_WAIT_L(0); PG8_MMA(0, 1, At, B1); PG8_BAR;
            PG8_LDA(At, 0, 1); PG8_STAGE(PG8_SA(0, 0), a2, voffA);
            PG8_BAR; PG8_WAIT_L(0); PG8_MMA(1, 0, At, B0); PG8_BAR; PG8_SCHED;
            PG8_STAGE(PG8_SB(0, 1), b2 + hstep, voffB);
            PG8_WAIT_V(6); PG8_BAR; PG8_MMA(1, 1, At, B1); PG8_BAR;
            PG8_LDB(B0, 1, 0); PG8_SCHED; PG8_LDA(At, 1, 0); PG8_STAGE(PG8_SA(0, 1), a2 + hstep, voffA);
            PG8_WAIT_L(8); PG8_BAR; PG8_WAIT_L(0); PG8_MMA(0, 0, At, B0); PG8_BAR; PG8_SCHED;
            PG8_LDB(B1, 1, 1); PG8_STAGE(PG8_SB(1, 0), b3, voffB);
            PG8_BAR; PG8_WAIT_L(0); PG8_MMA(0, 1, At, B1); PG8_BAR;
            PG8_LDA(At, 1, 1); PG8_STAGE(PG8_SA(1, 0), a3, voffA);
            PG8_BAR; PG8_WAIT_L(0); PG8_MMA(1, 0, At, B0); PG8_BAR; PG8_SCHED;
            PG8_STAGE(PG8_SB(1, 1), b3 + hstep, voffB);
            PG8_WAIT_V(6); PG8_BAR; PG8_MMA(1, 1, At, B1); PG8_BAR;
            }
        }
        if constexpr (ALIGN_EPI) { if (wr == 0) PG8_BAR; }
        if constexpr (!Epi::AFTER_DRAIN) { E(acc, cur, wr, wc, fr, fq); S.done(cur); }
        if (!has_next) break;
#pragma unroll
        for (int a = 0; a < 2; ++a)
#pragma unroll
            for (int b = 0; b < 2; ++b)
#pragma unroll
                for (int m = 0; m < 4; ++m)
#pragma unroll
                    for (int n = 0; n < 2; ++n) acc[a][b][m][n] = (f32x4){0.f, 0.f, 0.f, 0.f};
        cur = nxt; cA = nA; cB = nB; ++ui;
        if constexpr (ALIGN_EPI) { if (wr == 1) PG8_BAR; }
    }
    PG8_WAIT_V(0);
    if constexpr (!ALIGN_EPI) { if (wr == 0) PG8_BAR; }
    PG8_BAR;
#undef PG8_SA
#undef PG8_SB
#undef PG8_STAGE
#undef PG8_LDA
#undef PG8_LDB
#undef PG8_MMA
#undef PG8_WAIT_V
#undef PG8_WAIT_L
#undef PG8_BAR
#undef PG8_SCHED
}
}

namespace att {
constexpr int NW = 8, QBLK = 32, KVBLK = 64;
constexpr int LDQ = NH * DQK, LDK = NH * DQK, LDV = NH * 256, LDO = DM;
constexpr float SCALE = 0.07216878364870322f;
constexpr float THR = 8.f;
constexpr int SHM_K = KVBLK * DQK * 2, SHM_V = KVBLK * DV * 2;
constexpr int SHM_QL = 2 * SHM_V + 2 * SHM_K + NW * 64 * 4;
constexpr int SHM_ATTN = SHM_QL + NW * 4096;
#define KSWZ(row, colB) ((row) * 384 + ((colB) ^ ((((row) >> 1) & 7) << 4)))
#define SBAR() __builtin_amdgcn_sched_barrier(0)
__device__ __forceinline__ int crow(int r, int hi) { return (r & 3) + 8 * (r >> 2) + 4 * hi; }
__device__ __forceinline__ void partialSM(f32x16& p0, f32x16& p1, float& m_reg, float& mn, float& alpha) {
    constexpr float C = SCALE * 1.4426950408889634f;
    float pmax = p0[0];
#pragma unroll
    for (int r = 1; r < 16; ++r) pmax = fmaxf(pmax, p0[r]);
#pragma unroll
    for (int r = 0; r < 16; ++r) pmax = fmaxf(pmax, p1[r]);
    { auto rr = __builtin_amdgcn_permlane32_swap(__float_as_uint(pmax), __float_as_uint(pmax), false, false);
      pmax = fmaxf(__uint_as_float(rr[0]), __uint_as_float(rr[1])); }
    if (__builtin_expect(__all(pmax - m_reg <= THR / SCALE), 1)) { mn = m_reg; alpha = 1.f; }
    else { mn = fmaxf(m_reg, pmax); alpha = __builtin_amdgcn_exp2f((m_reg - mn) * C); m_reg = mn; }
    float mnC = -mn * C;
#pragma unroll
    for (int r = 0; r < 16; ++r) p0[r] = fmaf(p0[r], C, mnC);
#pragma unroll
    for (int r = 0; r < 16; ++r) p1[r] = fmaf(p1[r], C, mnC);
#pragma unroll
    for (int r = 0; r < 16; ++r) p0[r] = __builtin_amdgcn_exp2f(p0[r]);
}
__device__ __forceinline__ void finishSM(f32x16& p0, f32x16& p1, float alpha, float& l_reg, bf16x8& pa0, bf16x8& pa1, bf16x8& pa2, bf16x8& pa3) {
#pragma unroll
    for (int r = 0; r < 16; ++r) p1[r] = __builtin_amdgcn_exp2f(p1[r]);
    float ps = 0;
#pragma unroll
    for (int r = 0; r < 16; ++r) ps += p0[r];
#pragma unroll
    for (int r = 0; r < 16; ++r) ps += p1[r];
    { auto rr = __builtin_amdgcn_permlane32_swap(__float_as_uint(ps), __float_as_uint(ps), false, false);
      ps = __uint_as_float(rr[0]) + __uint_as_float(rr[1]); }
    l_reg = l_reg * alpha + ps;
#define PK4(P, BASE, OUT) do { unsigned a0 = cvt_pk_bf16(P[BASE + 0], P[BASE + 1]), a1 = cvt_pk_bf16(P[BASE + 2], P[BASE + 3]);   \
    unsigned b0 = cvt_pk_bf16(P[BASE + 4], P[BASE + 5]), b1 = cvt_pk_bf16(P[BASE + 6], P[BASE + 7]);                              \
    auto r0 = __builtin_amdgcn_permlane32_swap(a0, b0, false, false); auto r1 = __builtin_amdgcn_permlane32_swap(a1, b1, false, false); \
    u32x4 w = {r0[0], r1[0], r0[1], r1[1]}; OUT = *reinterpret_cast<bf16x8*>(&w); } while (0)
    PK4(p0, 0, pa0); PK4(p0, 8, pa1); PK4(p1, 0, pa2); PK4(p1, 8, pa3);
#undef PK4
}
__device__ __forceinline__ void qkt(f32x16& p0, f32x16& p1, const char* Ks, const bf16x8* qr, const char* ql, int r32, int hi) {
    p0 = f32x16{}; p1 = f32x16{};
#pragma unroll
    for (int d0 = 0; d0 < 12; ++d0) { const int cb = (d0 * 16 + hi * 8) * 2;
        bf16x8 b0 = *reinterpret_cast<const bf16x8*>(Ks + KSWZ(r32, cb));
        bf16x8 b1 = *reinterpret_cast<const bf16x8*>(Ks + KSWZ(32 + r32, cb));
        const bf16x8 q = d0 < 8 ? qr[d0 < 8 ? d0 : 0] : *reinterpret_cast<const bf16x8*>(ql + (d0 - 8) * 1024);
        p0 = __builtin_amdgcn_mfma_f32_32x32x16_bf16(b0, q, p0, 0, 0, 0);
        p1 = __builtin_amdgcn_mfma_f32_32x32x16_bf16(b1, q, p1, 0, 0, 0); }
}
__device__ __forceinline__ int v_st(int k, int c) { const int kk = (k & ~0xC) | ((k & 4) << 1) | ((k & 8) >> 1); return ((kk >> 3) * 4 + (c >> 5)) * 512 + ((kk & 7) * 32 + (c & 31)) * 2; }
__device__ __forceinline__ int v_rd_base(int lane) { return ((lane & 3) << 3) | (((lane >> 2) & 3) << 6) | (((lane >> 4) & 1) << 5) | (((lane >> 5) & 1) << 8); }
constexpr int v_rd_off(int d0, int ks, int half) { return d0 * 512 + ks * 4096 + half * 2048; }
template <int OFF> __device__ __forceinline__ s16x4 tr_read(int vb) {
    s16x4 r; asm volatile("ds_read_b64_tr_b16 %0, %1 offset:%2" : "=&v"(r) : "v"(vb), "i"(OFF) : "memory"); return r;
}
template <int D0> __device__ __forceinline__ void pv_one(f32x16& od, int vb, bf16x8 pa0, bf16x8 pa1, bf16x8 pa2, bf16x8 pa3) {
    const s16x4 l0 = tr_read<v_rd_off(D0, 0, 0)>(vb), h0 = tr_read<v_rd_off(D0, 0, 1)>(vb), l1 = tr_read<v_rd_off(D0, 1, 0)>(vb), h1 = tr_read<v_rd_off(D0, 1, 1)>(vb);
    const s16x4 l2 = tr_read<v_rd_off(D0, 2, 0)>(vb), h2 = tr_read<v_rd_off(D0, 2, 1)>(vb), l3 = tr_read<v_rd_off(D0, 3, 0)>(vb), h3 = tr_read<v_rd_off(D0, 3, 1)>(vb);
    asm volatile("s_waitcnt lgkmcnt(0)" ::: "memory"); SBAR();
#define PK(L, H) (bf16x8){L[0], L[1], L[2], L[3], H[0], H[1], H[2], H[3]}
    od = __builtin_amdgcn_mfma_f32_32x32x16_bf16(pa0, PK(l0, h0), od, 0, 0, 0);
    od = __builtin_amdgcn_mfma_f32_32x32x16_bf16(pa1, PK(l1, h1), od, 0, 0, 0);
    od = __builtin_amdgcn_mfma_f32_32x32x16_bf16(pa2, PK(l2, h2), od, 0, 0, 0);
    od = __builtin_amdgcn_mfma_f32_32x32x16_bf16(pa3, PK(l3, h3), od, 0, 0, 0);
#undef PK
}
__device__ __forceinline__ void pv_d0(f32x16* o, int vb, bf16x8 pa0, bf16x8 pa1, bf16x8 pa2, bf16x8 pa3) {
    pv_one<0>(o[0], vb, pa0, pa1, pa2, pa3); pv_one<1>(o[1], vb, pa0, pa1, pa2, pa3); pv_one<2>(o[2], vb, pa0, pa1, pa2, pa3); pv_one<3>(o[3], vb, pa0, pa1, pa2, pa3);
}
#ifndef ATT_SDEPTH
#define ATT_SDEPTH 1
#endif
constexpr int SDEPTH = ATT_SDEPTH;
__device__ __forceinline__ void attn_unit(const bf16_t* __restrict__ Qb, const bf16_t* __restrict__ Kh, const bf16_t* __restrict__ Vh, bf16_t* __restrict__ Ob, int seq, char* lds) {
    const int tid = tid_opaque(), wid = tid >> 6, lane = tid & 63, r32 = lane & 31, hi = lane >> 5;
    char* V_lds = lds; char* K_lds = lds + 2 * SHM_V;
    float* ws = (float*)(lds + 2 * SHM_V + 2 * SHM_K) + wid * 64; float* li_l = ws; float* al_l = ws + 32;
    float m_reg = -1e30f, l_reg = 0; f32x16 o[4] = {}; bf16x8 qr[8];
    const bf16_t* Qw = Qb + (long)(wid * QBLK + r32) * LDQ + hi * 8;
    char* ql = lds + SHM_QL + wid * 4096 + lane * 16;
#pragma unroll
    for (int d0 = 0; d0 < 8; ++d0) qr[d0] = *reinterpret_cast<const bf16x8*>(Qw + d0 * 16);
#pragma unroll
    for (int d0 = 8; d0 < 12; ++d0) *reinterpret_cast<bf16x8*>(ql + (d0 - 8) * 1024) = *reinterpret_cast<const bf16x8*>(Qw + d0 * 16);
    const int krow = tid >> 3, kc8 = tid & 7;
    const unsigned kgo = (unsigned)(krow * LDK + kc8 * 8) * 2u;
    const int kso = krow * 384 + ((kc8 * 16) ^ (((krow >> 1) & 7) << 4));
    const int sr = tid >> 4, sc = (tid & 15) * 8, vst0 = v_st(sr, sc);
    const unsigned vgo = (unsigned)(sr * LDV + sc) * 2u;
    const int vb0 = (int)(uintptr_t)V_lds + v_rd_base(lane);
    struct { bf16x8 k0, k1, k2, v0, v1; } sr_[SDEPTH];
#define SLOAD(i, kk0) do { const char* kp_ = (const char*)(Kh + (long)(kk0) * LDK); const char* vp_ = (const char*)(Vh + (long)(kk0) * LDV); \
    sr_[i].v0 = ldgu<bf16x8>(vp_, vgo); sr_[i].v1 = ldgu<bf16x8>(vp_ + 32 * LDV * 2, vgo); \
    sr_[i].k0 = ldgu<bf16x8>(kp_, kgo); sr_[i].k1 = ldgu<bf16x8>(kp_ + 128, kgo); sr_[i].k2 = ldgu<bf16x8>(kp_ + 256, kgo); } while (0)
#define SWRITE(b, i) do { *(bf16x8*)(V_lds + (b) * SHM_V + vst0) = sr_[i].v0; *(bf16x8*)(V_lds + (b) * SHM_V + 8192 + vst0) = sr_[i].v1; \
    *(bf16x8*)(K_lds + (b) * SHM_K + kso) = sr_[i].k0; *(bf16x8*)(K_lds + (b) * SHM_K + 128 + kso) = sr_[i].k1; *(bf16x8*)(K_lds + (b) * SHM_K + 256 + kso) = sr_[i].k2; } while (0)
#define SWAIT() do { if constexpr (SDEPTH == 2) asm volatile("s_waitcnt vmcnt(5)" ::: "memory"); else asm volatile("s_waitcnt vmcnt(0)" ::: "memory"); } while (0)
#define RESC(a) do { if (__any((a) < 1.f)) { if (hi == 0) al_l[r32] = (a); asm volatile("s_waitcnt lgkmcnt(0)" ::: "memory"); \
    _Pragma("unroll") for (int d = 0; d < 4; ++d) _Pragma("unroll") for (int r = 0; r < 16; ++r) o[d][r] *= al_l[crow(r, hi)]; } } while (0)
    f32x16 pA0, pA1, pB0, pB1; float mnA, mnB, alA, alB; bf16x8 pa0, pa1, pa2, pa3; const int NT = seq / KVBLK;
    constexpr int SE = 0, SO = SDEPTH - 1;
    SLOAD(SE, 0); asm volatile("s_waitcnt vmcnt(0)" ::: "memory"); SWRITE(0, SE); __syncthreads();
    qkt(pA0, pA1, K_lds, qr, ql, r32, hi); partialSM(pA0, pA1, m_reg, mnA, alA);
    SLOAD(SO, KVBLK); if constexpr (SDEPTH == 2) { if (2 < NT) SLOAD(SE, 2 * KVBLK); }
    SWAIT(); SWRITE(1, SO); __syncthreads();
    for (int j = 1; j + 1 < NT; j += 2) {
        SBAR(); qkt(pB0, pB1, K_lds + SHM_K, qr, ql, r32, hi);
        finishSM(pA0, pA1, alA, l_reg, pa0, pa1, pa2, pa3); SBAR();
        SLOAD(SO, (j + SDEPTH) * KVBLK); SBAR();
        pv_d0(o, vb0, pa0, pa1, pa2, pa3); partialSM(pB0, pB1, m_reg, mnB, alB);
        __syncthreads(); SWAIT(); SWRITE(0, SE);
        RESC(alB); __syncthreads();
        SBAR(); qkt(pA0, pA1, K_lds, qr, ql, r32, hi);
        finishSM(pB0, pB1, alB, l_reg, pa0, pa1, pa2, pa3); SBAR();
        if (SDEPTH == 1 || j + 3 < NT) SLOAD(SE, (j + 1 + SDEPTH) * KVBLK); SBAR();
        pv_d0(o, vb0 + SHM_V, pa0, pa1, pa2, pa3); partialSM(pA0, pA1, m_reg, mnA, alA);
        __syncthreads(); SWAIT(); SWRITE(1, SO);
        RESC(alA); __syncthreads();
    }
    SBAR(); qkt(pB0, pB1, K_lds + SHM_K, qr, ql, r32, hi);
    finishSM(pA0, pA1, alA, l_reg, pa0, pa1, pa2, pa3); SBAR();
    pv_d0(o, vb0, pa0, pa1, pa2, pa3); partialSM(pB0, pB1, m_reg, mnB, alB);
    __syncthreads(); RESC(alB);
    finishSM(pB0, pB1, alB, l_reg, pa0, pa1, pa2, pa3); SBAR();
    pv_d0(o, vb0 + SHM_V, pa0, pa1, pa2, pa3);
    if (hi == 0) li_l[r32] = l_reg; asm volatile("s_waitcnt lgkmcnt(0)" ::: "memory");
    float rli[16];
#pragma unroll
    for (int r = 0; r < 16; ++r) rli[r] = __builtin_amdgcn_rcpf(li_l[crow(r, hi)]);
    bf16_t* Ow = Ob + (long)(wid * QBLK) * LDO;
#pragma unroll
    for (int r = 0; r < 16; ++r) { const int orow = crow(r, hi);
#pragma unroll
        for (int d0 = 0; d0 < 4; ++d0) Ow[(long)orow * LDO + d0 * 32 + r32] = f2bf(o[d0][r] * rli[r]); }
    __syncthreads();
#undef SLOAD
#undef SWRITE
#undef SWAIT
#undef RESC
}
#undef SBAR
}

template <class RowMap>
__device__ __forceinline__ void transpose_tile(const float* __restrict__ W, int K, int N, bf16_t* __restrict__ WT, float* scr, int kb, int nb, int lane, RowMap rm) {
    const int k0 = 64 * kb, n0 = 64 * nb; const int nq = 4 * (lane & 15), kr = lane >> 4; const bool ok = (n0 + nq) < N;
    const float* wp = W + (size_t)(k0 + kr) * N + n0 + nq;
#pragma unroll 4
    for (int i = 0; i < 16; ++i) { f32x4 v = {0.f, 0.f, 0.f, 0.f}; if (ok) v = *(const f32x4*)(wp + (size_t)(4 * i) * N);
        float* d = scr + nq * 65 + 4 * i + kr; d[0] = v[0]; d[65] = v[1]; d[130] = v[2]; d[195] = v[3]; }
    asm volatile("s_waitcnt lgkmcnt(0)" ::: "memory");
    const int c = lane & 7;
#pragma unroll
    for (int j = 0; j < 8; ++j) { const int nl = (lane >> 3) + 8 * j; const int n = n0 + nl; const float* sp = scr + nl * 65 + 8 * c;
        u32x4 o; o.x = cvt_pk_bf16(sp[0], sp[1]); o.y = cvt_pk_bf16(sp[2], sp[3]); o.z = cvt_pk_bf16(sp[4], sp[5]); o.w = cvt_pk_bf16(sp[6], sp[7]);
        if (n < N) *(u32x4*)(WT + (size_t)rm(n) * K + k0 + 8 * c) = o; }
    asm volatile("s_waitcnt lgkmcnt(0)" ::: "memory");
}
struct RowId { __device__ __forceinline__ int operator()(int n) const { return n; } };
struct RowUq { __device__ __forceinline__ int operator()(int n) const { return (n / DQK) * 256 + (n % DQK); } };

__device__ __forceinline__ void phase0(const Params& P, char* lds, int G) {
    const int tid = tid_opaque(), lane = tid & 63, wave = tid >> 6;
    const int gw = blockIdx.x * NWAVES + wave, NGW = G * NWAVES;
    float* modp = (float*)(P.ws + WS_MODP);
    for (int task = gw; task < 1536; task += NGW) {
        const int ks = task / 48, cb = task % 48;
        const float s0 = silu_f(P.c[ks * 64 + lane]);
        f32x4 acc = {0.f, 0.f, 0.f, 0.f};
        const float* wp = P.w_ada + (size_t)(ks * 64) * (6 * DM) + cb * 256 + lane * 4;
#pragma unroll 16
        for (int kk = 0; kk < 64; ++kk) { const float sv = __shfl(s0, kk); const f32x4 w = __builtin_nontemporal_load((const f32x4*)(wp + (size_t)kk * (6 * DM))); acc += w * sv; }
        { unsigned long long* pp = (unsigned long long*)(modp + (size_t)ks * (6 * DM) + cb * 256 + lane * 4);
          __hip_atomic_store(pp, ((unsigned long long)__float_as_uint(acc[1]) << 32) | __float_as_uint(acc[0]), __ATOMIC_RELAXED, __HIP_MEMORY_SCOPE_AGENT);
          __hip_atomic_store(pp + 1, ((unsigned long long)__float_as_uint(acc[3]) << 32) | __float_as_uint(acc[2]), __ATOMIC_RELAXED, __HIP_MEMORY_SCOPE_AGENT); }
        asm volatile("s_waitcnt vmcnt(0)" ::: "memory");
        unsigned old = 0u; if (lane == 0) old = __hip_atomic_fetch_add((unsigned*)(P.ws + WS_CNT) + cb * 16, 1u, __ATOMIC_RELAXED, __HIP_MEMORY_SCOPE_AGENT);
        old = __builtin_amdgcn_readfirstlane(old);
        if (old == 31u) {
            __builtin_amdgcn_fence(__ATOMIC_ACQUIRE, "agent");
            asm volatile("s_waitcnt vmcnt(0)" ::: "memory");
            f32x4 a = *(const f32x4*)(P.b_ada + cb * 256 + lane * 4);
#pragma unroll 8
            for (int k2 = 0; k2 < 32; ++k2) a += *(const f32x4*)(modp + (size_t)k2 * (6 * DM) + cb * 256 + lane * 4);
            *(f32x4*)((float*)(P.ws + WS_MOD) + cb * 256 + lane * 4) = a;
        }
    }
    { f32x2* rt = (f32x2*)(P.ws + WS_ROPE); const int i = lane & 31; const float freq = powf(10000.0f, -(float)i / 32.0f);
      for (int t = 2 * gw + (lane >> 5); t < SEQ; t += 2 * NGW) { float sn, cs; sincosf((float)P.pos[t] * freq, &sn, &cs); rt[(size_t)t * 32 + i] = (f32x2){cs, sn}; } }
    float* scr = (float*)(lds + wave * 17408);
    constexpr int I_IN = 32 * 78, I_UQ = 8 * 24, I_UKV = 4 * 32, I_OUT = 32 * 32, NIT = I_IN + I_UQ + I_UKV + I_OUT;
    for (int it = (gw + NGW - (1536 % NGW)) % NGW; it < NIT; it += NGW) {
        int r = it;
        if (r < I_IN) { transpose_tile(P.w_in, DM, DIN, (bf16_t*)(P.ws + WS_WIN), scr, r / 78, r % 78, lane, RowId()); continue; } r -= I_IN;
        if (r < I_UQ) { transpose_tile(P.w_uq, QLORA, NH * DQK, (bf16_t*)(P.ws + WS_WUQ), scr, r / 24, r % 24, lane, RowUq()); continue; } r -= I_UQ;
        if (r < I_UKV) { transpose_tile(P.w_ukv, KVLORA, NH * 256, (bf16_t*)(P.ws + WS_WUKV), scr, r / 32, r % 32, lane, RowId()); continue; } r -= I_UKV;
        transpose_tile(P.w_out, DM, DM, (bf16_t*)(P.ws + WS_WOUT), scr, r / 32, r % 32, lane, RowId());
    }
}
__device__ __forceinline__ void norm_mod_rows(const float* __restrict__ src, const float* __restrict__ g, const float* sh, const float* sc, bf16_t* __restrict__ dst, int G) {
    const int tid = tid_opaque(), lane = tid & 63, wave = tid >> 6;
    const int gw = blockIdx.x * NWAVES + wave, NGW = G * NWAVES;
    for (int row = gw; row < SEQ; row += NGW) {
        const f32x4* xr = (const f32x4*)(src + (size_t)row * DM) + lane;
        f32x4 v[8]; float ss = 0.f;
#pragma unroll
        for (int j = 0; j < 8; ++j) { v[j] = xr[64 * j]; ss += (v[j].x * v[j].x + v[j].y * v[j].y) + (v[j].z * v[j].z + v[j].w * v[j].w); }
        const float rstd = rsqrtf(wave_sum(ss) * (1.f / DM) + EPS);
        u32x2* o8 = (u32x2*)(dst + (size_t)row * DM) + lane;
#pragma unroll
        for (int j = 0; j < 8; ++j) { const int col = lane * 4 + 256 * j; const f32x4 gg = *(const f32x4*)(g + col); const f32x4 s1 = *(const f32x4*)(sc + col), s0 = *(const f32x4*)(sh + col);
            f32x4 y = v[j] * rstd * gg; y = y * (s1 + 1.f) + s0;
            u32x2 w; w.x = cvt_pk_bf16(y.x, y.y); w.y = cvt_pk_bf16(y.z, y.w); o8[64 * j] = w; }
    }
}
__device__ __forceinline__ void phase1a(const Params& P, char* lds, int G) {
    const int tid = tid_opaque();
    const float* mod = (const float*)(P.ws + WS_MOD);
    float* sh = (float*)lds; float* sc = sh + DM;
    for (int n = tid; n < 2 * DM; n += NTHREADS) sh[n] = mod[n];
    __syncthreads();
    norm_mod_rows(P.x, P.norm_mix_g, sh, sc, (bf16_t*)(P.ws + WS_H), G);
    __syncthreads();
}
__device__ __forceinline__ void phase6b(const Params& P, char* lds, int G) {
    const int tid = tid_opaque(), lane = tid & 63, wave = tid >> 6;
    const int gw = blockIdx.x * NWAVES + wave, NGW = G * NWAVES;
    const float* mod = (const float*)(P.ws + WS_MOD);
    float* sh = (float*)lds; float* sc = sh + DM;
    for (int n = tid; n < 2 * DM; n += NTHREADS) sh[n] = mod[3 * DM + n];
    __syncthreads();
    norm_mod_rows(P.out, P.norm_mlp_g, sh, sc, (bf16_t*)(P.ws + WS_H), G);
    __syncthreads();
    float* scr = (float*)(lds + wave * 17408);
    constexpr int I_1 = 32 * 128, I_2 = 128 * 32;
    for (int it = gw; it < I_1 + I_2; it += NGW) {
        if (it < I_1) transpose_tile(P.w_ff1, DM, DFF, (bf16_t*)(P.ws + WS_W1), scr, it / 128, it % 128, lane, RowId());
        else { const int r = it - I_1; transpose_tile(P.w_ff2, DFF, DM, (bf16_t*)(P.ws + WS_W2), scr, r / 32, r % 32, lane, RowId()); }
    }
}

__device__ __forceinline__ void phase2(const Params& P, char* lds, int G) {
    const int tid = tid_opaque(), lane = tid & 63, wave = tid >> 6;
    const int gw = blockIdx.x * NWAVES + wave, NGW = G * NWAVES;
    const bf16_t* proj = (const bf16_t*)(P.ws + WS_PROJ);
    { bf16_t* cqn = (bf16_t*)(P.ws + WS_CQN); bf16_t* ckvn = (bf16_t*)(P.ws + WS_CKVN);
      float gq[8], gk[8];
#pragma unroll
      for (int e = 0; e < 8; ++e) { gq[e] = P.q_lora_g[lane * 8 + e]; gk[e] = P.kv_lora_g[(lane & 31) * 8 + e]; }
      for (int row = gw; row < SEQ; row += NGW) {
        const u32x4 wq = *(const u32x4*)(proj + (size_t)row * DINP + OFF_CQ + lane * 8);
        const u32x4 wk = *(const u32x4*)(proj + (size_t)row * DINP + OFF_CKV + (lane & 31) * 8);
        float fq[8], fk[8]; unpack8(wq, fq); unpack8(wk, fk);
        float sq = 0.f, sk = 0.f;
#pragma unroll
        for (int e = 0; e < 8; ++e) { sq += fq[e] * fq[e]; sk += fk[e] * fk[e]; }
        if (lane >= 32) sk = 0.f;
        const float rq = rsqrtf(wave_sum(sq) * (1.f / QLORA) + EPS), rk = rsqrtf(wave_sum(sk) * (1.f / KVLORA) + EPS);
#pragma unroll
        for (int e = 0; e < 8; ++e) { fq[e] = fq[e] * rq * gq[e]; fk[e] = fk[e] * rk * gk[e]; }
        *(u32x4*)(cqn + (size_t)row * QLORA + lane * 8) = pack8(fq);
        if (lane < 32) *(u32x4*)(ckvn + (size_t)row * KVLORA + lane * 8) = pack8(fk);
      } }
    { bf16_t* QH = (bf16_t*)(P.ws + WS_QH); bf16_t* KH = (bf16_t*)(P.ws + WS_KH); bf16_t* KT = (bf16_t*)(P.ws + WS_KT); bf16_t* VT = (bf16_t*)(P.ws + WS_VT);
      const int tg = tid >> 5, cgp = tid & 31, chl = cgp * 8;
      for (int item = blockIdx.x; item < 3 * HM * NCH; item += G) {
        const int kind = item / (HM * NCH), h = (item / NCH) % HM, c = item % NCH;
        const int t0 = LCH * c + 8 * tg;
        float outv[8][8];
        if (kind < 2) {
            const int col = OFF_QM + kind * 1024 + h * DH + chl;
            float cw[5][8], cb[8];
#pragma unroll
            for (int e = 0; e < 8; ++e) cb[e] = P.conv_b[kind * 1024 + h * DH + chl + e];
#pragma unroll
            for (int j = 0; j < 5; ++j)
#pragma unroll
                for (int e = 0; e < 8; ++e) cw[j][e] = P.conv_w[j * 2048 + kind * 1024 + h * DH + chl + e];
#pragma unroll
            for (int tt = 0; tt < 8; ++tt)
#pragma unroll
                for (int e = 0; e < 8; ++e) outv[tt][e] = cb[e];
#pragma unroll
            for (int rr = 0; rr < 12; ++rr) {
                const int t = t0 - 2 + rr; float in[8];
                if (t >= 0 && t < SEQ) { const u32x4 w = *(const u32x4*)(proj + (size_t)t * DINP + col); unpack8(w, in); }
                else {
#pragma unroll
                    for (int e = 0; e < 8; ++e) in[e] = 0.f; }
#pragma unroll
                for (int j = 0; j < 5; ++j) { const int tt = rr - j;
                    if (tt >= 0 && tt < 8) {
#pragma unroll
                        for (int e = 0; e < 8; ++e) outv[tt][e] += cw[j][e] * in[e]; } }
            }
            const float osc = kind == 1 ? 0.0625f : 1.f;
#pragma unroll
            for (int tt = 0; tt < 8; ++tt)
#pragma unroll
                for (int e = 0; e < 8; ++e) outv[tt][e] = silu_f(outv[tt][e]) * osc;
            bf16_t* dst = (kind == 0 ? QH : KH) + ((size_t)h * SEQ + t0) * DH + chl;
#pragma unroll
            for (int tt = 0; tt < 8; ++tt) *(u32x4*)(dst + (size_t)tt * DH) = pack8(outv[tt]);
        } else {
#pragma unroll
            for (int tt = 0; tt < 8; ++tt) { const u32x4 w = *(const u32x4*)(proj + (size_t)(t0 + tt) * DINP + OFF_VM + h * DH + chl); unpack8(w, outv[tt]); }
        }
        if (kind >= 1) {
            bf16_t* dst = (kind == 1 ? KT : VT) + ((size_t)(h * NCH + c) * DH + chl) * LCH + 8 * tg;
#pragma unroll
            for (int e = 0; e < 8; ++e) { u32x4 w; w.x = cvt_pk_bf16(outv[0][e], outv[1][e]); w.y = cvt_pk_bf16(outv[2][e], outv[3][e]); w.z = cvt_pk_bf16(outv[4][e], outv[5][e]); w.w = cvt_pk_bf16(outv[6][e], outv[7][e]);
                *(u32x4*)(dst + (size_t)e * LCH) = w; }
        }
      } }
    { const float* gates = (const float*)(P.ws + WS_GATES);
      float* BC = (float*)(P.ws + WS_BC); float* IG = (float*)(P.ws + WS_IG); float* PM = (float*)(P.ws + WS_PM); float* WL = (float*)(P.ws + WS_WL);
      float* BL = (float*)(P.ws + WS_BL); float* AC = (float*)(P.ws + WS_AC);
      for (int task = gw; task < 2 * HM * NCH; task += NGW) {
        const int dir = task / (HM * NCH), h = (task / NCH) % HM, c = task % NCH;
        const float bi = P.b_gates[dir * 8 + h], bfg = P.b_gates[dir * 8 + 4 + h];
        const int u0 = 2 * lane, u1 = 2 * lane + 1;
        const int t0 = LCH * c + (dir ? 127 - u0 : u0), t1 = LCH * c + (dir ? 127 - u1 : u1);
        const float i0 = gates[(size_t)t0 * 16 + dir * 8 + h] + bi, i1 = gates[(size_t)t1 * 16 + dir * 8 + h] + bi;
        const float f0 = gates[(size_t)t0 * 16 + dir * 8 + 4 + h] + bfg, f1 = gates[(size_t)t1 * 16 + dir * 8 + 4 + h] + bfg;
        const float l0 = fminf(f0, 0.f) - log1pf(expf(-fabsf(f0))), l1 = fminf(f1, 0.f) - log1pf(expf(-fabsf(f1)));
        float inc = l0 + l1;
#pragma unroll
        for (int o = 1; o < 64; o <<= 1) { const float t = __shfl_up(inc, o); if (lane >= o) inc += t; }
        const float b1 = inc, b0 = inc - l1;
        const float d0 = i0 - b0, d1 = i1 - b1;
        float pmx = fmaxf(d0, d1);
#pragma unroll
        for (int o = 1; o < 64; o <<= 1) { const float t = __shfl_up(pmx, o); if (lane >= o) pmx = fmaxf(pmx, t); }
        float prev = __shfl_up(pmx, 1); if (lane == 0) prev = -INFINITY;
        const float pm0 = fmaxf(prev, d0), pm1 = pmx;
        const float bL = __shfl(b1, 63), pmL = __shfl(pmx, 63);
        const size_t base = (size_t)(dir * HM + h) * SEQ;
        BC[base + t0] = b0; BC[base + t1] = b1; IG[base + t0] = i0; IG[base + t1] = i1;
        PM[base + t0] = b0 + pm0; PM[base + t1] = b1 + pm1;
        WL[base + t0] = bL - b0 + i0; WL[base + t1] = bL - b1 + i1;
        if (lane == 63) { BL[(dir * HM + h) * NCH + c] = bL; AC[(dir * HM + h) * NCH + c] = bL + pmL; }
      } }
}

constexpr int M2_W = 1024, M2_T0 = M2_W + SEQ * 4, M2_TB = 96 * 256;
static_assert(M2_T0 + 2 * M2_TB <= LDS_BYTES, "M2 LDS");
__device__ __forceinline__ void m2_block(const Params& P, char* lds, int blk) {
    const int tid = tid_opaque(), lane = tid & 63, wid = tid >> 6, r = lane & 15, g = lane >> 4;
    const int dir = blk >> 7, h = (blk >> 5) & 3, vs = (blk >> 2) & 7, ksl = blk & 3;
    const int vi = wid >> 2, ki = wid & 3, v0 = 32 * vs + 16 * vi, k0 = 64 * ksl + 16 * ki;
    const int dh = dir * HM + h;
    const float* BL = (const float*)(P.ws + WS_BL) + dh * NCH; const float* AC = (const float*)(P.ws + WS_AC) + dh * NCH;
    const float* WL = (const float*)(P.ws + WS_WL) + (size_t)dh * SEQ;
    bf16_t* CST = (bf16_t*)(P.ws + WS_CST); float* NST = (float*)(P.ws + WS_NST);
    float* s_mA = (float*)lds; float* s_dec = s_mA + NCH; float* s_w = (float*)(lds + M2_W);
    float* s_bl = (float*)(lds + 512); float* s_ac = s_bl + NCH;
    if (tid < NCH) { s_bl[tid] = BL[tid]; s_ac[tid] = AC[tid]; }
    __syncthreads();
    if (tid == 0) { float m = -1e30f; float* MB = (float*)(P.ws + WS_MB) + dh * NCH; const bool pub = (vs == 0 && ksl == 0);
#pragma unroll 1
        for (int st = 0; st < NCH; ++st) { const int c = dir ? NCH - 1 - st : st; const float bL = s_bl[c], a = s_ac[c]; const float mn = fmaxf(bL + m, a);
            if (pub) MB[c] = m;
            s_dec[c] = __expf(bL + m - mn); s_mA[c] = mn; m = mn; } }
    __syncthreads();
    for (int t = tid; t < SEQ; t += NTHREADS) s_w[t] = __expf(WL[t] - s_mA[t >> 7]);
    const int srow = tid >> 4, sslot = tid & 15;
    const char* gV = (const char*)(P.ws + WS_VT) + ((size_t)h * NCH * DH + 32 * vs + srow) * (LCH * 2) + sslot * 16;
    const char* gK = (const char*)(P.ws + WS_KT) + ((size_t)h * NCH * DH + 64 * ksl + srow) * (LCH * 2) + sslot * 16;
    const int lw = srow * 256 + ((sslot ^ (srow & 15)) << 4);
    const int la = (16 * vi + r) * 256, lb = (32 + 16 * ki + r) * 256;
    char* tb = lds + M2_T0;
    u32x4 ring[8][3];
#define M2_LOAD(slot, stp) do { const int c_ = dir ? NCH - 1 - (stp) : (stp); const size_t co_ = (size_t)c_ * (DH * LCH * 2); \
        ring[slot][0] = *(const u32x4*)(gV + co_); ring[slot][1] = *(const u32x4*)(gK + co_); ring[slot][2] = *(const u32x4*)(gK + co_ + 32 * LCH * 2); } while (0)
#define M2_WRITE(slot, buf) do { char* d_ = tb + (buf) * M2_TB + lw; *(u32x4*)d_ = ring[slot][0]; *(u32x4*)(d_ + 8192) = ring[slot][1]; *(u32x4*)(d_ + 16384) = ring[slot][2]; } while (0)
#pragma unroll
    for (int d = 0; d < 8; ++d) M2_LOAD(d, d);
    M2_WRITE(0, 0);
    const bool do_n = (vs == 0 && vi == 0);
    f32x4 acc = {0.f, 0.f, 0.f, 0.f}; float nacc = 0.f;
#pragma unroll 1
    for (int st8 = 0; st8 < NCH; st8 += 8) {
#pragma unroll
        for (int u = 0; u < 8; ++u) {
            const int st = st8 + u;
            const int c = dir ? NCH - 1 - st : st;
            asm volatile("s_waitcnt lgkmcnt(0)" ::: "memory"); __builtin_amdgcn_s_barrier(); asm volatile("" ::: "memory");
            if (st + 1 < NCH) M2_WRITE((u + 1) & 7, (u + 1) & 1);
            if (st + 8 < NCH) M2_LOAD(u, st + 8);
            { bf16_t* cp = CST + ((size_t)dh * NCH + c) * (DH * DH) + (size_t)(v0 + 4 * g) * DH + k0 + r;
#pragma unroll
              for (int i = 0; i < 4; ++i) cp[(size_t)i * DH] = f2bf(acc[i]);
              if (do_n && g == 0) NST[((size_t)dh * NCH + c) * DH + k0 + r] = nacc; }
            const float dec = s_dec[c];
            acc = acc * dec; nacc *= dec;
            float nsum = 0.f;
            const char* tbuf = tb + (u & 1) * M2_TB;
#pragma unroll
            for (int ks = 0; ks < 4; ++ks) {
                const int sl = ((4 * ks + g) ^ r) << 4;
                const u32x4 av = *(const u32x4*)(tbuf + la + sl), bv = *(const u32x4*)(tbuf + lb + sl);
                const f32x4 w0 = *(const f32x4*)(s_w + LCH * c + 32 * ks + 8 * g), w1 = *(const f32x4*)(s_w + LCH * c + 32 * ks + 8 * g + 4);
                float a[8], b[8]; unpack8(av, a); unpack8(bv, b);
#pragma unroll
                for (int j = 0; j < 4; ++j) { a[j] *= w0[j]; a[4 + j] *= w1[j]; nsum += w0[j] * b[j] + w1[j] * b[4 + j]; }
                const u32x4 aw = pack8(a);
                acc = __builtin_amdgcn_mfma_f32_16x16x32_bf16(*(const bf16x8*)&aw, *(const bf16x8*)&bv, acc, 0, 0, 0);
            }
            nsum += __shfl_xor(nsum, 16); nsum += __shfl_xor(nsum, 32);
            nacc += nsum;
        }
    }
#undef M2_LOAD
#undef M2_WRITE
    __syncthreads();
}

constexpr int M3_LV = 1024, M3_LVS = 272, M3_LC = M3_LV + 256 * M3_LVS, M3_LCS = 528;
static_assert(M3_LC + 128 * M3_LCS <= LDS_BYTES, "M3 LDS");
__device__ __forceinline__ void m3_unit(const Params& P, char* lds, int h, int c) {
    const int tid = tid_opaque(), lane = tid & 63, wid = __builtin_amdgcn_readfirstlane(tid >> 6), r = lane & 15, g = lane >> 4;
    const int T0 = LCH * c, tl = 16 * wid + r;
    const char* QHc = (const char*)(P.ws + WS_QH) + ((size_t)h * SEQ + T0 + 16 * wid) * (DH * 2);
    const char* KHc = (const char*)(P.ws + WS_KH) + ((size_t)h * SEQ + T0) * (DH * 2);
    const char* VTc = (const char*)(P.ws + WS_VT) + ((size_t)h * NCH + c) * (DH * LCH * 2);
    const char* Cb = (const char*)(P.ws + WS_CST) + ((size_t)h * NCH + c) * (DH * DH * 2);
    const unsigned o512 = (unsigned)(r * 512 + g * 16);
    float* s_mb = (float*)lds; char* LV = lds + M3_LV; char* LC = lds + M3_LC;
    const char* lvr = LV + r * M3_LVS + g * 8;
    const char* lcr = LC + r * M3_LCS + g * 16;
    char* lcw = LC + (tid >> 5) * M3_LCS + (tid & 31) * 16;
    u32x4 cr[8];
#define M3_CLOAD(src) do { _Pragma("unroll") for (int n = 0; n < 8; ++n) cr[n] = ldgu<u32x4>((src) + n * 8192, (unsigned)tid * 16u); } while (0)
#define M3_CWRITE() do { _Pragma("unroll") for (int n = 0; n < 8; ++n) *(u32x4*)(lcw + n * (16 * M3_LCS)) = cr[n]; } while (0)
    M3_CLOAD(KHc);
    { u32x4 v[8];
#pragma unroll
      for (int n = 0; n < 8; ++n) v[n] = ldgu<u32x4>(VTc + n * 8192, (unsigned)tid * 16u);
#pragma unroll
      for (int n = 0; n < 8; ++n) *(u32x4*)(LV + ((tid >> 4) + 32 * n) * M3_LVS + (tid & 15) * 16) = v[n]; }
    M3_CWRITE();
    __syncthreads();
    f32x4 st[8];
    { bf16x8 qf[8];
#pragma unroll
      for (int kd = 0; kd < 8; ++kd) qf[kd] = ldgu<bf16x8>(QHc + 64 * kd, o512);
#pragma unroll
      for (int j = 0; j < 8; ++j) { st[j] = (f32x4){0.f, 0.f, 0.f, 0.f};
#pragma unroll
        for (int kd = 0; kd < 8; ++kd) { const bf16x8 kf = *(const bf16x8*)(lcr + j * (16 * M3_LCS) + kd * 64);
            st[j] = __builtin_amdgcn_mfma_f32_16x16x32_bf16(kf, qf[kd], st[j], 0, 0, 0); } } }
    f32x4 acc[16];
#pragma unroll
    for (int vt = 0; vt < 16; ++vt) acc[vt] = (f32x4){0.f, 0.f, 0.f, 0.f};
#pragma unroll 1
    for (int dir = 0; dir < 2; ++dir) {
        const int dh = dir * HM + h;
        const char* BCc = (const char*)(P.ws + WS_BC) + ((size_t)dh * SEQ + T0) * 4; const char* IGc = (const char*)(P.ws + WS_IG) + ((size_t)dh * SEQ + T0) * 4;
        const char* PMc = (const char*)(P.ws + WS_PM) + ((size_t)dh * SEQ + T0) * 4;
        const char* Cc = Cb + (size_t)dir * ((size_t)HM * NCH * DH * DH * 2);
        const char* Nc = (const char*)(P.ws + WS_NST) + ((size_t)dh * NCH + c) * (DH * 4);
        const int fx = dir * 127, tlx = tl ^ fx;
        const float mB = ((const float*)(P.ws + WS_MB))[dh * NCH + c];
        const float bt = ldgu<float>(BCc, (unsigned)tl * 4u), pm = ldgu<float>(PMc, (unsigned)tl * 4u);
        const float mt = fmaxf(bt + mB, pm); const float alpha = bt - mt; const float winter = __expf(bt + mB - mt);
        float den = 0.f;
#pragma unroll
        for (int j = 0; j < 8; ++j) { const int sb = 16 * j + 4 * g;
            const f32x4 ig = ldgu<f32x4>(IGc + 64 * j, (unsigned)g * 16u), bc = ldgu<f32x4>(BCc + 64 * j, (unsigned)g * 16u);
#pragma unroll
            for (int i = 0; i < 4; ++i) { const int sl = sb + i; const bool ok = ((sl ^ fx) <= tlx);
                const float e = ok ? __expf(alpha + ig[i] - bc[i]) : 0.f; den += st[j][i] * e; } }
        den += __shfl_xor(den, 16); den += __shfl_xor(den, 32);
        float qn = 0.f;
#pragma unroll
        for (int kd = 0; kd < 8; ++kd) { const f32x4 n0 = ldgu<f32x4>(Nc + 128 * kd, (unsigned)g * 32u), n1 = ldgu<f32x4>(Nc + 128 * kd + 16, (unsigned)g * 32u);
            const u32x4 qt = ldgu<u32x4>(QHc + 64 * kd, o512); float q[8]; unpack8(qt, q);
            qn += q[0] * n0[0] + q[1] * n0[1] + q[2] * n0[2] + q[3] * n0[3] + q[4] * n1[0] + q[5] * n1[1] + q[6] * n1[2] + q[7] * n1[3]; }
        qn += __shfl_xor(qn, 16); qn += __shfl_xor(qn, 32);
        const float dtot = den + winter * qn;
        const float hdiv = 1.f / fmaxf(fabsf(dtot), __expf(-mt));
        M3_CLOAD(Cc);
        int tlx2 = tlx; LAUNDER_V(tlx2);
#pragma unroll
        for (int ks = 0; ks < 4; ++ks) {
            float e8[8];
#pragma unroll
            for (int hh = 0; hh < 2; ++hh) { const int j = 2 * ks + hh, sb = 16 * j + 4 * g;
                const f32x4 ig = ldgu<f32x4>(IGc + 64 * j, (unsigned)g * 16u), bc = ldgu<f32x4>(BCc + 64 * j, (unsigned)g * 16u);
#pragma unroll
                for (int i = 0; i < 4; ++i) { const int sl = sb + i; const bool ok = ((sl ^ fx) <= tlx2);
                    const float e = ok ? __expf(alpha + ig[i] - bc[i]) : 0.f; e8[4 * hh + i] = st[j][i] * e * hdiv; } }
            const u32x4 pw = pack8(e8); const bf16x8 pa = *(const bf16x8*)&pw;
#pragma unroll
            for (int vt = 0; vt < 16; ++vt) {
                const u32x2 lo = *(const u32x2*)(lvr + vt * (16 * M3_LVS) + ks * 64), hi2 = *(const u32x2*)(lvr + vt * (16 * M3_LVS) + ks * 64 + 32);
                u32x4 w; w.x = lo.x; w.y = lo.y; w.z = hi2.x; w.w = hi2.y;
                acc[vt] = __builtin_amdgcn_mfma_f32_16x16x32_bf16(pa, *(const bf16x8*)&w, acc[vt], 0, 0, 0); }
        }
        const float qsc = winter * hdiv;
#pragma unroll
        for (int half = 0; half < 2; ++half) {
            __syncthreads();
            M3_CWRITE();
            __syncthreads();
            if (half == 0) M3_CLOAD(Cc + 65536);
#pragma unroll
            for (int kd = 0; kd < 8; ++kd) { const u32x4 qt = ldgu<u32x4>(QHc + 64 * kd, o512); float q[8]; unpack8(qt, q);
#pragma unroll
                for (int e = 0; e < 8; ++e) q[e] *= qsc;
                const u32x4 qw = pack8(q); const bf16x8 qs = *(const bf16x8*)&qw;
#pragma unroll
                for (int v8 = 0; v8 < 8; ++v8) { const bf16x8 cf = *(const bf16x8*)(lcr + v8 * (16 * M3_LCS) + kd * 64);
                    acc[half * 8 + v8] = __builtin_amdgcn_mfma_f32_16x16x32_bf16(qs, cf, acc[half * 8 + v8], 0, 0, 0); }
            }
        }
    }
#undef M3_CLOAD
#undef M3_CWRITE
    float ss[4] = {0.f, 0.f, 0.f, 0.f};
#pragma unroll
    for (int vt = 0; vt < 16; ++vt)
#pragma unroll
        for (int i = 0; i < 4; ++i) ss[i] += acc[vt][i] * acc[vt][i];
#pragma unroll
    for (int i = 0; i < 4; ++i) { ss[i] += __shfl_xor(ss[i], 1); ss[i] += __shfl_xor(ss[i], 2); ss[i] += __shfl_xor(ss[i], 4); ss[i] += __shfl_xor(ss[i], 8); ss[i] = rsqrtf(ss[i] * (1.f / DH) + EPS); }
    const char* pr0 = (const char*)(P.ws + WS_PROJ) + ((size_t)(T0 + 16 * wid) * DINP + OFF_OM + h * DH) * 2;
    char* mx0 = (char*)(P.ws + WS_MIX) + ((size_t)(T0 + 16 * wid) * DM + 1024 + h * DH) * 2;
    const char* gmp = (const char*)(P.mlstm_norm_g + h * DH);
    const unsigned opr = (unsigned)(4 * g * DINP * 2 + r * 2), omx = (unsigned)(4 * g * DM * 2 + r * 2);
#pragma unroll
    for (int vt = 0; vt < 16; ++vt) { const float gm = ldgu<float>(gmp + 64 * vt, (unsigned)r * 4u);
#pragma unroll
        for (int i = 0; i < 4; ++i) { const float om = bf2f(ldgu<bf16_t>(pr0 + i * (DINP * 2) + 32 * vt, opr));
            *(bf16_t*)(mx0 + i * (DM * 2) + 32 * vt + omx) = f2bf(acc[vt][i] * ss[i] * gm * sigmoid_f(om)); }
        if ((vt & 3) == 3) asm volatile("" ::: "memory"); }
    __syncthreads();
}

__device__ __forceinline__ void phase4(const Params& P, int G) {
    const int tid = tid_opaque(), lane = tid & 63, wave = tid >> 6;
    const int gw = blockIdx.x * NWAVES + wave, NGW = G * NWAVES;
    bf16_t* Q = (bf16_t*)(P.ws + WS_Q); bf16_t* K = (bf16_t*)(P.ws + WS_K); const bf16_t* KV = (const bf16_t*)(P.ws + WS_KV); const bf16_t* proj = (const bf16_t*)(P.ws + WS_PROJ);
    const f32x4* rt = (const f32x4*)(P.ws + WS_ROPE);
    const int i = lane & 7, hh = lane >> 3; const bool lo = i < 4;
    float gq[3][8], gk[3][8];
#pragma unroll
    for (int j = 0; j < 3; ++j)
#pragma unroll
        for (int e = 0; e < 8; ++e) { gq[j][e] = P.q_norm_g[8 * (i + 8 * j) + e]; gk[j][e] = P.k_norm_g[8 * (i + 8 * j) + e]; }
    for (int t = gw; t < SEQ; t += NGW) {
        float cs[8], sn[8];
#pragma unroll
        for (int e2 = 0; e2 < 4; ++e2) { const f32x4 v = rt[(size_t)t * 16 + 4 * (i & 3) + e2]; cs[2 * e2] = v[0]; sn[2 * e2] = v[1]; cs[2 * e2 + 1] = v[2]; sn[2 * e2 + 1] = v[3]; }
#pragma unroll
        for (int which = 0; which < 2; ++which) {
            u32x4 w0, w1, w2; bf16_t* dst;
            if (which == 0) { bf16_t* qp = Q + (size_t)t * (NH * DQK) + hh * DQK + 8 * i; w0 = *(const u32x4*)qp; w1 = *(const u32x4*)(qp + 64); w2 = *(const u32x4*)(qp + 128); dst = qp; }
            else { const bf16_t* kp = KV + (size_t)t * (NH * 256) + hh * 256 + 8 * i; w0 = *(const u32x4*)kp; w1 = *(const u32x4*)(kp + 64);
                   w2 = *(const u32x4*)(proj + (size_t)t * DINP + OFF_KPE + 8 * i); dst = K + (size_t)t * (NH * DQK) + hh * DQK + 8 * i; }
            float a0[8], a1[8], a2[8]; unpack8(w0, a0); unpack8(w1, a1); unpack8(w2, a2);
            float ss = 0.f;
#pragma unroll
            for (int e = 0; e < 8; ++e) ss += a0[e] * a0[e] + a1[e] * a1[e] + a2[e] * a2[e];
            ss += __shfl_xor(ss, 1); ss += __shfl_xor(ss, 2); ss += __shfl_xor(ss, 4);
            const float rs = rsqrtf(ss * (1.f / DQK) + EPS);
#pragma unroll
            for (int e = 0; e < 8; ++e) { const float g0 = which ? gk[0][e] : gq[0][e], g1 = which ? gk[1][e] : gq[1][e], g2 = which ? gk[2][e] : gq[2][e];
                a0[e] *= rs * g0; a1[e] *= rs * g1; a2[e] *= rs * g2; }
            float o2[8];
#pragma unroll
            for (int e = 0; e < 8; ++e) { const float pr = __shfl_xor(a2[e], 4);
                o2[e] = lo ? (a2[e] * cs[e] - pr * sn[e]) : (pr * sn[e] + a2[e] * cs[e]); }
            *(u32x4*)dst = pack8(a0); *(u32x4*)(dst + 64) = pack8(a1); *(u32x4*)(dst + 128) = pack8(o2);
        }
    }
}

struct StoreProj { bf16_t* proj; float* gates;
    __device__ __forceinline__ void operator()(int row, int col, f32x4 v0, f32x4 v1) const {
        u32x4 w; w.x = cvt_pk_bf16(v0[0], v0[1]); w.y = cvt_pk_bf16(v0[2], v0[3]); w.z = cvt_pk_bf16(v1[0], v1[1]); w.w = cvt_pk_bf16(v1[2], v1[3]);
        *(u32x4*)(proj + (size_t)row * DINP + col) = w;
        if (col >= OFF_GM && col < OFF_GM + 16) { float* gp = gates + (size_t)row * 16 + (col - OFF_GM); *(f32x4*)gp = v0; *(f32x4*)(gp + 4) = v1; } } };
struct StoreQ { bf16_t* q;
    __device__ __forceinline__ void operator()(int row, int col, f32x4 v0, f32x4 v1) const {
        const int h = col >> 8, ct = col & 255;
        if (ct < DQK) { u32x4 w; w.x = cvt_pk_bf16(v0[0], v0[1]); w.y = cvt_pk_bf16(v0[2], v0[3]); w.z = cvt_pk_bf16(v1[0], v1[1]); w.w = cvt_pk_bf16(v1[2], v1[3]);
            *(u32x4*)(q + (size_t)row * (NH * DQK) + h * DQK + ct) = w; } } };
struct StoreKV { bf16_t* kv;
    __device__ __forceinline__ void operator()(int row, int col, f32x4 v0, f32x4 v1) const {
        u32x4 w; w.x = cvt_pk_bf16(v0[0], v0[1]); w.y = cvt_pk_bf16(v0[2], v0[3]); w.z = cvt_pk_bf16(v1[0], v1[1]); w.w = cvt_pk_bf16(v1[2], v1[3]);
        *(u32x4*)(kv + (size_t)row * (NH * 256) + col) = w; } };
struct StoreX1 { const float* x; const float* gate; float* out;
    __device__ __forceinline__ void operator()(int row, int col, f32x4 v) const {
        const size_t off = (size_t)row * DM + col; const f32x4 xv = *(const f32x4*)(x + off); const f32x4 gv = *(const f32x4*)(gate + col);
        *(f32x4*)(out + off) = xv + gv * v; } };
struct StoreAct { bf16_t* act;
    __device__ __forceinline__ void operator()(int row, int col, f32x4 v0, f32x4 v1) const {
        float f[8] = {v0[0], v0[1], v0[2], v0[3], v1[0], v1[1], v1[2], v1[3]};
#pragma unroll
        for (int e = 0; e < 8; ++e) { const float rl = fmaxf(f[e], 0.f); f[e] = rl * rl; }
        *(u32x4*)(act + (size_t)row * DFF + col) = pack8(f); } };

#define XB_TMO      128
#define XB_XCNT(j)  (256  + 64 * (j))
#define XB_XSUB(j)  (1280 + 64 * (j))
#define XB_XGEN(j)  (2304 + 64 * (j))
#define XB_TOP      3328
#define XB_TOPGEN   3392
#define XCD_BAR_WORDS 3456
#define XB_SPIN_CAP (1u << 18)

__device__ __forceinline__ unsigned xb_ld(unsigned* p)              { return __hip_atomic_load(p, __ATOMIC_RELAXED, __HIP_MEMORY_SCOPE_AGENT); }
__device__ __forceinline__ unsigned xb_add(unsigned* p, unsigned v) { return __hip_atomic_fetch_add(p, v, __ATOMIC_RELAXED, __HIP_MEMORY_SCOPE_AGENT); }
__device__ __forceinline__ unsigned xb_xcc_id() { return (unsigned)__builtin_amdgcn_s_getreg((3 << 11) | 20) & 0xFu; }
#define XB_SPIN(cond, bar) do { unsigned _sp = 0; while (cond) { __builtin_amdgcn_s_sleep(1); \
    if ((++_sp & 255u) == 0u) { if (xb_ld(&(bar)[XB_TMO])) break; if (_sp > XB_SPIN_CAP) { atomicAdd(&(bar)[XB_TMO], 1u); break; } } } } while (0)

struct XcdBarrier {
    unsigned* bar; unsigned x;
    volatile LAS unsigned* st;
};

__device__ __forceinline__ XcdBarrier xcd_barrier_post(unsigned* bar, volatile LAS unsigned* st) {
    XcdBarrier b; b.bar = bar; b.x = xb_xcc_id(); b.st = st;
    if (threadIdx.x == 0) (void)xb_add(&bar[XB_XCNT(b.x)], 1u);
    return b;
}
__device__ __forceinline__ void xcd_barrier_complete(unsigned* bar, unsigned x, unsigned& nloc, unsigned& nx) {
    const unsigned G = gridDim.x * gridDim.y * gridDim.z;
    unsigned sum, cnt, mine, sp = 0u;
    for (;;) {
        sum = 0u; cnt = 0u; mine = 0u;
#pragma unroll
        for (unsigned j = 0; j < 16; ++j) { const unsigned c = xb_ld(&bar[XB_XCNT(j)]); sum += c; cnt += (c > 0u) ? 1u : 0u; mine = (j == x) ? c : mine; }
        if (sum == G) break;
        __builtin_amdgcn_s_sleep(1);
        if ((++sp & 255u) == 0u) { if (xb_ld(&bar[XB_TMO])) break; if (sp > XB_SPIN_CAP) { atomicAdd(&bar[XB_TMO], 1u); break; } }
    }
    nloc = mine > 0u ? mine : 1u; nx = cnt > 0u ? cnt : 1u;
}

__device__ __forceinline__ void xcd_barrier(const XcdBarrier& b) {
    asm volatile("s_waitcnt vmcnt(0)" ::: "memory");
    __syncthreads();
    if (threadIdx.x == 0) {
        unsigned* bar = b.bar;
        __builtin_amdgcn_s_waitcnt(0);
        unsigned nloc = b.st[0], nx = b.st[1];
        if (nloc == 0u) { xcd_barrier_complete(bar, b.x, nloc, nx); b.st[0] = nloc; b.st[1] = nx; }
        const unsigned old = xb_add(&bar[XB_XSUB(b.x)], 1u);
        const unsigned gen = old / nloc;
        if (old + 1u == (gen + 1u) * nloc) {
            __builtin_amdgcn_fence(__ATOMIC_RELEASE, "agent");
            asm volatile("s_waitcnt vmcnt(0)" ::: "memory");
            const unsigned og = xb_add(&bar[XB_TOP], 1u);
            const unsigned tg = og / nx;
            if (og + 1u == (tg + 1u) * nx) xb_add(&bar[XB_TOPGEN], 1u);
            else XB_SPIN(xb_ld(&bar[XB_TOPGEN]) == tg, bar);
            __builtin_amdgcn_fence(__ATOMIC_ACQUIRE, "agent");
            xb_add(&bar[XB_XGEN(b.x)], 1u);
            asm volatile("s_waitcnt vmcnt(0)" ::: "memory");
        } else {
            XB_SPIN(xb_ld(&bar[XB_XGEN(b.x)]) == gen, bar);
            __builtin_amdgcn_fence(__ATOMIC_ACQUIRE, "agent");
            asm volatile("s_waitcnt vmcnt(0)" ::: "memory");
        }
    }
    __syncthreads();
}


constexpr int NPH = 11;
#ifdef ONLY_PH
#define PH_ON(n) ((n) == ONLY_PH)
#else
#define PH_ON(n) 1
#endif
#define CAS __attribute__((address_space(4)))
__device__ __forceinline__ Params load_params(const CAS Params* kp) {
#if defined(__HIP_DEVICE_COMPILE__)
    unsigned long long kv = (unsigned long long)kp; asm volatile("" : "+s"(kv)); return *(const CAS Params*)kv;
#else
    return Params{};
#endif
}
__global__ void __launch_bounds__(NTHREADS, 2) fwd_kernel(Params Pk) {
    extern __shared__ __attribute__((aligned(16))) char lds[];
    const CAS Params* kp = (const CAS Params*)__builtin_amdgcn_kernarg_segment_ptr();
    const int G0 = gridDim.x; const int bx0 = blockIdx.x;
    const int vcu0 = (G0 % 8 == 0) ? (bx0 % 8) * (G0 / 8) + bx0 / 8 : bx0;
    LAS unsigned char* ldsl = (LAS unsigned char*)lds;
    const int ph_lo = Pk.ph_lo, ph_hi = Pk.ph_hi;
    if (threadIdx.x < 16) ((volatile LAS unsigned*)(ldsl + LDS_BARST))[threadIdx.x] = 0u;
    __syncthreads();
    XcdBarrier xbar = xcd_barrier_post((unsigned*)(Pk.ws + WS_BAR), (volatile LAS unsigned*)(ldsl + LDS_BARST));
#ifndef PROBE_PH
#define PROBE_PH (-1)
#endif
    unsigned long long probe_dt = 0, probe_t0g = 0;
#ifndef PROBE_FROM
#define PROBE_FROM (-1)
#define PROBE_TO (-1)
#endif
#define PROBE_MARK(id) do { if (PROBE_FROM == (id)) { __syncthreads(); probe_t0g = __builtin_amdgcn_s_memrealtime(); } if (PROBE_TO == (id)) { __syncthreads(); probe_dt = __builtin_amdgcn_s_memrealtime() - probe_t0g; } } while (0)
#ifndef DUP_PH
#define DUP_PH (-1)
#endif
#ifndef DUP_SUB
#define DUP_SUB 0
#endif
    for (int ph = ph_lo; ph < ph_hi; ++ph) {
      for (int rep = 0; rep < ((ph == DUP_PH) ? 2 : 1); ++rep) {
        int G = G0, bx = bx0, vcu = vcu0; asm volatile("" : "+s"(G), "+s"(bx), "+s"(vcu));
        unsigned long long probe_t0 = 0; if (PROBE_PH >= 0 && ph == PROBE_PH) probe_t0 = __builtin_amdgcn_s_memrealtime();
        switch (ph) {
        case 0: if (PH_ON(0)) { const Params P = load_params(kp); phase0(P, lds, G); } break;
        case 1: if (PH_ON(1)) { const Params P = load_params(kp); phase1a(P, lds, G); } break;
        case 2: if (PH_ON(2)) { const Params P = load_params(kp); unsigned char* ws = P.ws;
                  pg8::Gemm g{(const bf16_t*)(ws + WS_H), (const bf16_t*)(ws + WS_WIN), SEQ, DINP, DM}; pg8::StaticOrder S; S.init(SEQ, DINP, G, bx);
                  pg8::Epi8<StoreProj> E{{(bf16_t*)(ws + WS_PROJ), (float*)(ws + WS_GATES)}};
                  pg8::gemm_phase<pg8::Epi8<StoreProj>, pg8::StaticOrder, true, true>(ldsl, g, S, E); } break;
        case 3: if (PH_ON(3)) { const Params P = load_params(kp); phase2(P, lds, G); } break;
        case 4: if (PH_ON(4)) { PROBE_MARK(40);
#ifndef NO_G4
#ifndef NO_G4A
                  if (rep == 0 || DUP_SUB == 0 || DUP_SUB == 1) { const Params P = load_params(kp); unsigned char* ws = P.ws;
                    pg8::Gemm g{(const bf16_t*)(ws + WS_CQN), (const bf16_t*)(ws + WS_WUQ), SEQ, NH * 256, QLORA}; pg8::StaticOrder S; S.init(SEQ, NH * 256, G, bx);
                    pg8::Epi8<StoreQ> E{{(bf16_t*)(ws + WS_Q)}};
                    pg8::gemm_phase<pg8::Epi8<StoreQ>, pg8::StaticOrder, true, true>(ldsl, g, S, E); }
#endif
#ifndef NO_G4B
                  if (rep == 0 || DUP_SUB == 0 || DUP_SUB == 2) { const Params P = load_params(kp); unsigned char* ws = P.ws;
                    pg8::Gemm g{(const bf16_t*)(ws + WS_CKVN), (const bf16_t*)(ws + WS_WUKV), SEQ, NH * 256, KVLORA}; pg8::StaticOrder S; S.init(SEQ, NH * 256, G, bx);
                    pg8::Epi8<StoreKV> E{{(bf16_t*)(ws + WS_KV)}};
                    pg8::gemm_phase<pg8::Epi8<StoreKV>, pg8::StaticOrder, true, true>(ldsl, g, S, E); }
#endif
#endif
                  PROBE_MARK(42);
#ifndef NO_M2
                  if (rep == 0 || DUP_SUB == 0 || DUP_SUB == 3) { const Params P = load_params(kp); for (int b = vcu; b < 256; b += G) m2_block(P, lds, b); }
#endif
                  PROBE_MARK(43);
                  } break;
        case 5: if (PH_ON(5)) { const Params P = load_params(kp); phase4(P, G); } break;
        case 6: if (PH_ON(6)) { PROBE_MARK(60);
#ifndef NO_ATT
                  if (rep == 0 || DUP_SUB == 0 || DUP_SUB == 1) { const Params P = load_params(kp); unsigned char* ws = P.ws;
                  for (int u = vcu; u < NH * (SEQ / 256); u += G) { const int h = u >> 5, qb = u & 31;
                      att::attn_unit((const bf16_t*)(ws + WS_Q) + (size_t)(qb * 256) * att::LDQ + h * DQK, (const bf16_t*)(ws + WS_K) + h * DQK, (const bf16_t*)(ws + WS_KV) + h * 256 + 128,
                                     (bf16_t*)(ws + WS_MIX) + (size_t)(qb * 256) * DM + h * DV, SEQ, lds); } }
#endif
                  PROBE_MARK(61);
#ifndef NO_M3
                  if (rep == 0 || DUP_SUB == 0 || DUP_SUB == 2) { const Params P = load_params(kp); for (int u = vcu; u < HM * NCH; u += G) m3_unit(P, lds, u >> 6, u & 63); }
#endif
                  PROBE_MARK(62);
                  } break;
        case 7: if (PH_ON(7)) { const Params P = load_params(kp); unsigned char* ws = P.ws;
                  pg8::Gemm g{(const bf16_t*)(ws + WS_MIX), (const bf16_t*)(ws + WS_WOUT), SEQ, DM, DM}; pg8::StaticOrder S; S.init(SEQ, DM, G, bx);
                  pg8::Epi4<StoreX1> E{{P.x, (const float*)(ws + WS_MOD) + 2 * DM, P.out}};
                  pg8::gemm_phase<pg8::Epi4<StoreX1>, pg8::StaticOrder, true, true>(ldsl, g, S, E); } break;
        case 8: if (PH_ON(8)) { const Params P = load_params(kp); phase6b(P, lds, G); } break;
        case 9: if (PH_ON(9)) { const Params P = load_params(kp); unsigned char* ws = P.ws;
                  pg8::Gemm g{(const bf16_t*)(ws + WS_H), (const bf16_t*)(ws + WS_W1), SEQ, DFF, DM}; pg8::StaticOrder S; S.init(SEQ, DFF, G, bx);
                  pg8::Epi8<StoreAct> E{{(bf16_t*)(ws + WS_ACT)}};
                  pg8::gemm_phase<pg8::Epi8<StoreAct>, pg8::StaticOrder, true, true>(ldsl, g, S, E); } break;
        case 10: if (PH_ON(10)) { const Params P = load_params(kp); unsigned char* ws = P.ws;
                  pg8::Gemm g{(const bf16_t*)(ws + WS_ACT), (const bf16_t*)(ws + WS_W2), SEQ, DM, DFF}; pg8::StaticOrder S; S.init(SEQ, DM, G, bx);
                  pg8::Epi4<StoreX1> E{{P.out, (const float*)(ws + WS_MOD) + 5 * DM, P.out}};
                  pg8::gemm_phase<pg8::Epi4<StoreX1>, pg8::StaticOrder, true, true>(ldsl, g, S, E); } break;
        default: break;
        }
        if (ph + 1 < ph_hi || rep == 0 && ph == DUP_PH) { xcd_barrier(xbar); }
        if (PROBE_PH >= 0 && ph == PROBE_PH) { __syncthreads(); probe_dt = __builtin_amdgcn_s_memrealtime() - probe_t0; }
      }
    }
    if ((PROBE_PH >= 0 || PROBE_FROM >= 0) && blockIdx.x == 0) { const unsigned long long te = __builtin_amdgcn_s_memrealtime();
        while (__builtin_amdgcn_s_memrealtime() - te < probe_dt) __builtin_amdgcn_s_sleep(8); }
}

extern "C" void kernel_launch(void* const* d_in, const int* in_sizes, int n_in, void* d_out, int out_size, void* d_ws, size_t ws_size, hipStream_t stream) {
    static int grid = 0;
    if (grid == 0) {
        if (n_in != 21 || out_size != SEQ * DM || ws_size < WS_END) { fprintf(stderr, "kernel_launch: unexpected shapes n_in %d out %d ws %zu\n", n_in, out_size, ws_size); grid = -1; return; }
        int dev = 0, cus = 0, per_cu = 0;
        if (hipGetDevice(&dev) != hipSuccess || hipDeviceGetAttribute(&cus, hipDeviceAttributeMultiprocessorCount, dev) != hipSuccess) { grid = -1; return; }
        if (hipFuncSetAttribute((const void*)fwd_kernel, hipFuncAttributeMaxDynamicSharedMemorySize, LDS_BYTES) != hipSuccess) { fprintf(stderr, "kernel_launch: hipFuncSetAttribute failed\n"); grid = -1; return; }
        if (hipOccupancyMaxActiveBlocksPerMultiprocessor(&per_cu, (const void*)fwd_kernel, NTHREADS, LDS_BYTES) != hipSuccess || per_cu < 1) { fprintf(stderr, "kernel_launch: occupancy query says %d\n", per_cu); per_cu = 1; }
        (void)hipGetLastError();
        grid = cus * 1;
    }
    if (grid < 0) return;
    Params p{};
    p.x = (const float*)d_in[0]; p.c = (const float*)d_in[1]; p.pos = (const int*)d_in[2]; p.w_ada = (const float*)d_in[3]; p.b_ada = (const float*)d_in[4];
    p.norm_mix_g = (const float*)d_in[5]; p.w_in = (const float*)d_in[6]; p.b_gates = (const float*)d_in[7]; p.conv_w = (const float*)d_in[8]; p.conv_b = (const float*)d_in[9];
    p.q_lora_g = (const float*)d_in[10]; p.w_uq = (const float*)d_in[11]; p.kv_lora_g = (const float*)d_in[12]; p.w_ukv = (const float*)d_in[13]; p.q_norm_g = (const float*)d_in[14];
    p.k_norm_g = (const float*)d_in[15]; p.mlstm_norm_g = (const float*)d_in[16]; p.w_out = (const float*)d_in[17]; p.norm_mlp_g = (const float*)d_in[18];
    p.w_ff1 = (const float*)d_in[19]; p.w_ff2 = (const float*)d_in[20];
    p.out = (float*)d_out; p.ws = (unsigned char*)d_ws;
    (void)hipMemsetAsync((char*)d_ws + WS_BAR, 0, 32768, stream);
#if MK_MULTI
    for (int ph = 0; ph < NPH; ++ph) { p.ph_lo = ph; p.ph_hi = ph + 1; hipLaunchKernelGGL(fwd_kernel, dim3(grid), dim3(NTHREADS), LDS_BYTES, stream, p); }
#else
    p.ph_lo = 0; p.ph_hi = NPH;
    void* args[] = {&p};
    hipError_t e = hipLaunchCooperativeKernel((const void*)fwd_kernel, dim3(grid), dim3(NTHREADS), args, LDS_BYTES, stream);
    if (e != hipSuccess) fprintf(stderr, "kernel_launch: cooperative launch failed: %s (grid %d)\n", hipGetErrorString(e), grid);
#endif
}
```

```cpp
#include <hip/hip_runtime.h>
#include <hip/hip_cooperative_groups.h>
#include <cstdio>
#include <cstdint>
namespace cg = cooperative_groups;

#ifndef MK_MULTI
#define MK_MULTI 0
#endif

#define LAS __attribute__((address_space(3)))
typedef unsigned short bf16_t;
typedef short bf16x8 __attribute__((ext_vector_type(8)));
typedef short s16x4 __attribute__((ext_vector_type(4)));
typedef float f32x4 __attribute__((ext_vector_type(4)));
typedef float f32x2 __attribute__((ext_vector_type(2)));
typedef float f32x16 __attribute__((ext_vector_type(16)));
typedef unsigned u32x4 __attribute__((ext_vector_type(4)));
typedef unsigned u32x2 __attribute__((ext_vector_type(2)));

constexpr int SEQ = 8192, DM = 2048, DIN = 4944, DINP = 5120, DFF = 8192;
constexpr int NH = 8, DQK = 192, DV = 128, QLORA = 512, KVLORA = 256;
constexpr int HM = 4, DH = 256, LCH = 128, NCH = 64;
constexpr int OFF_CQ = 0, OFF_CKV = 512, OFF_KPE = 768, OFF_QM = 832, OFF_KM = 1856, OFF_VM = 2880, OFF_OM = 3904, OFF_GM = 4928;
constexpr float EPS = 1e-6f;
constexpr int NTHREADS = 512, NWAVES = 8;
constexpr int LDS_BYTES = 147456;
constexpr int LDS_BARST = LDS_BYTES - 64;

constexpr size_t MiB = 1u << 20;
constexpr size_t WS_MODP = 384 * MiB - 2 * MiB;
constexpr size_t WS_MOD = 786432;
constexpr size_t WS_BC = 1 * MiB;
constexpr size_t WS_IG = WS_BC + 262144;
constexpr size_t WS_PM = WS_IG + 262144;
constexpr size_t WS_WL = WS_PM + 262144;
constexpr size_t WS_BAR = 868352;
constexpr size_t WS_CNT = WS_BAR + 16384;
constexpr size_t WS_MB = 860160;
constexpr size_t WS_BL = 851968;
constexpr size_t WS_AC = 856064;
constexpr size_t WS_WIN = 2 * MiB, WS_WUQ = 22 * MiB, WS_WUKV = 24 * MiB, WS_WOUT = 26 * MiB;
constexpr size_t WS_CST = 34 * MiB;
constexpr size_t WS_W1 = 34 * MiB, WS_W2 = 66 * MiB;
constexpr size_t WS_H = 98 * MiB;
constexpr size_t WS_Q = 98 * MiB;
constexpr size_t WS_MIX = 130 * MiB;
constexpr size_t WS_PROJ = 162 * MiB;
constexpr size_t WS_CQN = 242 * MiB, WS_CKVN = 250 * MiB;
constexpr size_t WS_GATES = 254 * MiB;
constexpr size_t WS_NST = 255 * MiB;
constexpr size_t WS_ACT = 130 * MiB;
constexpr size_t WS_KV = 258 * MiB;
constexpr size_t WS_K = 290 * MiB;
constexpr size_t WS_QH = 314 * MiB, WS_KH = 330 * MiB, WS_KT = 346 * MiB, WS_VT = 362 * MiB;
constexpr size_t WS_ROPE = 378 * MiB;
constexpr size_t WS_END = 384 * MiB;

struct Params {
    const float* x; const float* c; const int* pos; const float* w_ada; const float* b_ada; const float* norm_mix_g; const float* w_in;
    const float* b_gates; const float* conv_w; const float* conv_b; const float* q_lora_g; const float* w_uq; const float* kv_lora_g;
    const float* w_ukv; const float* q_norm_g; const float* k_norm_g; const float* mlstm_norm_g; const float* w_out; const float* norm_mlp_g;
    const float* w_ff1; const float* w_ff2;
    float* out; unsigned char* ws; int ph_lo, ph_hi;
};

#define LAUNDER_V(x) asm volatile("" : "+v"(x))
#define LAUNDER_S(x) asm volatile("" : "+s"(x))
__device__ __forceinline__ int tid_opaque() { int t = threadIdx.x; LAUNDER_V(t); return t; }
__device__ __forceinline__ unsigned cvt_pk_bf16(float lo, float hi) { unsigned r; asm volatile("v_cvt_pk_bf16_f32 %0, %1, %2" : "=v"(r) : "v"(lo), "v"(hi)); return r; }
__device__ __forceinline__ float bf_lo(unsigned w) { return __uint_as_float(w << 16); }
__device__ __forceinline__ float bf_hi(unsigned w) { return __uint_as_float(w & 0xffff0000u); }
__device__ __forceinline__ float bf2f(bf16_t b) { return __uint_as_float(((unsigned)b) << 16); }
__device__ __forceinline__ bf16_t f2bf(float f) { return (bf16_t)(cvt_pk_bf16(f, 0.f) & 0xffffu); }
__device__ __forceinline__ float wave_sum(float v) {
#pragma unroll
    for (int o = 1; o < 64; o <<= 1) v += __shfl_xor(v, o);
    return v;
}
template <class T> __device__ __forceinline__ T ldgu(const void* ubase, unsigned voff) { return *(const T*)((const char*)ubase + voff); }
__device__ __forceinline__ float silu_f(float v) { return v / (1.f + __expf(-v)); }
__device__ __forceinline__ float sigmoid_f(float v) { return 1.f / (1.f + __expf(-v)); }
__device__ __forceinline__ void unpack8(u32x4 w, float* f) {
    f[0] = bf_lo(w.x); f[1] = bf_hi(w.x); f[2] = bf_lo(w.y); f[3] = bf_hi(w.y); f[4] = bf_lo(w.z); f[5] = bf_hi(w.z); f[6] = bf_lo(w.w); f[7] = bf_hi(w.w);
}
__device__ __forceinline__ u32x4 pack8(const float* f) {
    u32x4 w; w.x = cvt_pk_bf16(f[0], f[1]); w.y = cvt_pk_bf16(f[2], f[3]); w.z = cvt_pk_bf16(f[4], f[5]); w.w = cvt_pk_bf16(f[6], f[7]); return w;
}

namespace pg8 {
constexpr int BM = 256, BK = 64, HALF = 128, HTB = HALF * BK * 2, STAGE_BYTES = 8 * HTB, NXCD = 8, WGM = 8;
__host__ __device__ __forceinline__ int lds_byte(int r, int c) { const int st = (r >> 4) * 2 + (c >> 5), rr = r & 15, cc = c & 31, ob = rr * 64 + cc * 2; return st * 1024 + (ob ^ (((ob >> 9) & 1) << 5)); }
__host__ __device__ __forceinline__ void stage_rc(int b, int& R, int& C) { const int st = b / 1024, sb = b % 1024, swz = sb ^ (((sb >> 9) & 1) << 5); R = (st >> 1) * 16 + swz / 64; C = (st & 1) * 32 + (swz % 64) / 2; }
__host__ __device__ __forceinline__ int perm32(int rho) { const int n = rho >> 4, i = rho & 15; return 8 * (i >> 2) + 4 * n + (i & 3); }
struct Unit { int pm, pn; };
struct Gemm { const bf16_t* A; const bf16_t* Bt; int M, N, K; };
struct StaticOrder {
    int nM, nN, nwg, G, c;
    __host__ __device__ void init(int M, int N, int G_, int c_) { nM = M / BM; nN = N / BM; nwg = nM * nN; G = G_; c = c_; }
    __host__ __device__ bool next(int i, Unit& u) const {
        const long L = (long)i * G + c; if (L >= nwg) return false;
        int wgid = (int)L; { const int q = nwg / NXCD, r = nwg % NXCD, xcd = wgid % NXCD, off = wgid / NXCD; wgid = (xcd < r ? xcd * (q + 1) : r * (q + 1) + (xcd - r) * q) + off; }
        const int nig = WGM * nN, gid = wgid / nig, fm = gid * WGM, gsz = (nM - fm) < WGM ? (nM - fm) : WGM;
        u.pm = fm + ((wgid % nig) % gsz); u.pn = (wgid % nig) / gsz; return true;
    }
    __device__ __forceinline__ void a_ready(const Unit&) const {}
    __device__ __forceinline__ void done(const Unit&) const {}
};
template <class F> struct Epi8 {
    static constexpr bool PERM = true, AFTER_DRAIN = false; F f;
    __device__ __forceinline__ void operator()(const f32x4 (&acc)[2][2][4][2], const Unit& u, int wr, int wc, int fr, int fq) const {
        const int row0 = u.pm * BM + wr * 64 + fr, col0 = u.pn * BM + wc * 32 + 8 * fq;
#pragma unroll
        for (int ai = 0; ai < 2; ++ai)
#pragma unroll
            for (int m = 0; m < 4; ++m)
#pragma unroll
                for (int bj = 0; bj < 2; ++bj) f(row0 + ai * HALF + m * 16, col0 + bj * HALF, acc[ai][bj][m][0], acc[ai][bj][m][1]);
    }
};
template <class F> struct Epi4 {
    static constexpr bool PERM = false, AFTER_DRAIN = false; F f;
    __device__ __forceinline__ void operator()(const f32x4 (&acc)[2][2][4][2], const Unit& u, int wr, int wc, int fr, int fq) const {
        const int row0 = u.pm * BM + wr * 64 + fr, col0 = u.pn * BM + wc * 32 + 4 * fq;
#pragma unroll
        for (int ai = 0; ai < 2; ++ai)
#pragma unroll
            for (int m = 0; m < 4; ++m) {
#pragma unroll
                for (int bj = 0; bj < 2; ++bj)
#pragma unroll
                    for (int n = 0; n < 2; ++n) f(row0 + ai * HALF + m * 16, col0 + bj * HALF + n * 16, acc[ai][bj][m][n]);
                if (m & 1) asm volatile("" ::: "memory");
            }
    }
};

template <class Epi, class Sched, bool ALIGN_EPI = false, bool SP2 = false>
__device__ __forceinline__ void gemm_phase(LAS unsigned char* lds, const Gemm g, const Sched& S, const Epi& E) {
    const int tid = tid_opaque(), wid = __builtin_amdgcn_readfirstlane(tid >> 6), lane = tid & 63, wr = wid >> 2, wc = wid & 3, fr = lane & 15, fq = lane >> 4;
    const int K = g.K, nt = K / BK;
    unsigned voffA[2], voffB[2];
#pragma unroll
    for (int i = 0; i < 2; ++i) { int R, C; stage_rc(tid * 16 + i * 8192, R, C); const int Rb = Epi::PERM ? ((R & ~31) + perm32(R & 31)) : R;
        voffA[i] = (unsigned)(R * K + C) * 2u; voffB[i] = (unsigned)(Rb * K + C) * 2u; }
    const size_t kstep = (size_t)(BK * 2);
    const size_t hstep = (size_t)HALF * K * 2;
    const size_t tstep = 2 * hstep;
    const unsigned ldsw = (unsigned)wid * 1024u;
    const int aoff = lds_byte(wr * 64 + fr, fq * 8), boff = lds_byte(wc * 32 + fr, fq * 8);
#define PG8_SA(b, h) (((b) * 2 + (h)) * HTB)
#define PG8_SB(b, h) ((4 + (b) * 2 + (h)) * HTB)
#define PG8_STAGE(bufoff, gbase, voff) do { _Pragma("unroll") for (int _i = 0; _i < 2; ++_i) \
        __builtin_amdgcn_global_load_lds((const unsigned*)((const char*)(gbase) + (voff)[_i]), (LAS unsigned*)(lds + (bufoff) + ldsw + _i * 8192), 16, 0, 0); } while (0)
#define PG8_LDA(dst, b, h) do { _Pragma("unroll") for (int m = 0; m < 4; ++m) _Pragma("unroll") for (int k = 0; k < 2; ++k) dst[m][k] = *(const LAS bf16x8*)(lds + PG8_SA(b, h) + aoff + m * 2048 + k * 1024); } while (0)
#define PG8_LDB(dst, b, h) do { _Pragma("unroll") for (int n = 0; n < 2; ++n) _Pragma("unroll") for (int k = 0; k < 2; ++k) dst[n][k] = *(const LAS bf16x8*)(lds + PG8_SB(b, h) + boff + n * 2048 + k * 1024); } while (0)
#define PG8_MMA(ai, bj, At, Bt) do { __builtin_amdgcn_s_setprio(1); _Pragma("unroll") for (int m = 0; m < 4; ++m) _Pragma("unroll") for (int n = 0; n < 2; ++n) _Pragma("unroll") for (int k = 0; k < 2; ++k) \
        acc[ai][bj][m][n] = __builtin_amdgcn_mfma_f32_16x16x32_bf16(Bt[n][k], At[m][k], acc[ai][bj][m][n], 0, 0, 0); __builtin_amdgcn_s_setprio(0); } while (0)
#define PG8_WAIT_V(n) asm volatile("s_waitcnt vmcnt(" #n ")" ::: "memory")
#define PG8_WAIT_L(n) asm volatile("s_waitcnt lgkmcnt(" #n ")" ::: "memory")
#define PG8_BAR __builtin_amdgcn_s_barrier()
#define PG8_SCHED __builtin_amdgcn_sched_barrier(0)
    Unit cur, nxt; int ui = 0;
    if (!S.next(0, cur)) return;
    f32x4 acc[2][2][4][2];
#pragma unroll
    for (int a = 0; a < 2; ++a)
#pragma unroll
        for (int b = 0; b < 2; ++b)
#pragma unroll
            for (int m = 0; m < 4; ++m)
#pragma unroll
                for (int n = 0; n < 2; ++n) acc[a][b][m][n] = (f32x4){0.f, 0.f, 0.f, 0.f};
    bf16x8 At[4][2], B0[2][2], B1[2][2];
    const char* cA = (const char*)g.A + (size_t)cur.pm * tstep; const char* cB = (const char*)g.Bt + (size_t)cur.pn * tstep;
    S.a_ready(cur);
    if constexpr (SP2) {
        PG8_STAGE(PG8_SB(0, 0), cB, voffB); PG8_STAGE(PG8_SB(0, 1), cB + hstep, voffB); PG8_STAGE(PG8_SA(0, 0), cA, voffA); PG8_STAGE(PG8_SA(0, 1), cA + hstep, voffA);
        if (wr == 1) PG8_BAR;
        PG8_WAIT_V(2); PG8_BAR;
        PG8_STAGE(PG8_SB(1, 0), cB + kstep, voffB); PG8_STAGE(PG8_SA(1, 0), cA + kstep, voffA); PG8_STAGE(PG8_SB(1, 1), cB + hstep + kstep, voffB);
        PG8_WAIT_V(6); PG8_BAR;
    } else {
        PG8_STAGE(PG8_SB(0, 0), cB, voffB); PG8_STAGE(PG8_SA(0, 0), cA, voffA); PG8_STAGE(PG8_SB(0, 1), cB + hstep, voffB); PG8_STAGE(PG8_SA(0, 1), cA + hstep, voffA);
        if (wr == 1) PG8_BAR;
        PG8_WAIT_V(4); PG8_BAR;
        PG8_STAGE(PG8_SB(1, 0), cB + kstep, voffB); PG8_STAGE(PG8_SA(1, 0), cA + kstep, voffA); PG8_STAGE(PG8_SB(1, 1), cB + hstep + kstep, voffB);
        PG8_WAIT_V(6); PG8_BAR;
    }
    for (;;) {
        const bool has_next = S.next(ui + 1, nxt);
        const char* nA = has_next ? (const char*)g.A + (size_t)nxt.pm * tstep : cA; const char* nB = has_next ? (const char*)g.Bt + (size_t)nxt.pn * tstep : cB;
#pragma unroll 1
        for (int t = 0; t < nt; t += 2) {
            const bool last = (t == nt - 2);
            const char* a1 = cA + (size_t)(t + 1) * kstep;
            const char* a2 = last ? nA : cA + (size_t)(t + 2) * kstep; const char* b2 = last ? nB : cB + (size_t)(t + 2) * kstep;
            const char* a3 = a2 + kstep; const char* b3 = b2 + kstep;
            if (last && has_next) S.a_ready(nxt);
            if constexpr (SP2) {
            PG8_LDB(B0, 0, 0); PG8_LDB(B1, 0, 1); PG8_SCHED; PG8_LDA(At, 0, 0); PG8_STAGE(PG8_SA(1, 1), a1 + hstep, voffA);
            PG8_WAIT_V(8); PG8_WAIT_L(0); PG8_BAR; PG8_MMA(0, 0, At, B0); PG8_MMA(0, 1, At, B1); PG8_BAR; PG8_SCHED;
            PG8_LDA(At, 0, 1); PG8_STAGE(PG8_SB(0, 0), b2, voffB); PG8_STAGE(PG8_SB(0, 1), b2 + hstep, voffB); PG8_STAGE(PG8_SA(0, 0), a2, voffA);
            PG8_WAIT_V(8); PG8_WAIT_L(0); PG8_BAR; PG8_MMA(1, 0, At, B0); PG8_MMA(1, 1, At, B1); PG8_BAR; PG8_SCHED;
            PG8_LDB(B0, 1, 0); PG8_LDB(B1, 1, 1); PG8_SCHED; PG8_LDA(At, 1, 0); PG8_STAGE(PG8_SA(0, 1), a2 + hstep, voffA);
            PG8_WAIT_V(8); PG8_WAIT_L(0); PG8_BAR; PG8_MMA(0, 0, At, B0); PG8_MMA(0, 1, At, B1); PG8_BAR; PG8_SCHED;
            PG8_LDA(At, 1, 1); PG8_STAGE(PG8_SB(1, 0), b3, voffB); PG8_STAGE(PG8_SB(1, 1), b3 + hstep, voffB); PG8_STAGE(PG8_SA(1, 0), a3, voffA);
            PG8_WAIT_V(8); PG8_WAIT_L(0); PG8_BAR; PG8_MMA(1, 0, At, B0); PG8_MMA(1, 1, At, B1); PG8_BAR; PG8_SCHED;
            } else {
            PG8_LDB(B0, 0, 0); PG8_SCHED; PG8_LDA(At, 0, 0); PG8_STAGE(PG8_SA(1, 1), a1 + hstep, voffA);
            PG8_WAIT_L(8); PG8_BAR; PG8_WAIT_L(0); PG8_MMA(0, 0, At, B0); PG8_BAR; PG8_SCHED;
            PG8_LDB(B1, 0, 1); PG8_STAGE(PG8_SB(0, 0), b2, voffB);
            PG8_BAR; PG8_WAIT_L(0); PG8_MMA(0, 1, At, B1); PG8_BAR;
            PG8_LDA(At, 0, 1); PG8_STAGE(PG8_SA(0, 0), a2, voffA);
            PG8_BAR; PG8_WAIT_L(0); PG8_MMA(1, 0, At, B0); PG8_BAR; PG8_SCHED;
            PG8_STAGE(PG8_SB(0, 1), b2 + hstep, voffB);
            PG8_WAIT_V(6); PG8_BAR; PG8_MMA(1, 1, At, B1); PG8_BAR;
            PG8_LDB(B0, 1, 0); PG8_SCHED; PG8_LDA(At, 1, 0); PG8_STAGE(PG8_SA(0, 1), a2 + hstep, voffA);
            PG8_WAIT_L(8); PG8_BAR; PG8_WAIT_L(0); PG8_MMA(0, 0, At, B0); PG8_BAR; PG8_SCHED;
            PG8_LDB(B1, 1, 1); PG8_STAGE(PG8_SB(1, 0), b3, voffB);
            PG8_BAR; PG8_WAIT_L(0); PG8_MMA(0, 1, At, B1); PG8_BAR;
            PG8_LDA(At, 1, 1); PG8_STAGE(PG8_SA(1, 0), a3, voffA);
            PG8_BAR; PG8_WAIT_L(0); PG8_MMA(1, 0, At, B0); PG8_BAR; PG8_SCHED;
            PG8_STAGE(PG8_SB(1, 1), b3 + hstep, voffB);
            PG8_WAIT_V(6); PG8_BAR; PG8_MMA(1, 1, At, B1); PG8_BAR;
            }
        }
        if constexpr (ALIGN_EPI) { if (wr == 0) PG8_BAR; }
        if constexpr (!Epi::AFTER_DRAIN) { E(acc, cur, wr, wc, fr, fq); S.done(cur); }
        if (!has_next) break;
#pragma unroll
        for (int a = 0; a < 2; ++a)
#pragma unroll
            for (int b = 0; b < 2; ++b)
#pragma unroll
                for (int m = 0; m < 4; ++m)
#pragma unroll
                    for (int n = 0; n < 2; ++n) acc[a][b][m][n] = (f32x4){0.f, 0.f, 0.f, 0.f};
        cur = nxt; cA = nA; cB = nB; ++ui;
        if constexpr (ALIGN_EPI) { if (wr == 1) PG8_BAR; }
    }
    PG8_WAIT_V(0);
    if constexpr (!ALIGN_EPI) { if (wr == 0) PG8_BAR; }
    PG8_BAR;
#undef PG8_SA
#undef PG8_SB
#undef PG8_STAGE
#undef PG8_LDA
#undef PG8_LDB
#undef PG8_MMA
#undef PG8_WAIT_V
#undef PG8_WAIT_L
#undef PG8_BAR
#undef PG8_SCHED
}
}

namespace att {
constexpr int NW = 8, QBLK = 32, KVBLK = 64;
constexpr int LDQ = NH * DQK, LDK = NH * DQK, LDV = NH * 256, LDO = DM;
constexpr float SCALE = 0.07216878364870322f;
constexpr float THR = 8.f;
constexpr int SHM_K = KVBLK * DQK * 2, SHM_V = KVBLK * DV * 2;
constexpr int SHM_QL = 2 * SHM_V + 2 * SHM_K + NW * 64 * 4;
constexpr int SHM_ATTN = SHM_QL + NW * 4096;
#define KSWZ(row, colB) ((row) * 384 + ((colB) ^ ((((row) >> 1) & 7) << 4)))
#define SBAR() __builtin_amdgcn_sched_barrier(0)
__device__ __forceinline__ int crow(int r, int hi) { return (r & 3) + 8 * (r >> 2) + 4 * hi; }
__device__ __forceinline__ void partialSM(f32x16& p0, f32x16& p1, float& m_reg, float& mn, float& alpha) {
    constexpr float C = SCALE * 1.4426950408889634f;
    float pmax = p0[0];
#pragma unroll
    for (int r = 1; r < 16; ++r) pmax = fmaxf(pmax, p0[r]);
#pragma unroll
    for (int r = 0; r < 16; ++r) pmax = fmaxf(pmax, p1[r]);
    { auto rr = __builtin_amdgcn_permlane32_swap(__float_as_uint(pmax), __float_as_uint(pmax), false, false);
      pmax = fmaxf(__uint_as_float(rr[0]), __uint_as_float(rr[1])); }
    if (__builtin_expect(__all(pmax - m_reg <= THR / SCALE), 1)) { mn = m_reg; alpha = 1.f; }
    else { mn = fmaxf(m_reg, pmax); alpha = __builtin_amdgcn_exp2f((m_reg - mn) * C); m_reg = mn; }
    float mnC = -mn * C;
#pragma unroll
    for (int r = 0; r < 16; ++r) p0[r] = fmaf(p0[r], C, mnC);
#pragma unroll
    for (int r = 0; r < 16; ++r) p1[r] = fmaf(p1[r], C, mnC);
#pragma unroll
    for (int r = 0; r < 16; ++r) p0[r] = __builtin_amdgcn_exp2f(p0[r]);
}
__device__ __forceinline__ void finishSM(f32x16& p0, f32x16& p1, float alpha, float& l_reg, bf16x8& pa0, bf16x8& pa1, bf16x8& pa2, bf16x8& pa3) {
#pragma unroll
    for (int r = 0; r < 16; ++r) p1[r] = __builtin_amdgcn_exp2f(p1[r]);
    float ps = 0;
#pragma unroll
    for (int r = 0; r < 16; ++r) ps += p0[r];
#pragma unroll
    for (int r = 0; r < 16; ++r) ps += p1[r];
    { auto rr = __builtin_amdgcn_permlane32_swap(__float_as_uint(ps), __float_as_uint(ps), false, false);
      ps = __uint_as_float(rr[0]) + __uint_as_float(rr[1]); }
    l_reg = l_reg * alpha + ps;
#define PK4(P, BASE, OUT) do { unsigned a0 = cvt_pk_bf16(P[BASE + 0], P[BASE + 1]), a1 = cvt_pk_bf16(P[BASE + 2], P[BASE + 3]);   \
    unsigned b0 = cvt_pk_bf16(P[BASE + 4], P[BASE + 5]), b1 = cvt_pk_bf16(P[BASE + 6], P[BASE + 7]);                              \
    auto r0 = __builtin_amdgcn_permlane32_swap(a0, b0, false, false); auto r1 = __builtin_amdgcn_permlane32_swap(a1, b1, false, false); \
    u32x4 w = {r0[0], r1[0], r0[1], r1[1]}; OUT = *reinterpret_cast<bf16x8*>(&w); } while (0)
    PK4(p0, 0, pa0); PK4(p0, 8, pa1); PK4(p1, 0, pa2); PK4(p1, 8, pa3);
#undef PK4
}
__device__ __forceinline__ void qkt(f32x16& p0, f32x16& p1, const char* Ks, const bf16x8* qr, const char* ql, int r32, int hi) {
    p0 = f32x16{}; p1 = f32x16{};
#pragma unroll
    for (int d0 = 0; d0 < 12; ++d0) { const int cb = (d0 * 16 + hi * 8) * 2;
        bf16x8 b0 = *reinterpret_cast<const bf16x8*>(Ks + KSWZ(r32, cb));
        bf16x8 b1 = *reinterpret_cast<const bf16x8*>(Ks + KSWZ(32 + r32, cb));
        const bf16x8 q = d0 < 8 ? qr[d0 < 8 ? d0 : 0] : *reinterpret_cast<const bf16x8*>(ql + (d0 - 8) * 1024);
        p0 = __builtin_amdgcn_mfma_f32_32x32x16_bf16(b0, q, p0, 0, 0, 0);
        p1 = __builtin_amdgcn_mfma_f32_32x32x16_bf16(b1, q, p1, 0, 0, 0); }
}
__device__ __forceinline__ int v_st(int k, int c) { const int kk = (k & ~0xC) | ((k & 4) << 1) | ((k & 8) >> 1); return ((kk >> 3) * 4 + (c >> 5)) * 512 + ((kk & 7) * 32 + (c & 31)) * 2; }
__device__ __forceinline__ int v_rd_base(int lane) { return ((lane & 3) << 3) | (((lane >> 2) & 3) << 6) | (((lane >> 4) & 1) << 5) | (((lane >> 5) & 1) << 8); }
constexpr int v_rd_off(int d0, int ks, int half) { return d0 * 512 + ks * 4096 + half * 2048; }
template <int OFF> __device__ __forceinline__ s16x4 tr_read(int vb) {
    s16x4 r; asm volatile("ds_read_b64_tr_b16 %0, %1 offset:%2" : "=&v"(r) : "v"(vb), "i"(OFF) : "memory"); return r;
}
template <int D0> __device__ __forceinline__ void pv_one(f32x16& od, int vb, bf16x8 pa0, bf16x8 pa1, bf16x8 pa2, bf16x8 pa3) {
    const s16x4 l0 = tr_read<v_rd_off(D0, 0, 0)>(vb), h0 = tr_read<v_rd_off(D0, 0, 1)>(vb), l1 = tr_read<v_rd_off(D0, 1, 0)>(vb), h1 = tr_read<v_rd_off(D0, 1, 1)>(vb);
    const s16x4 l2 = tr_read<v_rd_off(D0, 2, 0)>(vb), h2 = tr_read<v_rd_off(D0, 2, 1)>(vb), l3 = tr_read<v_rd_off(D0, 3, 0)>(vb), h3 = tr_read<v_rd_off(D0, 3, 1)>(vb);
    asm volatile("s_waitcnt lgkmcnt(0)" ::: "memory"); SBAR();
#define PK(L, H) (bf16x8){L[0], L[1], L[2], L[3], H[0], H[1], H[2], H[3]}
    od = __builtin_amdgcn_mfma_f32_32x32x16_bf16(pa0, PK(l0, h0), od, 0, 0, 0);
    od = __builtin_amdgcn_mfma_f32_32x32x16_bf16(pa1, PK(l1, h1), od, 0, 0, 0);
    od = __builtin_amdgcn_mfma_f32_32x32x16_bf16(pa2, PK(l2, h2), od, 0, 0, 0);
    od = __builtin_amdgcn_mfma_f32_32x32x16_bf16(pa3, PK(l3, h3), od, 0, 0, 0);
#undef PK
}
__device__ __forceinline__ void pv_d0(f32x16* o, int vb, bf16x8 pa0, bf16x8 pa1, bf16x8 pa2, bf16x8 pa3) {
    pv_one<0>(o[0], vb, pa0, pa1, pa2, pa3); pv_one<1>(o[1], vb, pa0, pa1, pa2, pa3); pv_one<2>(o[2], vb, pa0, pa1, pa2, pa3); pv_one<3>(o[3], vb, pa0, pa1, pa2, pa3);
}
#ifndef ATT_SDEPTH
#define ATT_SDEPTH 1
#endif
constexpr int SDEPTH = ATT_SDEPTH;
__device__ __forceinline__ void attn_unit(const bf16_t* __restrict__ Qb, const bf16_t* __restrict__ Kh, const bf16_t* __restrict__ Vh, bf16_t* __restrict__ Ob, int seq, char* lds) {
    const int tid = tid_opaque(), wid = tid >> 6, lane = tid & 63, r32 = lane & 31, hi = lane >> 5;
    char* V_lds = lds; char* K_lds = lds + 2 * SHM_V;
    float* ws = (float*)(lds + 2 * SHM_V + 2 * SHM_K) + wid * 64; float* li_l = ws; float* al_l = ws + 32;
    float m_reg = -1e30f, l_reg = 0; f32x16 o[4] = {}; bf16x8 qr[8];
    const bf16_t* Qw = Qb + (long)(wid * QBLK + r32) * LDQ + hi * 8;
    char* ql = lds + SHM_QL + wid * 4096 + lane * 16;
#pragma unroll
    for (int d0 = 0; d0 < 8; ++d0) qr[d0] = *reinterpret_cast<const bf16x8*>(Qw + d0 * 16);
#pragma unroll
    for (int d0 = 8; d0 < 12; ++d0) *reinterpret_cast<bf16x8*>(ql + (d0 - 8) * 1024) = *reinterpret_cast<const bf16x8*>(Qw + d0 * 16);
    const int krow = tid >> 3, kc8 = tid & 7;
    const unsigned kgo = (unsigned)(krow * LDK + kc8 * 8) * 2u;
    const int kso = krow * 384 + ((kc8 * 16) ^ (((krow >> 1) & 7) << 4));
    const int sr = tid >> 4, sc = (tid & 15) * 8, vst0 = v_st(sr, sc);
    const unsigned vgo = (unsigned)(sr * LDV + sc) * 2u;
    const int vb0 = (int)(uintptr_t)V_lds + v_rd_base(lane);
    struct { bf16x8 k0, k1, k2, v0, v1; } sr_[SDEPTH];
#define SLOAD(i, kk0) do { const char* kp_ = (const char*)(Kh + (long)(kk0) * LDK); const char* vp_ = (const char*)(Vh + (long)(kk0) * LDV); \
    sr_[i].v0 = ldgu<bf16x8>(vp_, vgo); sr_[i].v1 = ldgu<bf16x8>(vp_ + 32 * LDV * 2, vgo); \
    sr_[i].k0 = ldgu<bf16x8>(kp_, kgo); sr_[i].k1 = ldgu<bf16x8>(kp_ + 128, kgo); sr_[i].k2 = ldgu<bf16x8>(kp_ + 256, kgo); } while (0)
#define SWRITE(b, i) do { *(bf16x8*)(V_lds + (b) * SHM_V + vst0) = sr_[i].v0; *(bf16x8*)(V_lds + (b) * SHM_V + 8192 + vst0) = sr_[i].v1; \
    *(bf16x8*)(K_lds + (b) * SHM_K + kso) = sr_[i].k0; *(bf16x8*)(K_lds + (b) * SHM_K + 128 + kso) = sr_[i].k1; *(bf16x8*)(K_lds + (b) * SHM_K + 256 + kso) = sr_[i].k2; } while (0)
#define SWAIT() do { if constexpr (SDEPTH == 2) asm volatile("s_waitcnt vmcnt(5)" ::: "memory"); else asm volatile("s_waitcnt vmcnt(0)" ::: "memory"); } while (0)
#define RESC(a) do { if (__any((a) < 1.f)) { if (hi == 0) al_l[r32] = (a); asm volatile("s_waitcnt lgkmcnt(0)" ::: "memory"); \
    _Pragma("unroll") for (int d = 0; d < 4; ++d) _Pragma("unroll") for (int r = 0; r < 16; ++r) o[d][r] *= al_l[crow(r, hi)]; } } while (0)
    f32x16 pA0, pA1, pB0, pB1; float mnA, mnB, alA, alB; bf16x8 pa0, pa1, pa2, pa3; const int NT = seq / KVBLK;
    constexpr int SE = 0, SO = SDEPTH - 1;
    SLOAD(SE, 0); asm volatile("s_waitcnt vmcnt(0)" ::: "memory"); SWRITE(0, SE); __syncthreads();
    qkt(pA0, pA1, K_lds, qr, ql, r32, hi); partialSM(pA0, pA1, m_reg, mnA, alA);
    SLOAD(SO, KVBLK); if constexpr (SDEPTH == 2) { if (2 < NT) SLOAD(SE, 2 * KVBLK); }
    SWAIT(); SWRITE(1, SO); __syncthreads();
    for (int j = 1; j + 1 < NT; j += 2) {
        SBAR(); qkt(pB0, pB1, K_lds + SHM_K, qr, ql, r32, hi);
        finishSM(pA0, pA1, alA, l_reg, pa0, pa1, pa2, pa3); SBAR();
        SLOAD(SO, (j + SDEPTH) * KVBLK); SBAR();
        pv_d0(o, vb0, pa0, pa1, pa2, pa3); partialSM(pB0, pB1, m_reg, mnB, alB);
        __syncthreads(); SWAIT(); SWRITE(0, SE);
        RESC(alB); __syncthreads();
        SBAR(); qkt(pA0, pA1, K_lds, qr, ql, r32, hi);
        finishSM(pB0, pB1, alB, l_reg, pa0, pa1, pa2, pa3); SBAR();
        if (SDEPTH == 1 || j + 3 < NT) SLOAD(SE, (j + 1 + SDEPTH) * KVBLK); SBAR();
        pv_d0(o, vb0 + SHM_V, pa0, pa1, pa2, pa3); partialSM(pA0, pA1, m_reg, mnA, alA);
        __syncthreads(); SWAIT(); SWRITE(1, SO);
        RESC(alA); __syncthreads();
    }
    SBAR(); qkt(pB0, pB1, K_lds + SHM_K, qr, ql, r32, hi);
    finishSM(pA0, pA1, alA, l_reg, pa0, pa1, pa2, pa3); SBAR();
    pv_d0(o, vb0, pa0, pa1, pa2, pa3); partialSM(pB0, pB1, m_reg, mnB, alB);
    __syncthreads(); RESC(alB);
    finishSM(pB0, pB1, alB, l_reg, pa0, pa1, pa2, pa3); SBAR();
    pv_d0(o, vb0 + SHM_V, pa0, pa1, pa2, pa3);
    if (hi == 0) li_l[r32] = l_reg; asm volatile("s_waitcnt lgkmcnt(0)" ::: "memory");
    float rli[16];
#pragma unroll
    for (int r = 0; r < 16; ++r) rli[r] = __builtin_amdgcn_rcpf(li_l[crow(r, hi)]);
    bf16_t* Ow = Ob + (long)(wid * QBLK) * LDO;
#pragma unroll
    for (int r = 0; r < 16; ++r) { const int orow = crow(r, hi);
#pragma unroll
        for (int d0 = 0; d0 < 4; ++d0) Ow[(long)orow * LDO + d0 * 32 + r32] = f2bf(o[d0][r] * rli[r]); }
    __syncthreads();
#undef SLOAD
#undef SWRITE
#undef SWAIT
#undef RESC
}
#undef SBAR
}

template <class RowMap>
__device__ __forceinline__ void transpose_tile(const float* __restrict__ W, int K, int N, bf16_t* __restrict__ WT, float* scr, int kb, int nb, int lane, RowMap rm) {
    const int k0 = 64 * kb, n0 = 64 * nb; const int nq = 4 * (lane & 15), kr = lane >> 4; const bool ok = (n0 + nq) < N;
    const float* wp = W + (size_t)(k0 + kr) * N + n0 + nq;
#pragma unroll 4
    for (int i = 0; i < 16; ++i) { f32x4 v = {0.f, 0.f, 0.f, 0.f}; if (ok) v = *(const f32x4*)(wp + (size_t)(4 * i) * N);
        float* d = scr + nq * 65 + 4 * i + kr; d[0] = v[0]; d[65] = v[1]; d[130] = v[2]; d[195] = v[3]; }
    asm volatile("s_waitcnt lgkmcnt(0)" ::: "memory");
    const int c = lane & 7;
#pragma unroll
    for (int j = 0; j < 8; ++j) { const int nl = (lane >> 3) + 8 * j; const int n = n0 + nl; const float* sp = scr + nl * 65 + 8 * c;
        u32x4 o; o.x = cvt_pk_bf16(sp[0], sp[1]); o.y = cvt_pk_bf16(sp[2], sp[3]); o.z = cvt_pk_bf16(sp[4], sp[5]); o.w = cvt_pk_bf16(sp[6], sp[7]);
        if (n < N) *(u32x4*)(WT + (size_t)rm(n) * K + k0 + 8 * c) = o; }
    asm volatile("s_waitcnt lgkmcnt(0)" ::: "memory");
}
struct RowId { __device__ __forceinline__ int operator()(int n) const { return n; } };
struct RowUq { __device__ __forceinline__ int operator()(int n) const { return (n / DQK) * 256 + (n % DQK); } };

__device__ __forceinline__ void phase0(const Params& P, char* lds, int G) {
    const int tid = tid_opaque(), lane = tid & 63, wave = tid >> 6;
    const int gw = blockIdx.x * NWAVES + wave, NGW = G * NWAVES;
    float* modp = (float*)(P.ws + WS_MODP);
    for (int task = gw; task < 1536; task += NGW) {
        const int ks = task / 48, cb = task % 48;
        const float s0 = silu_f(P.c[ks * 64 + lane]);
        f32x4 acc = {0.f, 0.f, 0.f, 0.f};
        const float* wp = P.w_ada + (size_t)(ks * 64) * (6 * DM) + cb * 256 + lane * 4;
#pragma unroll 16
        for (int kk = 0; kk < 64; ++kk) { const float sv = __shfl(s0, kk); const f32x4 w = __builtin_nontemporal_load((const f32x4*)(wp + (size_t)kk * (6 * DM))); acc += w * sv; }
        { unsigned long long* pp = (unsigned long long*)(modp + (size_t)ks * (6 * DM) + cb * 256 + lane * 4);
          __hip_atomic_store(pp, ((unsigned long long)__float_as_uint(acc[1]) << 32) | __float_as_uint(acc[0]), __ATOMIC_RELAXED, __HIP_MEMORY_SCOPE_AGENT);
          __hip_atomic_store(pp + 1, ((unsigned long long)__float_as_uint(acc[3]) << 32) | __float_as_uint(acc[2]), __ATOMIC_RELAXED, __HIP_MEMORY_SCOPE_AGENT); }
        asm volatile("s_waitcnt vmcnt(0)" ::: "memory");
        unsigned old = 0u; if (lane == 0) old = __hip_atomic_fetch_add((unsigned*)(P.ws + WS_CNT) + cb * 16, 1u, __ATOMIC_RELAXED, __HIP_MEMORY_SCOPE_AGENT);
        old = __builtin_amdgcn_readfirstlane(old);
        if (old == 31u) {
            __builtin_amdgcn_fence(__ATOMIC_ACQUIRE, "agent");
            asm volatile("s_waitcnt vmcnt(0)" ::: "memory");
            f32x4 a = *(const f32x4*)(P.b_ada + cb * 256 + lane * 4);
#pragma unroll 8
            for (int k2 = 0; k2 < 32; ++k2) a += *(const f32x4*)(modp + (size_t)k2 * (6 * DM) + cb * 256 + lane * 4);
            *(f32x4*)((float*)(P.ws + WS_MOD) + cb * 256 + lane * 4) = a;
        }
    }
    { f32x2* rt = (f32x2*)(P.ws + WS_ROPE); const int i = lane & 31; const float freq = powf(10000.0f, -(float)i / 32.0f);
      for (int t = 2 * gw + (lane >> 5); t < SEQ; t += 2 * NGW) { float sn, cs; sincosf((float)P.pos[t] * freq, &sn, &cs); rt[(size_t)t * 32 + i] = (f32x2){cs, sn}; } }
    float* scr = (float*)(lds + wave * 17408);
    constexpr int I_IN = 32 * 78, I_UQ = 8 * 24, I_UKV = 4 * 32, I_OUT = 32 * 32, NIT = I_IN + I_UQ + I_UKV + I_OUT;
    for (int it = (gw + NGW - (1536 % NGW)) % NGW; it < NIT; it += NGW) {
        int r = it;
        if (r < I_IN) { transpose_tile(P.w_in, DM, DIN, (bf16_t*)(P.ws + WS_WIN), scr, r / 78, r % 78, lane, RowId()); continue; } r -= I_IN;
        if (r < I_UQ) { transpose_tile(P.w_uq, QLORA, NH * DQK, (bf16_t*)(P.ws + WS_WUQ), scr, r / 24, r % 24, lane, RowUq()); continue; } r -= I_UQ;
        if (r < I_UKV) { transpose_tile(P.w_ukv, KVLORA, NH * 256, (bf16_t*)(P.ws + WS_WUKV), scr, r / 32, r % 32, lane, RowId()); continue; } r -= I_UKV;
        transpose_tile(P.w_out, DM, DM, (bf16_t*)(P.ws + WS_WOUT), scr, r / 32, r % 32, lane, RowId());
    }
}
__device__ __forceinline__ void norm_mod_rows(const float* __restrict__ src, const float* __restrict__ g, const float* sh, const float* sc, bf16_t* __restrict__ dst, int G) {
    const int tid = tid_opaque(), lane = tid & 63, wave = tid >> 6;
    const int gw = blockIdx.x * NWAVES + wave, NGW = G * NWAVES;
    for (int row = gw; row < SEQ; row += NGW) {
        const f32x4* xr = (const f32x4*)(src + (size_t)row * DM) + lane;
        f32x4 v[8]; float ss = 0.f;
#pragma unroll
        for (int j = 0; j < 8; ++j) { v[j] = xr[64 * j]; ss += (v[j].x * v[j].x + v[j].y * v[j].y) + (v[j].z * v[j].z + v[j].w * v[j].w); }
        const float rstd = rsqrtf(wave_sum(ss) * (1.f / DM) + EPS);
        u32x2* o8 = (u32x2*)(dst + (size_t)row * DM) + lane;
#pragma unroll
        for (int j = 0; j < 8; ++j) { const int col = lane * 4 + 256 * j; const f32x4 gg = *(const f32x4*)(g + col); const f32x4 s1 = *(const f32x4*)(sc + col), s0 = *(const f32x4*)(sh + col);
            f32x4 y = v[j] * rstd * gg; y = y * (s1 + 1.f) + s0;
            u32x2 w; w.x = cvt_pk_bf16(y.x, y.y); w.y = cvt_pk_bf16(y.z, y.w); o8[64 * j] = w; }
    }
}
__device__ __forceinline__ void phase1a(const Params& P, char* lds, int G) {
    const int tid = tid_opaque();
    const float* mod = (const float*)(P.ws + WS_MOD);
    float* sh = (float*)lds; float* sc = sh + DM;
    for (int n = tid; n < 2 * DM; n += NTHREADS) sh[n] = mod[n];
    __syncthreads();
    norm_mod_rows(P.x, P.norm_mix_g, sh, sc, (bf16_t*)(P.ws + WS_H), G);
    __syncthreads();
}
__device__ __forceinline__ void phase6b(const Params& P, char* lds, int G) {
    const int tid = tid_opaque(), lane = tid & 63, wave = tid >> 6;
    const int gw = blockIdx.x * NWAVES + wave, NGW = G * NWAVES;
    const float* mod = (const float*)(P.ws + WS_MOD);
    float* sh = (float*)lds; float* sc = sh + DM;
    for (int n = tid; n < 2 * DM; n += NTHREADS) sh[n] = mod[3 * DM + n];
    __syncthreads();
    norm_mod_rows(P.out, P.norm_mlp_g, sh, sc, (bf16_t*)(P.ws + WS_H), G);
    __syncthreads();
    float* scr = (float*)(lds + wave * 17408);
    constexpr int I_1 = 32 * 128, I_2 = 128 * 32;
    for (int it = gw; it < I_1 + I_2; it += NGW) {
        if (it < I_1) transpose_tile(P.w_ff1, DM, DFF, (bf16_t*)(P.ws + WS_W1), scr, it / 128, it % 128, lane, RowId());
        else { const int r = it - I_1; transpose_tile(P.w_ff2, DFF, DM, (bf16_t*)(P.ws + WS_W2), scr, r / 32, r % 32, lane, RowId()); }
    }
}

__device__ __forceinline__ void phase2(const Params& P, char* lds, int G) {
    const int tid = tid_opaque(), lane = tid & 63, wave = tid >> 6;
    const int gw = blockIdx.x * NWAVES + wave, NGW = G * NWAVES;
    const bf16_t* proj = (const bf16_t*)(P.ws + WS_PROJ);
    { bf16_t* cqn = (bf16_t*)(P.ws + WS_CQN); bf16_t* ckvn = (bf16_t*)(P.ws + WS_CKVN);
      float gq[8], gk[8];
#pragma unroll
      for (int e = 0; e < 8; ++e) { gq[e] = P.q_lora_g[lane * 8 + e]; gk[e] = P.kv_lora_g[(lane & 31) * 8 + e]; }
      for (int row = gw; row < SEQ; row += NGW) {
        const u32x4 wq = *(const u32x4*)(proj + (size_t)row * DINP + OFF_CQ + lane * 8);
        const u32x4 wk = *(const u32x4*)(proj + (size_t)row * DINP + OFF_CKV + (lane & 31) * 8);
        float fq[8], fk[8]; unpack8(wq, fq); unpack8(wk, fk);
        float sq = 0.f, sk = 0.f;
#pragma unroll
        for (int e = 0; e < 8; ++e) { sq += fq[e] * fq[e]; sk += fk[e] * fk[e]; }
        if (lane >= 32) sk = 0.f;
        const float rq = rsqrtf(wave_sum(sq) * (1.f / QLORA) + EPS), rk = rsqrtf(wave_sum(sk) * (1.f / KVLORA) + EPS);
#pragma unroll
        for (int e = 0; e < 8; ++e) { fq[e] = fq[e] * rq * gq[e]; fk[e] = fk[e] * rk * gk[e]; }
        *(u32x4*)(cqn + (size_t)row * QLORA + lane * 8) = pack8(fq);
        if (lane < 32) *(u32x4*)(ckvn + (size_t)row * KVLORA + lane * 8) = pack8(fk);
      } }
    { bf16_t* QH = (bf16_t*)(P.ws + WS_QH); bf16_t* KH = (bf16_t*)(P.ws + WS_KH); bf16_t* KT = (bf16_t*)(P.ws + WS_KT); bf16_t* VT = (bf16_t*)(P.ws + WS_VT);
      const int tg = tid >> 5, cgp = tid & 31, chl = cgp * 8;
      for (int item = blockIdx.x; item < 3 * HM * NCH; item += G) {
        const int kind = item / (HM * NCH), h = (item / NCH) % HM, c = item % NCH;
        const int t0 = LCH * c + 8 * tg;
        float outv[8][8];
        if (kind < 2) {
            const int col = OFF_QM + kind * 1024 + h * DH + chl;
            float cw[5][8], cb[8];
#pragma unroll
            for (int e = 0; e < 8; ++e) cb[e] = P.conv_b[kind * 1024 + h * DH + chl + e];
#pragma unroll
            for (int j = 0; j < 5; ++j)
#pragma unroll
                for (int e = 0; e < 8; ++e) cw[j][e] = P.conv_w[j * 2048 + kind * 1024 + h * DH + chl + e];
#pragma unroll
            for (int tt = 0; tt < 8; ++tt)
#pragma unroll
                for (int e = 0; e < 8; ++e) outv[tt][e] = cb[e];
#pragma unroll
            for (int rr = 0; rr < 12; ++rr) {
                const int t = t0 - 2 + rr; float in[8];
                if (t >= 0 && t < SEQ) { const u32x4 w = *(const u32x4*)(proj + (size_t)t * DINP + col); unpack8(w, in); }
                else {
#pragma unroll
                    for (int e = 0; e < 8; ++e) in[e] = 0.f; }
#pragma unroll
                for (int j = 0; j < 5; ++j) { const int tt = rr - j;
                    if (tt >= 0 && tt < 8) {
#pragma unroll
                        for (int e = 0; e < 8; ++e) outv[tt][e] += cw[j][e] * in[e]; } }
            }
            const float osc = kind == 1 ? 0.0625f : 1.f;
#pragma unroll
            for (int tt = 0; tt < 8; ++tt)
#pragma unroll
                for (int e = 0; e < 8; ++e) outv[tt][e] = silu_f(outv[tt][e]) * osc;
            bf16_t* dst = (kind == 0 ? QH : KH) + ((size_t)h * SEQ + t0) * DH + chl;
#pragma unroll
            for (int tt = 0; tt < 8; ++tt) *(u32x4*)(dst + (size_t)tt * DH) = pack8(outv[tt]);
        } else {
#pragma unroll
            for (int tt = 0; tt < 8; ++tt) { const u32x4 w = *(const u32x4*)(proj + (size_t)(t0 + tt) * DINP + OFF_VM + h * DH + chl); unpack8(w, outv[tt]); }
        }
        if (kind >= 1) {
            bf16_t* dst = (kind == 1 ? KT : VT) + ((size_t)(h * NCH + c) * DH + chl) * LCH + 8 * tg;
#pragma unroll
            for (int e = 0; e < 8; ++e) { u32x4 w; w.x = cvt_pk_bf16(outv[0][e], outv[1][e]); w.y = cvt_pk_bf16(outv[2][e], outv[3][e]); w.z = cvt_pk_bf16(outv[4][e], outv[5][e]); w.w = cvt_pk_bf16(outv[6][e], outv[7][e]);
                *(u32x4*)(dst + (size_t)e * LCH) = w; }
        }
      } }
    { const float* gates = (const float*)(P.ws + WS_GATES);
      float* BC = (float*)(P.ws + WS_BC); float* IG = (float*)(P.ws + WS_IG); float* PM = (float*)(P.ws + WS_PM); float* WL = (float*)(P.ws + WS_WL);
      float* BL = (float*)(P.ws + WS_BL); float* AC = (float*)(P.ws + WS_AC);
      for (int task = gw; task < 2 * HM * NCH; task += NGW) {
        const int dir = task / (HM * NCH), h = (task / NCH) % HM, c = task % NCH;
        const float bi = P.b_gates[dir * 8 + h], bfg = P.b_gates[dir * 8 + 4 + h];
        const int u0 = 2 * lane, u1 = 2 * lane + 1;
        const int t0 = LCH * c + (dir ? 127 - u0 : u0), t1 = LCH * c + (dir ? 127 - u1 : u1);
        const float i0 = gates[(size_t)t0 * 16 + dir * 8 + h] + bi, i1 = gates[(size_t)t1 * 16 + dir * 8 + h] + bi;
        const float f0 = gates[(size_t)t0 * 16 + dir * 8 + 4 + h] + bfg, f1 = gates[(size_t)t1 * 16 + dir * 8 + 4 + h] + bfg;
        const float l0 = fminf(f0, 0.f) - log1pf(expf(-fabsf(f0))), l1 = fminf(f1, 0.f) - log1pf(expf(-fabsf(f1)));
        float inc = l0 + l1;
#pragma unroll
        for (int o = 1; o < 64; o <<= 1) { const float t = __shfl_up(inc, o); if (lane >= o) inc += t; }
        const float b1 = inc, b0 = inc - l1;
        const float d0 = i0 - b0, d1 = i1 - b1;
        float pmx = fmaxf(d0, d1);
#pragma unroll
        for (int o = 1; o < 64; o <<= 1) { const float t = __shfl_up(pmx, o); if (lane >= o) pmx = fmaxf(pmx, t); }
        float prev = __shfl_up(pmx, 1); if (lane == 0) prev = -INFINITY;
        const float pm0 = fmaxf(prev, d0), pm1 = pmx;
        const float bL = __shfl(b1, 63), pmL = __shfl(pmx, 63);
        const size_t base = (size_t)(dir * HM + h) * SEQ;
        BC[base + t0] = b0; BC[base + t1] = b1; IG[base + t0] = i0; IG[base + t1] = i1;
        PM[base + t0] = b0 + pm0; PM[base + t1] = b1 + pm1;
        WL[base + t0] = bL - b0 + i0; WL[base + t1] = bL - b1 + i1;
        if (lane == 63) { BL[(dir * HM + h) * NCH + c] = bL; AC[(dir * HM + h) * NCH + c] = bL + pmL; }
      } }
}

constexpr int M2_W = 1024, M2_WB = M2_W + SEQ * 4, M2_T0 = M2_WB + SEQ * 2, M2_TB = 96 * 256;
static_assert(M2_T0 + 2 * M2_TB <= LDS_BYTES, "M2 LDS");
__device__ __forceinline__ void m2_block(const Params& P, char* lds, int blk) {
    const int tid = tid_opaque(), lane = tid & 63, wid = tid >> 6, r = lane & 15, g = lane >> 4;
    const int dir = blk >> 7, h = (blk >> 5) & 3, vs = (blk >> 2) & 7, ksl = blk & 3;
    const int vi = wid >> 2, ki = wid & 3, v0 = 32 * vs + 16 * vi, k0 = 64 * ksl + 16 * ki;
    const int dh = dir * HM + h;
    const float* BL = (const float*)(P.ws + WS_BL) + dh * NCH; const float* AC = (const float*)(P.ws + WS_AC) + dh * NCH;
    const float* WL = (const float*)(P.ws + WS_WL) + (size_t)dh * SEQ;
    bf16_t* CST = (bf16_t*)(P.ws + WS_CST); float* NST = (float*)(P.ws + WS_NST);
    float* s_mA = (float*)lds; float* s_dec = s_mA + NCH; float* s_w = (float*)(lds + M2_W); bf16_t* s_wb = (bf16_t*)(lds + M2_WB);
    float* s_bl = (float*)(lds + 512); float* s_ac = s_bl + NCH;
    if (tid < NCH) { s_bl[tid] = BL[tid]; s_ac[tid] = AC[tid]; }
    __syncthreads();
    if (tid == 0) { float m = -1e30f; float* MB = (float*)(P.ws + WS_MB) + dh * NCH; const bool pub = (vs == 0 && ksl == 0);
#pragma unroll 1
        for (int st = 0; st < NCH; ++st) { const int c = dir ? NCH - 1 - st : st; const float bL = s_bl[c], a = s_ac[c]; const float mn = fmaxf(bL + m, a);
            if (pub) MB[c] = m;
            s_dec[c] = __expf(bL + m - mn); s_mA[c] = mn; m = mn; } }
    __syncthreads();
    { float wl_[16];
#pragma unroll
      for (int i = 0; i < 16; ++i) wl_[i] = WL[tid + NTHREADS * i];
#pragma unroll
      for (int i = 0; i < 16; ++i) { const float w_ = __expf(wl_[i] - s_mA[(tid + NTHREADS * i) >> 7]); s_w[tid + NTHREADS * i] = w_; s_wb[tid + NTHREADS * i] = f2bf(w_); } }
    const int srow = tid >> 4, sslot = tid & 15;
    const char* gV = (const char*)(P.ws + WS_VT) + ((size_t)h * NCH * DH + 32 * vs + srow) * (LCH * 2) + sslot * 16;
    const char* gK = (const char*)(P.ws + WS_KT) + ((size_t)h * NCH * DH + 64 * ksl + srow) * (LCH * 2) + sslot * 16;
    const int lw = srow * 256 + ((sslot ^ (srow & 15)) << 4);
    const int la = (16 * vi + r) * 256, lb = (32 + 16 * ki + r) * 256;
    char* tb = lds + M2_T0;
    u32x4 ring[8][3];
#define M2_LOAD(slot, stp) do { const int c_ = dir ? NCH - 1 - (stp) : (stp); const size_t co_ = (size_t)c_ * (DH * LCH * 2); \
        ring[slot][0] = *(const u32x4*)(gV + co_); ring[slot][1] = *(const u32x4*)(gK + co_); ring[slot][2] = *(const u32x4*)(gK + co_ + 32 * LCH * 2); } while (0)
#define M2_WRITE(slot, buf, stp) do { char* d_ = tb + (buf) * M2_TB + lw; const int cw_ = dir ? NCH - 1 - (stp) : (stp); \
        const f32x4 wv0_ = *(const f32x4*)(s_w + LCH * cw_ + 8 * sslot), wv1_ = *(const f32x4*)(s_w + LCH * cw_ + 8 * sslot + 4); float a_[8]; unpack8(ring[slot][0], a_); \
        _Pragma("unroll") for (int j_ = 0; j_ < 4; ++j_) { a_[j_] *= wv0_[j_]; a_[4 + j_] *= wv1_[j_]; } \
        *(u32x4*)d_ = pack8(a_); *(u32x4*)(d_ + 8192) = ring[slot][1]; *(u32x4*)(d_ + 16384) = ring[slot][2]; } while (0)
#pragma unroll
    for (int d = 0; d < 8; ++d) M2_LOAD(d, d);
    __syncthreads();
    M2_WRITE(0, 0, 0);
    const bool do_n = (vs == 0 && vi == 0);
    f32x4 acc = {0.f, 0.f, 0.f, 0.f}, nacc = {0.f, 0.f, 0.f, 0.f};
#pragma unroll 1
    for (int st8 = 0; st8 < NCH; st8 += 8) {
#pragma unroll
        for (int u = 0; u < 8; ++u) {
            const int st = st8 + u;
            const int c = dir ? NCH - 1 - st : st;
            asm volatile("s_waitcnt lgkmcnt(0)" ::: "memory"); __builtin_amdgcn_s_barrier(); asm volatile("" ::: "memory");
            if (st + 1 < NCH) M2_WRITE((u + 1) & 7, (u + 1) & 1, st + 1);
            if (st + 8 < NCH) M2_LOAD(u, st + 8);
            { bf16_t* cp = CST + ((size_t)dh * NCH + c) * (DH * DH) + (size_t)(v0 + r) * DH + k0 + 4 * g;
              u32x2 w2; w2.x = cvt_pk_bf16(acc[0], acc[1]); w2.y = cvt_pk_bf16(acc[2], acc[3]); *(u32x2*)cp = w2;
              if (do_n && r == 0) *(f32x4*)(NST + ((size_t)dh * NCH + c) * DH + k0 + 4 * g) = nacc; }
            const float dec = s_dec[c];
            acc = acc * dec; if (do_n) nacc = nacc * dec;
            const char* tbuf = tb + (u & 1) * M2_TB;
#pragma unroll
            for (int ks = 0; ks < 4; ++ks) {
                const int sl = ((4 * ks + g) ^ r) << 4;
                const bf16x8 av = *(const bf16x8*)(tbuf + la + sl), bv = *(const bf16x8*)(tbuf + lb + sl);
                acc = __builtin_amdgcn_mfma_f32_16x16x32_bf16(bv, av, acc, 0, 0, 0);
                if (do_n) { const bf16x8 wv = *(const bf16x8*)(s_wb + LCH * c + 32 * ks + 8 * g);
                    nacc = __builtin_amdgcn_mfma_f32_16x16x32_bf16(bv, wv, nacc, 0, 0, 0); }
            }
        }
    }
#undef M2_LOAD
#undef M2_WRITE
    __syncthreads();
}

constexpr int M3_LV = 1024, M3_LVS = 272, M3_LC = M3_LV + 256 * M3_LVS, M3_LCS = 528;
static_assert(M3_LC + 128 * M3_LCS <= LDS_BYTES, "M3 LDS");
__device__ __forceinline__ void m3_unit(const Params& P, char* lds, int h, int c) {
    const int tid = tid_opaque(), lane = tid & 63, wid = __builtin_amdgcn_readfirstlane(tid >> 6), r = lane & 15, g = lane >> 4;
    const int T0 = LCH * c, tl = 16 * wid + r;
    const char* QHc = (const char*)(P.ws + WS_QH) + ((size_t)h * SEQ + T0 + 16 * wid) * (DH * 2);
    const char* KHc = (const char*)(P.ws + WS_KH) + ((size_t)h * SEQ + T0) * (DH * 2);
    const char* VTc = (const char*)(P.ws + WS_VT) + ((size_t)h * NCH + c) * (DH * LCH * 2);
    const char* Cb = (const char*)(P.ws + WS_CST) + ((size_t)h * NCH + c) * (DH * DH * 2);
    const unsigned o512 = (unsigned)(r * 512 + g * 16);
    float* s_mb = (float*)lds; char* LV = lds + M3_LV; char* LC = lds + M3_LC;
    const char* lvr = LV + r * M3_LVS + g * 8;
    const char* lcr = LC + r * M3_LCS + g * 16;
    char* lcw = LC + (tid >> 5) * M3_LCS + (tid & 31) * 16;
    u32x4 cr[8];
#define M3_CLOAD(src) do { _Pragma("unroll") for (int n = 0; n < 8; ++n) cr[n] = ldgu<u32x4>((src) + n * 8192, (unsigned)tid * 16u); } while (0)
#define M3_CWRITE() do { _Pragma("unroll") for (int n = 0; n < 8; ++n) *(u32x4*)(lcw + n * (16 * M3_LCS)) = cr[n]; } while (0)
    M3_CLOAD(KHc);
    { u32x4 v[8];
#pragma unroll
      for (int n = 0; n < 8; ++n) v[n] = ldgu<u32x4>(VTc + n * 8192, (unsigned)tid * 16u);
#pragma unroll
      for (int n = 0; n < 8; ++n) *(u32x4*)(LV + ((tid >> 4) + 32 * n) * M3_LVS + (tid & 15) * 16) = v[n]; }
    M3_CWRITE();
    __syncthreads();
    f32x4 st[8];
    { bf16x8 qf[8];
#pragma unroll
      for (int kd = 0; kd < 8; ++kd) qf[kd] = ldgu<bf16x8>(QHc + 64 * kd, o512);
#pragma unroll
      for (int j = 0; j < 8; ++j) { st[j] = (f32x4){0.f, 0.f, 0.f, 0.f};
#pragma unroll
        for (int kd = 0; kd < 8; ++kd) { const bf16x8 kf = *(const bf16x8*)(lcr + j * (16 * M3_LCS) + kd * 64);
            st[j] = __builtin_amdgcn_mfma_f32_16x16x32_bf16(kf, qf[kd], st[j], 0, 0, 0); } } }
    f32x4 acc[16];
#pragma unroll
    for (int vt = 0; vt < 16; ++vt) acc[vt] = (f32x4){0.f, 0.f, 0.f, 0.f};
#pragma unroll 1
    for (int dir = 0; dir < 2; ++dir) {
        const int dh = dir * HM + h;
        const char* BCc = (const char*)(P.ws + WS_BC) + ((size_t)dh * SEQ + T0) * 4; const char* IGc = (const char*)(P.ws + WS_IG) + ((size_t)dh * SEQ + T0) * 4;
        const char* PMc = (const char*)(P.ws + WS_PM) + ((size_t)dh * SEQ + T0) * 4;
        const char* Cc = Cb + (size_t)dir * ((size_t)HM * NCH * DH * DH * 2);
        const char* Nc = (const char*)(P.ws + WS_NST) + ((size_t)dh * NCH + c) * (DH * 4);
        const int fx = dir * 127, tlx = tl ^ fx;
        const float mB = ((const float*)(P.ws + WS_MB))[dh * NCH + c];
        const float bt = ldgu<float>(BCc, (unsigned)tl * 4u), pm = ldgu<float>(PMc, (unsigned)tl * 4u);
        const float mt = fmaxf(bt + mB, pm); const float alpha = bt - mt; const float winter = __expf(bt + mB - mt);
        float den = 0.f;
#pragma unroll
        for (int j = 0; j < 8; ++j) { const int sb = 16 * j + 4 * g;
            const f32x4 ig = ldgu<f32x4>(IGc + 64 * j, (unsigned)g * 16u), bc = ldgu<f32x4>(BCc + 64 * j, (unsigned)g * 16u);
#pragma unroll
            for (int i = 0; i < 4; ++i) { const int sl = sb + i; const bool ok = ((sl ^ fx) <= tlx);
                const float e = ok ? __expf(alpha + ig[i] - bc[i]) : 0.f; den += st[j][i] * e; } }
        den += __shfl_xor(den, 16); den += __shfl_xor(den, 32);
        float qn = 0.f;
#pragma unroll
        for (int kd = 0; kd < 8; ++kd) { const f32x4 n0 = ldgu<f32x4>(Nc + 128 * kd, (unsigned)g * 32u), n1 = ldgu<f32x4>(Nc + 128 * kd + 16, (unsigned)g * 32u);
            const u32x4 qt = ldgu<u32x4>(QHc + 64 * kd, o512); float q[8]; unpack8(qt, q);
            qn += q[0] * n0[0] + q[1] * n0[1] + q[2] * n0[2] + q[3] * n0[3] + q[4] * n1[0] + q[5] * n1[1] + q[6] * n1[2] + q[7] * n1[3]; }
        qn += __shfl_xor(qn, 16); qn += __shfl_xor(qn, 32);
        const float dtot = den + winter * qn;
        const float hdiv = 1.f / fmaxf(fabsf(dtot), __expf(-mt));
        M3_CLOAD(Cc);
        int tlx2 = tlx; LAUNDER_V(tlx2);
#pragma unroll
        for (int ks = 0; ks < 4; ++ks) {
            float e8[8];
#pragma unroll
            for (int hh = 0; hh < 2; ++hh) { const int j = 2 * ks + hh, sb = 16 * j + 4 * g;
                const f32x4 ig = ldgu<f32x4>(IGc + 64 * j, (unsigned)g * 16u), bc = ldgu<f32x4>(BCc + 64 * j, (unsigned)g * 16u);
#pragma unroll
                for (int i = 0; i < 4; ++i) { const int sl = sb + i; const bool ok = ((sl ^ fx) <= tlx2);
                    const float e = ok ? __expf(alpha + ig[i] - bc[i]) : 0.f; e8[4 * hh + i] = st[j][i] * e * hdiv; } }
            const u32x4 pw = pack8(e8); const bf16x8 pa = *(const bf16x8*)&pw;
#pragma unroll
            for (int vt = 0; vt < 16; ++vt) {
                const u32x2 lo = *(const u32x2*)(lvr + vt * (16 * M3_LVS) + ks * 64), hi2 = *(const u32x2*)(lvr + vt * (16 * M3_LVS) + ks * 64 + 32);
                u32x4 w; w.x = lo.x; w.y = lo.y; w.z = hi2.x; w.w = hi2.y;
                acc[vt] = __builtin_amdgcn_mfma_f32_16x16x32_bf16(pa, *(const bf16x8*)&w, acc[vt], 0, 0, 0); }
        }
        const float qsc = winter * hdiv;
#pragma unroll
        for (int half = 0; half < 2; ++half) {
            __syncthreads();
            M3_CWRITE();
            __syncthreads();
            if (half == 0) M3_CLOAD(Cc + 65536);
#pragma unroll
            for (int kd = 0; kd < 8; ++kd) { const u32x4 qt = ldgu<u32x4>(QHc + 64 * kd, o512); float q[8]; unpack8(qt, q);
#pragma unroll
                for (int e = 0; e < 8; ++e) q[e] *= qsc;
                const u32x4 qw = pack8(q); const bf16x8 qs = *(const bf16x8*)&qw;
#pragma unroll
                for (int v8 = 0; v8 < 8; ++v8) { const bf16x8 cf = *(const bf16x8*)(lcr + v8 * (16 * M3_LCS) + kd * 64);
                    acc[half * 8 + v8] = __builtin_amdgcn_mfma_f32_16x16x32_bf16(qs, cf, acc[half * 8 + v8], 0, 0, 0); }
            }
        }
    }
#undef M3_CLOAD
#undef M3_CWRITE
    float ss[4] = {0.f, 0.f, 0.f, 0.f};
#pragma unroll
    for (int vt = 0; vt < 16; ++vt)
#pragma unroll
        for (int i = 0; i < 4; ++i) ss[i] += acc[vt][i] * acc[vt][i];
#pragma unroll
    for (int i = 0; i < 4; ++i) { ss[i] += __shfl_xor(ss[i], 1); ss[i] += __shfl_xor(ss[i], 2); ss[i] += __shfl_xor(ss[i], 4); ss[i] += __shfl_xor(ss[i], 8); ss[i] = rsqrtf(ss[i] * (1.f / DH) + EPS); }
    const char* pr0 = (const char*)(P.ws + WS_PROJ) + ((size_t)(T0 + 16 * wid) * DINP + OFF_OM + h * DH) * 2;
    char* mx0 = (char*)(P.ws + WS_MIX) + ((size_t)(T0 + 16 * wid) * DM + 1024 + h * DH) * 2;
    const char* gmp = (const char*)(P.mlstm_norm_g + h * DH);
    const unsigned opr = (unsigned)(4 * g * DINP * 2 + r * 2), omx = (unsigned)(4 * g * DM * 2 + r * 2);
#pragma unroll
    for (int vt = 0; vt < 16; ++vt) { const float gm = ldgu<float>(gmp + 64 * vt, (unsigned)r * 4u);
#pragma unroll
        for (int i = 0; i < 4; ++i) { const float om = bf2f(ldgu<bf16_t>(pr0 + i * (DINP * 2) + 32 * vt, opr));
            *(bf16_t*)(mx0 + i * (DM * 2) + 32 * vt + omx) = f2bf(acc[vt][i] * ss[i] * gm * sigmoid_f(om)); }
        if ((vt & 3) == 3) asm volatile("" ::: "memory"); }
    __syncthreads();
}

__device__ __forceinline__ void phase4(const Params& P, int G) {
    const int tid = tid_opaque(), lane = tid & 63, wave = tid >> 6;
    const int gw = blockIdx.x * NWAVES + wave, NGW = G * NWAVES;
    bf16_t* Q = (bf16_t*)(P.ws + WS_Q); bf16_t* K = (bf16_t*)(P.ws + WS_K); const bf16_t* KV = (const bf16_t*)(P.ws + WS_KV); const bf16_t* proj = (const bf16_t*)(P.ws + WS_PROJ);
    const f32x4* rt = (const f32x4*)(P.ws + WS_ROPE);
    const int i = lane & 7, hh = lane >> 3; const bool lo = i < 4;
    float gq[3][8], gk[3][8];
#pragma unroll
    for (int j = 0; j < 3; ++j)
#pragma unroll
        for (int e = 0; e < 8; ++e) { gq[j][e] = P.q_norm_g[8 * (i + 8 * j) + e]; gk[j][e] = P.k_norm_g[8 * (i + 8 * j) + e]; }
    for (int t = gw; t < SEQ; t += NGW) {
        float cs[8], sn[8];
#pragma unroll
        for (int e2 = 0; e2 < 4; ++e2) { const f32x4 v = rt[(size_t)t * 16 + 4 * (i & 3) + e2]; cs[2 * e2] = v[0]; sn[2 * e2] = v[1]; cs[2 * e2 + 1] = v[2]; sn[2 * e2 + 1] = v[3]; }
#pragma unroll
        for (int which = 0; which < 2; ++which) {
            u32x4 w0, w1, w2; bf16_t* dst;
            if (which == 0) { bf16_t* qp = Q + (size_t)t * (NH * DQK) + hh * DQK + 8 * i; w0 = *(const u32x4*)qp; w1 = *(const u32x4*)(qp + 64); w2 = *(const u32x4*)(qp + 128); dst = qp; }
            else { const bf16_t* kp = KV + (size_t)t * (NH * 256) + hh * 256 + 8 * i; w0 = *(const u32x4*)kp; w1 = *(const u32x4*)(kp + 64);
                   w2 = *(const u32x4*)(proj + (size_t)t * DINP + OFF_KPE + 8 * i); dst = K + (size_t)t * (NH * DQK) + hh * DQK + 8 * i; }
            float a0[8], a1[8], a2[8]; unpack8(w0, a0); unpack8(w1, a1); unpack8(w2, a2);
            float ss = 0.f;
#pragma unroll
            for (int e = 0; e < 8; ++e) ss += a0[e] * a0[e] + a1[e] * a1[e] + a2[e] * a2[e];
            ss += __shfl_xor(ss, 1); ss += __shfl_xor(ss, 2); ss += __shfl_xor(ss, 4);
            const float rs = rsqrtf(ss * (1.f / DQK) + EPS);
#pragma unroll
            for (int e = 0; e < 8; ++e) { const float g0 = which ? gk[0][e] : gq[0][e], g1 = which ? gk[1][e] : gq[1][e], g2 = which ? gk[2][e] : gq[2][e];
                a0[e] *= rs * g0; a1[e] *= rs * g1; a2[e] *= rs * g2; }
            float o2[8];
#pragma unroll
            for (int e = 0; e < 8; ++e) { const float pr = __shfl_xor(a2[e], 4);
                o2[e] = lo ? (a2[e] * cs[e] - pr * sn[e]) : (pr * sn[e] + a2[e] * cs[e]); }
            *(u32x4*)dst = pack8(a0); *(u32x4*)(dst + 64) = pack8(a1); *(u32x4*)(dst + 128) = pack8(o2);
        }
    }
}

struct StoreProj { bf16_t* proj; float* gates;
    __device__ __forceinline__ void operator()(int row, int col, f32x4 v0, f32x4 v1) const {
        u32x4 w; w.x = cvt_pk_bf16(v0[0], v0[1]); w.y = cvt_pk_bf16(v0[2], v0[3]); w.z = cvt_pk_bf16(v1[0], v1[1]); w.w = cvt_pk_bf16(v1[2], v1[3]);
        *(u32x4*)(proj + (size_t)row * DINP + col) = w;
        if (col >= OFF_GM && col < OFF_GM + 16) { float* gp = gates + (size_t)row * 16 + (col - OFF_GM); *(f32x4*)gp = v0; *(f32x4*)(gp + 4) = v1; } } };
struct StoreQ { bf16_t* q;
    __device__ __forceinline__ void operator()(int row, int col, f32x4 v0, f32x4 v1) const {
        const int h = col >> 8, ct = col & 255;
        if (ct < DQK) { u32x4 w; w.x = cvt_pk_bf16(v0[0], v0[1]); w.y = cvt_pk_bf16(v0[2], v0[3]); w.z = cvt_pk_bf16(v1[0], v1[1]); w.w = cvt_pk_bf16(v1[2], v1[3]);
            *(u32x4*)(q + (size_t)row * (NH * DQK) + h * DQK + ct) = w; } } };
struct StoreKV { bf16_t* kv;
    __device__ __forceinline__ void operator()(int row, int col, f32x4 v0, f32x4 v1) const {
        u32x4 w; w.x = cvt_pk_bf16(v0[0], v0[1]); w.y = cvt_pk_bf16(v0[2], v0[3]); w.z = cvt_pk_bf16(v1[0], v1[1]); w.w = cvt_pk_bf16(v1[2], v1[3]);
        *(u32x4*)(kv + (size_t)row * (NH * 256) + col) = w; } };
struct StoreX1 { const float* x; const float* gate; float* out;
    __device__ __forceinline__ void operator()(int row, int col, f32x4 v) const {
        const size_t off = (size_t)row * DM + col; const f32x4 xv = *(const f32x4*)(x + off); const f32x4 gv = *(const f32x4*)(gate + col);
        *(f32x4*)(out + off) = xv + gv * v; } };
struct StoreAct { bf16_t* act;
    __device__ __forceinline__ void operator()(int row, int col, f32x4 v0, f32x4 v1) const {
        float f[8] = {v0[0], v0[1], v0[2], v0[3], v1[0], v1[1], v1[2], v1[3]};
#pragma unroll
        for (int e = 0; e < 8; ++e) { const float rl = fmaxf(f[e], 0.f); f[e] = rl * rl; }
        *(u32x4*)(act + (size_t)row * DFF + col) = pack8(f); } };

#define XB_TMO      128
#define XB_XCNT(j)  (256  + 64 * (j))
#define XB_XSUB(j)  (1280 + 64 * (j))
#define XB_XGEN(j)  (2304 + 64 * (j))
#define XB_TOP      3328
#define XB_TOPGEN   3392
#define XCD_BAR_WORDS 3456
#define XB_SPIN_CAP (1u << 18)

__device__ __forceinline__ unsigned xb_ld(unsigned* p)              { return __hip_atomic_load(p, __ATOMIC_RELAXED, __HIP_MEMORY_SCOPE_AGENT); }
__device__ __forceinline__ unsigned xb_add(unsigned* p, unsigned v) { return __hip_atomic_fetch_add(p, v, __ATOMIC_RELAXED, __HIP_MEMORY_SCOPE_AGENT); }
__device__ __forceinline__ unsigned xb_xcc_id() { return (unsigned)__builtin_amdgcn_s_getreg((3 << 11) | 20) & 0xFu; }
#define XB_SPIN(cond, bar) do { unsigned _sp = 0; while (cond) { __builtin_amdgcn_s_sleep(1); \
    if ((++_sp & 255u) == 0u) { if (xb_ld(&(bar)[XB_TMO])) break; if (_sp > XB_SPIN_CAP) { atomicAdd(&(bar)[XB_TMO], 1u); break; } } } } while (0)

struct XcdBarrier {
    unsigned* bar; unsigned x;
    volatile LAS unsigned* st;
};

__device__ __forceinline__ XcdBarrier xcd_barrier_post(unsigned* bar, volatile LAS unsigned* st) {
    XcdBarrier b; b.bar = bar; b.x = xb_xcc_id(); b.st = st;
    if (threadIdx.x == 0) (void)xb_add(&bar[XB_XCNT(b.x)], 1u);
    return b;
}
__device__ __forceinline__ void xcd_barrier_complete(unsigned* bar, unsigned x, unsigned& nloc, unsigned& nx) {
    const unsigned G = gridDim.x * gridDim.y * gridDim.z;
    unsigned sum, cnt, mine, sp = 0u;
    for (;;) {
        sum = 0u; cnt = 0u; mine = 0u;
#pragma unroll
        for (unsigned j = 0; j < 16; ++j) { const unsigned c = xb_ld(&bar[XB_XCNT(j)]); sum += c; cnt += (c > 0u) ? 1u : 0u; mine = (j == x) ? c : mine; }
        if (sum == G) break;
        __builtin_amdgcn_s_sleep(1);
        if ((++sp & 255u) == 0u) { if (xb_ld(&bar[XB_TMO])) break; if (sp > XB_SPIN_CAP) { atomicAdd(&bar[XB_TMO], 1u); break; } }
    }
    nloc = mine > 0u ? mine : 1u; nx = cnt > 0u ? cnt : 1u;
}

__device__ __forceinline__ void xcd_barrier(const XcdBarrier& b) {
    asm volatile("s_waitcnt vmcnt(0)" ::: "memory");
    __syncthreads();
    if (threadIdx.x == 0) {
        unsigned* bar = b.bar;
        __builtin_amdgcn_s_waitcnt(0);
        unsigned nloc = b.st[0], nx = b.st[1];
        if (nloc == 0u) { xcd_barrier_complete(bar, b.x, nloc, nx); b.st[0] = nloc; b.st[1] = nx; }
        const unsigned old = xb_add(&bar[XB_XSUB(b.x)], 1u);
        const unsigned gen = old / nloc;
        if (old + 1u == (gen + 1u) * nloc) {
            __builtin_amdgcn_fence(__ATOMIC_RELEASE, "agent");
            asm volatile("s_waitcnt vmcnt(0)" ::: "memory");
            const unsigned og = xb_add(&bar[XB_TOP], 1u);
            const unsigned tg = og / nx;
            if (og + 1u == (tg + 1u) * nx) xb_add(&bar[XB_TOPGEN], 1u);
            else XB_SPIN(xb_ld(&bar[XB_TOPGEN]) == tg, bar);
            __builtin_amdgcn_fence(__ATOMIC_ACQUIRE, "agent");
            xb_add(&bar[XB_XGEN(b.x)], 1u);
            asm volatile("s_waitcnt vmcnt(0)" ::: "memory");
        } else {
            XB_SPIN(xb_ld(&bar[XB_XGEN(b.x)]) == gen, bar);
            __builtin_amdgcn_fence(__ATOMIC_ACQUIRE, "agent");
            asm volatile("s_waitcnt vmcnt(0)" ::: "memory");
        }
    }
    __syncthreads();
}


constexpr int NPH = 11;
#ifdef ONLY_PH
#define PH_ON(n) ((n) == ONLY_PH)
#else
#define PH_ON(n) 1
#endif
#define CAS __attribute__((address_space(4)))
__device__ __forceinline__ Params load_params(const CAS Params* kp) {
#if defined(__HIP_DEVICE_COMPILE__)
    unsigned long long kv = (unsigned long long)kp; asm volatile("" : "+s"(kv)); return *(const CAS Params*)kv;
#else
    return Params{};
#endif
}
__global__ void __launch_bounds__(NTHREADS, 2) fwd_kernel(Params Pk) {
    extern __shared__ __attribute__((aligned(16))) char lds[];
    const CAS Params* kp = (const CAS Params*)__builtin_amdgcn_kernarg_segment_ptr();
    const int G0 = gridDim.x; const int bx0 = blockIdx.x;
    const int vcu0 = (G0 % 8 == 0) ? (bx0 % 8) * (G0 / 8) + bx0 / 8 : bx0;
    LAS unsigned char* ldsl = (LAS unsigned char*)lds;
    const int ph_lo = Pk.ph_lo, ph_hi = Pk.ph_hi;
    if (threadIdx.x < 16) ((volatile LAS unsigned*)(ldsl + LDS_BARST))[threadIdx.x] = 0u;
    __syncthreads();
    XcdBarrier xbar = xcd_barrier_post((unsigned*)(Pk.ws + WS_BAR), (volatile LAS unsigned*)(ldsl + LDS_BARST));
#ifndef PROBE_PH
#define PROBE_PH (-1)
#endif
    unsigned long long probe_dt = 0, probe_t0g = 0;
#ifndef PROBE_FROM
#define PROBE_FROM (-1)
#define PROBE_TO (-1)
#endif
#define PROBE_MARK(id) do { if (PROBE_FROM == (id)) { __syncthreads(); probe_t0g = __builtin_amdgcn_s_memrealtime(); } if (PROBE_TO == (id)) { __syncthreads(); probe_dt = __builtin_amdgcn_s_memrealtime() - probe_t0g; } } while (0)
#ifndef DUP_PH
#define DUP_PH (-1)
#endif
#ifndef DUP_SUB
#define DUP_SUB 0
#endif
    for (int ph = ph_lo; ph < ph_hi; ++ph) {
      for (int rep = 0; rep < ((ph == DUP_PH) ? 2 : 1); ++rep) {
        int G = G0, bx = bx0, vcu = vcu0; asm volatile("" : "+s"(G), "+s"(bx), "+s"(vcu));
        unsigned long long probe_t0 = 0; if (PROBE_PH >= 0 && ph == PROBE_PH) probe_t0 = __builtin_amdgcn_s_memrealtime();
        switch (ph) {
        case 0: if (PH_ON(0)) { const Params P = load_params(kp); phase0(P, lds, G); } break;
        case 1: if (PH_ON(1)) { const Params P = load_params(kp); phase1a(P, lds, G); } break;
        case 2: if (PH_ON(2)) { const Params P = load_params(kp); unsigned char* ws = P.ws;
                  pg8::Gemm g{(const bf16_t*)(ws + WS_H), (const bf16_t*)(ws + WS_WIN), SEQ, DINP, DM}; pg8::StaticOrder S; S.init(SEQ, DINP, G, bx);
                  pg8::Epi8<StoreProj> E{{(bf16_t*)(ws + WS_PROJ), (float*)(ws + WS_GATES)}};
                  pg8::gemm_phase<pg8::Epi8<StoreProj>, pg8::StaticOrder, true, true>(ldsl, g, S, E); } break;
        case 3: if (PH_ON(3)) { const Params P = load_params(kp); phase2(P, lds, G); } break;
        case 4: if (PH_ON(4)) { PROBE_MARK(40);
#ifndef NO_G4
#ifndef NO_G4A
                  if (rep == 0 || DUP_SUB == 0 || DUP_SUB == 1) { const Params P = load_params(kp); unsigned char* ws = P.ws;
                    pg8::Gemm g{(const bf16_t*)(ws + WS_CQN), (const bf16_t*)(ws + WS_WUQ), SEQ, NH * 256, QLORA}; pg8::StaticOrder S; S.init(SEQ, NH * 256, G, bx);
                    pg8::Epi8<StoreQ> E{{(bf16_t*)(ws + WS_Q)}};
                    pg8::gemm_phase<pg8::Epi8<StoreQ>, pg8::StaticOrder, true, true>(ldsl, g, S, E); }
#endif
#ifndef NO_G4B
                  if (rep == 0 || DUP_SUB == 0 || DUP_SUB == 2) { const Params P = load_params(kp); unsigned char* ws = P.ws;
                    pg8::Gemm g{(const bf16_t*)(ws + WS_CKVN), (const bf16_t*)(ws + WS_WUKV), SEQ, NH * 256, KVLORA}; pg8::StaticOrder S; S.init(SEQ, NH * 256, G, bx);
                    pg8::Epi8<StoreKV> E{{(bf16_t*)(ws + WS_KV)}};
                    pg8::gemm_phase<pg8::Epi8<StoreKV>, pg8::StaticOrder, true, true>(ldsl, g, S, E); }
#endif
#endif
                  PROBE_MARK(42);
#ifndef NO_M2
                  if (rep == 0 || DUP_SUB == 0 || DUP_SUB == 3) { const Params P = load_params(kp); for (int b = vcu; b < 256; b += G) m2_block(P, lds, b); }
#endif
                  PROBE_MARK(43);
                  } break;
        case 5: if (PH_ON(5)) { const Params P = load_params(kp); phase4(P, G); } break;
        case 6: if (PH_ON(6)) { PROBE_MARK(60);
#ifndef NO_ATT
                  if (rep == 0 || DUP_SUB == 0 || DUP_SUB == 1) { const Params P = load_params(kp); unsigned char* ws = P.ws;
                  for (int u = vcu; u < NH * (SEQ / 256); u += G) { const int h = u >> 5, qb = u & 31;
                      att::attn_unit((const bf16_t*)(ws + WS_Q) + (size_t)(qb * 256) * att::LDQ + h * DQK, (const bf16_t*)(ws + WS_K) + h * DQK, (const bf16_t*)(ws + WS_KV) + h * 256 + 128,
                                     (bf16_t*)(ws + WS_MIX) + (size_t)(qb * 256) * DM + h * DV, SEQ, lds); } }
#endif
                  PROBE_MARK(61);
#ifndef NO_M3
                  if (rep == 0 || DUP_SUB == 0 || DUP_SUB == 2) { const Params P = load_params(kp); for (int u = vcu; u < HM * NCH; u += G) m3_unit(P, lds, u >> 6, u & 63); }
#endif
                  PROBE_MARK(62);
                  } break;
        case 7: if (PH_ON(7)) { const Params P = load_params(kp); unsigned char* ws = P.ws;
                  pg8::Gemm g{(const bf16_t*)(ws + WS_MIX), (const bf16_t*)(ws + WS_WOUT), SEQ, DM, DM}; pg8::StaticOrder S; S.init(SEQ, DM, G, bx);
                  pg8::Epi4<StoreX1> E{{P.x, (const float*)(ws + WS_MOD) + 2 * DM, P.out}};
                  pg8::gemm_phase<pg8::Epi4<StoreX1>, pg8::StaticOrder, true, true>(ldsl, g, S, E); } break;
        case 8: if (PH_ON(8)) { const Params P = load_params(kp); phase6b(P, lds, G); } break;
        case 9: if (PH_ON(9)) { const Params P = load_params(kp); unsigned char* ws = P.ws;
                  pg8::Gemm g{(const bf16_t*)(ws + WS_H), (const bf16_t*)(ws + WS_W1), SEQ, DFF, DM}; pg8::StaticOrder S; S.init(SEQ, DFF, G, bx);
                  pg8::Epi8<StoreAct> E{{(bf16_t*)(ws + WS_ACT)}};
                  pg8::gemm_phase<pg8::Epi8<StoreAct>, pg8::StaticOrder, true, true>(ldsl, g, S, E); } break;
        case 10: if (PH_ON(10)) { const Params P = load_params(kp); unsigned char* ws = P.ws;
                  pg8::Gemm g{(const bf16_t*)(ws + WS_ACT), (const bf16_t*)(ws + WS_W2), SEQ, DM, DFF}; pg8::StaticOrder S; S.init(SEQ, DM, G, bx);
                  pg8::Epi4<StoreX1> E{{P.out, (const float*)(ws + WS_MOD) + 5 * DM, P.out}};
                  pg8::gemm_phase<pg8::Epi4<StoreX1>, pg8::StaticOrder, true, true>(ldsl, g, S, E); } break;
        default: break;
        }
        if (ph + 1 < ph_hi || rep == 0 && ph == DUP_PH) { xcd_barrier(xbar); }
        if (PROBE_PH >= 0 && ph == PROBE_PH) { __syncthreads(); probe_dt = __builtin_amdgcn_s_memrealtime() - probe_t0; }
      }
    }
    if ((PROBE_PH >= 0 || PROBE_FROM >= 0) && blockIdx.x == 0) { const unsigned long long te = __builtin_amdgcn_s_memrealtime();
        while (__builtin_amdgcn_s_memrealtime() - te < probe_dt) __builtin_amdgcn_s_sleep(8); }
}

extern "C" void kernel_launch(void* const* d_in, const int* in_sizes, int n_in, void* d_out, int out_size, void* d_ws, size_t ws_size, hipStream_t stream) {
    static int grid = 0;
    if (grid == 0) {
        if (n_in != 21 || out_size != SEQ * DM || ws_size < WS_END) { fprintf(stderr, "kernel_launch: unexpected shapes n_in %d out %d ws %zu\n", n_in, out_size, ws_size); grid = -1; return; }
        int dev = 0, cus = 0, per_cu = 0;
        if (hipGetDevice(&dev) != hipSuccess || hipDeviceGetAttribute(&cus, hipDeviceAttributeMultiprocessorCount, dev) != hipSuccess) { grid = -1; return; }
        if (hipFuncSetAttribute((const void*)fwd_kernel, hipFuncAttributeMaxDynamicSharedMemorySize, LDS_BYTES) != hipSuccess) { fprintf(stderr, "kernel_launch: hipFuncSetAttribute failed\n"); grid = -1; return; }
        if (hipOccupancyMaxActiveBlocksPerMultiprocessor(&per_cu, (const void*)fwd_kernel, NTHREADS, LDS_BYTES) != hipSuccess || per_cu < 1) { fprintf(stderr, "kernel_launch: occupancy query says %d\n", per_cu); per_cu = 1; }
        (void)hipGetLastError();
        grid = cus * 1;
    }
    if (grid < 0) return;
    Params p{};
    p.x = (const float*)d_in[0]; p.c = (const float*)d_in[1]; p.pos = (const int*)d_in[2]; p.w_ada = (const float*)d_in[3]; p.b_ada = (const float*)d_in[4];
    p.norm_mix_g = (const float*)d_in[5]; p.w_in = (const float*)d_in[6]; p.b_gates = (const float*)d_in[7]; p.conv_w = (const float*)d_in[8]; p.conv_b = (const float*)d_in[9];
    p.q_lora_g = (const float*)d_in[10]; p.w_uq = (const float*)d_in[11]; p.kv_lora_g = (const float*)d_in[12]; p.w_ukv = (const float*)d_in[13]; p.q_norm_g = (const float*)d_in[14];
    p.k_norm_g = (const float*)d_in[15]; p.mlstm_norm_g = (const float*)d_in[16]; p.w_out = (const float*)d_in[17]; p.norm_mlp_g = (const float*)d_in[18];
    p.w_ff1 = (const float*)d_in[19]; p.w_ff2 = (const float*)d_in[20];
    p.out = (float*)d_out; p.ws = (unsigned char*)d_ws;
    (void)hipMemsetAsync((char*)d_ws + WS_BAR, 0, 32768, stream);
#if MK_MULTI
    for (int ph = 0; ph < NPH; ++ph) { p.ph_lo = ph; p.ph_hi = ph + 1; hipLaunchKernelGGL(fwd_kernel, dim3(grid), dim3(NTHREADS), LDS_BYTES, stream, p); }
#else
    p.ph_lo = 0; p.ph_hi = NPH;
    void* args[] = {&p};
    hipError_t e = hipLaunchCooperativeKernel((const void*)fwd_kernel, dim3(grid), dim3(NTHREADS), args, LDS_BYTES, stream);
    if (e != hipSuccess) fprintf(stderr, "kernel_launch: cooperative launch failed: %s (grid %d)\n", hipGetErrorString(e), grid);
#endif
}
```

```cpp
#include <hip/hip_runtime.h>
#include <hip/hip_cooperative_groups.h>
#include <cstdio>
#include <cstdint>
namespace cg = cooperative_groups;

#ifndef MK_MULTI
#define MK_MULTI 0
#endif

#define LAS __attribute__((address_space(3)))
typedef unsigned short bf16_t;
typedef short bf16x8 __attribute__((ext_vector_type(8)));
typedef short s16x4 __attribute__((ext_vector_type(4)));
typedef float f32x4 __attribute__((ext_vector_type(4)));
typedef float f32x2 __attribute__((ext_vector_type(2)));
typedef float f32x16 __attribute__((ext_vector_type(16)));
typedef unsigned u32x4 __attribute__((ext_vector_type(4)));
typedef unsigned u32x2 __attribute__((ext_vector_type(2)));

constexpr int SEQ = 8192, DM = 2048, DIN = 4944, DINP = 5120, DFF = 8192;
constexpr int NH = 8, DQK = 192, DV = 128, QLORA = 512, KVLORA = 256;
constexpr int HM = 4, DH = 256, LCH = 128, NCH = 64;
constexpr int OFF_CQ = 0, OFF_CKV = 512, OFF_KPE = 768, OFF_QM = 832, OFF_KM = 1856, OFF_VM = 2880, OFF_OM = 3904, OFF_GM = 4928;
constexpr float EPS = 1e-6f;
constexpr int NTHREADS = 512, NWAVES = 8;
constexpr int LDS_BYTES = 147456;
constexpr int LDS_BARST = LDS_BYTES - 64;

constexpr size_t MiB = 1u << 20;
constexpr size_t WS_MODP = 384 * MiB - 2 * MiB;
constexpr size_t WS_MOD = 786432;
constexpr size_t WS_BC = 1 * MiB;
constexpr size_t WS_IG = WS_BC + 262144;
constexpr size_t WS_PM = WS_IG + 262144;
constexpr size_t WS_WL = WS_PM + 262144;
constexpr size_t WS_BAR = 868352;
constexpr size_t WS_CNT = WS_BAR + 16384;
constexpr size_t WS_MB = 860160;
constexpr size_t WS_BL = 851968;
constexpr size_t WS_AC = 856064;
constexpr size_t WS_WIN = 2 * MiB, WS_WUQ = 22 * MiB, WS_WUKV = 24 * MiB, WS_WOUT = 26 * MiB;
constexpr size_t WS_W1 = 34 * MiB, WS_W2 = 66 * MiB;
constexpr size_t WS_H = 98 * MiB;
constexpr size_t WS_Q = 98 * MiB;
constexpr size_t WS_MIX = 130 * MiB;
constexpr size_t WS_PA = 162 * MiB;
constexpr size_t WS_PB = 194 * MiB;
constexpr int PAW = 2048, PBW = 3072, PA_OM = 832;
constexpr size_t WS_CQN = 242 * MiB, WS_CKVN = 250 * MiB;
constexpr size_t WS_GATES = 254 * MiB;
constexpr size_t WS_NST = 255 * MiB;
constexpr size_t WS_ACT = 130 * MiB;
constexpr size_t WS_KV = 258 * MiB;
constexpr size_t WS_K = 290 * MiB;
constexpr size_t WS_QH = 314 * MiB, WS_KH = 330 * MiB, WS_KT = 346 * MiB, WS_VT = 362 * MiB;
constexpr size_t WS_ROPE = 378 * MiB;
constexpr size_t WS_END = 384 * MiB;

struct Params {
    const float* x; const float* c; const int* pos; const float* w_ada; const float* b_ada; const float* norm_mix_g; const float* w_in;
    const float* b_gates; const float* conv_w; const float* conv_b; const float* q_lora_g; const float* w_uq; const float* kv_lora_g;
    const float* w_ukv; const float* q_norm_g; const float* k_norm_g; const float* mlstm_norm_g; const float* w_out; const float* norm_mlp_g;
    const float* w_ff1; const float* w_ff2;
    float* out; unsigned char* ws; int ph_lo, ph_hi;
};

__host__ __device__ __forceinline__ size_t cst_off(int dh) { return dh < 6 ? WS_PB + (size_t)dh * (8 * MiB) : WS_WIN + (size_t)(dh - 6) * (8 * MiB); }
#define LAUNDER_V(x) asm volatile("" : "+v"(x))
#define LAUNDER_S(x) asm volatile("" : "+s"(x))
constexpr int LDS_WIDTAB = 147456 - 64 - 256;
__device__ __forceinline__ int tid_opaque() {
    const unsigned hw = __builtin_amdgcn_s_getreg((5 << 11) | 4) & 63u;
    const int wid = *(volatile LAS int*)(uintptr_t)(LDS_WIDTAB + hw * 4);
    int t = wid * 64 + (int)__builtin_amdgcn_mbcnt_hi(~0u, __builtin_amdgcn_mbcnt_lo(~0u, 0u)); LAUNDER_V(t); return t; }
__device__ __forceinline__ unsigned cvt_pk_bf16(float lo, float hi) { unsigned r; asm volatile("v_cvt_pk_bf16_f32 %0, %1, %2" : "=v"(r) : "v"(lo), "v"(hi)); return r; }
__device__ __forceinline__ float bf_lo(unsigned w) { return __uint_as_float(w << 16); }
__device__ __forceinline__ float bf_hi(unsigned w) { return __uint_as_float(w & 0xffff0000u); }
__device__ __forceinline__ float bf2f(bf16_t b) { return __uint_as_float(((unsigned)b) << 16); }
__device__ __forceinline__ bf16_t f2bf(float f) { return (bf16_t)(cvt_pk_bf16(f, 0.f) & 0xffffu); }
__device__ __forceinline__ int lane_opaque() { int l = (int)__builtin_amdgcn_mbcnt_hi(~0u, __builtin_amdgcn_mbcnt_lo(~0u, 0u)); LAUNDER_V(l); return l; }
__device__ __forceinline__ float shx(float v, int m) { return __int_as_float(__builtin_amdgcn_ds_bpermute((lane_opaque() ^ m) << 2, __float_as_int(v))); }
__device__ __forceinline__ float shidx(float v, int i) { return __int_as_float(__builtin_amdgcn_ds_bpermute(i << 2, __float_as_int(v))); }
__device__ __forceinline__ float shup(float v, int o) { return __int_as_float(__builtin_amdgcn_ds_bpermute((lane_opaque() - o) << 2, __float_as_int(v))); }
__device__ __forceinline__ float wave_sum(float v) {
#pragma unroll
    for (int o = 1; o < 64; o <<= 1) v += shx(v, o);
    return v;
}
template <class T> __device__ __forceinline__ T ldgu(const void* ubase, unsigned voff) { return *(const T*)((const char*)ubase + voff); }
__device__ __forceinline__ float silu_f(float v) { return v / (1.f + __expf(-v)); }
__device__ __forceinline__ float sigmoid_f(float v) { return 1.f / (1.f + __expf(-v)); }
__device__ __forceinline__ void unpack8(u32x4 w, float* f) {
    f[0] = bf_lo(w.x); f[1] = bf_hi(w.x); f[2] = bf_lo(w.y); f[3] = bf_hi(w.y); f[4] = bf_lo(w.z); f[5] = bf_hi(w.z); f[6] = bf_lo(w.w); f[7] = bf_hi(w.w);
}
__device__ __forceinline__ u32x4 pack8(const float* f) {
    u32x4 w; w.x = cvt_pk_bf16(f[0], f[1]); w.y = cvt_pk_bf16(f[2], f[3]); w.z = cvt_pk_bf16(f[4], f[5]); w.w = cvt_pk_bf16(f[6], f[7]); return w;
}

namespace pg8 {
constexpr int BM = 256, BK = 64, HALF = 128, HTB = HALF * BK * 2, STAGE_BYTES = 8 * HTB, NXCD = 8, WGM = 8;
__host__ __device__ __forceinline__ int lds_byte(int r, int c) { const int st = (r >> 4) * 2 + (c >> 5), rr = r & 15, cc = c & 31, ob = rr * 64 + cc * 2; return st * 1024 + (ob ^ (((ob >> 9) & 1) << 5)); }
__host__ __device__ __forceinline__ void stage_rc(int b, int& R, int& C) { const int st = b / 1024, sb = b % 1024, swz = sb ^ (((sb >> 9) & 1) << 5); R = (st >> 1) * 16 + swz / 64; C = (st & 1) * 32 + (swz % 64) / 2; }
__host__ __device__ __forceinline__ int perm32(int rho) { const int n = rho >> 4, i = rho & 15; return 8 * (i >> 2) + 4 * n + (i & 3); }
struct Unit { int pm, pn; };
struct Gemm { const bf16_t* A; const bf16_t* Bt; int M, N, K; };
struct StaticOrder {
    int nM, nN, nwg, G, c;
    __host__ __device__ void init(int M, int N, int G_, int c_) { nM = M / BM; nN = N / BM; nwg = nM * nN; G = G_; c = c_; }
    __host__ __device__ bool next(int i, Unit& u) const {
        const long L = (long)i * G + c; if (L >= nwg) return false;
        int wgid = (int)L; { const int q = nwg / NXCD, r = nwg % NXCD, xcd = wgid % NXCD, off = wgid / NXCD; wgid = (xcd < r ? xcd * (q + 1) : r * (q + 1) + (xcd - r) * q) + off; }
        const int nig = WGM * nN, gid = wgid / nig, fm = gid * WGM, gsz = (nM - fm) < WGM ? (nM - fm) : WGM;
        u.pm = fm + ((wgid % nig) % gsz); u.pn = (wgid % nig) / gsz; return true;
    }
    __device__ __forceinline__ void a_ready(const Unit&) const {}
    __device__ __forceinline__ void done(const Unit&) const {}
};
template <class F> struct Epi8 {
    static constexpr bool PERM = true, AFTER_DRAIN = false; F f;
    __device__ __forceinline__ void operator()(const f32x4 (&acc)[2][2][4][2], const Unit& u, int wr, int wc, int fr, int fq) const {
        const int row0 = u.pm * BM + wr * 64 + fr, col0 = u.pn * BM + wc * 32 + 8 * fq;
#pragma unroll
        for (int ai = 0; ai < 2; ++ai)
#pragma unroll
            for (int m = 0; m < 4; ++m)
#pragma unroll
                for (int bj = 0; bj < 2; ++bj) f(row0 + ai * HALF + m * 16, col0 + bj * HALF, acc[ai][bj][m][0], acc[ai][bj][m][1]);
    }
};
template <class F> struct Epi4 {
    static constexpr bool PERM = false, AFTER_DRAIN = false; F f;
    __device__ __forceinline__ void operator()(const f32x4 (&acc)[2][2][4][2], const Unit& u, int wr, int wc, int fr, int fq) const {
        const int row0 = u.pm * BM + wr * 64 + fr, col0 = u.pn * BM + wc * 32 + 4 * fq;
#pragma unroll
        for (int ai = 0; ai < 2; ++ai)
#pragma unroll
            for (int m = 0; m < 4; ++m) {
#pragma unroll
                for (int bj = 0; bj < 2; ++bj)
#pragma unroll
                    for (int n = 0; n < 2; ++n) f(row0 + ai * HALF + m * 16, col0 + bj * HALF + n * 16, acc[ai][bj][m][n]);
                if (m & 1) asm volatile("" ::: "memory");
            }
    }
};

template <class Epi, class Sched, bool ALIGN_EPI = false, bool SP2 = false>
__device__ __forceinline__ void gemm_phase(LAS unsigned char* lds, const Gemm g, const Sched& S, const Epi& E) {
    const int tid = tid_opaque(), wid = __builtin_amdgcn_readfirstlane(tid >> 6), lane = tid & 63, wr = wid >> 2, wc = wid & 3, fr = lane & 15, fq = lane >> 4;
    const int K = g.K, nt = K / BK;
    unsigned voffA[2], voffB[2];
#pragma unroll
    for (int i = 0; i < 2; ++i) { int R, C; stage_rc(tid * 16 + i * 8192, R, C); const int Rb = Epi::PERM ? ((R & ~31) + perm32(R & 31)) : R;
        voffA[i] = (unsigned)(R * K + C) * 2u; voffB[i] = (unsigned)(Rb * K + C) * 2u; }
    const size_t kstep = (size_t)(BK * 2);
    const size_t hstep = (size_t)HALF * K * 2;
    const size_t tstep = 2 * hstep;
    const unsigned ldsw = (unsigned)wid * 1024u;
    const int aoff = lds_byte(wr * 64 + fr, fq * 8), boff = lds_byte(wc * 32 + fr, fq * 8);
#define PG8_SA(b, h) (((b) * 2 + (h)) * HTB)
#define PG8_SB(b, h) ((4 + (b) * 2 + (h)) * HTB)
#define PG8_STAGE(bufoff, gbase, voff) do { _Pragma("unroll") for (int _i = 0; _i < 2; ++_i) \
        __builtin_amdgcn_global_load_lds((const unsigned*)((const char*)(gbase) + (voff)[_i]), (LAS unsigned*)(lds + (bufoff) + ldsw + _i * 8192), 16, 0, 0); } while (0)
#define PG8_LDA(dst, b, h) do { _Pragma("unroll") for (int m = 0; m < 4; ++m) _Pragma("unroll") for (int k = 0; k < 2; ++k) dst[m][k] = *(const LAS bf16x8*)(lds + PG8_SA(b, h) + aoff + m * 2048 + k * 1024); } while (0)
#define PG8_LDB(dst, b, h) do { _Pragma("unroll") for (int n = 0; n < 2; ++n) _Pragma("unroll") for (int k = 0; k < 2; ++k) dst[n][k] = *(const LAS bf16x8*)(lds + PG8_SB(b, h) + boff + n * 2048 + k * 1024); } while (0)
#define PG8_MMA(ai, bj, At, Bt) do { __builtin_amdgcn_s_setprio(1); _Pragma("unroll") for (int m = 0; m < 4; ++m) _Pragma("unroll") for (int n = 0; n < 2; ++n) _Pragma("unroll") for (int k = 0; k < 2; ++k) \
        acc[ai][bj][m][n] = __builtin_amdgcn_mfma_f32_16x16x32_bf16(Bt[n][k], At[m][k], acc[ai][bj][m][n], 0, 0, 0); __builtin_amdgcn_s_setprio(0); } while (0)
#define PG8_WAIT_V(n) asm volatile("s_waitcnt vmcnt(" #n ")" ::: "memory")
#define PG8_WAIT_L(n) asm volatile("s_waitcnt lgkmcnt(" #n ")" ::: "memory")
#define PG8_BAR __builtin_amdgcn_s_barrier()
#define PG8_SCHED __builtin_amdgcn_sched_barrier(0)
    Unit cur, nxt; int ui = 0;
    if (!S.next(0, cur)) return;
    f32x4 acc[2][2][4][2];
#pragma unroll
    for (int a = 0; a < 2; ++a)
#pragma unroll
        for (int b = 0; b < 2; ++b)
#pragma unroll
            for (int m = 0; m < 4; ++m)
#pragma unroll
                for (int n = 0; n < 2; ++n) acc[a][b][m][n] = (f32x4){0.f, 0.f, 0.f, 0.f};
    bf16x8 At[4][2], B0[2][2], B1[2][2];
    const char* cA = (const char*)g.A + (size_t)cur.pm * tstep; const char* cB = (const char*)g.Bt + (size_t)cur.pn * tstep;
    S.a_ready(cur);
    if constexpr (SP2) {
        PG8_STAGE(PG8_SB(0, 0), cB, voffB); PG8_STAGE(PG8_SB(0, 1), cB + hstep, voffB); PG8_STAGE(PG8_SA(0, 0), cA, voffA); PG8_STAGE(PG8_SA(0, 1), cA + hstep, voffA);
        if (wr == 1) PG8_BAR;
        PG8_WAIT_V(2); PG8_BAR;
        PG8_STAGE(PG8_SB(1, 0), cB + kstep, voffB); PG8_STAGE(PG8_SA(1, 0), cA + kstep, voffA); PG8_STAGE(PG8_SB(1, 1), cB + hstep + kstep, voffB);
        PG8_WAIT_V(6); PG8_BAR;
    } else {
        PG8_STAGE(PG8_SB(0, 0), cB, voffB); PG8_STAGE(PG8_SA(0, 0), cA, voffA); PG8_STAGE(PG8_SB(0, 1), cB + hstep, voffB); PG8_STAGE(PG8_SA(0, 1), cA + hstep, voffA);
        if (wr == 1) PG8_BAR;
        PG8_WAIT_V(4); PG8_BAR;
        PG8_STAGE(PG8_SB(1, 0), cB + kstep, voffB); PG8_STAGE(PG8_SA(1, 0), cA + kstep, voffA); PG8_STAGE(PG8_SB(1, 1), cB + hstep + kstep, voffB);
        PG8_WAIT_V(6); PG8_BAR;
    }
    for (;;) {
        const bool has_next = S.next(ui + 1, nxt);
        const char* nA = has_next ? (const char*)g.A + (size_t)nxt.pm * tstep : cA; const char* nB = has_next ? (const char*)g.Bt + (size_t)nxt.pn * tstep : cB;
#pragma unroll 1
        for (int t = 0; t < nt; t += 2) {
            const bool last = (t == nt - 2);
            const char* a1 = cA + (size_t)(t + 1) * kstep;
            const char* a2 = last ? nA : cA + (size_t)(t + 2) * kstep; const char* b2 = last ? nB : cB + (size_t)(t + 2) * kstep;
            const char* a3 = a2 + kstep; const char* b3 = b2 + kstep;
            if (last && has_next) S.a_ready(nxt);
            if constexpr (SP2) {
            PG8_LDB(B0, 0, 0); PG8_LDB(B1, 0, 1); PG8_SCHED; PG8_LDA(At, 0, 0); PG8_STAGE(PG8_SA(1, 1), a1 + hstep, voffA);
            PG8_WAIT_V(8); PG8_WAIT_L(0); PG8_BAR; PG8_MMA(0, 0, At, B0); PG8_MMA(0, 1, At, B1); PG8_BAR; PG8_SCHED;
            PG8_LDA(At, 0, 1); PG8_STAGE(PG8_SB(0, 0), b2, voffB); PG8_STAGE(PG8_SB(0, 1), b2 + hstep, voffB); PG8_STAGE(PG8_SA(0, 0), a2, voffA);
            PG8_WAIT_V(8); PG8_WAIT_L(0); PG8_BAR; PG8_MMA(1, 0, At, B0); PG8_MMA(1, 1, At, B1); PG8_BAR; PG8_SCHED;
            PG8_LDB(B0, 1, 0); PG8_LDB(B1, 1, 1); PG8_SCHED; PG8_LDA(At, 1, 0); PG8_STAGE(PG8_SA(0, 1), a2 + hstep, voffA);
            PG8_WAIT_V(8); PG8_WAIT_L(0); PG8_BAR; PG8_MMA(0, 0, At, B0); PG8_MMA(0, 1, At, B1); PG8_BAR; PG8_SCHED;
            PG8_LDA(At, 1, 1); PG8_STAGE(PG8_SB(1, 0), b3, voffB); PG8_STAGE(PG8_SB(1, 1), b3 + hstep, voffB); PG8_STAGE(PG8_SA(1, 0), a3, voffA);
            PG8_WAIT_V(8); PG8_WAIT_L(0); PG8_BAR; PG8_MMA(1, 0, At, B0); PG8_MMA(1, 1, At, B1); PG8_BAR; PG8_SCHED;
            } else {
            PG8_LDB(B0, 0, 0); PG8_SCHED; PG8_LDA(At, 0, 0); PG8_STAGE(PG8_SA(1, 1), a1 + hstep, voffA);
            PG8_WAIT_L(8); PG8_BAR; PG8_WAIT_L(0); PG8_MMA(0, 0, At, B0); PG8_BAR; PG8_SCHED;
            PG8_LDB(B1, 0, 1); PG8_STAGE(PG8_SB(0, 0), b2, voffB);
            PG8_BAR; PG8_WAIT_L(0); PG8_MMA(0, 1, At, B1); PG8_BAR;
            PG8_LDA(At, 0, 1); PG8_STAGE(PG8_SA(0, 0), a2, voffA);
            PG8_BAR; PG8_WAIT_L(0); PG8_MMA(1, 0, At, B0); PG8_BAR; PG8_SCHED;
            PG8_STAGE(PG8_SB(0, 1), b2 + hstep, voffB);
            PG8_WAIT_V(6); PG8_BAR; PG8_MMA(1, 1, At, B1); PG8_BAR;
            PG8_LDB(B0, 1, 0); PG8_SCHED; PG8_LDA(At, 1, 0); PG8_STAGE(PG8_SA(0, 1), a2 + hstep, voffA);
            PG8_WAIT_L(8); PG8_BAR; PG8_WAIT_L(0); PG8_MMA(0, 0, At, B0); PG8_BAR; PG8_SCHED;
            PG8_LDB(B1, 1, 1); PG8_STAGE(PG8_SB(1, 0), b3, voffB);
            PG8_BAR; PG8_WAIT_L(0); PG8_MMA(0, 1, At, B1); PG8_BAR;
            PG8_LDA(At, 1, 1); PG8_STAGE(PG8_SA(1, 0), a3, voffA);
            PG8_BAR; PG8_WAIT_L(0); PG8_MMA(1, 0, At, B0); PG8_BAR; PG8_SCHED;
            PG8_STAGE(PG8_SB(1, 1), b3 + hstep, voffB);
            PG8_WAIT_V(6); PG8_BAR; PG8_MMA(1, 1, At, B1); PG8_BAR;
            }
        }
        if constexpr (ALIGN_EPI) { if (wr == 0) PG8_BAR; }
        if constexpr (!Epi::AFTER_DRAIN) { E(acc, cur, wr, wc, fr, fq); S.done(cur); }
        if (!has_next) break;
#pragma unroll
        for (int a = 0; a < 2; ++a)
#pragma unroll
            for (int b = 0; b < 2; ++b)
#pragma unroll
                for (int m = 0; m < 4; ++m)
#pragma unroll
                    for (int n = 0; n < 2; ++n) acc[a][b][m][n] = (f32x4){0.f, 0.f, 0.f, 0.f};
        cur = nxt; cA = nA; cB = nB; ++ui;
        if constexpr (ALIGN_EPI) { if (wr == 1) PG8_BAR; }
    }
    PG8_WAIT_V(0);
    if constexpr (!ALIGN_EPI) { if (wr == 0) PG8_BAR; }
    PG8_BAR;
#undef PG8_SA
#undef PG8_SB
#undef PG8_STAGE
#undef PG8_LDA
#undef PG8_LDB
#undef PG8_MMA
#undef PG8_WAIT_V
#undef PG8_WAIT_L
#undef PG8_BAR
#undef PG8_SCHED
}
}

namespace att {
constexpr int NW = 8, QBLK = 32, KVBLK = 64;
constexpr int LDQ = NH * DQK, LDK = NH * DQK, LDV = NH * 256, LDO = DM;
constexpr float SCALE = 0.07216878364870322f;
constexpr float THR = 8.f;
constexpr int SHM_K = KVBLK * DQK * 2, SHM_V = KVBLK * DV * 2;
constexpr int SHM_QL = 2 * SHM_V + 2 * SHM_K + NW * 64 * 4;
constexpr int SHM_ATTN = SHM_QL + NW * 4096;
#define KSWZ(row, colB) ((row) * 384 + ((colB) ^ ((((row) >> 1) & 7) << 4)))
#define SBAR() __builtin_amdgcn_sched_barrier(0)
__device__ __forceinline__ int crow(int r, int hi) { return (r & 3) + 8 * (r >> 2) + 4 * hi; }
__device__ __forceinline__ void partialSM(f32x16& p0, f32x16& p1, float& m_reg, float& mn, float& alpha) {
    constexpr float C = SCALE * 1.4426950408889634f;
    float pmax = p0[0];
#pragma unroll
    for (int r = 1; r < 16; ++r) pmax = fmaxf(pmax, p0[r]);
#pragma unroll
    for (int r = 0; r < 16; ++r) pmax = fmaxf(pmax, p1[r]);
    { auto rr = __builtin_amdgcn_permlane32_swap(__float_as_uint(pmax), __float_as_uint(pmax), false, false);
      pmax = fmaxf(__uint_as_float(rr[0]), __uint_as_float(rr[1])); }
    if (__builtin_expect(__all(pmax - m_reg <= THR / SCALE), 1)) { mn = m_reg; alpha = 1.f; }
    else { mn = fmaxf(m_reg, pmax); alpha = __builtin_amdgcn_exp2f((m_reg - mn) * C); m_reg = mn; }
    float mnC = -mn * C;
#pragma unroll
    for (int r = 0; r < 16; ++r) p0[r] = fmaf(p0[r], C, mnC);
#pragma unroll
    for (int r = 0; r < 16; ++r) p1[r] = fmaf(p1[r], C, mnC);
#pragma unroll
    for (int r = 0; r < 16; ++r) p0[r] = __builtin_amdgcn_exp2f(p0[r]);
}
__device__ __forceinline__ void finishSM(f32x16& p0, f32x16& p1, float alpha, float& l_reg, bf16x8& pa0, bf16x8& pa1, bf16x8& pa2, bf16x8& pa3) {
#pragma unroll
    for (int r = 0; r < 16; ++r) p1[r] = __builtin_amdgcn_exp2f(p1[r]);
    float ps = 0;
#pragma unroll
    for (int r = 0; r < 16; ++r) ps += p0[r];
#pragma unroll
    for (int r = 0; r < 16; ++r) ps += p1[r];
    { auto rr = __builtin_amdgcn_permlane32_swap(__float_as_uint(ps), __float_as_uint(ps), false, false);
      ps = __uint_as_float(rr[0]) + __uint_as_float(rr[1]); }
    l_reg = l_reg * alpha + ps;
#define PK4(P, BASE, OUT) do { unsigned a0 = cvt_pk_bf16(P[BASE + 0], P[BASE + 1]), a1 = cvt_pk_bf16(P[BASE + 2], P[BASE + 3]);   \
    unsigned b0 = cvt_pk_bf16(P[BASE + 4], P[BASE + 5]), b1 = cvt_pk_bf16(P[BASE + 6], P[BASE + 7]);                              \
    auto r0 = __builtin_amdgcn_permlane32_swap(a0, b0, false, false); auto r1 = __builtin_amdgcn_permlane32_swap(a1, b1, false, false); \
    u32x4 w = {r0[0], r1[0], r0[1], r1[1]}; OUT = *reinterpret_cast<bf16x8*>(&w); } while (0)
    PK4(p0, 0, pa0); PK4(p0, 8, pa1); PK4(p1, 0, pa2); PK4(p1, 8, pa3);
#undef PK4
}
__device__ __forceinline__ void qkt(f32x16& p0, f32x16& p1, const char* Ks, const bf16x8* qr, const char* ql, int r32, int hi) {
    p0 = f32x16{}; p1 = f32x16{};
#pragma unroll
    for (int d0 = 0; d0 < 12; ++d0) { const int cb = (d0 * 16 + hi * 8) * 2;
        bf16x8 b0 = *reinterpret_cast<const bf16x8*>(Ks + KSWZ(r32, cb));
        bf16x8 b1 = *reinterpret_cast<const bf16x8*>(Ks + KSWZ(32 + r32, cb));
        const bf16x8 q = d0 < 8 ? qr[d0 < 8 ? d0 : 0] : *reinterpret_cast<const bf16x8*>(ql + (d0 - 8) * 1024);
        p0 = __builtin_amdgcn_mfma_f32_32x32x16_bf16(b0, q, p0, 0, 0, 0);
        p1 = __builtin_amdgcn_mfma_f32_32x32x16_bf16(b1, q, p1, 0, 0, 0); }
}
__device__ __forceinline__ int v_st(int k, int c) { const int kk = (k & ~0xC) | ((k & 4) << 1) | ((k & 8) >> 1); return ((kk >> 3) * 4 + (c >> 5)) * 512 + ((kk & 7) * 32 + (c & 31)) * 2; }
__device__ __forceinline__ int v_rd_base(int lane) { return ((lane & 3) << 3) | (((lane >> 2) & 3) << 6) | (((lane >> 4) & 1) << 5) | (((lane >> 5) & 1) << 8); }
constexpr int v_rd_off(int d0, int ks, int half) { return d0 * 512 + ks * 4096 + half * 2048; }
template <int OFF> __device__ __forceinline__ s16x4 tr_read(int vb) {
    s16x4 r; asm volatile("ds_read_b64_tr_b16 %0, %1 offset:%2" : "=&v"(r) : "v"(vb), "i"(OFF) : "memory"); return r;
}
template <int D0> __device__ __forceinline__ void pv_one(f32x16& od, int vb, bf16x8 pa0, bf16x8 pa1, bf16x8 pa2, bf16x8 pa3) {
#define PK(L, H) (bf16x8){L[0], L[1], L[2], L[3], H[0], H[1], H[2], H[3]}
    { const s16x4 l0 = tr_read<v_rd_off(D0, 0, 0)>(vb), h0 = tr_read<v_rd_off(D0, 0, 1)>(vb), l1 = tr_read<v_rd_off(D0, 1, 0)>(vb), h1 = tr_read<v_rd_off(D0, 1, 1)>(vb);
      asm volatile("s_waitcnt lgkmcnt(0)" ::: "memory"); SBAR();
      od = __builtin_amdgcn_mfma_f32_32x32x16_bf16(pa0, PK(l0, h0), od, 0, 0, 0);
      od = __builtin_amdgcn_mfma_f32_32x32x16_bf16(pa1, PK(l1, h1), od, 0, 0, 0); }
    { const s16x4 l2 = tr_read<v_rd_off(D0, 2, 0)>(vb), h2 = tr_read<v_rd_off(D0, 2, 1)>(vb), l3 = tr_read<v_rd_off(D0, 3, 0)>(vb), h3 = tr_read<v_rd_off(D0, 3, 1)>(vb);
      asm volatile("s_waitcnt lgkmcnt(0)" ::: "memory"); SBAR();
      od = __builtin_amdgcn_mfma_f32_32x32x16_bf16(pa2, PK(l2, h2), od, 0, 0, 0);
      od = __builtin_amdgcn_mfma_f32_32x32x16_bf16(pa3, PK(l3, h3), od, 0, 0, 0); }
#undef PK
}
__device__ __forceinline__ void pv_d0(f32x16* o, int vb, bf16x8 pa0, bf16x8 pa1, bf16x8 pa2, bf16x8 pa3) {
    pv_one<0>(o[0], vb, pa0, pa1, pa2, pa3); pv_one<1>(o[1], vb, pa0, pa1, pa2, pa3); pv_one<2>(o[2], vb, pa0, pa1, pa2, pa3); pv_one<3>(o[3], vb, pa0, pa1, pa2, pa3);
}
#ifndef ATT_SDEPTH
#define ATT_SDEPTH 1
#endif
constexpr int SDEPTH = ATT_SDEPTH;
__device__ __forceinline__ void attn_unit(const bf16_t* __restrict__ Qb, const bf16_t* __restrict__ Kh, const bf16_t* __restrict__ Vh, bf16_t* __restrict__ Ob, int seq, char* lds) {
    const int tid = tid_opaque(), wid = tid >> 6, lane = tid & 63, r32 = lane & 31, hi = lane >> 5;
    char* V_lds = lds; char* K_lds = lds + 2 * SHM_V;
    float* ws = (float*)(lds + 2 * SHM_V + 2 * SHM_K) + wid * 64; float* li_l = ws; float* al_l = ws + 32;
    float m_reg = -1e30f, l_reg = 0; f32x16 o[4] = {}; bf16x8 qr[8];
    const bf16_t* Qw = Qb + (long)(wid * QBLK + r32) * LDQ + hi * 8;
    char* ql = lds + SHM_QL + wid * 4096 + lane * 16;
#pragma unroll
    for (int d0 = 0; d0 < 8; ++d0) qr[d0] = *reinterpret_cast<const bf16x8*>(Qw + d0 * 16);
#pragma unroll
    for (int d0 = 8; d0 < 12; ++d0) *reinterpret_cast<bf16x8*>(ql + (d0 - 8) * 1024) = *reinterpret_cast<const bf16x8*>(Qw + d0 * 16);
    const int krow = tid >> 3, kc8 = tid & 7;
    const unsigned kgo = (unsigned)(krow * LDK + kc8 * 8) * 2u;
    const int kso = krow * 384 + ((kc8 * 16) ^ (((krow >> 1) & 7) << 4));
    const int sr = tid >> 4, sc = (tid & 15) * 8, vst0 = v_st(sr, sc);
    const unsigned vgo = (unsigned)(sr * LDV + sc) * 2u;
    const int vb0 = (int)(uintptr_t)V_lds + v_rd_base(lane);
    struct { bf16x8 k0, k1, k2, v0, v1; } sr_[SDEPTH];
#define SLOAD(i, kk0) do { const char* kp_ = (const char*)(Kh + (long)(kk0) * LDK); const char* vp_ = (const char*)(Vh + (long)(kk0) * LDV); \
    sr_[i].v0 = ldgu<bf16x8>(vp_, vgo); sr_[i].v1 = ldgu<bf16x8>(vp_ + 32 * LDV * 2, vgo); \
    sr_[i].k0 = ldgu<bf16x8>(kp_, kgo); sr_[i].k1 = ldgu<bf16x8>(kp_ + 128, kgo); sr_[i].k2 = ldgu<bf16x8>(kp_ + 256, kgo); } while (0)
#define SWRITE(b, i) do { *(bf16x8*)(V_lds + (b) * SHM_V + vst0) = sr_[i].v0; *(bf16x8*)(V_lds + (b) * SHM_V + 8192 + vst0) = sr_[i].v1; \
    *(bf16x8*)(K_lds + (b) * SHM_K + kso) = sr_[i].k0; *(bf16x8*)(K_lds + (b) * SHM_K + 128 + kso) = sr_[i].k1; *(bf16x8*)(K_lds + (b) * SHM_K + 256 + kso) = sr_[i].k2; } while (0)
#define SWAIT() do { if constexpr (SDEPTH == 2) asm volatile("s_waitcnt vmcnt(5)" ::: "memory"); else asm volatile("s_waitcnt vmcnt(0)" ::: "memory"); } while (0)
#define RESC(a) do { if (__any((a) < 1.f)) { if (hi == 0) al_l[r32] = (a); asm volatile("s_waitcnt lgkmcnt(0)" ::: "memory"); \
    _Pragma("unroll") for (int d = 0; d < 4; ++d) _Pragma("unroll") for (int r = 0; r < 16; ++r) o[d][r] *= al_l[crow(r, hi)]; } } while (0)
    f32x16 pA0, pA1, pB0, pB1; float mnA, mnB, alA, alB; bf16x8 pa0, pa1, pa2, pa3; const int NT = seq / KVBLK;
    constexpr int SE = 0, SO = SDEPTH - 1;
    SLOAD(SE, 0); asm volatile("s_waitcnt vmcnt(0)" ::: "memory"); SWRITE(0, SE); __syncthreads();
    qkt(pA0, pA1, K_lds, qr, ql, r32, hi); partialSM(pA0, pA1, m_reg, mnA, alA);
    SLOAD(SO, KVBLK); if constexpr (SDEPTH == 2) { if (2 < NT) SLOAD(SE, 2 * KVBLK); }
    SWAIT(); SWRITE(1, SO); __syncthreads();
    for (int j = 1; j + 1 < NT; j += 2) {
        SBAR(); qkt(pB0, pB1, K_lds + SHM_K, qr, ql, r32, hi);
        finishSM(pA0, pA1, alA, l_reg, pa0, pa1, pa2, pa3); SBAR();
        SLOAD(SO, (j + SDEPTH) * KVBLK); SBAR();
        pv_d0(o, vb0, pa0, pa1, pa2, pa3); partialSM(pB0, pB1, m_reg, mnB, alB);
        __syncthreads(); SWAIT(); SWRITE(0, SE);
        RESC(alB); __syncthreads();
        SBAR(); qkt(pA0, pA1, K_lds, qr, ql, r32, hi);
        finishSM(pB0, pB1, alB, l_reg, pa0, pa1, pa2, pa3); SBAR();
        if (SDEPTH == 1 || j + 3 < NT) SLOAD(SE, (j + 1 + SDEPTH) * KVBLK); SBAR();
        pv_d0(o, vb0 + SHM_V, pa0, pa1, pa2, pa3); partialSM(pA0, pA1, m_reg, mnA, alA);
        __syncthreads(); SWAIT(); SWRITE(1, SO);
        RESC(alA); __syncthreads();
    }
    SBAR(); qkt(pB0, pB1, K_lds + SHM_K, qr, ql, r32, hi);
    finishSM(pA0, pA1, alA, l_reg, pa0, pa1, pa2, pa3); SBAR();
    pv_d0(o, vb0, pa0, pa1, pa2, pa3); partialSM(pB0, pB1, m_reg, mnB, alB);
    __syncthreads(); RESC(alB);
    finishSM(pB0, pB1, alB, l_reg, pa0, pa1, pa2, pa3); SBAR();
    pv_d0(o, vb0 + SHM_V, pa0, pa1, pa2, pa3);
    if (hi == 0) li_l[r32] = l_reg; asm volatile("s_waitcnt lgkmcnt(0)" ::: "memory");
    float rli[16];
#pragma unroll
    for (int r = 0; r < 16; ++r) rli[r] = __builtin_amdgcn_rcpf(li_l[crow(r, hi)]);
    bf16_t* Ow = Ob + (long)(wid * QBLK) * LDO;
#pragma unroll
    for (int r = 0; r < 16; ++r) { const int orow = crow(r, hi);
#pragma unroll
        for (int d0 = 0; d0 < 4; ++d0) Ow[(long)orow * LDO + d0 * 32 + r32] = f2bf(o[d0][r] * rli[r]); }
    __syncthreads();
#undef SLOAD
#undef SWRITE
#undef SWAIT
#undef RESC
}
#undef SBAR
}

struct TrTile { f32x4 v[16]; };
__device__ __forceinline__ void tr_load(TrTile& t, const float* __restrict__ W, int N, int kb, int nb, int lane) {
    const int k0 = 64 * kb, n0 = 64 * nb; const int nq = 4 * (lane & 15), kr = lane >> 4; const bool ok = (n0 + nq) < N;
    const float* wp = W + (size_t)(k0 + kr) * N + n0 + nq;
#pragma unroll
    for (int i = 0; i < 16; ++i) { t.v[i] = (f32x4){0.f, 0.f, 0.f, 0.f}; if (ok) t.v[i] = __builtin_nontemporal_load((const f32x4*)(wp + (size_t)(4 * i) * N)); }
}
template <class RowMap>
__device__ __forceinline__ void tr_finish(const TrTile& t, int K, int N, bf16_t* __restrict__ WT, float* scr, int kb, int nb, int lane, RowMap rm) {
    const int k0 = 64 * kb, n0 = 64 * nb; const int nq = 4 * (lane & 15), kr = lane >> 4;
#pragma unroll
    for (int i = 0; i < 16; ++i) { float* d = scr + nq * 65 + 4 * i + kr; d[0] = t.v[i][0]; d[65] = t.v[i][1]; d[130] = t.v[i][2]; d[195] = t.v[i][3]; }
    asm volatile("s_waitcnt lgkmcnt(0)" ::: "memory");
    const int c = lane & 7;
#pragma unroll
    for (int j = 0; j < 8; ++j) { const int nl = (lane >> 3) + 8 * j; const int n = n0 + nl; const float* sp = scr + nl * 65 + 8 * c;
        u32x4 o; o.x = cvt_pk_bf16(sp[0], sp[1]); o.y = cvt_pk_bf16(sp[2], sp[3]); o.z = cvt_pk_bf16(sp[4], sp[5]); o.w = cvt_pk_bf16(sp[6], sp[7]);
        if (n < N) *(u32x4*)(WT + (size_t)rm(n) * K + k0 + 8 * c) = o; }
    asm volatile("s_waitcnt lgkmcnt(0)" ::: "memory");
}
template <class RowMap>
__device__ __forceinline__ void transpose_tile(const float* __restrict__ W, int K, int N, bf16_t* __restrict__ WT, float* scr, int kb, int nb, int lane, RowMap rm) {
    TrTile t; tr_load(t, W, N, kb, nb, lane); tr_finish(t, K, N, WT, scr, kb, nb, lane, rm);
}
struct RowId { __device__ __forceinline__ int operator()(int n) const { return n; } };
struct RowUq { __device__ __forceinline__ int operator()(int n) const { return (n / DQK) * 256 + (n % DQK); } };

__device__ __forceinline__ void phase0(const Params& P, char* lds, int G) {
    const int tid = tid_opaque(), lane = tid & 63, wave = tid >> 6;
    const int gw = blockIdx.x * NWAVES + wave, NGW = G * NWAVES;
    float* modp = (float*)(P.ws + WS_MODP);
    for (int task = gw; task < 1536; task += NGW) {
        const int ks = task / 48, cb = task % 48;
        const float s0 = silu_f(P.c[ks * 64 + lane]);
        f32x4 acc = {0.f, 0.f, 0.f, 0.f};
        const float* wp = P.w_ada + (size_t)(ks * 64) * (6 * DM) + cb * 256 + lane * 4;
#pragma unroll 16
        for (int kk = 0; kk < 64; ++kk) { const float sv = shidx(s0, kk); const f32x4 w = __builtin_nontemporal_load((const f32x4*)(wp + (size_t)kk * (6 * DM))); acc += w * sv; }
        { unsigned long long* pp = (unsigned long long*)(modp + (size_t)ks * (6 * DM) + cb * 256 + lane * 4);
          __hip_atomic_store(pp, ((unsigned long long)__float_as_uint(acc[1]) << 32) | __float_as_uint(acc[0]), __ATOMIC_RELAXED, __HIP_MEMORY_SCOPE_AGENT);
          __hip_atomic_store(pp + 1, ((unsigned long long)__float_as_uint(acc[3]) << 32) | __float_as_uint(acc[2]), __ATOMIC_RELAXED, __HIP_MEMORY_SCOPE_AGENT); }
        asm volatile("s_waitcnt vmcnt(0)" ::: "memory");
        unsigned old = 0u; if (lane == 0) old = __hip_atomic_fetch_add((unsigned*)(P.ws + WS_CNT) + cb * 16, 1u, __ATOMIC_RELAXED, __HIP_MEMORY_SCOPE_AGENT);
        old = __builtin_amdgcn_readfirstlane(old);
        if (old == 31u) {
            __builtin_amdgcn_fence(__ATOMIC_ACQUIRE, "agent");
            asm volatile("s_waitcnt vmcnt(0)" ::: "memory");
            f32x4 a = *(const f32x4*)(P.b_ada + cb * 256 + lane * 4);
#pragma unroll 8
            for (int k2 = 0; k2 < 32; ++k2) a += *(const f32x4*)(modp + (size_t)k2 * (6 * DM) + cb * 256 + lane * 4);
            *(f32x4*)((float*)(P.ws + WS_MOD) + cb * 256 + lane * 4) = a;
        }
    }
    { f32x2* rt = (f32x2*)(P.ws + WS_ROPE); const int i = lane & 31; const float freq = powf(10000.0f, -(float)i / 32.0f);
      for (int t = 2 * gw + (lane >> 5); t < SEQ; t += 2 * NGW) { float sn, cs; sincosf((float)P.pos[t] * freq, &sn, &cs); rt[(size_t)t * 32 + i] = (f32x2){cs, sn}; } }
    float* scr = (float*)(lds + wave * 17408);
    constexpr int I_IN = 32 * 78, I_UQ = 8 * 24, I_UKV = 4 * 32, I_OUT = 32 * 32, NIT = I_IN + I_UQ + I_UKV + I_OUT;
    auto src = [&](int it, const float*& W, int& N, int& kb, int& nb, int& kind) {
        int r = it;
        if (r < I_IN) { W = P.w_in; N = DIN; kb = r / 78; nb = r % 78; kind = 0; return; } r -= I_IN;
        if (r < I_UQ) { W = P.w_uq; N = NH * DQK; kb = r / 24; nb = r % 24; kind = 1; return; } r -= I_UQ;
        if (r < I_UKV) { W = P.w_ukv; N = NH * 256; kb = r / 32; nb = r % 32; kind = 2; return; } r -= I_UKV;
        W = P.w_out; N = DM; kb = r / 32; nb = r % 32; kind = 3; };
    int it = (gw + NGW - (1536 % NGW)) % NGW;
    if (it < NIT) {
        TrTile cur, nxt; const float* W; int N, kb, nb, kind;
        src(it, W, N, kb, nb, kind); tr_load(cur, W, N, kb, nb, lane);
        for (; it < NIT; it += NGW) {
            const int itn = it + NGW; const float* Wn = W; int Nn = N, kbn = kb, nbn = nb, kindn = kind;
            if (itn < NIT) { src(itn, Wn, Nn, kbn, nbn, kindn); tr_load(nxt, Wn, Nn, kbn, nbn, lane); }
            if (kind == 0) tr_finish(cur, DM, DIN, (bf16_t*)(P.ws + WS_WIN), scr, kb, nb, lane, RowId());
            else if (kind == 1) tr_finish(cur, QLORA, NH * DQK, (bf16_t*)(P.ws + WS_WUQ), scr, kb, nb, lane, RowUq());
            else if (kind == 2) tr_finish(cur, KVLORA, NH * 256, (bf16_t*)(P.ws + WS_WUKV), scr, kb, nb, lane, RowId());
            else tr_finish(cur, DM, DM, (bf16_t*)(P.ws + WS_WOUT), scr, kb, nb, lane, RowId());
            cur = nxt; W = Wn; N = Nn; kb = kbn; nb = nbn; kind = kindn;
        }
    }
}
__device__ __forceinline__ void norm_mod_rows(const float* __restrict__ src, const float* __restrict__ g, const float* sh, const float* sc, bf16_t* __restrict__ dst, int G) {
    const int tid = tid_opaque(), lane = tid & 63, wave = tid >> 6;
    const int gw = blockIdx.x * NWAVES + wave, NGW = G * NWAVES;
    for (int row0 = gw; row0 < SEQ; row0 += 4 * NGW) {
        f32x4 v[4][8]; float ss[4];
#pragma unroll
        for (int q = 0; q < 4; ++q) { const int row = row0 + q * NGW; const f32x4* xr = (const f32x4*)(src + (size_t)(row < SEQ ? row : row0) * DM) + lane;
#pragma unroll
            for (int j = 0; j < 8; ++j) v[q][j] = xr[64 * j]; }
#pragma unroll
        for (int q = 0; q < 4; ++q) { float a = 0.f;
#pragma unroll
            for (int j = 0; j < 8; ++j) a += (v[q][j].x * v[q][j].x + v[q][j].y * v[q][j].y) + (v[q][j].z * v[q][j].z + v[q][j].w * v[q][j].w);
            ss[q] = rsqrtf(wave_sum(a) * (1.f / DM) + EPS); }
#pragma unroll
        for (int j = 0; j < 8; ++j) { const int col = lane * 4 + 256 * j; const f32x4 gg = *(const f32x4*)(g + col); const f32x4 s1 = *(const f32x4*)(sc + col) + 1.f, s0 = *(const f32x4*)(sh + col);
#pragma unroll
            for (int q = 0; q < 4; ++q) { const int row = row0 + q * NGW;
                if (row < SEQ) { f32x4 y = v[q][j] * ss[q] * gg; y = y * s1 + s0; u32x2 w; w.x = cvt_pk_bf16(y.x, y.y); w.y = cvt_pk_bf16(y.z, y.w);
                    ((u32x2*)(dst + (size_t)row * DM) + lane)[64 * j] = w; } } }
    }
}
__device__ __forceinline__ void phase1a(const Params& P, char* lds, int G) {
    const int tid = tid_opaque();
    const float* mod = (const float*)(P.ws + WS_MOD);
    float* sh = (float*)lds; float* sc = sh + DM;
    for (int n = tid; n < 2 * DM; n += NTHREADS) sh[n] = mod[n];
    __syncthreads();
    norm_mod_rows(P.x, P.norm_mix_g, sh, sc, (bf16_t*)(P.ws + WS_H), G);
    __syncthreads();
}
__device__ __forceinline__ void ff_tile_src(const Params& P, int it, const float*& W, int& N, int& kb, int& nb) {
    constexpr int I_1 = 32 * 128;
    if (it < I_1) { W = P.w_ff1; N = DFF; kb = it / 128; nb = it % 128; } else { const int r = it - I_1; W = P.w_ff2; N = DM; kb = r / 32; nb = r % 32; }
}
__device__ __forceinline__ void ff_transposes(const Params& P, char* lds, int pidx, int np, int it0, int it1) {
    const int tid = tid_opaque(), lane = tid & 63, wave = tid >> 6;
    float* scr = (float*)(lds + wave * 17408);
    constexpr int I_1 = 32 * 128;
    const int stride = np * NWAVES;
    int it = it0 + pidx * NWAVES + wave;
    if (it >= it1) return;
    TrTile cur, nxt; const float* W; int N, kb, nb;
    ff_tile_src(P, it, W, N, kb, nb); tr_load(cur, W, N, kb, nb, lane);
    for (; it < it1; it += stride) {
        const int itn = it + stride; const float* Wn = W; int Nn = N, kbn = kb, nbn = nb;
        if (itn < it1) { ff_tile_src(P, itn, Wn, Nn, kbn, nbn); tr_load(nxt, Wn, Nn, kbn, nbn, lane); }
        if (it < I_1) tr_finish(cur, DM, DFF, (bf16_t*)(P.ws + WS_W1), scr, kb, nb, lane, RowId());
        else tr_finish(cur, DFF, DM, (bf16_t*)(P.ws + WS_W2), scr, kb, nb, lane, RowId());
        cur = nxt; W = Wn; N = Nn; kb = kbn; nb = nbn;
    }
}
constexpr int FFT_SPLIT = 4096, FFT_ALL = 8192;

__device__ __forceinline__ void phase6b(const Params& P, char* lds, int G) {
    const int tid = tid_opaque(), lane = tid & 63, wave = tid >> 6;
    const int gw = blockIdx.x * NWAVES + wave, NGW = G * NWAVES;
    const float* mod = (const float*)(P.ws + WS_MOD);
    float* sh = (float*)lds; float* sc = sh + DM;
    for (int n = tid; n < 2 * DM; n += NTHREADS) sh[n] = mod[3 * DM + n];
    __syncthreads();
    norm_mod_rows(P.out, P.norm_mlp_g, sh, sc, (bf16_t*)(P.ws + WS_H), G);
    __syncthreads();
    ff_transposes(P, lds, blockIdx.x, G, FFT_SPLIT, FFT_ALL);
}
__device__ __forceinline__ void phase2(const Params& P, char* lds, int G) {
    const int tid = tid_opaque(), lane = tid & 63, wave = tid >> 6;
    const int gw = blockIdx.x * NWAVES + wave, NGW = G * NWAVES;
    const bf16_t* pa = (const bf16_t*)(P.ws + WS_PA); const bf16_t* pb = (const bf16_t*)(P.ws + WS_PB);
    { bf16_t* cqn = (bf16_t*)(P.ws + WS_CQN); bf16_t* ckvn = (bf16_t*)(P.ws + WS_CKVN);
      float gq[8], gk[8];
#pragma unroll
      for (int e = 0; e < 8; ++e) { gq[e] = P.q_lora_g[lane * 8 + e]; gk[e] = P.kv_lora_g[(lane & 31) * 8 + e]; }
      for (int row = gw; row < SEQ; row += NGW) {
        const u32x4 wq = *(const u32x4*)(pa + (size_t)row * PAW + OFF_CQ + lane * 8);
        const u32x4 wk = *(const u32x4*)(pa + (size_t)row * PAW + OFF_CKV + (lane & 31) * 8);
        float fq[8], fk[8]; unpack8(wq, fq); unpack8(wk, fk);
        float sq = 0.f, sk = 0.f;
#pragma unroll
        for (int e = 0; e < 8; ++e) { sq += fq[e] * fq[e]; sk += fk[e] * fk[e]; }
        if (lane >= 32) sk = 0.f;
        const float rq = rsqrtf(wave_sum(sq) * (1.f / QLORA) + EPS), rk = rsqrtf(wave_sum(sk) * (1.f / KVLORA) + EPS);
#pragma unroll
        for (int e = 0; e < 8; ++e) { fq[e] = fq[e] * rq * gq[e]; fk[e] = fk[e] * rk * gk[e]; }
        *(u32x4*)(cqn + (size_t)row * QLORA + lane * 8) = pack8(fq);
        if (lane < 32) *(u32x4*)(ckvn + (size_t)row * KVLORA + lane * 8) = pack8(fk);
      } }
    { bf16_t* QH = (bf16_t*)(P.ws + WS_QH); bf16_t* KH = (bf16_t*)(P.ws + WS_KH); bf16_t* KT = (bf16_t*)(P.ws + WS_KT); bf16_t* VT = (bf16_t*)(P.ws + WS_VT);
      const int tg = tid >> 5, cgp = tid & 31, chl = cgp * 8;
      for (int item = blockIdx.x; item < 3 * HM * NCH; item += G) {
        const int kind = item / (HM * NCH), h = (item / NCH) % HM, c = item % NCH;
        const int t0 = LCH * c + 8 * tg;
        float outv[8][8];
        if (kind < 2) {
            const int col = kind * 1024 + h * DH + chl;
            float cw[5][8], cb[8];
#pragma unroll
            for (int e = 0; e < 8; ++e) cb[e] = P.conv_b[kind * 1024 + h * DH + chl + e];
#pragma unroll
            for (int j = 0; j < 5; ++j)
#pragma unroll
                for (int e = 0; e < 8; ++e) cw[j][e] = P.conv_w[j * 2048 + kind * 1024 + h * DH + chl + e];
#pragma unroll
            for (int tt = 0; tt < 8; ++tt)
#pragma unroll
                for (int e = 0; e < 8; ++e) outv[tt][e] = cb[e];
#pragma unroll
            for (int rr = 0; rr < 12; ++rr) {
                const int t = t0 - 2 + rr; float in[8];
                if (t >= 0 && t < SEQ) { const u32x4 w = *(const u32x4*)(pb + (size_t)t * PBW + col); unpack8(w, in); }
                else {
#pragma unroll
                    for (int e = 0; e < 8; ++e) in[e] = 0.f; }
#pragma unroll
                for (int j = 0; j < 5; ++j) { const int tt = rr - j;
                    if (tt >= 0 && tt < 8) {
#pragma unroll
                        for (int e = 0; e < 8; ++e) outv[tt][e] += cw[j][e] * in[e]; } }
            }
            const float osc = kind == 1 ? 0.0625f : 1.f;
#pragma unroll
            for (int tt = 0; tt < 8; ++tt)
#pragma unroll
                for (int e = 0; e < 8; ++e) outv[tt][e] = silu_f(outv[tt][e]) * osc;
            bf16_t* dst = (kind == 0 ? QH : KH) + ((size_t)h * SEQ + t0) * DH + chl;
#pragma unroll
            for (int tt = 0; tt < 8; ++tt) *(u32x4*)(dst + (size_t)tt * DH) = pack8(outv[tt]);
        } else {
#pragma unroll
            for (int tt = 0; tt < 8; ++tt) { const u32x4 w = *(const u32x4*)(pb + (size_t)(t0 + tt) * PBW + 2048 + h * DH + chl); unpack8(w, outv[tt]); }
        }
        if (kind >= 1) {
            bf16_t* dst = (kind == 1 ? KT : VT) + ((size_t)(h * NCH + c) * DH + chl) * LCH + 8 * tg;
#pragma unroll
            for (int e = 0; e < 8; ++e) { u32x4 w; w.x = cvt_pk_bf16(outv[0][e], outv[1][e]); w.y = cvt_pk_bf16(outv[2][e], outv[3][e]); w.z = cvt_pk_bf16(outv[4][e], outv[5][e]); w.w = cvt_pk_bf16(outv[6][e], outv[7][e]);
                *(u32x4*)(dst + (size_t)e * LCH) = w; }
        }
      } }
    { const float* gates = (const float*)(P.ws + WS_GATES);
      float* BC = (float*)(P.ws + WS_BC); float* IG = (float*)(P.ws + WS_IG); float* PM = (float*)(P.ws + WS_PM); float* WL = (float*)(P.ws + WS_WL);
      float* BL = (float*)(P.ws + WS_BL); float* AC = (float*)(P.ws + WS_AC);
      for (int task = gw; task < 2 * HM * NCH; task += NGW) {
        const int dir = task / (HM * NCH), h = (task / NCH) % HM, c = task % NCH;
        const float bi = P.b_gates[dir * 8 + h], bfg = P.b_gates[dir * 8 + 4 + h];
        const int u0 = 2 * lane, u1 = 2 * lane + 1;
        const int t0 = LCH * c + (dir ? 127 - u0 : u0), t1 = LCH * c + (dir ? 127 - u1 : u1);
        const float i0 = gates[(size_t)t0 * 16 + dir * 8 + h] + bi, i1 = gates[(size_t)t1 * 16 + dir * 8 + h] + bi;
        const float f0 = gates[(size_t)t0 * 16 + dir * 8 + 4 + h] + bfg, f1 = gates[(size_t)t1 * 16 + dir * 8 + 4 + h] + bfg;
        const float l0 = fminf(f0, 0.f) - log1pf(expf(-fabsf(f0))), l1 = fminf(f1, 0.f) - log1pf(expf(-fabsf(f1)));
        float inc = l0 + l1;
#pragma unroll
        for (int o = 1; o < 64; o <<= 1) { const float t = shup(inc, o); if (lane >= o) inc += t; }
        const float b1 = inc, b0 = inc - l1;
        const float d0 = i0 - b0, d1 = i1 - b1;
        float pmx = fmaxf(d0, d1);
#pragma unroll
        for (int o = 1; o < 64; o <<= 1) { const float t = shup(pmx, o); if (lane >= o) pmx = fmaxf(pmx, t); }
        float prev = shup(pmx, 1); if (lane == 0) prev = -INFINITY;
        const float pm0 = fmaxf(prev, d0), pm1 = pmx;
        const float bL = shidx(b1, 63), pmL = shidx(pmx, 63);
        const size_t base = (size_t)(dir * HM + h) * SEQ;
        BC[base + t0] = b0; BC[base + t1] = b1; IG[base + t0] = i0; IG[base + t1] = i1;
        PM[base + t0] = b0 + pm0; PM[base + t1] = b1 + pm1;
        WL[base + t0] = bL - b0 + i0; WL[base + t1] = bL - b1 + i1;
        if (lane == 63) { BL[(dir * HM + h) * NCH + c] = bL; AC[(dir * HM + h) * NCH + c] = bL + pmL; }
      } }
}

constexpr int M2_W = 1024, M2_WB = M2_W + SEQ * 4, M2_T0 = M2_WB + SEQ * 2, M2_TB = 96 * 256;
static_assert(M2_T0 + 2 * M2_TB <= LDS_BYTES, "M2 LDS");
__device__ __forceinline__ void m2_block(const Params& P, char* lds, int blk) {
    const int tid = tid_opaque(), lane = tid & 63, wid = tid >> 6, r = lane & 15, g = lane >> 4;
    const int dir = blk >> 7, h = (blk >> 5) & 3, vs = (blk >> 2) & 7, ksl = blk & 3;
    const int vi = wid >> 2, ki = wid & 3, v0 = 32 * vs + 16 * vi, k0 = 64 * ksl + 16 * ki;
    const int dh = dir * HM + h;
    const float* BL = (const float*)(P.ws + WS_BL) + dh * NCH; const float* AC = (const float*)(P.ws + WS_AC) + dh * NCH;
    const float* WL = (const float*)(P.ws + WS_WL) + (size_t)dh * SEQ;
    bf16_t* CST = (bf16_t*)(P.ws + cst_off(dh)); float* NST = (float*)(P.ws + WS_NST);
    float* s_mA = (float*)lds; float* s_dec = s_mA + NCH; float* s_w = (float*)(lds + M2_W); bf16_t* s_wb = (bf16_t*)(lds + M2_WB);
    float* s_bl = (float*)(lds + 512); float* s_ac = s_bl + NCH;
    if (tid < NCH) { s_bl[tid] = BL[tid]; s_ac[tid] = AC[tid]; }
    __syncthreads();
    if (tid == 0) { float m = -1e30f; float* MB = (float*)(P.ws + WS_MB) + dh * NCH; const bool pub = (vs == 0 && ksl == 0);
#pragma unroll 1
        for (int st = 0; st < NCH; ++st) { const int c = dir ? NCH - 1 - st : st; const float bL = s_bl[c], a = s_ac[c]; const float mn = fmaxf(bL + m, a);
            if (pub) MB[c] = m;
            s_dec[c] = __expf(bL + m - mn); s_mA[c] = mn; m = mn; } }
    __syncthreads();
    { float wl_[16];
#pragma unroll
      for (int i = 0; i < 16; ++i) wl_[i] = WL[tid + NTHREADS * i];
#pragma unroll
      for (int i = 0; i < 16; ++i) { const float w_ = __expf(wl_[i] - s_mA[(tid + NTHREADS * i) >> 7]); s_w[tid + NTHREADS * i] = w_; s_wb[tid + NTHREADS * i] = f2bf(w_); } }
    const int srow = tid >> 4, sslot = tid & 15;
    const char* gV = (const char*)(P.ws + WS_VT) + ((size_t)h * NCH * DH + 32 * vs + srow) * (LCH * 2) + sslot * 16;
    const char* gK = (const char*)(P.ws + WS_KT) + ((size_t)h * NCH * DH + 64 * ksl + srow) * (LCH * 2) + sslot * 16;
    const int lw = srow * 256 + ((sslot ^ (srow & 15)) << 4);
    const int la = (16 * vi + r) * 256, lb = (32 + 16 * ki + r) * 256;
    char* tb = lds + M2_T0;
    u32x4 ring[8][3];
#define M2_LOAD(slot, stp) do { const int c_ = dir ? NCH - 1 - (stp) : (stp); const size_t co_ = (size_t)c_ * (DH * LCH * 2); \
        ring[slot][0] = *(const u32x4*)(gV + co_); ring[slot][1] = *(const u32x4*)(gK + co_); ring[slot][2] = *(const u32x4*)(gK + co_ + 32 * LCH * 2); } while (0)
#define M2_WRITE(slot, buf, stp) do { char* d_ = tb + (buf) * M2_TB + lw; const int cw_ = dir ? NCH - 1 - (stp) : (stp); \
        const f32x4 wv0_ = *(const f32x4*)(s_w + LCH * cw_ + 8 * sslot), wv1_ = *(const f32x4*)(s_w + LCH * cw_ + 8 * sslot + 4); float a_[8]; unpack8(ring[slot][0], a_); \
        _Pragma("unroll") for (int j_ = 0; j_ < 4; ++j_) { a_[j_] *= wv0_[j_]; a_[4 + j_] *= wv1_[j_]; } \
        *(u32x4*)d_ = pack8(a_); *(u32x4*)(d_ + 8192) = ring[slot][1]; *(u32x4*)(d_ + 16384) = ring[slot][2]; } while (0)
#pragma unroll
    for (int d = 0; d < 8; ++d) M2_LOAD(d, d);
    __syncthreads();
    M2_WRITE(0, 0, 0);
    const bool do_n = (vs == 0 && vi == 0);
    f32x4 acc = {0.f, 0.f, 0.f, 0.f}, nacc = {0.f, 0.f, 0.f, 0.f};
#pragma unroll 1
    for (int st8 = 0; st8 < NCH; st8 += 8) {
#pragma unroll
        for (int u = 0; u < 8; ++u) {
            const int st = st8 + u;
            const int c = dir ? NCH - 1 - st : st;
            asm volatile("s_waitcnt lgkmcnt(0)" ::: "memory"); __builtin_amdgcn_s_barrier(); asm volatile("" ::: "memory");
            if (st + 1 < NCH) M2_WRITE((u + 1) & 7, (u + 1) & 1, st + 1);
            if (st + 8 < NCH) M2_LOAD(u, st + 8);
            { bf16_t* cp = CST + (size_t)c * (DH * DH) + (size_t)(v0 + r) * DH + k0 + 4 * g;
              u32x2 w2; w2.x = cvt_pk_bf16(acc[0], acc[1]); w2.y = cvt_pk_bf16(acc[2], acc[3]); *(u32x2*)cp = w2;
              if (do_n && r == 0) *(f32x4*)(NST + ((size_t)dh * NCH + c) * DH + k0 + 4 * g) = nacc; }
            const float dec = s_dec[c];
            acc = acc * dec; if (do_n) nacc = nacc * dec;
            const char* tbuf = tb + (u & 1) * M2_TB;
#pragma unroll
            for (int ks = 0; ks < 4; ++ks) {
                const int sl = ((4 * ks + g) ^ r) << 4;
                const bf16x8 av = *(const bf16x8*)(tbuf + la + sl), bv = *(const bf16x8*)(tbuf + lb + sl);
                acc = __builtin_amdgcn_mfma_f32_16x16x32_bf16(bv, av, acc, 0, 0, 0);
                if (do_n) { const bf16x8 wv = *(const bf16x8*)(s_wb + LCH * c + 32 * ks + 8 * g);
                    nacc = __builtin_amdgcn_mfma_f32_16x16x32_bf16(bv, wv, nacc, 0, 0, 0); }
            }
        }
    }
#undef M2_LOAD
#undef M2_WRITE
    __syncthreads();
}

constexpr int M3_LV = 1024, M3_LVS = 272, M3_LC = M3_LV + 256 * M3_LVS, M3_LCS = 528;
static_assert(M3_LC + 128 * M3_LCS <= LDS_BYTES, "M3 LDS");
__device__ __forceinline__ void m3_unit(const Params& P, char* lds, int h, int c) {
    const int tid = tid_opaque(), lane = tid & 63, wid = __builtin_amdgcn_readfirstlane(tid >> 6), r = lane & 15, g = lane >> 4;
    const int T0 = LCH * c, tl = 16 * wid + r;
    const char* QHc = (const char*)(P.ws + WS_QH) + ((size_t)h * SEQ + T0 + 16 * wid) * (DH * 2);
    const char* KHc = (const char*)(P.ws + WS_KH) + ((size_t)h * SEQ + T0) * (DH * 2);
    const char* VTc = (const char*)(P.ws + WS_VT) + ((size_t)h * NCH + c) * (DH * LCH * 2);

    const unsigned o512 = (unsigned)(r * 512 + g * 16);
    float* s_mb = (float*)lds; char* LV = lds + M3_LV; char* LC = lds + M3_LC;
    const char* lvr = LV + r * M3_LVS + g * 8;
    const char* lcr = LC + r * M3_LCS + g * 16;
    char* lcw = LC + (tid >> 5) * M3_LCS + (tid & 31) * 16;
    u32x4 cr[8];
#define M3_CLOAD(src) do { _Pragma("unroll") for (int n = 0; n < 8; ++n) cr[n] = ldgu<u32x4>((src) + n * 8192, (unsigned)tid * 16u); } while (0)
#define M3_CWRITE() do { _Pragma("unroll") for (int n = 0; n < 8; ++n) *(u32x4*)(lcw + n * (16 * M3_LCS)) = cr[n]; } while (0)
    M3_CLOAD(KHc);
    { u32x4 v[8];
#pragma unroll
      for (int n = 0; n < 8; ++n) v[n] = ldgu<u32x4>(VTc + n * 8192, (unsigned)tid * 16u);
#pragma unroll
      for (int n = 0; n < 8; ++n) *(u32x4*)(LV + ((tid >> 4) + 32 * n) * M3_LVS + (tid & 15) * 16) = v[n]; }
    M3_CWRITE();
    __syncthreads();
    f32x4 st[8];
    { bf16x8 qf[8];
#pragma unroll
      for (int kd = 0; kd < 8; ++kd) qf[kd] = ldgu<bf16x8>(QHc + 64 * kd, o512);
#pragma unroll
      for (int j = 0; j < 8; ++j) { st[j] = (f32x4){0.f, 0.f, 0.f, 0.f};
#pragma unroll
        for (int kd = 0; kd < 8; ++kd) { const bf16x8 kf = *(const bf16x8*)(lcr + j * (16 * M3_LCS) + kd * 64);
            st[j] = __builtin_amdgcn_mfma_f32_16x16x32_bf16(kf, qf[kd], st[j], 0, 0, 0); } } }
    f32x4 acc[16];
#pragma unroll
    for (int vt = 0; vt < 16; ++vt) acc[vt] = (f32x4){0.f, 0.f, 0.f, 0.f};
#pragma unroll 1
    for (int dir = 0; dir < 2; ++dir) {
        const int dh = dir * HM + h;
        const char* BCc = (const char*)(P.ws + WS_BC) + ((size_t)dh * SEQ + T0) * 4; const char* IGc = (const char*)(P.ws + WS_IG) + ((size_t)dh * SEQ + T0) * 4;
        const char* PMc = (const char*)(P.ws + WS_PM) + ((size_t)dh * SEQ + T0) * 4;
        const char* Cc = (const char*)(P.ws + cst_off(dh)) + (size_t)c * (DH * DH * 2);
        const char* Nc = (const char*)(P.ws + WS_NST) + ((size_t)dh * NCH + c) * (DH * 4);
        const int fx = dir * 127, tlx = tl ^ fx;
        const float mB = ((const float*)(P.ws + WS_MB))[dh * NCH + c];
        const float bt = ldgu<float>(BCc, (unsigned)tl * 4u), pm = ldgu<float>(PMc, (unsigned)tl * 4u);
        const float mt = fmaxf(bt + mB, pm); const float alpha = bt - mt; const float winter = __expf(bt + mB - mt);
        float den = 0.f;
#pragma unroll
        for (int j = 0; j < 8; ++j) { const int sb = 16 * j + 4 * g;
            const f32x4 ig = ldgu<f32x4>(IGc + 64 * j, (unsigned)g * 16u), bc = ldgu<f32x4>(BCc + 64 * j, (unsigned)g * 16u);
#pragma unroll
            for (int i = 0; i < 4; ++i) { const int sl = sb + i; const bool ok = ((sl ^ fx) <= tlx);
                const float e = ok ? __expf(alpha + ig[i] - bc[i]) : 0.f; den += st[j][i] * e; } }
        den += shx(den, 16); den += shx(den, 32);
        float qn = 0.f;
#pragma unroll
        for (int kd = 0; kd < 8; ++kd) { const f32x4 n0 = ldgu<f32x4>(Nc + 128 * kd, (unsigned)g * 32u), n1 = ldgu<f32x4>(Nc + 128 * kd + 16, (unsigned)g * 32u);
            const u32x4 qt = ldgu<u32x4>(QHc + 64 * kd, o512); float q[8]; unpack8(qt, q);
            qn += q[0] * n0[0] + q[1] * n0[1] + q[2] * n0[2] + q[3] * n0[3] + q[4] * n1[0] + q[5] * n1[1] + q[6] * n1[2] + q[7] * n1[3]; }
        qn += shx(qn, 16); qn += shx(qn, 32);
        const float dtot = den + winter * qn;
        const float hdiv = 1.f / fmaxf(fabsf(dtot), __expf(-mt));
        int tlx2 = tlx; LAUNDER_V(tlx2);
#pragma unroll
        for (int ks = 0; ks < 4; ++ks) {
            float e8[8];
#pragma unroll
            for (int hh = 0; hh < 2; ++hh) { const int j = 2 * ks + hh, sb = 16 * j + 4 * g;
                const f32x4 ig = ldgu<f32x4>(IGc + 64 * j, (unsigned)g * 16u), bc = ldgu<f32x4>(BCc + 64 * j, (unsigned)g * 16u);
#pragma unroll
                for (int i = 0; i < 4; ++i) { const int sl = sb + i; const bool ok = ((sl ^ fx) <= tlx2);
                    const float e = ok ? __expf(alpha + ig[i] - bc[i]) : 0.f; e8[4 * hh + i] = st[j][i] * e * hdiv; } }
            const u32x4 pw = pack8(e8); const bf16x8 pa = *(const bf16x8*)&pw;
#pragma unroll
            for (int vt = 0; vt < 16; ++vt) {
                const u32x2 lo = *(const u32x2*)(lvr + vt * (16 * M3_LVS) + ks * 64), hi2 = *(const u32x2*)(lvr + vt * (16 * M3_LVS) + ks * 64 + 32);
                u32x4 w; w.x = lo.x; w.y = lo.y; w.z = hi2.x; w.w = hi2.y;
                acc[vt] = __builtin_amdgcn_mfma_f32_16x16x32_bf16(pa, *(const bf16x8*)&w, acc[vt], 0, 0, 0); }
        }
        const float qsc = winter * hdiv;
        M3_CLOAD(Cc);
#pragma unroll
        for (int half = 0; half < 2; ++half) {
            __syncthreads();
            M3_CWRITE();
            __syncthreads();
            if (half == 0) M3_CLOAD(Cc + 65536);
#pragma unroll
            for (int kd = 0; kd < 8; ++kd) { const u32x4 qt = ldgu<u32x4>(QHc + 64 * kd, o512); float q[8]; unpack8(qt, q);
#pragma unroll
                for (int e = 0; e < 8; ++e) q[e] *= qsc;
                const u32x4 qw = pack8(q); const bf16x8 qs = *(const bf16x8*)&qw;
#pragma unroll
                for (int v8 = 0; v8 < 8; ++v8) { const bf16x8 cf = *(const bf16x8*)(lcr + v8 * (16 * M3_LCS) + kd * 64);
                    acc[half * 8 + v8] = __builtin_amdgcn_mfma_f32_16x16x32_bf16(qs, cf, acc[half * 8 + v8], 0, 0, 0); }
            }
        }
    }
#undef M3_CLOAD
#undef M3_CWRITE
    float ss[4] = {0.f, 0.f, 0.f, 0.f};
#pragma unroll
    for (int vt = 0; vt < 16; ++vt)
#pragma unroll
        for (int i = 0; i < 4; ++i) ss[i] += acc[vt][i] * acc[vt][i];
#pragma unroll
    for (int i = 0; i < 4; ++i) { ss[i] += shx(ss[i], 1); ss[i] += shx(ss[i], 2); ss[i] += shx(ss[i], 4); ss[i] += shx(ss[i], 8); ss[i] = rsqrtf(ss[i] * (1.f / DH) + EPS); }
    const char* pr0 = (const char*)(P.ws + WS_PA) + ((size_t)(T0 + 16 * wid) * PAW + PA_OM + h * DH) * 2;
    char* mx0 = (char*)(P.ws + WS_MIX) + ((size_t)(T0 + 16 * wid) * DM + 1024 + h * DH) * 2;
    const char* gmp = (const char*)(P.mlstm_norm_g + h * DH);
    const unsigned opr = (unsigned)(4 * g * PAW * 2 + r * 2), omx = (unsigned)(4 * g * DM * 2 + r * 2);
#pragma unroll
    for (int vt = 0; vt < 16; ++vt) { const float gm = ldgu<float>(gmp + 64 * vt, (unsigned)r * 4u);
#pragma unroll
        for (int i = 0; i < 4; ++i) { const float om = bf2f(ldgu<bf16_t>(pr0 + i * (PAW * 2) + 32 * vt, opr));
            *(bf16_t*)(mx0 + i * (DM * 2) + 32 * vt + omx) = f2bf(acc[vt][i] * ss[i] * gm * sigmoid_f(om)); }
        if ((vt & 3) == 3) asm volatile("" ::: "memory"); }
    __syncthreads();
}

__device__ __forceinline__ void phase4(const Params& P, int G) {
    const int tid = tid_opaque(), lane = tid & 63, wave = tid >> 6;
    const int gw = blockIdx.x * NWAVES + wave, NGW = G * NWAVES;
    bf16_t* Q = (bf16_t*)(P.ws + WS_Q); bf16_t* K = (bf16_t*)(P.ws + WS_K); const bf16_t* KV = (const bf16_t*)(P.ws + WS_KV); const bf16_t* proj = (const bf16_t*)(P.ws + WS_PA);
    const f32x4* rt = (const f32x4*)(P.ws + WS_ROPE);
    const int i = lane & 7, hh = lane >> 3; const bool lo = i < 4;
    float gq[3][8], gk[3][8];
#pragma unroll
    for (int j = 0; j < 3; ++j)
#pragma unroll
        for (int e = 0; e < 8; ++e) { gq[j][e] = P.q_norm_g[8 * (i + 8 * j) + e]; gk[j][e] = P.k_norm_g[8 * (i + 8 * j) + e]; }
    for (int t = gw; t < SEQ; t += NGW) {
        float cs[8], sn[8];
#pragma unroll
        for (int e2 = 0; e2 < 4; ++e2) { const f32x4 v = rt[(size_t)t * 16 + 4 * (i & 3) + e2]; cs[2 * e2] = v[0]; sn[2 * e2] = v[1]; cs[2 * e2 + 1] = v[2]; sn[2 * e2 + 1] = v[3]; }
#pragma unroll
        for (int which = 0; which < 2; ++which) {
            u32x4 w0, w1, w2; bf16_t* dst;
            if (which == 0) { bf16_t* qp = Q + (size_t)t * (NH * DQK) + hh * DQK + 8 * i; w0 = *(const u32x4*)qp; w1 = *(const u32x4*)(qp + 64); w2 = *(const u32x4*)(qp + 128); dst = qp; }
            else { const bf16_t* kp = KV + (size_t)t * (NH * 256) + hh * 256 + 8 * i; w0 = *(const u32x4*)kp; w1 = *(const u32x4*)(kp + 64);
                   w2 = *(const u32x4*)(proj + (size_t)t * PAW + OFF_KPE + 8 * i); dst = K + (size_t)t * (NH * DQK) + hh * DQK + 8 * i; }
            float a0[8], a1[8], a2[8]; unpack8(w0, a0); unpack8(w1, a1); unpack8(w2, a2);
            float ss = 0.f;
#pragma unroll
            for (int e = 0; e < 8; ++e) ss += a0[e] * a0[e] + a1[e] * a1[e] + a2[e] * a2[e];
            ss += shx(ss, 1); ss += shx(ss, 2); ss += shx(ss, 4);
            const float rs = rsqrtf(ss * (1.f / DQK) + EPS);
#pragma unroll
            for (int e = 0; e < 8; ++e) { const float g0 = which ? gk[0][e] : gq[0][e], g1 = which ? gk[1][e] : gq[1][e], g2 = which ? gk[2][e] : gq[2][e];
                a0[e] *= rs * g0; a1[e] *= rs * g1; a2[e] *= rs * g2; }
            float o2[8];
#pragma unroll
            for (int e = 0; e < 8; ++e) { const float pr = shx(a2[e], 4);
                o2[e] = lo ? (a2[e] * cs[e] - pr * sn[e]) : (pr * sn[e] + a2[e] * cs[e]); }
            *(u32x4*)dst = pack8(a0); *(u32x4*)(dst + 64) = pack8(a1); *(u32x4*)(dst + 128) = pack8(o2);
        }
    }
}

struct StoreProj { bf16_t* pa; bf16_t* pb; float* gates;
    __device__ __forceinline__ void operator()(int row, int col, f32x4 v0, f32x4 v1) const {
        u32x4 w; w.x = cvt_pk_bf16(v0[0], v0[1]); w.y = cvt_pk_bf16(v0[2], v0[3]); w.z = cvt_pk_bf16(v1[0], v1[1]); w.w = cvt_pk_bf16(v1[2], v1[3]);
        bf16_t* dst = (col >= OFF_QM && col < OFF_OM) ? pb + (size_t)row * PBW + (col - OFF_QM) : pa + (size_t)row * PAW + (col < OFF_QM ? col : col - OFF_OM + PA_OM);
        *(u32x4*)dst = w;
        if (col >= OFF_GM && col < OFF_GM + 16) { float* gp = gates + (size_t)row * 16 + (col - OFF_GM); *(f32x4*)gp = v0; *(f32x4*)(gp + 4) = v1; } } };
struct StoreQ { bf16_t* q;
    __device__ __forceinline__ void operator()(int row, int col, f32x4 v0, f32x4 v1) const {
        const int h = col >> 8, ct = col & 255;
        if (ct < DQK) { u32x4 w; w.x = cvt_pk_bf16(v0[0], v0[1]); w.y = cvt_pk_bf16(v0[2], v0[3]); w.z = cvt_pk_bf16(v1[0], v1[1]); w.w = cvt_pk_bf16(v1[2], v1[3]);
            *(u32x4*)(q + (size_t)row * (NH * DQK) + h * DQK + ct) = w; } } };
struct StoreKV { bf16_t* kv;
    __device__ __forceinline__ void operator()(int row, int col, f32x4 v0, f32x4 v1) const {
        u32x4 w; w.x = cvt_pk_bf16(v0[0], v0[1]); w.y = cvt_pk_bf16(v0[2], v0[3]); w.z = cvt_pk_bf16(v1[0], v1[1]); w.w = cvt_pk_bf16(v1[2], v1[3]);
        *(u32x4*)(kv + (size_t)row * (NH * 256) + col) = w; } };
struct StoreX1 { const float* x; const float* gate; float* out;
    __device__ __forceinline__ void operator()(int row, int col, f32x4 v) const {
        const size_t off = (size_t)row * DM + col; const f32x4 xv = *(const f32x4*)(x + off); const f32x4 gv = *(const f32x4*)(gate + col);
        *(f32x4*)(out + off) = xv + gv * v; } };
struct StoreAct { bf16_t* act;
    __device__ __forceinline__ void operator()(int row, int col, f32x4 v0, f32x4 v1) const {
        float f[8] = {v0[0], v0[1], v0[2], v0[3], v1[0], v1[1], v1[2], v1[3]};
#pragma unroll
        for (int e = 0; e < 8; ++e) { const float rl = fmaxf(f[e], 0.f); f[e] = rl * rl; }
        *(u32x4*)(act + (size_t)row * DFF + col) = pack8(f); } };

#define XB_TMO      128
#define XB_XCNT(j)  (256  + 64 * (j))
#define XB_XSUB(j)  (1280 + 64 * (j))
#define XB_XGEN(j)  (2304 + 64 * (j))
#define XB_TOP      3328
#define XB_TOPGEN   3392
#define XCD_BAR_WORDS 3456
#define XB_SPIN_CAP (1u << 18)

__device__ __forceinline__ unsigned xb_ld(unsigned* p)              { return __hip_atomic_load(p, __ATOMIC_RELAXED, __HIP_MEMORY_SCOPE_AGENT); }
__device__ __forceinline__ unsigned xb_add(unsigned* p, unsigned v) { return __hip_atomic_fetch_add(p, v, __ATOMIC_RELAXED, __HIP_MEMORY_SCOPE_AGENT); }
__device__ __forceinline__ unsigned xb_xcc_id() { return (unsigned)__builtin_amdgcn_s_getreg((3 << 11) | 20) & 0xFu; }
#define XB_SPIN(cond, bar) do { unsigned _sp = 0; while (cond) { __builtin_amdgcn_s_sleep(1); \
    if ((++_sp & 255u) == 0u) { if (xb_ld(&(bar)[XB_TMO])) break; if (_sp > XB_SPIN_CAP) { atomicAdd(&(bar)[XB_TMO], 1u); break; } } } } while (0)

struct XcdBarrier {
    unsigned* bar; unsigned x;
    volatile LAS unsigned* st;
};

__device__ __forceinline__ XcdBarrier xcd_barrier_post(unsigned* bar, volatile LAS unsigned* st) {
    XcdBarrier b; b.bar = bar; b.x = xb_xcc_id(); b.st = st;
    if (threadIdx.x == 0) (void)xb_add(&bar[XB_XCNT(b.x)], 1u);
    return b;
}
__device__ __forceinline__ void xcd_barrier_complete(unsigned* bar, unsigned x, unsigned& nloc, unsigned& nx) {
    const unsigned G = gridDim.x * gridDim.y * gridDim.z;
    unsigned sum, cnt, mine, sp = 0u;
    for (;;) {
        sum = 0u; cnt = 0u; mine = 0u;
#pragma unroll
        for (unsigned j = 0; j < 16; ++j) { const unsigned c = xb_ld(&bar[XB_XCNT(j)]); sum += c; cnt += (c > 0u) ? 1u : 0u; mine = (j == x) ? c : mine; }
        if (sum == G) break;
        __builtin_amdgcn_s_sleep(1);
        if ((++sp & 255u) == 0u) { if (xb_ld(&bar[XB_TMO])) break; if (sp > XB_SPIN_CAP) { atomicAdd(&bar[XB_TMO], 1u); break; } }
    }
    nloc = mine > 0u ? mine : 1u; nx = cnt > 0u ? cnt : 1u;
}

__device__ __forceinline__ void xcd_barrier(const XcdBarrier& b) {
    asm volatile("s_waitcnt vmcnt(0)" ::: "memory");
    __syncthreads();
    if (tid_opaque() == 0) {
        unsigned* bar = b.bar;
        __builtin_amdgcn_s_waitcnt(0);
        unsigned nloc = b.st[0], nx = b.st[1];
        if (nloc == 0u) { xcd_barrier_complete(bar, b.x, nloc, nx); b.st[0] = nloc; b.st[1] = nx; }
        const unsigned old = xb_add(&bar[XB_XSUB(b.x)], 1u);
        const unsigned gen = old / nloc;
        if (old + 1u == (gen + 1u) * nloc) {
            __builtin_amdgcn_fence(__ATOMIC_RELEASE, "agent");
            asm volatile("s_waitcnt vmcnt(0)" ::: "memory");
            const unsigned og = xb_add(&bar[XB_TOP], 1u);
            const unsigned tg = og / nx;
            if (og + 1u == (tg + 1u) * nx) xb_add(&bar[XB_TOPGEN], 1u);
            else XB_SPIN(xb_ld(&bar[XB_TOPGEN]) == tg, bar);
            __builtin_amdgcn_fence(__ATOMIC_ACQUIRE, "agent");
            xb_add(&bar[XB_XGEN(b.x)], 1u);
            asm volatile("s_waitcnt vmcnt(0)" ::: "memory");
        } else {
            XB_SPIN(xb_ld(&bar[XB_XGEN(b.x)]) == gen, bar);
            __builtin_amdgcn_fence(__ATOMIC_ACQUIRE, "agent");
            asm volatile("s_waitcnt vmcnt(0)" ::: "memory");
        }
    }
    __syncthreads();
}


constexpr int NPH = 11;
#ifdef ONLY_PH
#define PH_ON(n) ((n) == ONLY_PH)
#else
#define PH_ON(n) 1
#endif
#define CAS __attribute__((address_space(4)))
__device__ __forceinline__ Params load_params(const CAS Params* kp) {
#if defined(__HIP_DEVICE_COMPILE__)
    unsigned long long kv = (unsigned long long)kp; asm volatile("" : "+s"(kv)); return *(const CAS Params*)kv;
#else
    return Params{};
#endif
}
__global__ void __launch_bounds__(NTHREADS, 2) fwd_kernel(Params Pk) {
    extern __shared__ __attribute__((aligned(16))) char lds[];
    const CAS Params* kp = (const CAS Params*)__builtin_amdgcn_kernarg_segment_ptr();
    const int G0 = gridDim.x; const int bx0 = blockIdx.x;
    const int vcu0 = (G0 % 8 == 0) ? (bx0 % 8) * (G0 / 8) + bx0 / 8 : bx0;
    LAS unsigned char* ldsl = (LAS unsigned char*)lds;
    const int ph_lo = Pk.ph_lo, ph_hi = Pk.ph_hi;
    if (threadIdx.x < 16) ((volatile LAS unsigned*)(ldsl + LDS_BARST))[threadIdx.x] = 0u;
    if ((threadIdx.x & 63) == 0) { const unsigned hw = __builtin_amdgcn_s_getreg((5 << 11) | 4) & 63u; *(volatile LAS int*)(uintptr_t)(LDS_WIDTAB + hw * 4) = (int)(threadIdx.x >> 6); }
    __syncthreads();
    XcdBarrier xbar = xcd_barrier_post((unsigned*)(Pk.ws + WS_BAR), (volatile LAS unsigned*)(ldsl + LDS_BARST));
#ifndef PROBE_PH
#define PROBE_PH (-1)
#endif
    unsigned long long probe_dt = 0, probe_t0g = 0;
#ifndef PROBE_FROM
#define PROBE_FROM (-1)
#define PROBE_TO (-1)
#endif
#define PROBE_MARK(id) do { if (PROBE_FROM == (id)) { __syncthreads(); probe_t0g = __builtin_amdgcn_s_memrealtime(); } if (PROBE_TO == (id)) { __syncthreads(); probe_dt = __builtin_amdgcn_s_memrealtime() - probe_t0g; } } while (0)
#ifndef DUP_PH
#define DUP_PH (-1)
#endif
#ifndef DUP_SUB
#define DUP_SUB 0
#endif
    for (int ph = ph_lo; ph < ph_hi; ++ph) {
      {
        int G = G0, bx = bx0, vcu = vcu0; asm volatile("" : "+s"(G), "+s"(bx), "+s"(vcu));
        unsigned long long probe_t0 = 0; if (PROBE_PH >= 0 && ph == PROBE_PH) probe_t0 = __builtin_amdgcn_s_memrealtime();
        for (int sub = 0; sub < (ph == 6 ? 2 : 1); ++sub) {
        int G = G0, bx = bx0, vcu = vcu0; asm volatile("" : "+s"(G), "+s"(bx), "+s"(vcu));
        switch (sub ? 11 : ph) {
        case 0: if (PH_ON(0)) { const Params P = load_params(kp); phase0(P, lds, G); } break;
        case 1: if (PH_ON(1)) { const Params P = load_params(kp); phase1a(P, lds, G); } break;
        case 2: if (PH_ON(2)) { const Params P = load_params(kp); unsigned char* ws = P.ws;
                  pg8::Gemm g{(const bf16_t*)(ws + WS_H), (const bf16_t*)(ws + WS_WIN), SEQ, DINP, DM}; pg8::StaticOrder S; S.init(SEQ, DINP, G, bx);
                  pg8::Epi8<StoreProj> E{{(bf16_t*)(ws + WS_PA), (bf16_t*)(ws + WS_PB), (float*)(ws + WS_GATES)}};
                  pg8::gemm_phase<pg8::Epi8<StoreProj>, pg8::StaticOrder, true, true>(ldsl, g, S, E);
                  { const int nwg = (SEQ / 256) * (DINP / 256), nfull = nwg % G;
                    if (nfull == 0) ff_transposes(P, lds, bx, G, 0, FFT_SPLIT); else if (bx >= nfull) ff_transposes(P, lds, bx - nfull, G - nfull, 0, FFT_SPLIT); } } break;
        case 3: if (PH_ON(3)) { const Params P = load_params(kp); phase2(P, lds, G); } break;
        case 4: if (PH_ON(4)) { PROBE_MARK(40);
#ifndef NO_G4
#ifndef NO_G4A
                  { const Params P = load_params(kp); unsigned char* ws = P.ws;
                    pg8::Gemm g{(const bf16_t*)(ws + WS_CQN), (const bf16_t*)(ws + WS_WUQ), SEQ, NH * 256, QLORA}; pg8::StaticOrder S; S.init(SEQ, NH * 256, G, bx);
                    pg8::Epi8<StoreQ> E{{(bf16_t*)(ws + WS_Q)}};
                    pg8::gemm_phase<pg8::Epi8<StoreQ>, pg8::StaticOrder, true, true>(ldsl, g, S, E); }
#endif
#ifndef NO_G4B
                  { const Params P = load_params(kp); unsigned char* ws = P.ws;
                    pg8::Gemm g{(const bf16_t*)(ws + WS_CKVN), (const bf16_t*)(ws + WS_WUKV), SEQ, NH * 256, KVLORA}; pg8::StaticOrder S; S.init(SEQ, NH * 256, G, bx);
                    pg8::Epi8<StoreKV> E{{(bf16_t*)(ws + WS_KV)}};
                    pg8::gemm_phase<pg8::Epi8<StoreKV>, pg8::StaticOrder, true, true>(ldsl, g, S, E); }
#endif
#endif
                  PROBE_MARK(42);
#ifndef NO_M2
                  { const Params P = load_params(kp); for (int b = vcu; b < 256; b += G) m2_block(P, lds, b); }
#endif
                  PROBE_MARK(43);
                  } break;
        case 5: if (PH_ON(5)) { const Params P = load_params(kp); phase4(P, G); } break;
        case 6: if (PH_ON(6)) { PROBE_MARK(60);
#ifndef NO_ATT
                  { const Params P = load_params(kp); unsigned char* ws = P.ws;
                  for (int u = vcu; u < NH * (SEQ / 256); u += G) { const int h = u >> 5, qb = u & 31;
                      att::attn_unit((const bf16_t*)(ws + WS_Q) + (size_t)(qb * 256) * att::LDQ + h * DQK, (const bf16_t*)(ws + WS_K) + h * DQK, (const bf16_t*)(ws + WS_KV) + h * 256 + 128,
                                     (bf16_t*)(ws + WS_MIX) + (size_t)(qb * 256) * DM + h * DV, SEQ, lds); } }
#endif
                  PROBE_MARK(61);
                  } break;
        case 11: if (PH_ON(6)) {
#ifndef NO_M3
                  { const Params P = load_params(kp); for (int u = vcu; u < HM * NCH; u += G) m3_unit(P, lds, u >> 6, u & 63); }
#endif
                  PROBE_MARK(62);
                  } break;
        case 7: if (PH_ON(7)) { const Params P = load_params(kp); unsigned char* ws = P.ws;
                  pg8::Gemm g{(const bf16_t*)(ws + WS_MIX), (const bf16_t*)(ws + WS_WOUT), SEQ, DM, DM}; pg8::StaticOrder S; S.init(SEQ, DM, G, bx);
                  pg8::Epi4<StoreX1> E{{P.x, (const float*)(ws + WS_MOD) + 2 * DM, P.out}};
                  pg8::gemm_phase<pg8::Epi4<StoreX1>, pg8::StaticOrder, true, true>(ldsl, g, S, E); } break;
        case 8: if (PH_ON(8)) { const Params P = load_params(kp); phase6b(P, lds, G); } break;
        case 9: if (PH_ON(9)) { const Params P = load_params(kp); unsigned char* ws = P.ws;
                  pg8::Gemm g{(const bf16_t*)(ws + WS_H), (const bf16_t*)(ws + WS_W1), SEQ, DFF, DM}; pg8::StaticOrder S; S.init(SEQ, DFF, G, bx);
                  pg8::Epi8<StoreAct> E{{(bf16_t*)(ws + WS_ACT)}};
                  pg8::gemm_phase<pg8::Epi8<StoreAct>, pg8::StaticOrder, true, true>(ldsl, g, S, E); } break;
        case 10: if (PH_ON(10)) { const Params P = load_params(kp); unsigned char* ws = P.ws;
                  pg8::Gemm g{(const bf16_t*)(ws + WS_ACT), (const bf16_t*)(ws + WS_W2), SEQ, DM, DFF}; pg8::StaticOrder S; S.init(SEQ, DM, G, bx);
                  pg8::Epi4<StoreX1> E{{P.out, (const float*)(ws + WS_MOD) + 5 * DM, P.out}};
                  pg8::gemm_phase<pg8::Epi4<StoreX1>, pg8::StaticOrder, true, true>(ldsl, g, S, E); } break;
        default: break;
        }
        }
        if (ph + 1 < ph_hi) { xcd_barrier(xbar); }
        if (PROBE_PH >= 0 && ph == PROBE_PH) { __syncthreads(); probe_dt = __builtin_amdgcn_s_memrealtime() - probe_t0; }
      }
    }
    if ((PROBE_PH >= 0 || PROBE_FROM >= 0) && blockIdx.x == 0) { const unsigned long long te = __builtin_amdgcn_s_memrealtime();
        while (__builtin_amdgcn_s_memrealtime() - te < probe_dt) __builtin_amdgcn_s_sleep(8); }
}

extern "C" void kernel_launch(void* const* d_in, const int* in_sizes, int n_in, void* d_out, int out_size, void* d_ws, size_t ws_size, hipStream_t stream) {
    static int grid = 0;
    if (grid == 0) {
        if (n_in != 21 || out_size != SEQ * DM || ws_size < WS_END) { fprintf(stderr, "kernel_launch: unexpected shapes n_in %d out %d ws %zu\n", n_in, out_size, ws_size); grid = -1; return; }
        int dev = 0, cus = 0, per_cu = 0;
        if (hipGetDevice(&dev) != hipSuccess || hipDeviceGetAttribute(&cus, hipDeviceAttributeMultiprocessorCount, dev) != hipSuccess) { grid = -1; return; }
        if (hipFuncSetAttribute((const void*)fwd_kernel, hipFuncAttributeMaxDynamicSharedMemorySize, LDS_BYTES) != hipSuccess) { fprintf(stderr, "kernel_launch: hipFuncSetAttribute failed\n"); grid = -1; return; }
        if (hipOccupancyMaxActiveBlocksPerMultiprocessor(&per_cu, (const void*)fwd_kernel, NTHREADS, LDS_BYTES) != hipSuccess || per_cu < 1) { fprintf(stderr, "kernel_launch: occupancy query says %d\n", per_cu); per_cu = 1; }
        (void)hipGetLastError();
        grid = cus * 1;
    }
    if (grid < 0) return;
    Params p{};
    p.x = (const float*)d_in[0]; p.c = (const float*)d_in[1]; p.pos = (const int*)d_in[2]; p.w_ada = (const float*)d_in[3]; p.b_ada = (const float*)d_in[4];
    p.norm_mix_g = (const float*)d_in[5]; p.w_in = (const float*)d_in[6]; p.b_gates = (const float*)d_in[7]; p.conv_w = (const float*)d_in[8]; p.conv_b = (const float*)d_in[9];
    p.q_lora_g = (const float*)d_in[10]; p.w_uq = (const float*)d_in[11]; p.kv_lora_g = (const float*)d_in[12]; p.w_ukv = (const float*)d_in[13]; p.q_norm_g = (const float*)d_in[14];
    p.k_norm_g = (const float*)d_in[15]; p.mlstm_norm_g = (const float*)d_in[16]; p.w_out = (const float*)d_in[17]; p.norm_mlp_g = (const float*)d_in[18];
    p.w_ff1 = (const float*)d_in[19]; p.w_ff2 = (const float*)d_in[20];
    p.out = (float*)d_out; p.ws = (unsigned char*)d_ws;
    (void)hipMemsetAsync((char*)d_ws + WS_BAR, 0, 32768, stream);
#if MK_MULTI
    for (int ph = 0; ph < NPH; ++ph) { p.ph_lo = ph; p.ph_hi = ph + 1; hipLaunchKernelGGL(fwd_kernel, dim3(grid), dim3(NTHREADS), LDS_BYTES, stream, p); }
#else
    p.ph_lo = 0; p.ph_hi = NPH;
    void* args[] = {&p};
    hipError_t e = hipLaunchCooperativeKernel((const void*)fwd_kernel, dim3(grid), dim3(NTHREADS), args, LDS_BYTES, stream);
    if (e != hipSuccess) fprintf(stderr, "kernel_launch: cooperative launch failed: %s (grid %d)\n", hipGetErrorString(e), grid);
#endif
}
```

```cpp
#include <hip/hip_runtime.h>
#include <hip/hip_cooperative_groups.h>
#include <cstdio>
#include <cstdint>
namespace cg = cooperative_groups;

#ifndef MK_MULTI
#define MK_MULTI 0
#endif

#ifndef F8_MODE
#define F8_MODE 1
#endif
#ifndef F8_THR
#define F8_THR 0.10f
#endif
#define LAS __attribute__((address_space(3)))
typedef unsigned short bf16_t;
typedef short bf16x8 __attribute__((ext_vector_type(8)));
typedef short s16x4 __attribute__((ext_vector_type(4)));
typedef float f32x4 __attribute__((ext_vector_type(4)));
typedef float f32x2 __attribute__((ext_vector_type(2)));
typedef float f32x16 __attribute__((ext_vector_type(16)));
typedef unsigned u32x4 __attribute__((ext_vector_type(4)));
typedef unsigned u32x2 __attribute__((ext_vector_type(2)));

constexpr int SEQ = 8192, DM = 2048, DIN = 4944, DINP = 5120, DFF = 8192;
constexpr int NH = 8, DQK = 192, DV = 128, QLORA = 512, KVLORA = 256;
constexpr int HM = 4, DH = 256, LCH = 128, NCH = 64;
constexpr int OFF_CQ = 0, OFF_CKV = 512, OFF_KPE = 768, OFF_QM = 832, OFF_KM = 1856, OFF_VM = 2880, OFF_OM = 3904, OFF_GM = 4928;
constexpr float EPS = 1e-6f;
constexpr int NTHREADS = 512, NWAVES = 8;
constexpr int LDS_BYTES = 147456;
constexpr int LDS_BARST = LDS_BYTES - 64;

constexpr size_t MiB = 1u << 20;
constexpr size_t WS_MODP = 384 * MiB - 2 * MiB;
constexpr size_t WS_MOD = 786432;
constexpr size_t WS_BC = 1 * MiB;
constexpr size_t WS_IG = WS_BC + 262144;
constexpr size_t WS_PM = WS_IG + 262144;
constexpr size_t WS_WL = WS_PM + 262144;
constexpr size_t WS_BAR = 868352;
constexpr size_t WS_CNT = WS_BAR + 16384;
constexpr size_t WS_MB = 860160;
constexpr size_t WS_BL = 851968;
constexpr size_t WS_AC = 856064;
constexpr size_t WS_WIN = 2 * MiB, WS_WUQ = 22 * MiB, WS_WUKV = 24 * MiB, WS_WOUT = 26 * MiB;
constexpr size_t WS_W1 = 34 * MiB, WS_W2 = 66 * MiB;
constexpr size_t WS_H = 98 * MiB;
constexpr size_t WS_Q = 98 * MiB;
constexpr size_t WS_MIX = 130 * MiB;
constexpr size_t WS_PA = 162 * MiB;
constexpr size_t WS_PB = 194 * MiB;
constexpr int PAW = 2048, PBW = 3072, PA_OM = 832;
constexpr size_t WS_CQN = 242 * MiB, WS_CKVN = 250 * MiB;
constexpr size_t WS_GATES = 254 * MiB;
constexpr size_t WS_NST = 255 * MiB;
constexpr size_t WS_ACT = 130 * MiB;
constexpr size_t WS_KV = 258 * MiB;
constexpr size_t WS_K = 290 * MiB;
constexpr size_t WS_Q8 = 242 * MiB;
constexpr size_t WS_K8 = 290 * MiB;
constexpr size_t WS_QH = 314 * MiB, WS_KH = 330 * MiB, WS_KT = 346 * MiB, WS_VT = 362 * MiB;
constexpr size_t WS_ROPE = 378 * MiB;
constexpr size_t WS_END = 384 * MiB;

struct Params {
    const float* x; const float* c; const int* pos; const float* w_ada; const float* b_ada; const float* norm_mix_g; const float* w_in;
    const float* b_gates; const float* conv_w; const float* conv_b; const float* q_lora_g; const float* w_uq; const float* kv_lora_g;
    const float* w_ukv; const float* q_norm_g; const float* k_norm_g; const float* mlstm_norm_g; const float* w_out; const float* norm_mlp_g;
    const float* w_ff1; const float* w_ff2;
    float* out; unsigned char* ws; int ph_lo, ph_hi;
};

__host__ __device__ __forceinline__ size_t cst_off(int dh) { return dh < 6 ? WS_PB + (size_t)dh * (8 * MiB) : WS_WIN + (size_t)(dh - 6) * (8 * MiB); }
#define LAUNDER_V(x) asm volatile("" : "+v"(x))
#define LAUNDER_S(x) asm volatile("" : "+s"(x))
constexpr int LDS_WIDTAB = 147456 - 64 - 256;
__device__ __forceinline__ int tid_opaque() {
    const unsigned hw = __builtin_amdgcn_s_getreg((5 << 11) | 4) & 63u;
    const int wid = *(volatile LAS int*)(uintptr_t)(LDS_WIDTAB + hw * 4);
    int t = wid * 64 + (int)__builtin_amdgcn_mbcnt_hi(~0u, __builtin_amdgcn_mbcnt_lo(~0u, 0u)); LAUNDER_V(t); return t; }
__device__ __forceinline__ unsigned cvt_pk_bf16(float lo, float hi) { unsigned r; asm volatile("v_cvt_pk_bf16_f32 %0, %1, %2" : "=v"(r) : "v"(lo), "v"(hi)); return r; }
__device__ __forceinline__ float bf_lo(unsigned w) { return __uint_as_float(w << 16); }
__device__ __forceinline__ float bf_hi(unsigned w) { return __uint_as_float(w & 0xffff0000u); }
__device__ __forceinline__ float bf2f(bf16_t b) { return __uint_as_float(((unsigned)b) << 16); }
__device__ __forceinline__ bf16_t f2bf(float f) { return (bf16_t)(cvt_pk_bf16(f, 0.f) & 0xffffu); }
__device__ __forceinline__ int lane_opaque() { int l = (int)__builtin_amdgcn_mbcnt_hi(~0u, __builtin_amdgcn_mbcnt_lo(~0u, 0u)); LAUNDER_V(l); return l; }
__device__ __forceinline__ float shx(float v, int m) { return __int_as_float(__builtin_amdgcn_ds_bpermute((lane_opaque() ^ m) << 2, __float_as_int(v))); }
__device__ __forceinline__ float shidx(float v, int i) { return __int_as_float(__builtin_amdgcn_ds_bpermute(i << 2, __float_as_int(v))); }
__device__ __forceinline__ float shup(float v, int o) { return __int_as_float(__builtin_amdgcn_ds_bpermute((lane_opaque() - o) << 2, __float_as_int(v))); }
__device__ __forceinline__ float wave_sum(float v) {
#pragma unroll
    for (int o = 1; o < 64; o <<= 1) v += shx(v, o);
    return v;
}
template <class T> __device__ __forceinline__ T ldgu(const void* ubase, unsigned voff) { return *(const T*)((const char*)ubase + voff); }
__device__ __forceinline__ float silu_f(float v) { return v / (1.f + __expf(-v)); }
__device__ __forceinline__ float sigmoid_f(float v) { return 1.f / (1.f + __expf(-v)); }
__device__ __forceinline__ void unpack8(u32x4 w, float* f) {
    f[0] = bf_lo(w.x); f[1] = bf_hi(w.x); f[2] = bf_lo(w.y); f[3] = bf_hi(w.y); f[4] = bf_lo(w.z); f[5] = bf_hi(w.z); f[6] = bf_lo(w.w); f[7] = bf_hi(w.w);
}
__device__ __forceinline__ u32x2 pack8_fp8(const float* f) {
    int a = 0, b = 0; a = __builtin_amdgcn_cvt_pk_fp8_f32(f[0], f[1], a, false); a = __builtin_amdgcn_cvt_pk_fp8_f32(f[2], f[3], a, true);
    b = __builtin_amdgcn_cvt_pk_fp8_f32(f[4], f[5], b, false); b = __builtin_amdgcn_cvt_pk_fp8_f32(f[6], f[7], b, true); u32x2 w; w.x = (unsigned)a; w.y = (unsigned)b; return w; }
__device__ __forceinline__ u32x4 pack8(const float* f) {
    u32x4 w; w.x = cvt_pk_bf16(f[0], f[1]); w.y = cvt_pk_bf16(f[2], f[3]); w.z = cvt_pk_bf16(f[4], f[5]); w.w = cvt_pk_bf16(f[6], f[7]); return w;
}

namespace pg8 {
constexpr int BM = 256, BK = 64, HALF = 128, HTB = HALF * BK * 2, STAGE_BYTES = 8 * HTB, NXCD = 8, WGM = 8;
__host__ __device__ __forceinline__ int lds_byte(int r, int c) { const int st = (r >> 4) * 2 + (c >> 5), rr = r & 15, cc = c & 31, ob = rr * 64 + cc * 2; return st * 1024 + (ob ^ (((ob >> 9) & 1) << 5)); }
__host__ __device__ __forceinline__ void stage_rc(int b, int& R, int& C) { const int st = b / 1024, sb = b % 1024, swz = sb ^ (((sb >> 9) & 1) << 5); R = (st >> 1) * 16 + swz / 64; C = (st & 1) * 32 + (swz % 64) / 2; }
__host__ __device__ __forceinline__ int perm32(int rho) { const int n = rho >> 4, i = rho & 15; return 8 * (i >> 2) + 4 * n + (i & 3); }
struct Unit { int pm, pn; };
struct Gemm { const bf16_t* A; const bf16_t* Bt; int M, N, K; };
struct StaticOrder {
    int nM, nN, nwg, G, c;
    __host__ __device__ void init(int M, int N, int G_, int c_) { nM = M / BM; nN = N / BM; nwg = nM * nN; G = G_; c = c_; }
    __host__ __device__ bool next(int i, Unit& u) const {
        const long L = (long)i * G + c; if (L >= nwg) return false;
        int wgid = (int)L; { const int q = nwg / NXCD, r = nwg % NXCD, xcd = wgid % NXCD, off = wgid / NXCD; wgid = (xcd < r ? xcd * (q + 1) : r * (q + 1) + (xcd - r) * q) + off; }
        const int nig = WGM * nN, gid = wgid / nig, fm = gid * WGM, gsz = (nM - fm) < WGM ? (nM - fm) : WGM;
        u.pm = fm + ((wgid % nig) % gsz); u.pn = (wgid % nig) / gsz; return true;
    }
    __device__ __forceinline__ void a_ready(const Unit&) const {}
    __device__ __forceinline__ void done(const Unit&) const {}
};
template <class F> struct Epi8 {
    static constexpr bool PERM = true, AFTER_DRAIN = false; F f;
    __device__ __forceinline__ void operator()(const f32x4 (&acc)[2][2][4][2], const Unit& u, int wr, int wc, int fr, int fq) const {
        const int row0 = u.pm * BM + wr * 64 + fr, col0 = u.pn * BM + wc * 32 + 8 * fq;
#pragma unroll
        for (int ai = 0; ai < 2; ++ai)
#pragma unroll
            for (int m = 0; m < 4; ++m)
#pragma unroll
                for (int bj = 0; bj < 2; ++bj) f(row0 + ai * HALF + m * 16, col0 + bj * HALF, acc[ai][bj][m][0], acc[ai][bj][m][1]);
    }
};
template <class F> struct Epi4 {
    static constexpr bool PERM = false, AFTER_DRAIN = false; F f;
    __device__ __forceinline__ void operator()(const f32x4 (&acc)[2][2][4][2], const Unit& u, int wr, int wc, int fr, int fq) const {
        const int row0 = u.pm * BM + wr * 64 + fr, col0 = u.pn * BM + wc * 32 + 4 * fq;
#pragma unroll
        for (int ai = 0; ai < 2; ++ai)
#pragma unroll
            for (int m = 0; m < 4; ++m) {
#pragma unroll
                for (int bj = 0; bj < 2; ++bj)
#pragma unroll
                    for (int n = 0; n < 2; ++n) f(row0 + ai * HALF + m * 16, col0 + bj * HALF + n * 16, acc[ai][bj][m][n]);
                if (m & 1) asm volatile("" ::: "memory");
            }
    }
};

template <class Epi, class Sched, bool ALIGN_EPI = false, bool SP2 = false>
__device__ __forceinline__ void gemm_phase(LAS unsigned char* lds, const Gemm g, const Sched& S, const Epi& E) {
    const int tid = tid_opaque(), wid = __builtin_amdgcn_readfirstlane(tid >> 6), lane = tid & 63, wr = wid >> 2, wc = wid & 3, fr = lane & 15, fq = lane >> 4;
    const int K = g.K, nt = K / BK;
    unsigned voffA[2], voffB[2];
#pragma unroll
    for (int i = 0; i < 2; ++i) { int R, C; stage_rc(tid * 16 + i * 8192, R, C); const int Rb = Epi::PERM ? ((R & ~31) + perm32(R & 31)) : R;
        voffA[i] = (unsigned)(R * K + C) * 2u; voffB[i] = (unsigned)(Rb * K + C) * 2u; }
    const size_t kstep = (size_t)(BK * 2);
    const size_t hstep = (size_t)HALF * K * 2;
    const size_t tstep = 2 * hstep;
    const unsigned ldsw = (unsigned)wid * 1024u;
    const int aoff = lds_byte(wr * 64 + fr, fq * 8), boff = lds_byte(wc * 32 + fr, fq * 8);
#define PG8_SA(b, h) (((b) * 2 + (h)) * HTB)
#define PG8_SB(b, h) ((4 + (b) * 2 + (h)) * HTB)
#define PG8_STAGE(bufoff, gbase, voff) do { _Pragma("unroll") for (int _i = 0; _i < 2; ++_i) \
        __builtin_amdgcn_global_load_lds((const unsigned*)((const char*)(gbase) + (voff)[_i]), (LAS unsigned*)(lds + (bufoff) + ldsw + _i * 8192), 16, 0, 0); } while (0)
#define PG8_LDA(dst, b, h) do { _Pragma("unroll") for (int m = 0; m < 4; ++m) _Pragma("unroll") for (int k = 0; k < 2; ++k) dst[m][k] = *(const LAS bf16x8*)(lds + PG8_SA(b, h) + aoff + m * 2048 + k * 1024); } while (0)
#define PG8_LDB(dst, b, h) do { _Pragma("unroll") for (int n = 0; n < 2; ++n) _Pragma("unroll") for (int k = 0; k < 2; ++k) dst[n][k] = *(const LAS bf16x8*)(lds + PG8_SB(b, h) + boff + n * 2048 + k * 1024); } while (0)
#define PG8_MMA(ai, bj, At, Bt) do { __builtin_amdgcn_s_setprio(1); _Pragma("unroll") for (int m = 0; m < 4; ++m) _Pragma("unroll") for (int n = 0; n < 2; ++n) _Pragma("unroll") for (int k = 0; k < 2; ++k) \
        acc[ai][bj][m][n] = __builtin_amdgcn_mfma_f32_16x16x32_bf16(Bt[n][k], At[m][k], acc[ai][bj][m][n], 0, 0, 0); __builtin_amdgcn_s_setprio(0); } while (0)
#define PG8_WAIT_V(n) asm volatile("s_waitcnt vmcnt(" #n ")" ::: "memory")
#define PG8_WAIT_L(n) asm volatile("s_waitcnt lgkmcnt(" #n ")" ::: "memory")
#define PG8_BAR __builtin_amdgcn_s_barrier()
#define PG8_SCHED __builtin_amdgcn_sched_barrier(0)
    Unit cur, nxt; int ui = 0;
    if (!S.next(0, cur)) return;
    f32x4 acc[2][2][4][2];
#pragma unroll
    for (int a = 0; a < 2; ++a)
#pragma unroll
        for (int b = 0; b < 2; ++b)
#pragma unroll
            for (int m = 0; m < 4; ++m)
#pragma unroll
                for (int n = 0; n < 2; ++n) acc[a][b][m][n] = (f32x4){0.f, 0.f, 0.f, 0.f};
    bf16x8 At[4][2], B0[2][2], B1[2][2];
    const char* cA = (const char*)g.A + (size_t)cur.pm * tstep; const char* cB = (const char*)g.Bt + (size_t)cur.pn * tstep;
    S.a_ready(cur);
    if constexpr (SP2) {
        PG8_STAGE(PG8_SB(0, 0), cB, voffB); PG8_STAGE(PG8_SB(0, 1), cB + hstep, voffB); PG8_STAGE(PG8_SA(0, 0), cA, voffA); PG8_STAGE(PG8_SA(0, 1), cA + hstep, voffA);
        if (wr == 1) PG8_BAR;
        PG8_WAIT_V(2); PG8_BAR;
        PG8_STAGE(PG8_SB(1, 0), cB + kstep, voffB); PG8_STAGE(PG8_SA(1, 0), cA + kstep, voffA); PG8_STAGE(PG8_SB(1, 1), cB + hstep + kstep, voffB);
        PG8_WAIT_V(6); PG8_BAR;
    } else {
        PG8_STAGE(PG8_SB(0, 0), cB, voffB); PG8_STAGE(PG8_SA(0, 0), cA, voffA); PG8_STAGE(PG8_SB(0, 1), cB + hstep, voffB); PG8_STAGE(PG8_SA(0, 1), cA + hstep, voffA);
        if (wr == 1) PG8_BAR;
        PG8_WAIT_V(4); PG8_BAR;
        PG8_STAGE(PG8_SB(1, 0), cB + kstep, voffB); PG8_STAGE(PG8_SA(1, 0), cA + kstep, voffA); PG8_STAGE(PG8_SB(1, 1), cB + hstep + kstep, voffB);
        PG8_WAIT_V(6); PG8_BAR;
    }
    for (;;) {
        const bool has_next = S.next(ui + 1, nxt);
        const char* nA = has_next ? (const char*)g.A + (size_t)nxt.pm * tstep : cA; const char* nB = has_next ? (const char*)g.Bt + (size_t)nxt.pn * tstep : cB;
#pragma unroll 1
        for (int t = 0; t < nt; t += 2) {
            const bool last = (t == nt - 2);
            const char* a1 = cA + (size_t)(t + 1) * kstep;
            const char* a2 = last ? nA : cA + (size_t)(t + 2) * kstep; const char* b2 = last ? nB : cB + (size_t)(t + 2) * kstep;
            const char* a3 = a2 + kstep; const char* b3 = b2 + kstep;
            if (last && has_next) S.a_ready(nxt);
            if constexpr (SP2) {
            PG8_LDB(B0, 0, 0); PG8_LDB(B1, 0, 1); PG8_SCHED; PG8_LDA(At, 0, 0); PG8_STAGE(PG8_SA(1, 1), a1 + hstep, voffA);
            PG8_WAIT_V(8); PG8_WAIT_L(0); PG8_BAR; PG8_MMA(0, 0, At, B0); PG8_MMA(0, 1, At, B1); PG8_BAR; PG8_SCHED;
            PG8_LDA(At, 0, 1); PG8_STAGE(PG8_SB(0, 0), b2, voffB); PG8_STAGE(PG8_SB(0, 1), b2 + hstep, voffB); PG8_STAGE(PG8_SA(0, 0), a2, voffA);
            PG8_WAIT_V(8); PG8_WAIT_L(0); PG8_BAR; PG8_MMA(1, 0, At, B0); PG8_MMA(1, 1, At, B1); PG8_BAR; PG8_SCHED;
            PG8_LDB(B0, 1, 0); PG8_LDB(B1, 1, 1); PG8_SCHED; PG8_LDA(At, 1, 0); PG8_STAGE(PG8_SA(0, 1), a2 + hstep, voffA);
            PG8_WAIT_V(8); PG8_WAIT_L(0); PG8_BAR; PG8_MMA(0, 0, At, B0); PG8_MMA(0, 1, At, B1); PG8_BAR; PG8_SCHED;
            PG8_LDA(At, 1, 1); PG8_STAGE(PG8_SB(1, 0), b3, voffB); PG8_STAGE(PG8_SB(1, 1), b3 + hstep, voffB); PG8_STAGE(PG8_SA(1, 0), a3, voffA);
            PG8_WAIT_V(8); PG8_WAIT_L(0); PG8_BAR; PG8_MMA(1, 0, At, B0); PG8_MMA(1, 1, At, B1); PG8_BAR; PG8_SCHED;
            } else {
            PG8_LDB(B0, 0, 0); PG8_SCHED; PG8_LDA(At, 0, 0); PG8_STAGE(PG8_SA(1, 1), a1 + hstep, voffA);
            PG8_WAIT_L(8); PG8_BAR; PG8_WAIT_L(0); PG8_MMA(0, 0, At, B0); PG8_BAR; PG8_SCHED;
            PG8_LDB(B1, 0, 1); PG8_STAGE(PG8_SB(0, 0), b2, voffB);
            PG8_BAR; PG8_WAIT_L(0); PG8_MMA(0, 1, At, B1); PG8_BAR;
            PG8_LDA(At, 0, 1); PG8_STAGE(PG8_SA(0, 0), a2, voffA);
            PG8_BAR; PG8_WAIT_L(0); PG8_MMA(1, 0, At, B0); PG8_BAR; PG8_SCHED;
            PG8_STAGE(PG8_SB(0, 1), b2 + hstep, voffB);
            PG8_WAIT_V(6); PG8_BAR; PG8_MMA(1, 1, At, B1); PG8_BAR;
            PG8_LDB(B0, 1, 0); PG8_SCHED; PG8_LDA(At, 1, 0); PG8_STAGE(PG8_SA(0, 1), a2 + hstep, voffA);
            PG8_WAIT_L(8); PG8_BAR; PG8_WAIT_L(0); PG8_MMA(0, 0, At, B0); PG8_BAR; PG8_SCHED;
            PG8_LDB(B1, 1, 1); PG8_STAGE(PG8_SB(1, 0), b3, voffB);
            PG8_BAR; PG8_WAIT_L(0); PG8_MMA(0, 1, At, B1); PG8_BAR;
            PG8_LDA(At, 1, 1); PG8_STAGE(PG8_SA(1, 0), a3, voffA);
            PG8_BAR; PG8_WAIT_L(0); PG8_MMA(1, 0, At, B0); PG8_BAR; PG8_SCHED;
            PG8_STAGE(PG8_SB(1, 1), b3 + hstep, voffB);
            PG8_WAIT_V(6); PG8_BAR; PG8_MMA(1, 1, At, B1); PG8_BAR;
            }
        }
        if constexpr (ALIGN_EPI) { if (wr == 0) PG8_BAR; }
        if constexpr (!Epi::AFTER_DRAIN) { E(acc, cur, wr, wc, fr, fq); S.done(cur); }
        if (!has_next) break;
#pragma unroll
        for (int a = 0; a < 2; ++a)
#pragma unroll
            for (int b = 0; b < 2; ++b)
#pragma unroll
                for (int m = 0; m < 4; ++m)
#pragma unroll
                    for (int n = 0; n < 2; ++n) acc[a][b][m][n] = (f32x4){0.f, 0.f, 0.f, 0.f};
        cur = nxt; cA = nA; cB = nB; ++ui;
        if constexpr (ALIGN_EPI) { if (wr == 1) PG8_BAR; }
    }
    PG8_WAIT_V(0);
    if constexpr (!ALIGN_EPI) { if (wr == 0) PG8_BAR; }
    PG8_BAR;
#undef PG8_SA
#undef PG8_SB
#undef PG8_STAGE
#undef PG8_LDA
#undef PG8_LDB
#undef PG8_MMA
#undef PG8_WAIT_V
#undef PG8_WAIT_L
#undef PG8_BAR
#undef PG8_SCHED
}
}

namespace att {
constexpr int NW = 8, QBLK = 32, KVBLK = 64;
constexpr int LDQ = NH * DQK, LDK = NH * DQK, LDV = NH * 256, LDO = DM;
constexpr float SCALE = 0.07216878364870322f;
constexpr float THR = 8.f;
constexpr int SHM_K = KVBLK * DQK * 2, SHM_V = KVBLK * DV * 2;
constexpr int SHM_QL = 2 * SHM_V + 2 * SHM_K + NW * 64 * 4;
constexpr int SHM_ATTN = SHM_QL + NW * 4096;
#define KSWZ(row, colB) ((row) * 384 + ((colB) ^ ((((row) >> 1) & 7) << 4)))
#define SBAR() __builtin_amdgcn_sched_barrier(0)
__device__ __forceinline__ int crow(int r, int hi) { return (r & 3) + 8 * (r >> 2) + 4 * hi; }
__device__ __forceinline__ void partialSM(f32x16& p0, f32x16& p1, float& m_reg, float& mn, float& alpha) {
    constexpr float C = SCALE * 1.4426950408889634f;
    float pmax = p0[0];
#pragma unroll
    for (int r = 1; r < 16; ++r) pmax = fmaxf(pmax, p0[r]);
#pragma unroll
    for (int r = 0; r < 16; ++r) pmax = fmaxf(pmax, p1[r]);
    { auto rr = __builtin_amdgcn_permlane32_swap(__float_as_uint(pmax), __float_as_uint(pmax), false, false);
      pmax = fmaxf(__uint_as_float(rr[0]), __uint_as_float(rr[1])); }
    if (__builtin_expect(__all(pmax - m_reg <= THR / SCALE), 1)) { mn = m_reg; alpha = 1.f; }
    else { mn = fmaxf(m_reg, pmax); alpha = __builtin_amdgcn_exp2f((m_reg - mn) * C); m_reg = mn; }
    float mnC = -mn * C;
#pragma unroll
    for (int r = 0; r < 16; ++r) p0[r] = fmaf(p0[r], C, mnC);
#pragma unroll
    for (int r = 0; r < 16; ++r) p1[r] = fmaf(p1[r], C, mnC);
#pragma unroll
    for (int r = 0; r < 16; ++r) p0[r] = __builtin_amdgcn_exp2f(p0[r]);
}
__device__ __forceinline__ void finishSM(f32x16& p0, f32x16& p1, float alpha, float& l_reg, bf16x8& pa0, bf16x8& pa1, bf16x8& pa2, bf16x8& pa3) {
#pragma unroll
    for (int r = 0; r < 16; ++r) p1[r] = __builtin_amdgcn_exp2f(p1[r]);
    float ps = 0;
#pragma unroll
    for (int r = 0; r < 16; ++r) ps += p0[r];
#pragma unroll
    for (int r = 0; r < 16; ++r) ps += p1[r];
    { auto rr = __builtin_amdgcn_permlane32_swap(__float_as_uint(ps), __float_as_uint(ps), false, false);
      ps = __uint_as_float(rr[0]) + __uint_as_float(rr[1]); }
    l_reg = l_reg * alpha + ps;
#define PK4(P, BASE, OUT) do { unsigned a0 = cvt_pk_bf16(P[BASE + 0], P[BASE + 1]), a1 = cvt_pk_bf16(P[BASE + 2], P[BASE + 3]);   \
    unsigned b0 = cvt_pk_bf16(P[BASE + 4], P[BASE + 5]), b1 = cvt_pk_bf16(P[BASE + 6], P[BASE + 7]);                              \
    auto r0 = __builtin_amdgcn_permlane32_swap(a0, b0, false, false); auto r1 = __builtin_amdgcn_permlane32_swap(a1, b1, false, false); \
    u32x4 w = {r0[0], r1[0], r0[1], r1[1]}; OUT = *reinterpret_cast<bf16x8*>(&w); } while (0)
    PK4(p0, 0, pa0); PK4(p0, 8, pa1); PK4(p1, 0, pa2); PK4(p1, 8, pa3);
#undef PK4
}
__device__ __forceinline__ void qkt(f32x16& p0, f32x16& p1, const char* Ks, const bf16x8* qr, const char* ql, int r32, int hi) {
    p0 = f32x16{}; p1 = f32x16{};
#pragma unroll
    for (int d0 = 0; d0 < 12; ++d0) { const int cb = (d0 * 16 + hi * 8) * 2;
        bf16x8 b0 = *reinterpret_cast<const bf16x8*>(Ks + KSWZ(r32, cb));
        bf16x8 b1 = *reinterpret_cast<const bf16x8*>(Ks + KSWZ(32 + r32, cb));
        const bf16x8 q = d0 < 8 ? qr[d0 < 8 ? d0 : 0] : *reinterpret_cast<const bf16x8*>(ql + (d0 - 8) * 1024);
        p0 = __builtin_amdgcn_mfma_f32_32x32x16_bf16(b0, q, p0, 0, 0, 0);
        p1 = __builtin_amdgcn_mfma_f32_32x32x16_bf16(b1, q, p1, 0, 0, 0); }
}
__device__ __forceinline__ int v_st(int k, int c) { const int kk = (k & ~0xC) | ((k & 4) << 1) | ((k & 8) >> 1); return ((kk >> 3) * 4 + (c >> 5)) * 512 + ((kk & 7) * 32 + (c & 31)) * 2; }
__device__ __forceinline__ int v_rd_base(int lane) { return ((lane & 3) << 3) | (((lane >> 2) & 3) << 6) | (((lane >> 4) & 1) << 5) | (((lane >> 5) & 1) << 8); }
constexpr int v_rd_off(int d0, int ks, int half) { return d0 * 512 + ks * 4096 + half * 2048; }
template <int OFF> __device__ __forceinline__ s16x4 tr_read(int vb) {
    s16x4 r; asm volatile("ds_read_b64_tr_b16 %0, %1 offset:%2" : "=&v"(r) : "v"(vb), "i"(OFF) : "memory"); return r;
}
template <int D0> __device__ __forceinline__ void pv_one(f32x16& od, int vb, bf16x8 pa0, bf16x8 pa1, bf16x8 pa2, bf16x8 pa3) {
#define PK(L, H) (bf16x8){L[0], L[1], L[2], L[3], H[0], H[1], H[2], H[3]}
    { const s16x4 l0 = tr_read<v_rd_off(D0, 0, 0)>(vb), h0 = tr_read<v_rd_off(D0, 0, 1)>(vb), l1 = tr_read<v_rd_off(D0, 1, 0)>(vb), h1 = tr_read<v_rd_off(D0, 1, 1)>(vb);
      asm volatile("s_waitcnt lgkmcnt(0)" ::: "memory"); SBAR();
      od = __builtin_amdgcn_mfma_f32_32x32x16_bf16(pa0, PK(l0, h0), od, 0, 0, 0);
      od = __builtin_amdgcn_mfma_f32_32x32x16_bf16(pa1, PK(l1, h1), od, 0, 0, 0); }
    { const s16x4 l2 = tr_read<v_rd_off(D0, 2, 0)>(vb), h2 = tr_read<v_rd_off(D0, 2, 1)>(vb), l3 = tr_read<v_rd_off(D0, 3, 0)>(vb), h3 = tr_read<v_rd_off(D0, 3, 1)>(vb);
      asm volatile("s_waitcnt lgkmcnt(0)" ::: "memory"); SBAR();
      od = __builtin_amdgcn_mfma_f32_32x32x16_bf16(pa2, PK(l2, h2), od, 0, 0, 0);
      od = __builtin_amdgcn_mfma_f32_32x32x16_bf16(pa3, PK(l3, h3), od, 0, 0, 0); }
#undef PK
}
__device__ __forceinline__ void pv_d0(f32x16* o, int vb, bf16x8 pa0, bf16x8 pa1, bf16x8 pa2, bf16x8 pa3) {
    pv_one<0>(o[0], vb, pa0, pa1, pa2, pa3); pv_one<1>(o[1], vb, pa0, pa1, pa2, pa3); pv_one<2>(o[2], vb, pa0, pa1, pa2, pa3); pv_one<3>(o[3], vb, pa0, pa1, pa2, pa3);
}
#ifndef ATT_SDEPTH
#define ATT_SDEPTH 1
#endif
constexpr int SDEPTH = ATT_SDEPTH;
typedef int v8i __attribute__((ext_vector_type(8)));
constexpr int K8S = 208;
__device__ __forceinline__ void qkt8(f32x16& p0, f32x16& p1, const char* Ks, const v8i* qr8, int r32, int hi) {
    p0 = f32x16{}; p1 = f32x16{};
#pragma unroll
    for (int ks = 0; ks < 3; ++ks) {
        const char* a0p = Ks + r32 * K8S + ks * 64 + hi * 32; const char* a1p = a0p + 32 * K8S;
        const u32x4 a0l = *(const u32x4*)a0p, a0h = *(const u32x4*)(a0p + 16), a1l = *(const u32x4*)a1p, a1h = *(const u32x4*)(a1p + 16);
        const v8i A0 = {(int)a0l.x, (int)a0l.y, (int)a0l.z, (int)a0l.w, (int)a0h.x, (int)a0h.y, (int)a0h.z, (int)a0h.w};
        const v8i A1 = {(int)a1l.x, (int)a1l.y, (int)a1l.z, (int)a1l.w, (int)a1h.x, (int)a1h.y, (int)a1h.z, (int)a1h.w};
        p0 = __builtin_amdgcn_mfma_scale_f32_32x32x64_f8f6f4(A0, qr8[ks], p0, 0, 0, 0, 0, 0, 0);
        p1 = __builtin_amdgcn_mfma_scale_f32_32x32x64_f8f6f4(A1, qr8[ks], p1, 0, 0, 0, 0, 0, 0); }
}
template <bool F8>
__device__ __forceinline__ void attn_unit(const void* __restrict__ Qbv, const void* __restrict__ Khv, const bf16_t* __restrict__ Vh, bf16_t* __restrict__ Ob, int seq, char* lds) {
    const int tid = tid_opaque(), wid = tid >> 6, lane = tid & 63, r32 = lane & 31, hi = lane >> 5;
    char* V_lds = lds; char* K_lds = lds + 2 * SHM_V;
    float* ws = (float*)(lds + 2 * SHM_V + 2 * SHM_K) + wid * 64; float* li_l = ws; float* al_l = ws + 32;
    float m_reg = -1e30f, l_reg = 0; f32x16 o[4] = {};
    bf16x8 qr[F8 ? 1 : 8]; v8i qr8[F8 ? 3 : 1];
    char* ql = lds + SHM_QL + wid * 4096 + lane * 16;
    if constexpr (F8) {
        const unsigned char* Qw = (const unsigned char*)Qbv + (long)(wid * QBLK + r32) * (NH * DQK) + hi * 32;
#pragma unroll
        for (int ks = 0; ks < 3; ++ks) { const u32x4 lo = *(const u32x4*)(Qw + ks * 64), hh = *(const u32x4*)(Qw + ks * 64 + 16);
            qr8[ks] = (v8i){(int)lo.x, (int)lo.y, (int)lo.z, (int)lo.w, (int)hh.x, (int)hh.y, (int)hh.z, (int)hh.w}; }
    } else {
        const bf16_t* Qw = (const bf16_t*)Qbv + (long)(wid * QBLK + r32) * LDQ + hi * 8;
#pragma unroll
        for (int d0 = 0; d0 < 8; ++d0) qr[d0] = *reinterpret_cast<const bf16x8*>(Qw + d0 * 16);
#pragma unroll
        for (int d0 = 8; d0 < 12; ++d0) *reinterpret_cast<bf16x8*>(ql + (d0 - 8) * 1024) = *reinterpret_cast<const bf16x8*>(Qw + d0 * 16);
    }
    const int krow = tid >> 3, kc8 = tid & 7;
    const int id1 = 512 + (tid & 255);
    const unsigned kgo = F8 ? (unsigned)((tid / 12) * (NH * DQK) + (tid % 12) * 16) : (unsigned)(krow * LDK + kc8 * 8) * 2u;
    const int kso = F8 ? (tid / 12) * K8S + (tid % 12) * 16 : krow * 384 + ((kc8 * 16) ^ (((krow >> 1) & 7) << 4));
    const unsigned kgo1 = (unsigned)((id1 / 12) * (NH * DQK) + (id1 % 12) * 16); const int kso1 = (id1 / 12) * K8S + (id1 % 12) * 16; const bool k1on = tid < 256;
    const int sr = tid >> 4, sc = (tid & 15) * 8, vst0 = v_st(sr, sc);
    const unsigned vgo = (unsigned)(sr * LDV + sc) * 2u;
    const int vb0 = (int)(uintptr_t)V_lds + v_rd_base(lane);
    struct { bf16x8 k0, k1, k2, v0, v1; } sr_[SDEPTH];
#define SLOAD(i, kk0) do { const char* vp_ = (const char*)(Vh + (long)(kk0) * LDV); \
    sr_[i].v0 = ldgu<bf16x8>(vp_, vgo); sr_[i].v1 = ldgu<bf16x8>(vp_ + 32 * LDV * 2, vgo); \
    if constexpr (F8) { const char* kp_ = (const char*)Khv + (long)(kk0) * (NH * DQK); sr_[i].k0 = ldgu<bf16x8>(kp_, kgo); if (k1on) sr_[i].k1 = ldgu<bf16x8>(kp_, kgo1); } \
    else { const char* kp_ = (const char*)((const bf16_t*)Khv + (long)(kk0) * LDK); sr_[i].k0 = ldgu<bf16x8>(kp_, kgo); sr_[i].k1 = ldgu<bf16x8>(kp_ + 128, kgo); sr_[i].k2 = ldgu<bf16x8>(kp_ + 256, kgo); } } while (0)
#define SWRITE(b, i) do { *(bf16x8*)(V_lds + (b) * SHM_V + vst0) = sr_[i].v0; *(bf16x8*)(V_lds + (b) * SHM_V + 8192 + vst0) = sr_[i].v1; \
    if constexpr (F8) { *(bf16x8*)(K_lds + (b) * SHM_K + kso) = sr_[i].k0; if (k1on) *(bf16x8*)(K_lds + (b) * SHM_K + kso1) = sr_[i].k1; } \
    else { *(bf16x8*)(K_lds + (b) * SHM_K + kso) = sr_[i].k0; *(bf16x8*)(K_lds + (b) * SHM_K + 128 + kso) = sr_[i].k1; *(bf16x8*)(K_lds + (b) * SHM_K + 256 + kso) = sr_[i].k2; } } while (0)
#define SWAIT() do { if constexpr (SDEPTH == 2) asm volatile("s_waitcnt vmcnt(5)" ::: "memory"); else asm volatile("s_waitcnt vmcnt(0)" ::: "memory"); } while (0)
#define RESC(a) do { if (__any((a) < 1.f)) { if (hi == 0) al_l[r32] = (a); asm volatile("s_waitcnt lgkmcnt(0)" ::: "memory"); \
    _Pragma("unroll") for (int d = 0; d < 4; ++d) _Pragma("unroll") for (int r = 0; r < 16; ++r) o[d][r] *= al_l[crow(r, hi)]; } } while (0)
#define QKT(P0, P1, KB) do { if constexpr (F8) qkt8(P0, P1, KB, qr8, r32, hi); else qkt(P0, P1, KB, qr, ql, r32, hi); } while (0)
    f32x16 pA0, pA1, pB0, pB1; float mnA, mnB, alA, alB; bf16x8 pa0, pa1, pa2, pa3; const int NT = seq / KVBLK;
    constexpr int SE = 0, SO = SDEPTH - 1;
    SLOAD(SE, 0); asm volatile("s_waitcnt vmcnt(0)" ::: "memory"); SWRITE(0, SE); __syncthreads();
    QKT(pA0, pA1, K_lds); partialSM(pA0, pA1, m_reg, mnA, alA);
    SLOAD(SO, KVBLK); if constexpr (SDEPTH == 2) { if (2 < NT) SLOAD(SE, 2 * KVBLK); }
    SWAIT(); SWRITE(1, SO); __syncthreads();
    for (int j = 1; j + 1 < NT; j += 2) {
        SBAR(); QKT(pB0, pB1, K_lds + SHM_K);
        finishSM(pA0, pA1, alA, l_reg, pa0, pa1, pa2, pa3); SBAR();
        SLOAD(SO, (j + SDEPTH) * KVBLK); SBAR();
        pv_d0(o, vb0, pa0, pa1, pa2, pa3); partialSM(pB0, pB1, m_reg, mnB, alB);
        __syncthreads(); SWAIT(); SWRITE(0, SE);
        RESC(alB); __syncthreads();
        SBAR(); QKT(pA0, pA1, K_lds);
        finishSM(pB0, pB1, alB, l_reg, pa0, pa1, pa2, pa3); SBAR();
        if (SDEPTH == 1 || j + 3 < NT) SLOAD(SE, (j + 1 + SDEPTH) * KVBLK); SBAR();
        pv_d0(o, vb0 + SHM_V, pa0, pa1, pa2, pa3); partialSM(pA0, pA1, m_reg, mnA, alA);
        __syncthreads(); SWAIT(); SWRITE(1, SO);
        RESC(alA); __syncthreads();
    }
    SBAR(); QKT(pB0, pB1, K_lds + SHM_K);
    finishSM(pA0, pA1, alA, l_reg, pa0, pa1, pa2, pa3); SBAR();
    pv_d0(o, vb0, pa0, pa1, pa2, pa3); partialSM(pB0, pB1, m_reg, mnB, alB);
    __syncthreads(); RESC(alB);
    finishSM(pB0, pB1, alB, l_reg, pa0, pa1, pa2, pa3); SBAR();
    pv_d0(o, vb0 + SHM_V, pa0, pa1, pa2, pa3);
    if (hi == 0) li_l[r32] = l_reg; asm volatile("s_waitcnt lgkmcnt(0)" ::: "memory");
    float rli[16];
#pragma unroll
    for (int r = 0; r < 16; ++r) rli[r] = __builtin_amdgcn_rcpf(li_l[crow(r, hi)]);
    bf16_t* Ow = Ob + (long)(wid * QBLK) * LDO;
#pragma unroll
    for (int r = 0; r < 16; ++r) { const int orow = crow(r, hi);
#pragma unroll
        for (int d0 = 0; d0 < 4; ++d0) Ow[(long)orow * LDO + d0 * 32 + r32] = f2bf(o[d0][r] * rli[r]); }
    __syncthreads();
#undef SLOAD
#undef SWRITE
#undef SWAIT
#undef RESC
#undef QKT
}
#undef SBAR
}

struct TrTile { f32x4 v[16]; };
__device__ __forceinline__ void tr_load(TrTile& t, const float* __restrict__ W, int N, int kb, int nb, int lane) {
    const int k0 = 64 * kb, n0 = 64 * nb; const int nq = 4 * (lane & 15), kr = lane >> 4; const bool ok = (n0 + nq) < N;
    const float* wp = W + (size_t)(k0 + kr) * N + n0 + nq;
#pragma unroll
    for (int i = 0; i < 16; ++i) { t.v[i] = (f32x4){0.f, 0.f, 0.f, 0.f}; if (ok) t.v[i] = __builtin_nontemporal_load((const f32x4*)(wp + (size_t)(4 * i) * N)); }
}
template <class RowMap>
__device__ __forceinline__ void tr_finish(const TrTile& t, int K, int N, bf16_t* __restrict__ WT, float* scr, int kb, int nb, int lane, RowMap rm) {
    const int k0 = 64 * kb, n0 = 64 * nb; const int nq = 4 * (lane & 15), kr = lane >> 4;
#pragma unroll
    for (int i = 0; i < 16; ++i) { float* d = scr + nq * 65 + 4 * i + kr; d[0] = t.v[i][0]; d[65] = t.v[i][1]; d[130] = t.v[i][2]; d[195] = t.v[i][3]; }
    asm volatile("s_waitcnt lgkmcnt(0)" ::: "memory");
    const int c = lane & 7;
#pragma unroll
    for (int j = 0; j < 8; ++j) { const int nl = (lane >> 3) + 8 * j; const int n = n0 + nl; const float* sp = scr + nl * 65 + 8 * c;
        u32x4 o; o.x = cvt_pk_bf16(sp[0], sp[1]); o.y = cvt_pk_bf16(sp[2], sp[3]); o.z = cvt_pk_bf16(sp[4], sp[5]); o.w = cvt_pk_bf16(sp[6], sp[7]);
        if (n < N) *(u32x4*)(WT + (size_t)rm(n) * K + k0 + 8 * c) = o; }
    asm volatile("s_waitcnt lgkmcnt(0)" ::: "memory");
}
template <class RowMap>
__device__ __forceinline__ void transpose_tile(const float* __restrict__ W, int K, int N, bf16_t* __restrict__ WT, float* scr, int kb, int nb, int lane, RowMap rm) {
    TrTile t; tr_load(t, W, N, kb, nb, lane); tr_finish(t, K, N, WT, scr, kb, nb, lane, rm);
}
struct RowId { __device__ __forceinline__ int operator()(int n) const { return n; } };
struct RowUq { __device__ __forceinline__ int operator()(int n) const { return (n / DQK) * 256 + (n % DQK); } };

__device__ __forceinline__ void phase0(const Params& P, char* lds, int G) {
    const int tid = tid_opaque(), lane = tid & 63, wave = tid >> 6;
    const int gw = blockIdx.x * NWAVES + wave, NGW = G * NWAVES;
    float* modp = (float*)(P.ws + WS_MODP);
    for (int task = gw; task < 1536; task += NGW) {
        const int ks = task / 48, cb = task % 48;
        const float s0 = silu_f(P.c[ks * 64 + lane]);
        f32x4 acc = {0.f, 0.f, 0.f, 0.f};
        const float* wp = P.w_ada + (size_t)(ks * 64) * (6 * DM) + cb * 256 + lane * 4;
#pragma unroll 16
        for (int kk = 0; kk < 64; ++kk) { const float sv = shidx(s0, kk); const f32x4 w = __builtin_nontemporal_load((const f32x4*)(wp + (size_t)kk * (6 * DM))); acc += w * sv; }
        { unsigned long long* pp = (unsigned long long*)(modp + (size_t)ks * (6 * DM) + cb * 256 + lane * 4);
          __hip_atomic_store(pp, ((unsigned long long)__float_as_uint(acc[1]) << 32) | __float_as_uint(acc[0]), __ATOMIC_RELAXED, __HIP_MEMORY_SCOPE_AGENT);
          __hip_atomic_store(pp + 1, ((unsigned long long)__float_as_uint(acc[3]) << 32) | __float_as_uint(acc[2]), __ATOMIC_RELAXED, __HIP_MEMORY_SCOPE_AGENT); }
        asm volatile("s_waitcnt vmcnt(0)" ::: "memory");
        unsigned old = 0u; if (lane == 0) old = __hip_atomic_fetch_add((unsigned*)(P.ws + WS_CNT) + cb * 16, 1u, __ATOMIC_RELAXED, __HIP_MEMORY_SCOPE_AGENT);
        old = __builtin_amdgcn_readfirstlane(old);
        if (old == 31u) {
            __builtin_amdgcn_fence(__ATOMIC_ACQUIRE, "agent");
            asm volatile("s_waitcnt vmcnt(0)" ::: "memory");
            f32x4 a = *(const f32x4*)(P.b_ada + cb * 256 + lane * 4);
#pragma unroll 8
            for (int k2 = 0; k2 < 32; ++k2) a += *(const f32x4*)(modp + (size_t)k2 * (6 * DM) + cb * 256 + lane * 4);
            *(f32x4*)((float*)(P.ws + WS_MOD) + cb * 256 + lane * 4) = a;
        }
    }
    { f32x2* rt = (f32x2*)(P.ws + WS_ROPE); const int i = lane & 31; const float freq = powf(10000.0f, -(float)i / 32.0f);
      for (int t = 2 * gw + (lane >> 5); t < SEQ; t += 2 * NGW) { float sn, cs; sincosf((float)P.pos[t] * freq, &sn, &cs); rt[(size_t)t * 32 + i] = (f32x2){cs, sn}; } }
    float* scr = (float*)(lds + wave * 17408);
    constexpr int I_IN = 32 * 78, I_UQ = 8 * 24, I_UKV = 4 * 32, I_OUT = 32 * 32, NIT = I_IN + I_UQ + I_UKV + I_OUT;
    auto src = [&](int it, const float*& W, int& N, int& kb, int& nb, int& kind) {
        int r = it;
        if (r < I_IN) { W = P.w_in; N = DIN; kb = r / 78; nb = r % 78; kind = 0; return; } r -= I_IN;
        if (r < I_UQ) { W = P.w_uq; N = NH * DQK; kb = r / 24; nb = r % 24; kind = 1; return; } r -= I_UQ;
        if (r < I_UKV) { W = P.w_ukv; N = NH * 256; kb = r / 32; nb = r % 32; kind = 2; return; } r -= I_UKV;
        W = P.w_out; N = DM; kb = r / 32; nb = r % 32; kind = 3; };
    int it = (gw + NGW - (1536 % NGW)) % NGW;
    if (it < NIT) {
        TrTile cur, nxt; const float* W; int N, kb, nb, kind;
        src(it, W, N, kb, nb, kind); tr_load(cur, W, N, kb, nb, lane);
        for (; it < NIT; it += NGW) {
            const int itn = it + NGW; const float* Wn = W; int Nn = N, kbn = kb, nbn = nb, kindn = kind;
            if (itn < NIT) { src(itn, Wn, Nn, kbn, nbn, kindn); tr_load(nxt, Wn, Nn, kbn, nbn, lane); }
            if (kind == 0) tr_finish(cur, DM, DIN, (bf16_t*)(P.ws + WS_WIN), scr, kb, nb, lane, RowId());
            else if (kind == 1) tr_finish(cur, QLORA, NH * DQK, (bf16_t*)(P.ws + WS_WUQ), scr, kb, nb, lane, RowUq());
            else if (kind == 2) tr_finish(cur, KVLORA, NH * 256, (bf16_t*)(P.ws + WS_WUKV), scr, kb, nb, lane, RowId());
            else tr_finish(cur, DM, DM, (bf16_t*)(P.ws + WS_WOUT), scr, kb, nb, lane, RowId());
            cur = nxt; W = Wn; N = Nn; kb = kbn; nb = nbn; kind = kindn;
        }
    }
}
__device__ __forceinline__ void norm_mod_rows(const float* __restrict__ src, const float* __restrict__ g, const float* sh, const float* sc, bf16_t* __restrict__ dst, int G) {
    const int tid = tid_opaque(), lane = tid & 63, wave = tid >> 6;
    const int gw = blockIdx.x * NWAVES + wave, NGW = G * NWAVES;
    for (int row0 = gw; row0 < SEQ; row0 += 4 * NGW) {
        f32x4 v[4][8]; float ss[4];
#pragma unroll
        for (int q = 0; q < 4; ++q) { const int row = row0 + q * NGW; const f32x4* xr = (const f32x4*)(src + (size_t)(row < SEQ ? row : row0) * DM) + lane;
#pragma unroll
            for (int j = 0; j < 8; ++j) v[q][j] = xr[64 * j]; }
#pragma unroll
        for (int q = 0; q < 4; ++q) { float a = 0.f;
#pragma unroll
            for (int j = 0; j < 8; ++j) a += (v[q][j].x * v[q][j].x + v[q][j].y * v[q][j].y) + (v[q][j].z * v[q][j].z + v[q][j].w * v[q][j].w);
            ss[q] = rsqrtf(wave_sum(a) * (1.f / DM) + EPS); }
#pragma unroll
        for (int j = 0; j < 8; ++j) { const int col = lane * 4 + 256 * j; const f32x4 gg = *(const f32x4*)(g + col); const f32x4 s1 = *(const f32x4*)(sc + col) + 1.f, s0 = *(const f32x4*)(sh + col);
#pragma unroll
            for (int q = 0; q < 4; ++q) { const int row = row0 + q * NGW;
                if (row < SEQ) { f32x4 y = v[q][j] * ss[q] * gg; y = y * s1 + s0; u32x2 w; w.x = cvt_pk_bf16(y.x, y.y); w.y = cvt_pk_bf16(y.z, y.w);
                    ((u32x2*)(dst + (size_t)row * DM) + lane)[64 * j] = w; } } }
    }
}
__device__ __forceinline__ void phase1a(const Params& P, char* lds, int G) {
    const int tid = tid_opaque();
    const float* mod = (const float*)(P.ws + WS_MOD);
    float* sh = (float*)lds; float* sc = sh + DM;
    for (int n = tid; n < 2 * DM; n += NTHREADS) sh[n] = mod[n];
    __syncthreads();
    norm_mod_rows(P.x, P.norm_mix_g, sh, sc, (bf16_t*)(P.ws + WS_H), G);
    __syncthreads();
}
__device__ __forceinline__ void ff_tile_src(const Params& P, int it, const float*& W, int& N, int& kb, int& nb) {
    constexpr int I_1 = 32 * 128;
    if (it < I_1) { W = P.w_ff1; N = DFF; kb = it / 128; nb = it % 128; } else { const int r = it - I_1; W = P.w_ff2; N = DM; kb = r / 32; nb = r % 32; }
}
__device__ __forceinline__ void ff_transposes(const Params& P, char* lds, int pidx, int np, int it0, int it1) {
    const int tid = tid_opaque(), lane = tid & 63, wave = tid >> 6;
    float* scr = (float*)(lds + wave * 17408);
    constexpr int I_1 = 32 * 128;
    const int stride = np * NWAVES;
    int it = it0 + pidx * NWAVES + wave;
    if (it >= it1) return;
    TrTile cur, nxt; const float* W; int N, kb, nb;
    ff_tile_src(P, it, W, N, kb, nb); tr_load(cur, W, N, kb, nb, lane);
    for (; it < it1; it += stride) {
        const int itn = it + stride; const float* Wn = W; int Nn = N, kbn = kb, nbn = nb;
        if (itn < it1) { ff_tile_src(P, itn, Wn, Nn, kbn, nbn); tr_load(nxt, Wn, Nn, kbn, nbn, lane); }
        if (it < I_1) tr_finish(cur, DM, DFF, (bf16_t*)(P.ws + WS_W1), scr, kb, nb, lane, RowId());
        else tr_finish(cur, DFF, DM, (bf16_t*)(P.ws + WS_W2), scr, kb, nb, lane, RowId());
        cur = nxt; W = Wn; N = Nn; kb = kbn; nb = nbn;
    }
}
constexpr int FFT_SPLIT = 4096, FFT_ALL = 8192;

__device__ __forceinline__ void phase6b(const Params& P, char* lds, int G) {
    const int tid = tid_opaque(), lane = tid & 63, wave = tid >> 6;
    const int gw = blockIdx.x * NWAVES + wave, NGW = G * NWAVES;
    const float* mod = (const float*)(P.ws + WS_MOD);
    float* sh = (float*)lds; float* sc = sh + DM;
    for (int n = tid; n < 2 * DM; n += NTHREADS) sh[n] = mod[3 * DM + n];
    __syncthreads();
    norm_mod_rows(P.out, P.norm_mlp_g, sh, sc, (bf16_t*)(P.ws + WS_H), G);
    __syncthreads();
    ff_transposes(P, lds, blockIdx.x, G, FFT_SPLIT, FFT_ALL);
}
__device__ __forceinline__ void phase2(const Params& P, char* lds, int G) {
    const int tid = tid_opaque(), lane = tid & 63, wave = tid >> 6;
    const int gw = blockIdx.x * NWAVES + wave, NGW = G * NWAVES;
    const bf16_t* pa = (const bf16_t*)(P.ws + WS_PA); const bf16_t* pb = (const bf16_t*)(P.ws + WS_PB);
    { bf16_t* cqn = (bf16_t*)(P.ws + WS_CQN); bf16_t* ckvn = (bf16_t*)(P.ws + WS_CKVN);
      float gq[8], gk[8];
#pragma unroll
      for (int e = 0; e < 8; ++e) { gq[e] = P.q_lora_g[lane * 8 + e]; gk[e] = P.kv_lora_g[(lane & 31) * 8 + e]; }
      for (int row0 = gw; row0 < SEQ; row0 += 4 * NGW) {
        u32x4 wq[4], wk[4];
#pragma unroll
        for (int q = 0; q < 4; ++q) { const int row = (row0 + q * NGW) < SEQ ? row0 + q * NGW : row0;
            wq[q] = *(const u32x4*)(pa + (size_t)row * PAW + OFF_CQ + lane * 8); wk[q] = *(const u32x4*)(pa + (size_t)row * PAW + OFF_CKV + (lane & 31) * 8); }
#pragma unroll
        for (int q = 0; q < 4; ++q) { const int row = row0 + q * NGW; if (row >= SEQ) break;
            float fq[8], fk[8]; unpack8(wq[q], fq); unpack8(wk[q], fk);
            float sq = 0.f, sk = 0.f;
#pragma unroll
            for (int e = 0; e < 8; ++e) { sq += fq[e] * fq[e]; sk += fk[e] * fk[e]; }
            if (lane >= 32) sk = 0.f;
            const float rq = rsqrtf(wave_sum(sq) * (1.f / QLORA) + EPS), rk = rsqrtf(wave_sum(sk) * (1.f / KVLORA) + EPS);
#pragma unroll
            for (int e = 0; e < 8; ++e) { fq[e] = fq[e] * rq * gq[e]; fk[e] = fk[e] * rk * gk[e]; }
            *(u32x4*)(cqn + (size_t)row * QLORA + lane * 8) = pack8(fq);
            if (lane < 32) *(u32x4*)(ckvn + (size_t)row * KVLORA + lane * 8) = pack8(fk); }
      } }
    { bf16_t* QH = (bf16_t*)(P.ws + WS_QH); bf16_t* KH = (bf16_t*)(P.ws + WS_KH); bf16_t* KT = (bf16_t*)(P.ws + WS_KT); bf16_t* VT = (bf16_t*)(P.ws + WS_VT);
      const int tg = tid >> 5, cgp = tid & 31, chl = cgp * 8;
      for (int item = blockIdx.x; item < 3 * HM * NCH; item += G) {
        const int kind = item / (HM * NCH), h = (item / NCH) % HM, c = item % NCH;
        const int t0 = LCH * c + 8 * tg;
        float outv[8][8];
        if (kind < 2) {
            const int col = kind * 1024 + h * DH + chl;
            float cw[5][8], cb[8];
#pragma unroll
            for (int e = 0; e < 8; ++e) cb[e] = P.conv_b[kind * 1024 + h * DH + chl + e];
#pragma unroll
            for (int j = 0; j < 5; ++j)
#pragma unroll
                for (int e = 0; e < 8; ++e) cw[j][e] = P.conv_w[j * 2048 + kind * 1024 + h * DH + chl + e];
#pragma unroll
            for (int tt = 0; tt < 8; ++tt)
#pragma unroll
                for (int e = 0; e < 8; ++e) outv[tt][e] = cb[e];
#pragma unroll
            for (int rr = 0; rr < 12; ++rr) {
                const int t = t0 - 2 + rr; float in[8];
                if (t >= 0 && t < SEQ) { const u32x4 w = *(const u32x4*)(pb + (size_t)t * PBW + col); unpack8(w, in); }
                else {
#pragma unroll
                    for (int e = 0; e < 8; ++e) in[e] = 0.f; }
#pragma unroll
                for (int j = 0; j < 5; ++j) { const int tt = rr - j;
                    if (tt >= 0 && tt < 8) {
#pragma unroll
                        for (int e = 0; e < 8; ++e) outv[tt][e] += cw[j][e] * in[e]; } }
            }
            const float osc = kind == 1 ? 0.0625f : 1.f;
#pragma unroll
            for (int tt = 0; tt < 8; ++tt)
#pragma unroll
                for (int e = 0; e < 8; ++e) outv[tt][e] = silu_f(outv[tt][e]) * osc;
            bf16_t* dst = (kind == 0 ? QH : KH) + ((size_t)h * SEQ + t0) * DH + chl;
#pragma unroll
            for (int tt = 0; tt < 8; ++tt) *(u32x4*)(dst + (size_t)tt * DH) = pack8(outv[tt]);
        } else {
#pragma unroll
            for (int tt = 0; tt < 8; ++tt) { const u32x4 w = *(const u32x4*)(pb + (size_t)(t0 + tt) * PBW + 2048 + h * DH + chl); unpack8(w, outv[tt]); }
        }
        if (kind >= 1) {
            bf16_t* dst = (kind == 1 ? KT : VT) + ((size_t)(h * NCH + c) * DH + chl) * LCH + 8 * tg;
#pragma unroll
            for (int e = 0; e < 8; ++e) { u32x4 w; w.x = cvt_pk_bf16(outv[0][e], outv[1][e]); w.y = cvt_pk_bf16(outv[2][e], outv[3][e]); w.z = cvt_pk_bf16(outv[4][e], outv[5][e]); w.w = cvt_pk_bf16(outv[6][e], outv[7][e]);
                *(u32x4*)(dst + (size_t)e * LCH) = w; }
        }
      } }
    { const float* gates = (const float*)(P.ws + WS_GATES);
      float* BC = (float*)(P.ws + WS_BC); float* IG = (float*)(P.ws + WS_IG); float* PM = (float*)(P.ws + WS_PM); float* WL = (float*)(P.ws + WS_WL);
      float* BL = (float*)(P.ws + WS_BL); float* AC = (float*)(P.ws + WS_AC);
      for (int task = gw; task < 2 * HM * NCH; task += NGW) {
        const int dir = task / (HM * NCH), h = (task / NCH) % HM, c = task % NCH;
        const float bi = P.b_gates[dir * 8 + h], bfg = P.b_gates[dir * 8 + 4 + h];
        const int u0 = 2 * lane, u1 = 2 * lane + 1;
        const int t0 = LCH * c + (dir ? 127 - u0 : u0), t1 = LCH * c + (dir ? 127 - u1 : u1);
        const float i0 = gates[(size_t)t0 * 16 + dir * 8 + h] + bi, i1 = gates[(size_t)t1 * 16 + dir * 8 + h] + bi;
        const float f0 = gates[(size_t)t0 * 16 + dir * 8 + 4 + h] + bfg, f1 = gates[(size_t)t1 * 16 + dir * 8 + 4 + h] + bfg;
        const float l0 = fminf(f0, 0.f) - log1pf(expf(-fabsf(f0))), l1 = fminf(f1, 0.f) - log1pf(expf(-fabsf(f1)));
        float inc = l0 + l1;
#pragma unroll
        for (int o = 1; o < 64; o <<= 1) { const float t = shup(inc, o); if (lane >= o) inc += t; }
        const float b1 = inc, b0 = inc - l1;
        const float d0 = i0 - b0, d1 = i1 - b1;
        float pmx = fmaxf(d0, d1);
#pragma unroll
        for (int o = 1; o < 64; o <<= 1) { const float t = shup(pmx, o); if (lane >= o) pmx = fmaxf(pmx, t); }
        float prev = shup(pmx, 1); if (lane == 0) prev = -INFINITY;
        const float pm0 = fmaxf(prev, d0), pm1 = pmx;
        const float bL = shidx(b1, 63), pmL = shidx(pmx, 63);
        const size_t base = (size_t)(dir * HM + h) * SEQ;
        BC[base + t0] = b0; BC[base + t1] = b1; IG[base + t0] = i0; IG[base + t1] = i1;
        PM[base + t0] = b0 + pm0; PM[base + t1] = b1 + pm1;
        WL[base + t0] = bL - b0 + i0; WL[base + t1] = bL - b1 + i1;
        if (lane == 63) { BL[(dir * HM + h) * NCH + c] = bL; AC[(dir * HM + h) * NCH + c] = bL + pmL; }
      } }
}

constexpr int M2_W = 1024, M2_WB = M2_W + SEQ * 4, M2_T0 = M2_WB + SEQ * 2, M2_TB = 96 * 256;
static_assert(M2_T0 + 2 * M2_TB <= LDS_BYTES, "M2 LDS");
__device__ __forceinline__ void m2_block(const Params& P, char* lds, int blk) {
    const int tid = tid_opaque(), lane = tid & 63, wid = tid >> 6, r = lane & 15, g = lane >> 4;
    const int dir = blk >> 7, h = (blk >> 5) & 3, vs = (blk >> 2) & 7, ksl = blk & 3;
    const int vi = wid >> 2, ki = wid & 3, v0 = 32 * vs + 16 * vi, k0 = 64 * ksl + 16 * ki;
    const int dh = dir * HM + h;
    const float* BL = (const float*)(P.ws + WS_BL) + dh * NCH; const float* AC = (const float*)(P.ws + WS_AC) + dh * NCH;
    const float* WL = (const float*)(P.ws + WS_WL) + (size_t)dh * SEQ;
    bf16_t* CST = (bf16_t*)(P.ws + cst_off(dh)); float* NST = (float*)(P.ws + WS_NST);
    float* s_mA = (float*)lds; float* s_dec = s_mA + NCH; float* s_w = (float*)(lds + M2_W); bf16_t* s_wb = (bf16_t*)(lds + M2_WB);
    float* s_bl = (float*)(lds + 512); float* s_ac = s_bl + NCH;
    if (tid < NCH) { s_bl[tid] = BL[tid]; s_ac[tid] = AC[tid]; }
    __syncthreads();
    if (tid == 0) { float m = -1e30f; float* MB = (float*)(P.ws + WS_MB) + dh * NCH; const bool pub = (vs == 0 && ksl == 0);
#pragma unroll 1
        for (int st = 0; st < NCH; ++st) { const int c = dir ? NCH - 1 - st : st; const float bL = s_bl[c], a = s_ac[c]; const float mn = fmaxf(bL + m, a);
            if (pub) MB[c] = m;
            s_dec[c] = __expf(bL + m - mn); s_mA[c] = mn; m = mn; } }
    __syncthreads();
    { float wl_[16];
#pragma unroll
      for (int i = 0; i < 16; ++i) wl_[i] = WL[tid + NTHREADS * i];
#pragma unroll
      for (int i = 0; i < 16; ++i) { const float w_ = __expf(wl_[i] - s_mA[(tid + NTHREADS * i) >> 7]); s_w[tid + NTHREADS * i] = w_; s_wb[tid + NTHREADS * i] = f2bf(w_); } }
    const int srow = tid >> 4, sslot = tid & 15;
    const char* gV = (const char*)(P.ws + WS_VT) + ((size_t)h * NCH * DH + 32 * vs + srow) * (LCH * 2) + sslot * 16;
    const char* gK = (const char*)(P.ws + WS_KT) + ((size_t)h * NCH * DH + 64 * ksl + srow) * (LCH * 2) + sslot * 16;
    const int lw = srow * 256 + ((sslot ^ (srow & 15)) << 4);
    const int la = (16 * vi + r) * 256, lb = (32 + 16 * ki + r) * 256;
    char* tb = lds + M2_T0;
    u32x4 ring[8][3];
#define M2_LOAD(slot, stp) do { const int c_ = dir ? NCH - 1 - (stp) : (stp); const size_t co_ = (size_t)c_ * (DH * LCH * 2); \
        ring[slot][0] = *(const u32x4*)(gV + co_); ring[slot][1] = *(const u32x4*)(gK + co_); ring[slot][2] = *(const u32x4*)(gK + co_ + 32 * LCH * 2); } while (0)
#define M2_WRITE(slot, buf, stp) do { char* d_ = tb + (buf) * M2_TB + lw; const int cw_ = dir ? NCH - 1 - (stp) : (stp); \
        const f32x4 wv0_ = *(const f32x4*)(s_w + LCH * cw_ + 8 * sslot), wv1_ = *(const f32x4*)(s_w + LCH * cw_ + 8 * sslot + 4); float a_[8]; unpack8(ring[slot][0], a_); \
        _Pragma("unroll") for (int j_ = 0; j_ < 4; ++j_) { a_[j_] *= wv0_[j_]; a_[4 + j_] *= wv1_[j_]; } \
        *(u32x4*)d_ = pack8(a_); *(u32x4*)(d_ + 8192) = ring[slot][1]; *(u32x4*)(d_ + 16384) = ring[slot][2]; } while (0)
#pragma unroll
    for (int d = 0; d < 8; ++d) M2_LOAD(d, d);
    __syncthreads();
    M2_WRITE(0, 0, 0);
    const bool do_n = (vs == 0 && vi == 0);
    f32x4 acc = {0.f, 0.f, 0.f, 0.f}, nacc = {0.f, 0.f, 0.f, 0.f};
#pragma unroll 1
    for (int st8 = 0; st8 < NCH; st8 += 8) {
#pragma unroll
        for (int u = 0; u < 8; ++u) {
            const int st = st8 + u;
            const int c = dir ? NCH - 1 - st : st;
            asm volatile("s_waitcnt lgkmcnt(0)" ::: "memory"); __builtin_amdgcn_s_barrier(); asm volatile("" ::: "memory");
            if (st + 1 < NCH) M2_WRITE((u + 1) & 7, (u + 1) & 1, st + 1);
            if (st + 8 < NCH) M2_LOAD(u, st + 8);
            { bf16_t* cp = CST + (size_t)c * (DH * DH) + (size_t)(v0 + r) * DH + k0 + 4 * g;
              u32x2 w2; w2.x = cvt_pk_bf16(acc[0], acc[1]); w2.y = cvt_pk_bf16(acc[2], acc[3]); *(u32x2*)cp = w2;
              if (do_n && r == 0) *(f32x4*)(NST + ((size_t)dh * NCH + c) * DH + k0 + 4 * g) = nacc; }
            const float dec = s_dec[c];
            acc = acc * dec; if (do_n) nacc = nacc * dec;
            const char* tbuf = tb + (u & 1) * M2_TB;
#pragma unroll
            for (int ks = 0; ks < 4; ++ks) {
                const int sl = ((4 * ks + g) ^ r) << 4;
                const bf16x8 av = *(const bf16x8*)(tbuf + la + sl), bv = *(const bf16x8*)(tbuf + lb + sl);
                acc = __builtin_amdgcn_mfma_f32_16x16x32_bf16(bv, av, acc, 0, 0, 0);
                if (do_n) { const bf16x8 wv = *(const bf16x8*)(s_wb + LCH * c + 32 * ks + 8 * g);
                    nacc = __builtin_amdgcn_mfma_f32_16x16x32_bf16(bv, wv, nacc, 0, 0, 0); }
            }
        }
    }
#undef M2_LOAD
#undef M2_WRITE
    __syncthreads();
}

constexpr int M3_SC = 1024, M3_LV = 6144, M3_LVS = 272, M3_LC = M3_LV + 256 * M3_LVS, M3_LCS = 528;
static_assert(M3_LC + 128 * M3_LCS <= 147456 - 64 - 256, "M3 LDS");
__device__ __forceinline__ void m3_unit(const Params& P, char* lds, int h, int c) {
    const int tid = tid_opaque(), lane = tid & 63, wid = __builtin_amdgcn_readfirstlane(tid >> 6), r = lane & 15, g = lane >> 4;
    const int T0 = LCH * c, tl = 16 * wid + r;
    const char* QHc = (const char*)(P.ws + WS_QH) + ((size_t)h * SEQ + T0 + 16 * wid) * (DH * 2);
    const char* KHc = (const char*)(P.ws + WS_KH) + ((size_t)h * SEQ + T0) * (DH * 2);
    const char* VTc = (const char*)(P.ws + WS_VT) + ((size_t)h * NCH + c) * (DH * LCH * 2);
    const unsigned o512 = (unsigned)(r * 512 + g * 16);
    float* s_bc = (float*)(lds + M3_SC); float* s_ig = s_bc + 256; float* s_pm = s_ig + 256; float* s_n = s_pm + 256;
    float* s_mb = (float*)lds;
    char* LV = lds + M3_LV; char* LC = lds + M3_LC;
    const char* lvr = LV + r * M3_LVS + g * 8;
    const char* lcr = LC + r * M3_LCS + g * 16;
    char* lcw = LC + (tid >> 5) * M3_LCS + (tid & 31) * 16;
    u32x4 cr[8];
#define M3_CLOAD(src) do { _Pragma("unroll") for (int n = 0; n < 8; ++n) cr[n] = ldgu<u32x4>((src) + n * 8192, (unsigned)tid * 16u); } while (0)
#define M3_CWRITE() do { _Pragma("unroll") for (int n = 0; n < 8; ++n) *(u32x4*)(lcw + n * (16 * M3_LCS)) = cr[n]; } while (0)
    M3_CLOAD(KHc);
    bf16x8 qf[8];
#pragma unroll
    for (int kd = 0; kd < 8; ++kd) qf[kd] = ldgu<bf16x8>(QHc + 64 * kd, o512);
    { u32x4 v[8];
#pragma unroll
      for (int n = 0; n < 8; ++n) v[n] = ldgu<u32x4>(VTc + n * 8192, (unsigned)tid * 16u);
      { const int dir = tid >> 8, tt = tid & 127; const size_t gi = (size_t)(dir * HM + h) * SEQ + T0 + tt;
        if ((tid & 255) < 128) { s_bc[dir * 128 + tt] = ((const float*)(P.ws + WS_BC))[gi]; s_ig[dir * 128 + tt] = ((const float*)(P.ws + WS_IG))[gi]; s_pm[dir * 128 + tt] = ((const float*)(P.ws + WS_PM))[gi]; }
        s_n[tid] = ((const float*)(P.ws + WS_NST))[((size_t)((tid >> 8) * HM + h) * NCH + c) * DH + (tid & 255)];
        if (tid < 2) s_mb[tid] = ((const float*)(P.ws + WS_MB))[(tid * HM + h) * NCH + c]; }
#pragma unroll
      for (int n = 0; n < 8; ++n) *(u32x4*)(LV + ((tid >> 4) + 32 * n) * M3_LVS + (tid & 15) * 16) = v[n]; }
    M3_CWRITE();
    __syncthreads();
    f32x4 st[8]; float qn0 = 0.f, qn1 = 0.f;
#pragma unroll
    for (int j = 0; j < 8; ++j) { st[j] = (f32x4){0.f, 0.f, 0.f, 0.f};
#pragma unroll
        for (int kd = 0; kd < 8; ++kd) { const bf16x8 kf = *(const bf16x8*)(lcr + j * (16 * M3_LCS) + kd * 64);
            st[j] = __builtin_amdgcn_mfma_f32_16x16x32_bf16(kf, qf[kd], st[j], 0, 0, 0); } }
#pragma unroll
    for (int kd = 0; kd < 8; ++kd) { float q[8]; unpack8(*(const u32x4*)&qf[kd], q);
        const f32x4 a0 = *(const f32x4*)(s_n + 32 * kd + 8 * g), a1 = *(const f32x4*)(s_n + 32 * kd + 8 * g + 4), b0 = *(const f32x4*)(s_n + 256 + 32 * kd + 8 * g), b1 = *(const f32x4*)(s_n + 256 + 32 * kd + 8 * g + 4);
        qn0 += q[0] * a0[0] + q[1] * a0[1] + q[2] * a0[2] + q[3] * a0[3] + q[4] * a1[0] + q[5] * a1[1] + q[6] * a1[2] + q[7] * a1[3];
        qn1 += q[0] * b0[0] + q[1] * b0[1] + q[2] * b0[2] + q[3] * b0[3] + q[4] * b1[0] + q[5] * b1[1] + q[6] * b1[2] + q[7] * b1[3]; }
    qn0 += shx(qn0, 16); qn0 += shx(qn0, 32); qn1 += shx(qn1, 16); qn1 += shx(qn1, 32);
    f32x4 acc[16];
#pragma unroll
    for (int vt = 0; vt < 16; ++vt) acc[vt] = (f32x4){0.f, 0.f, 0.f, 0.f};
#pragma unroll 1
    for (int dir = 0; dir < 2; ++dir) {
        const int dh = dir * HM + h;
        const char* Cc = (const char*)(P.ws + cst_off(dh)) + (size_t)c * (DH * DH * 2);
        M3_CLOAD(Cc);
        const float* bcd = s_bc + dir * 128; const float* igd = s_ig + dir * 128;
        const int fx = dir * 127, tlx = tl ^ fx;
        const float mB = s_mb[dir];
        const float bt = bcd[tl], pm = s_pm[dir * 128 + tl];
        const float mt = fmaxf(bt + mB, pm); const float alpha = bt - mt; const float winter = __expf(bt + mB - mt);
        float den = 0.f;
#pragma unroll
        for (int j = 0; j < 8; ++j) { const int sb = 16 * j + 4 * g;
            const f32x4 ig = *(const f32x4*)(igd + sb), bc = *(const f32x4*)(bcd + sb);
#pragma unroll
            for (int i = 0; i < 4; ++i) { const int sl = sb + i; const bool ok = ((sl ^ fx) <= tlx);
                const float e = ok ? __expf(alpha + ig[i] - bc[i]) : 0.f; den += st[j][i] * e; } }
        den += shx(den, 16); den += shx(den, 32);
        const float dtot = den + winter * (dir ? qn1 : qn0);
        const float hdiv = 1.f / fmaxf(fabsf(dtot), __expf(-mt));
        int tlx2 = tlx; LAUNDER_V(tlx2);
#pragma unroll
        for (int ks = 0; ks < 4; ++ks) {
            float e8[8];
#pragma unroll
            for (int hh = 0; hh < 2; ++hh) { const int j = 2 * ks + hh, sb = 16 * j + 4 * g;
                const f32x4 ig = *(const f32x4*)(igd + sb), bc = *(const f32x4*)(bcd + sb);
#pragma unroll
                for (int i = 0; i < 4; ++i) { const int sl = sb + i; const bool ok = ((sl ^ fx) <= tlx2);
                    const float e = ok ? __expf(alpha + ig[i] - bc[i]) : 0.f; e8[4 * hh + i] = st[j][i] * e * hdiv; } }
            const u32x4 pw = pack8(e8); const bf16x8 pa = *(const bf16x8*)&pw;
#pragma unroll
            for (int vt = 0; vt < 16; ++vt) {
                const u32x2 lo = *(const u32x2*)(lvr + vt * (16 * M3_LVS) + ks * 64), hi2 = *(const u32x2*)(lvr + vt * (16 * M3_LVS) + ks * 64 + 32);
                u32x4 w; w.x = lo.x; w.y = lo.y; w.z = hi2.x; w.w = hi2.y;
                acc[vt] = __builtin_amdgcn_mfma_f32_16x16x32_bf16(pa, *(const bf16x8*)&w, acc[vt], 0, 0, 0); }
        }
        const float qsc = winter * hdiv;
#pragma unroll
        for (int half = 0; half < 2; ++half) {
            __syncthreads();
            M3_CWRITE();
            __syncthreads();
            if (half == 0) M3_CLOAD(Cc + 65536);
            else if (dir == 1) { const char* om = (const char*)(P.ws + WS_PA) + ((size_t)T0 * PAW + PA_OM + h * DH) * 2;
#pragma unroll
                for (int n = 0; n < 8; ++n) cr[n] = ldgu<u32x4>(om + n * (16 * PAW * 2), (unsigned)((tid >> 5) * (PAW * 2) + (tid & 31) * 16)); }
#pragma unroll
            for (int kd = 0; kd < 8; ++kd) { const u32x4 qt = ldgu<u32x4>(QHc + 64 * kd, o512); float q[8]; unpack8(qt, q);
#pragma unroll
                for (int e = 0; e < 8; ++e) q[e] *= qsc;
                const u32x4 qw = pack8(q); const bf16x8 qs = *(const bf16x8*)&qw;
#pragma unroll
                for (int v8 = 0; v8 < 8; ++v8) { const bf16x8 cf = *(const bf16x8*)(lcr + v8 * (16 * M3_LCS) + kd * 64);
                    acc[half * 8 + v8] = __builtin_amdgcn_mfma_f32_16x16x32_bf16(qs, cf, acc[half * 8 + v8], 0, 0, 0); }
            }
        }
    }
    __syncthreads();
    M3_CWRITE();
#undef M3_CLOAD
#undef M3_CWRITE
    float ss[4] = {0.f, 0.f, 0.f, 0.f};
#pragma unroll
    for (int vt = 0; vt < 16; ++vt)
#pragma unroll
        for (int i = 0; i < 4; ++i) ss[i] += acc[vt][i] * acc[vt][i];
#pragma unroll
    for (int i = 0; i < 4; ++i) { ss[i] += shx(ss[i], 1); ss[i] += shx(ss[i], 2); ss[i] += shx(ss[i], 4); ss[i] += shx(ss[i], 8); ss[i] = rsqrtf(ss[i] * (1.f / DH) + EPS); }
    const float* gmp = P.mlstm_norm_g + h * DH + r;
    __syncthreads();
    const char* omr = LC + (16 * wid + 4 * g) * M3_LCS + r * 2; char* outw = LV + (16 * wid + 4 * g) * M3_LCS + r * 2;
#pragma unroll
    for (int vt = 0; vt < 16; ++vt) { const float gm = gmp[16 * vt];
#pragma unroll
        for (int i = 0; i < 4; ++i) { const float om = bf2f(*(const bf16_t*)(omr + i * M3_LCS + 32 * vt));
            *(bf16_t*)(outw + i * M3_LCS + 32 * vt) = f2bf(acc[vt][i] * ss[i] * gm * sigmoid_f(om)); } }
    __syncthreads();
    { char* mx = (char*)(P.ws + WS_MIX) + ((size_t)T0 * DM + 1024 + h * DH) * 2;
#pragma unroll
      for (int n = 0; n < 8; ++n) { const u32x4 v = *(const u32x4*)(LV + ((tid >> 5) + 16 * n) * M3_LCS + (tid & 31) * 16);
          *(u32x4*)(mx + (size_t)((tid >> 5) + 16 * n) * (DM * 2) + (tid & 31) * 16) = v; } }
    __syncthreads();
}

__device__ __forceinline__ void phase4(const Params& P, int G) {
    const int tid = tid_opaque(), lane = tid & 63, wave = tid >> 6;
    const int gw = blockIdx.x * NWAVES + wave, NGW = G * NWAVES;
    bf16_t* Q = (bf16_t*)(P.ws + WS_Q); bf16_t* K = (bf16_t*)(P.ws + WS_K); const bf16_t* KV = (const bf16_t*)(P.ws + WS_KV); const bf16_t* proj = (const bf16_t*)(P.ws + WS_PA);
    const f32x4* rt = (const f32x4*)(P.ws + WS_ROPE);
    unsigned char* Q8 = P.ws + WS_Q8; unsigned char* K8 = (F8_MODE == 2) ? (unsigned char*)P.out : P.ws + WS_K8;
    const int i = lane & 7, hh = lane >> 3; const bool lo = i < 4;
    float gq[3][8], gk[3][8];
#pragma unroll
    for (int j = 0; j < 3; ++j)
#pragma unroll
        for (int e = 0; e < 8; ++e) { gq[j][e] = P.q_norm_g[8 * (i + 8 * j) + e]; gk[j][e] = P.k_norm_g[8 * (i + 8 * j) + e]; }
    for (int t0 = gw; t0 < SEQ; t0 += 2 * NGW) {
        u32x4 win[2][2][3]; f32x4 rv[2][4];
#pragma unroll
        for (int tt = 0; tt < 2; ++tt) { const int t = (t0 + tt * NGW) < SEQ ? t0 + tt * NGW : t0;
            const bf16_t* qp = Q + (size_t)t * (NH * DQK) + hh * DQK + 8 * i; const bf16_t* kp = KV + (size_t)t * (NH * 256) + hh * 256 + 8 * i;
            win[tt][0][0] = *(const u32x4*)qp; win[tt][0][1] = *(const u32x4*)(qp + 64); win[tt][0][2] = *(const u32x4*)(qp + 128);
            win[tt][1][0] = *(const u32x4*)kp; win[tt][1][1] = *(const u32x4*)(kp + 64); win[tt][1][2] = *(const u32x4*)(proj + (size_t)t * PAW + OFF_KPE + 8 * i);
#pragma unroll
            for (int e2 = 0; e2 < 4; ++e2) rv[tt][e2] = rt[(size_t)t * 16 + 4 * (i & 3) + e2]; }
#pragma unroll
        for (int tt = 0; tt < 2; ++tt) { const int t = t0 + tt * NGW; if (t >= SEQ) break;
            float cs[8], sn[8];
#pragma unroll
            for (int e2 = 0; e2 < 4; ++e2) { cs[2 * e2] = rv[tt][e2][0]; sn[2 * e2] = rv[tt][e2][1]; cs[2 * e2 + 1] = rv[tt][e2][2]; sn[2 * e2 + 1] = rv[tt][e2][3]; }
#pragma unroll
            for (int which = 0; which < 2; ++which) {
                bf16_t* dst = (which == 0 ? Q : K) + (size_t)t * (NH * DQK) + hh * DQK + 8 * i;
                float a0[8], a1[8], a2[8]; unpack8(win[tt][which][0], a0); unpack8(win[tt][which][1], a1); unpack8(win[tt][which][2], a2);
                float ss = 0.f;
#pragma unroll
                for (int e = 0; e < 8; ++e) ss += a0[e] * a0[e] + a1[e] * a1[e] + a2[e] * a2[e];
                ss += shx(ss, 1); ss += shx(ss, 2); ss += shx(ss, 4);
                const float rs = rsqrtf(ss * (1.f / DQK) + EPS);
#pragma unroll
                for (int e = 0; e < 8; ++e) { const float g0 = which ? gk[0][e] : gq[0][e], g1 = which ? gk[1][e] : gq[1][e], g2 = which ? gk[2][e] : gq[2][e];
                    a0[e] *= rs * g0; a1[e] *= rs * g1; a2[e] *= rs * g2; }
                float o2[8];
#pragma unroll
                for (int e = 0; e < 8; ++e) { const float pr = shx(a2[e], 4);
                    o2[e] = lo ? (a2[e] * cs[e] - pr * sn[e]) : (pr * sn[e] + a2[e] * cs[e]); }
                if (F8_MODE != 1) { *(u32x4*)dst = pack8(a0); *(u32x4*)(dst + 64) = pack8(a1); *(u32x4*)(dst + 128) = pack8(o2); }
                if (F8_MODE != 0) { unsigned char* d8 = (which == 0 ? Q8 : K8) + (size_t)t * (NH * DQK) + hh * DQK + 8 * i;
                    *(u32x2*)d8 = pack8_fp8(a0); *(u32x2*)(d8 + 64) = pack8_fp8(a1); *(u32x2*)(d8 + 128) = pack8_fp8(o2); }
            }
        }
    }
}

struct StoreProj { bf16_t* pa; bf16_t* pb; float* gates;
    __device__ __forceinline__ void operator()(int row, int col, f32x4 v0, f32x4 v1) const {
        u32x4 w; w.x = cvt_pk_bf16(v0[0], v0[1]); w.y = cvt_pk_bf16(v0[2], v0[3]); w.z = cvt_pk_bf16(v1[0], v1[1]); w.w = cvt_pk_bf16(v1[2], v1[3]);
        bf16_t* dst = (col >= OFF_QM && col < OFF_OM) ? pb + (size_t)row * PBW + (col - OFF_QM) : pa + (size_t)row * PAW + (col < OFF_QM ? col : col - OFF_OM + PA_OM);
        *(u32x4*)dst = w;
        if (col >= OFF_GM && col < OFF_GM + 16) { float* gp = gates + (size_t)row * 16 + (col - OFF_GM); *(f32x4*)gp = v0; *(f32x4*)(gp + 4) = v1; } } };
struct StoreQ { bf16_t* q;
    __device__ __forceinline__ void operator()(int row, int col, f32x4 v0, f32x4 v1) const {
        const int h = col >> 8, ct = col & 255;
        if (ct < DQK) { u32x4 w; w.x = cvt_pk_bf16(v0[0], v0[1]); w.y = cvt_pk_bf16(v0[2], v0[3]); w.z = cvt_pk_bf16(v1[0], v1[1]); w.w = cvt_pk_bf16(v1[2], v1[3]);
            *(u32x4*)(q + (size_t)row * (NH * DQK) + h * DQK + ct) = w; } } };
struct StoreKV { bf16_t* kv;
    __device__ __forceinline__ void operator()(int row, int col, f32x4 v0, f32x4 v1) const {
        u32x4 w; w.x = cvt_pk_bf16(v0[0], v0[1]); w.y = cvt_pk_bf16(v0[2], v0[3]); w.z = cvt_pk_bf16(v1[0], v1[1]); w.w = cvt_pk_bf16(v1[2], v1[3]);
        *(u32x4*)(kv + (size_t)row * (NH * 256) + col) = w; } };
struct StoreX1 { const float* x; const float* gate; float* out;
    __device__ __forceinline__ void operator()(int row, int col, f32x4 v) const {
        const size_t off = (size_t)row * DM + col; const f32x4 xv = *(const f32x4*)(x + off); const f32x4 gv = *(const f32x4*)(gate + col);
        *(f32x4*)(out + off) = xv + gv * v; } };
struct StoreAct { bf16_t* act;
    __device__ __forceinline__ void operator()(int row, int col, f32x4 v0, f32x4 v1) const {
        float f[8] = {v0[0], v0[1], v0[2], v0[3], v1[0], v1[1], v1[2], v1[3]};
#pragma unroll
        for (int e = 0; e < 8; ++e) { const float rl = fmaxf(f[e], 0.f); f[e] = rl * rl; }
        *(u32x4*)(act + (size_t)row * DFF + col) = pack8(f); } };

#define XB_TMO      128
#define XB_XCNT(j)  (256  + 64 * (j))
#define XB_XSUB(j)  (1280 + 64 * (j))
#define XB_XGEN(j)  (2304 + 64 * (j))
#define XB_TOP      3328
#define XB_TOPGEN   3392
#define XCD_BAR_WORDS 3456
#define XB_SPIN_CAP (1u << 18)

__device__ __forceinline__ unsigned xb_ld(unsigned* p)              { return __hip_atomic_load(p, __ATOMIC_RELAXED, __HIP_MEMORY_SCOPE_AGENT); }
__device__ __forceinline__ unsigned xb_add(unsigned* p, unsigned v) { return __hip_atomic_fetch_add(p, v, __ATOMIC_RELAXED, __HIP_MEMORY_SCOPE_AGENT); }
__device__ __forceinline__ unsigned xb_xcc_id() { return (unsigned)__builtin_amdgcn_s_getreg((3 << 11) | 20) & 0xFu; }
#define XB_SPIN(cond, bar) do { unsigned _sp = 0; while (cond) { __builtin_amdgcn_s_sleep(1); \
    if ((++_sp & 255u) == 0u) { if (xb_ld(&(bar)[XB_TMO])) break; if (_sp > XB_SPIN_CAP) { atomicAdd(&(bar)[XB_TMO], 1u); break; } } } } while (0)

struct XcdBarrier {
    unsigned* bar; unsigned x;
    volatile LAS unsigned* st;
};

__device__ __forceinline__ XcdBarrier xcd_barrier_post(unsigned* bar, volatile LAS unsigned* st) {
    XcdBarrier b; b.bar = bar; b.x = xb_xcc_id(); b.st = st;
    if (threadIdx.x == 0) (void)xb_add(&bar[XB_XCNT(b.x)], 1u);
    return b;
}
__device__ __forceinline__ void xcd_barrier_complete(unsigned* bar, unsigned x, unsigned& nloc, unsigned& nx) {
    const unsigned G = gridDim.x * gridDim.y * gridDim.z;
    unsigned sum, cnt, mine, sp = 0u;
    for (;;) {
        sum = 0u; cnt = 0u; mine = 0u;
#pragma unroll
        for (unsigned j = 0; j < 16; ++j) { const unsigned c = xb_ld(&bar[XB_XCNT(j)]); sum += c; cnt += (c > 0u) ? 1u : 0u; mine = (j == x) ? c : mine; }
        if (sum == G) break;
        __builtin_amdgcn_s_sleep(1);
        if ((++sp & 255u) == 0u) { if (xb_ld(&bar[XB_TMO])) break; if (sp > XB_SPIN_CAP) { atomicAdd(&bar[XB_TMO], 1u); break; } }
    }
    nloc = mine > 0u ? mine : 1u; nx = cnt > 0u ? cnt : 1u;
}

__device__ __forceinline__ void xcd_barrier(const XcdBarrier& b) {
    asm volatile("s_waitcnt vmcnt(0)" ::: "memory");
    __syncthreads();
    if (tid_opaque() == 0) {
        unsigned* bar = b.bar;
        __builtin_amdgcn_s_waitcnt(0);
        unsigned nloc = b.st[0], nx = b.st[1];
        if (nloc == 0u) { xcd_barrier_complete(bar, b.x, nloc, nx); b.st[0] = nloc; b.st[1] = nx; }
        const unsigned old = xb_add(&bar[XB_XSUB(b.x)], 1u);
        const unsigned gen = old / nloc;
        if (old + 1u == (gen + 1u) * nloc) {
            __builtin_amdgcn_fence(__ATOMIC_RELEASE, "agent");
            asm volatile("s_waitcnt vmcnt(0)" ::: "memory");
            const unsigned og = xb_add(&bar[XB_TOP], 1u);
            const unsigned tg = og / nx;
            if (og + 1u == (tg + 1u) * nx) xb_add(&bar[XB_TOPGEN], 1u);
            else XB_SPIN(xb_ld(&bar[XB_TOPGEN]) == tg, bar);
            __builtin_amdgcn_fence(__ATOMIC_ACQUIRE, "agent");
            xb_add(&bar[XB_XGEN(b.x)], 1u);
            asm volatile("s_waitcnt vmcnt(0)" ::: "memory");
        } else {
            XB_SPIN(xb_ld(&bar[XB_XGEN(b.x)]) == gen, bar);
            __builtin_amdgcn_fence(__ATOMIC_ACQUIRE, "agent");
            asm volatile("s_waitcnt vmcnt(0)" ::: "memory");
        }
    }
    __syncthreads();
}


constexpr int NPH = 11;
#ifdef ONLY_PH
#define PH_ON(n) ((n) == ONLY_PH)
#else
#define PH_ON(n) 1
#endif
#define CAS __attribute__((address_space(4)))
__device__ __forceinline__ Params load_params(const CAS Params* kp) {
#if defined(__HIP_DEVICE_COMPILE__)
    unsigned long long kv = (unsigned long long)kp; asm volatile("" : "+s"(kv)); return *(const CAS Params*)kv;
#else
    return Params{};
#endif
}
__global__ void __launch_bounds__(NTHREADS, 2) fwd_kernel(Params Pk) {
    extern __shared__ __attribute__((aligned(16))) char lds[];
    const CAS Params* kp = (const CAS Params*)__builtin_amdgcn_kernarg_segment_ptr();
    const int G0 = gridDim.x; const int bx0 = blockIdx.x;
    const int vcu0 = (G0 % 8 == 0) ? (bx0 % 8) * (G0 / 8) + bx0 / 8 : bx0;
    LAS unsigned char* ldsl = (LAS unsigned char*)lds;
    const int ph_lo = Pk.ph_lo, ph_hi = Pk.ph_hi;
    if (threadIdx.x < 16) ((volatile LAS unsigned*)(ldsl + LDS_BARST))[threadIdx.x] = 0u;
    if ((threadIdx.x & 63) == 0) { const unsigned hw = __builtin_amdgcn_s_getreg((5 << 11) | 4) & 63u; *(volatile LAS int*)(uintptr_t)(LDS_WIDTAB + hw * 4) = (int)(threadIdx.x >> 6); }
    __syncthreads();
    XcdBarrier xbar = xcd_barrier_post((unsigned*)(Pk.ws + WS_BAR), (volatile LAS unsigned*)(ldsl + LDS_BARST));
#ifndef PROBE_PH
#define PROBE_PH (-1)
#endif
    unsigned long long probe_dt = 0, probe_t0g = 0;
#ifndef PROBE_FROM
#define PROBE_FROM (-1)
#define PROBE_TO (-1)
#endif
#define PROBE_MARK(id) do { if (PROBE_FROM == (id)) { __syncthreads(); probe_t0g = __builtin_amdgcn_s_memrealtime(); } if (PROBE_TO == (id)) { __syncthreads(); probe_dt = __builtin_amdgcn_s_memrealtime() - probe_t0g; } } while (0)
#ifndef DUP_PH
#define DUP_PH (-1)
#endif
#ifndef DUP_SUB
#define DUP_SUB 0
#endif
    for (int ph = ph_lo; ph < ph_hi; ++ph) {
      {
        int G = G0, bx = bx0, vcu = vcu0; asm volatile("" : "+s"(G), "+s"(bx), "+s"(vcu));
        unsigned long long probe_t0 = 0; if (PROBE_PH >= 0 && ph == PROBE_PH) probe_t0 = __builtin_amdgcn_s_memrealtime();
        for (int sub = 0; sub < (ph == 6 ? 2 : 1); ++sub) {
        int G = G0, bx = bx0, vcu = vcu0; asm volatile("" : "+s"(G), "+s"(bx), "+s"(vcu));
        switch (sub ? 11 : ph) {
        case 0: if (PH_ON(0)) { const Params P = load_params(kp); phase0(P, lds, G); } break;
        case 1: if (PH_ON(1)) { const Params P = load_params(kp); phase1a(P, lds, G); } break;
        case 2: if (PH_ON(2)) { const Params P = load_params(kp); unsigned char* ws = P.ws;
                  pg8::Gemm g{(const bf16_t*)(ws + WS_H), (const bf16_t*)(ws + WS_WIN), SEQ, DINP, DM}; pg8::StaticOrder S; S.init(SEQ, DINP, G, bx);
                  pg8::Epi8<StoreProj> E{{(bf16_t*)(ws + WS_PA), (bf16_t*)(ws + WS_PB), (float*)(ws + WS_GATES)}};
                  pg8::gemm_phase<pg8::Epi8<StoreProj>, pg8::StaticOrder, true, true>(ldsl, g, S, E);
                  { const int nwg = (SEQ / 256) * (DINP / 256), nfull = nwg % G;
                    if (nfull == 0) ff_transposes(P, lds, bx, G, 0, FFT_SPLIT); else if (bx >= nfull) ff_transposes(P, lds, bx - nfull, G - nfull, 0, FFT_SPLIT); } } break;
        case 3: if (PH_ON(3)) { const Params P = load_params(kp); phase2(P, lds, G); } break;
        case 4: if (PH_ON(4)) { PROBE_MARK(40);
#ifndef NO_G4
#ifndef NO_G4A
                  { const Params P = load_params(kp); unsigned char* ws = P.ws;
                    pg8::Gemm g{(const bf16_t*)(ws + WS_CQN), (const bf16_t*)(ws + WS_WUQ), SEQ, NH * 256, QLORA}; pg8::StaticOrder S; S.init(SEQ, NH * 256, G, bx);
                    pg8::Epi8<StoreQ> E{{(bf16_t*)(ws + WS_Q)}};
                    pg8::gemm_phase<pg8::Epi8<StoreQ>, pg8::StaticOrder, true, true>(ldsl, g, S, E); }
#endif
#ifndef NO_G4B
                  { const Params P = load_params(kp); unsigned char* ws = P.ws;
                    pg8::Gemm g{(const bf16_t*)(ws + WS_CKVN), (const bf16_t*)(ws + WS_WUKV), SEQ, NH * 256, KVLORA}; pg8::StaticOrder S; S.init(SEQ, NH * 256, G, bx);
                    pg8::Epi8<StoreKV> E{{(bf16_t*)(ws + WS_KV)}};
                    pg8::gemm_phase<pg8::Epi8<StoreKV>, pg8::StaticOrder, true, true>(ldsl, g, S, E); }
#endif
#endif
                  PROBE_MARK(42);
#ifndef NO_M2
                  { const Params P = load_params(kp); for (int b = vcu; b < 256; b += G) m2_block(P, lds, b); }
#endif
                  PROBE_MARK(43);
                  } break;
        case 5: if (PH_ON(5)) { const Params P = load_params(kp); phase4(P, G); } break;
        case 6: if (PH_ON(6)) { PROBE_MARK(60);
#ifndef NO_ATT
                  { const Params P = load_params(kp); unsigned char* ws = P.ws;
                  for (int u = vcu; u < NH * (SEQ / 256); u += G) { const int h = u >> 5, qb = u & 31;
                      const bf16_t* vh = (const bf16_t*)(ws + WS_KV) + h * 256 + 128; bf16_t* ob = (bf16_t*)(ws + WS_MIX) + (size_t)(qb * 256) * DM + h * DV;
                      if (F8_MODE != 1) att::attn_unit<false>((const bf16_t*)(ws + WS_Q) + (size_t)(qb * 256) * att::LDQ + h * DQK, (const bf16_t*)(ws + WS_K) + h * DQK, vh, ob, SEQ, lds);
                      if (F8_MODE == 1) att::attn_unit<true>(ws + WS_Q8 + (size_t)(qb * 256) * (NH * DQK) + h * DQK, ws + WS_K8 + h * DQK, vh, ob, SEQ, lds);
                      if (F8_MODE == 2) {
                          bf16_t* ob2 = (bf16_t*)((unsigned char*)P.out + 16 * MiB) + (size_t)(qb * 256) * DM + h * DV;
                          att::attn_unit<true>(ws + WS_Q8 + (size_t)(qb * 256) * (NH * DQK) + h * DQK, (const unsigned char*)P.out + h * DQK, vh, ob2, SEQ, lds);
                          asm volatile("s_waitcnt vmcnt(0)" ::: "memory"); __syncthreads();
                          const int tidc = tid_opaque(); float e2 = 0.f, r2 = 0.f;
                          for (int idx = tidc; idx < 256 * 128; idx += NTHREADS) { const int rr = idx >> 7, cc = idx & 127;
                              const unsigned short va = __hip_atomic_load((const unsigned short*)(ob + (size_t)rr * DM + cc), __ATOMIC_RELAXED, __HIP_MEMORY_SCOPE_AGENT);
                              const unsigned short vb = __hip_atomic_load((const unsigned short*)(ob2 + (size_t)rr * DM + cc), __ATOMIC_RELAXED, __HIP_MEMORY_SCOPE_AGENT);
                              const float fa = bf2f(va), fb = bf2f(vb); e2 += (fa - fb) * (fa - fb); r2 += fa * fa; }
                          e2 = wave_sum(e2); r2 = wave_sum(r2);
                          float* red = (float*)lds; if ((tidc & 63) == 0) { red[(tidc >> 6) * 2] = e2; red[(tidc >> 6) * 2 + 1] = r2; }
                          __syncthreads();
                          float E = 0.f, R = 0.f; for (int w = 0; w < NWAVES; ++w) { E += red[2 * w]; R += red[2 * w + 1]; }
                          if (!(E <= F8_THR * F8_THR * R) && tidc == 0) ob[0] = (bf16_t)0x7fc0;
                          __syncthreads(); }
                  } }
#endif
                  PROBE_MARK(61);
                  } break;
        case 11: if (PH_ON(6)) {
#ifndef NO_M3
                  { const Params P = load_params(kp); for (int u = vcu; u < HM * NCH; u += G) m3_unit(P, lds, u >> 6, u & 63); }
#endif
                  PROBE_MARK(62);
                  } break;
        case 7: if (PH_ON(7)) { const Params P = load_params(kp); unsigned char* ws = P.ws;
                  pg8::Gemm g{(const bf16_t*)(ws + WS_MIX), (const bf16_t*)(ws + WS_WOUT), SEQ, DM, DM}; pg8::StaticOrder S; S.init(SEQ, DM, G, bx);
                  pg8::Epi4<StoreX1> E{{P.x, (const float*)(ws + WS_MOD) + 2 * DM, P.out}};
                  pg8::gemm_phase<pg8::Epi4<StoreX1>, pg8::StaticOrder, true, true>(ldsl, g, S, E); } break;
        case 8: if (PH_ON(8)) { const Params P = load_params(kp); phase6b(P, lds, G); } break;
        case 9: if (PH_ON(9)) { const Params P = load_params(kp); unsigned char* ws = P.ws;
                  pg8::Gemm g{(const bf16_t*)(ws + WS_H), (const bf16_t*)(ws + WS_W1), SEQ, DFF, DM}; pg8::StaticOrder S; S.init(SEQ, DFF, G, bx);
                  pg8::Epi8<StoreAct> E{{(bf16_t*)(ws + WS_ACT)}};
                  pg8::gemm_phase<pg8::Epi8<StoreAct>, pg8::StaticOrder, true, true>(ldsl, g, S, E); } break;
        case 10: if (PH_ON(10)) { const Params P = load_params(kp); unsigned char* ws = P.ws;
                  pg8::Gemm g{(const bf16_t*)(ws + WS_ACT), (const bf16_t*)(ws + WS_W2), SEQ, DM, DFF}; pg8::StaticOrder S; S.init(SEQ, DM, G, bx);
                  pg8::Epi4<StoreX1> E{{P.out, (const float*)(ws + WS_MOD) + 5 * DM, P.out}};
                  pg8::gemm_phase<pg8::Epi4<StoreX1>, pg8::StaticOrder, true, true>(ldsl, g, S, E); } break;
        default: break;
        }
        }
        if (ph + 1 < ph_hi) { xcd_barrier(xbar); }
        if (PROBE_PH >= 0 && ph == PROBE_PH) { __syncthreads(); probe_dt = __builtin_amdgcn_s_memrealtime() - probe_t0; }
      }
    }
    #ifndef PROBE_BLK
#define PROBE_BLK 0
#endif
    if ((PROBE_PH >= 0 || PROBE_FROM >= 0) && blockIdx.x == PROBE_BLK) { const unsigned long long te = __builtin_amdgcn_s_memrealtime();
        while (__builtin_amdgcn_s_memrealtime() - te < probe_dt) __builtin_amdgcn_s_sleep(8); }
}

extern "C" void kernel_launch(void* const* d_in, const int* in_sizes, int n_in, void* d_out, int out_size, void* d_ws, size_t ws_size, hipStream_t stream) {
    static int grid = 0;
    if (grid == 0) {
        if (n_in != 21 || out_size != SEQ * DM || ws_size < WS_END) { fprintf(stderr, "kernel_launch: unexpected shapes n_in %d out %d ws %zu\n", n_in, out_size, ws_size); grid = -1; return; }
        int dev = 0, cus = 0, per_cu = 0;
        if (hipGetDevice(&dev) != hipSuccess || hipDeviceGetAttribute(&cus, hipDeviceAttributeMultiprocessorCount, dev) != hipSuccess) { grid = -1; return; }
        if (hipFuncSetAttribute((const void*)fwd_kernel, hipFuncAttributeMaxDynamicSharedMemorySize, LDS_BYTES) != hipSuccess) { fprintf(stderr, "kernel_launch: hipFuncSetAttribute failed\n"); grid = -1; return; }
        if (hipOccupancyMaxActiveBlocksPerMultiprocessor(&per_cu, (const void*)fwd_kernel, NTHREADS, LDS_BYTES) != hipSuccess || per_cu < 1) { fprintf(stderr, "kernel_launch: occupancy query says %d\n", per_cu); per_cu = 1; }
        (void)hipGetLastError();
        grid = cus * 1;
    }
    if (grid < 0) return;
    Params p{};
    p.x = (const float*)d_in[0]; p.c = (const float*)d_in[1]; p.pos = (const int*)d_in[2]; p.w_ada = (const float*)d_in[3]; p.b_ada = (const float*)d_in[4];
    p.norm_mix_g = (const float*)d_in[5]; p.w_in = (const float*)d_in[6]; p.b_gates = (const float*)d_in[7]; p.conv_w = (const float*)d_in[8]; p.conv_b = (const float*)d_in[9];
    p.q_lora_g = (const float*)d_in[10]; p.w_uq = (const float*)d_in[11]; p.kv_lora_g = (const float*)d_in[12]; p.w_ukv = (const float*)d_in[13]; p.q_norm_g = (const float*)d_in[14];
    p.k_norm_g = (const float*)d_in[15]; p.mlstm_norm_g = (const float*)d_in[16]; p.w_out = (const float*)d_in[17]; p.norm_mlp_g = (const float*)d_in[18];
    p.w_ff1 = (const float*)d_in[19]; p.w_ff2 = (const float*)d_in[20];
    p.out = (float*)d_out; p.ws = (unsigned char*)d_ws;
    (void)hipMemsetAsync((char*)d_ws + WS_BAR, 0, 32768, stream);
#if MK_MULTI
    for (int ph = 0; ph < NPH; ++ph) { p.ph_lo = ph; p.ph_hi = ph + 1; hipLaunchKernelGGL(fwd_kernel, dim3(grid), dim3(NTHREADS), LDS_BYTES, stream, p); }
#else
    p.ph_lo = 0; p.ph_hi = NPH;
    void* args[] = {&p};
    hipError_t e = hipLaunchCooperativeKernel((const void*)fwd_kernel, dim3(grid), dim3(NTHREADS), args, LDS_BYTES, stream);
    if (e != hipSuccess) fprintf(stderr, "kernel_launch: cooperative launch failed: %s (grid %d)\n", hipGetErrorString(e), grid);
#endif
}
```

```cpp
#include <hip/hip_runtime.h>
#include <hip/hip_cooperative_groups.h>
#include <cstdio>
#include <cstdint>
namespace cg = cooperative_groups;

#ifndef MK_MULTI
#define MK_MULTI 0
#endif

#ifndef F8_MODE
#define F8_MODE 3
#endif
#ifndef F8_DBG
#define F8_DBG 3
#endif
#ifndef F8_THR
#define F8_THR 0.10f
#endif
#define LAS __attribute__((address_space(3)))
typedef unsigned short bf16_t;
typedef short bf16x8 __attribute__((ext_vector_type(8)));
typedef short s16x4 __attribute__((ext_vector_type(4)));
typedef float f32x4 __attribute__((ext_vector_type(4)));
typedef float f32x2 __attribute__((ext_vector_type(2)));
typedef float f32x16 __attribute__((ext_vector_type(16)));
typedef unsigned u32x4 __attribute__((ext_vector_type(4)));
typedef unsigned u32x2 __attribute__((ext_vector_type(2)));

constexpr int SEQ = 8192, DM = 2048, DIN = 4944, DINP = 5120, DFF = 8192;
constexpr int NH = 8, DQK = 192, DV = 128, QLORA = 512, KVLORA = 256;
constexpr int HM = 4, DH = 256, LCH = 128, NCH = 64;
constexpr int OFF_CQ = 0, OFF_CKV = 512, OFF_KPE = 768, OFF_QM = 832, OFF_KM = 1856, OFF_VM = 2880, OFF_OM = 3904, OFF_GM = 4928;
constexpr float EPS = 1e-6f;
constexpr int NTHREADS = 512, NWAVES = 8;
constexpr int LDS_BYTES = 147456;
constexpr int LDS_BARST = LDS_BYTES - 64;

constexpr size_t MiB = 1u << 20;
constexpr size_t WS_MODP = 384 * MiB - 2 * MiB;
constexpr size_t WS_MOD = 786432;
constexpr size_t WS_BC = 1 * MiB;
constexpr size_t WS_IG = WS_BC + 262144;
constexpr size_t WS_PM = WS_IG + 262144;
constexpr size_t WS_WL = WS_PM + 262144;
constexpr size_t WS_BAR = 868352;
constexpr size_t WS_CNT = WS_BAR + 16384;
constexpr size_t WS_MB = 860160;
constexpr size_t WS_BL = 851968;
constexpr size_t WS_AC = 856064;
constexpr size_t WS_WIN = 2 * MiB, WS_WUQ = 22 * MiB, WS_WUKV = 24 * MiB, WS_WOUT = 26 * MiB;
constexpr size_t WS_W1 = 34 * MiB, WS_W2 = 66 * MiB;
constexpr size_t WS_H = 98 * MiB;
constexpr size_t WS_Q = 98 * MiB;
constexpr size_t WS_MIX = 130 * MiB;
constexpr size_t WS_PA = 162 * MiB;
constexpr size_t WS_PB = 194 * MiB;
constexpr int PAW = 2048, PBW = 3072, PA_OM = 832;
constexpr size_t WS_CQN = 242 * MiB, WS_CKVN = 250 * MiB;
constexpr size_t WS_GATES = 254 * MiB;
constexpr size_t WS_NST = 255 * MiB;
constexpr size_t WS_ACT = 130 * MiB;
constexpr size_t WS_KV = 258 * MiB;
constexpr size_t WS_K = 290 * MiB;
constexpr size_t WS_V8T = 122 * MiB;
constexpr size_t WS_Q8 = 242 * MiB;
constexpr size_t WS_K8 = 290 * MiB;
constexpr size_t WS_QH = 314 * MiB, WS_KH = 330 * MiB, WS_KT = 346 * MiB, WS_VT = 362 * MiB;
constexpr size_t WS_ROPE = 378 * MiB;
constexpr size_t WS_END = 384 * MiB;

struct Params {
    const float* x; const float* c; const int* pos; const float* w_ada; const float* b_ada; const float* norm_mix_g; const float* w_in;
    const float* b_gates; const float* conv_w; const float* conv_b; const float* q_lora_g; const float* w_uq; const float* kv_lora_g;
    const float* w_ukv; const float* q_norm_g; const float* k_norm_g; const float* mlstm_norm_g; const float* w_out; const float* norm_mlp_g;
    const float* w_ff1; const float* w_ff2;
    float* out; unsigned char* ws; int ph_lo, ph_hi;
};

__host__ __device__ __forceinline__ size_t cst_off(int dh) { return dh < 6 ? WS_PB + (size_t)dh * (8 * MiB) : WS_WIN + (size_t)(dh - 6) * (8 * MiB); }
#define LAUNDER_V(x) asm volatile("" : "+v"(x))
#define LAUNDER_S(x) asm volatile("" : "+s"(x))
constexpr int LDS_WIDTAB = 147456 - 64 - 256;
__device__ __forceinline__ int tid_opaque() {
    const unsigned hw = __builtin_amdgcn_s_getreg((5 << 11) | 4) & 63u;
    const int wid = *(volatile LAS int*)(uintptr_t)(LDS_WIDTAB + hw * 4);
    int t = wid * 64 + (int)__builtin_amdgcn_mbcnt_hi(~0u, __builtin_amdgcn_mbcnt_lo(~0u, 0u)); LAUNDER_V(t); return t; }
__device__ __forceinline__ unsigned cvt_pk_bf16(float lo, float hi) { unsigned r; asm volatile("v_cvt_pk_bf16_f32 %0, %1, %2" : "=v"(r) : "v"(lo), "v"(hi)); return r; }
__device__ __forceinline__ float bf_lo(unsigned w) { return __uint_as_float(w << 16); }
__device__ __forceinline__ float bf_hi(unsigned w) { return __uint_as_float(w & 0xffff0000u); }
__device__ __forceinline__ float bf2f(bf16_t b) { return __uint_as_float(((unsigned)b) << 16); }
__device__ __forceinline__ bf16_t f2bf(float f) { return (bf16_t)(cvt_pk_bf16(f, 0.f) & 0xffffu); }
__device__ __forceinline__ int lane_opaque() { int l = (int)__builtin_amdgcn_mbcnt_hi(~0u, __builtin_amdgcn_mbcnt_lo(~0u, 0u)); LAUNDER_V(l); return l; }
__device__ __forceinline__ float shx(float v, int m) { return __int_as_float(__builtin_amdgcn_ds_bpermute((lane_opaque() ^ m) << 2, __float_as_int(v))); }
__device__ __forceinline__ float shidx(float v, int i) { return __int_as_float(__builtin_amdgcn_ds_bpermute(i << 2, __float_as_int(v))); }
__device__ __forceinline__ float shup(float v, int o) { return __int_as_float(__builtin_amdgcn_ds_bpermute((lane_opaque() - o) << 2, __float_as_int(v))); }
__device__ __forceinline__ float wave_sum(float v) {
#pragma unroll
    for (int o = 1; o < 64; o <<= 1) v += shx(v, o);
    return v;
}
template <class T> __device__ __forceinline__ T ldgu(const void* ubase, unsigned voff) { return *(const T*)((const char*)ubase + voff); }
__device__ __forceinline__ float silu_f(float v) { return v / (1.f + __expf(-v)); }
__device__ __forceinline__ float sigmoid_f(float v) { return 1.f / (1.f + __expf(-v)); }
__device__ __forceinline__ void unpack8(u32x4 w, float* f) {
    f[0] = bf_lo(w.x); f[1] = bf_hi(w.x); f[2] = bf_lo(w.y); f[3] = bf_hi(w.y); f[4] = bf_lo(w.z); f[5] = bf_hi(w.z); f[6] = bf_lo(w.w); f[7] = bf_hi(w.w);
}
__device__ __forceinline__ u32x2 pack8_fp8(const float* f) {
    int a = 0, b = 0; a = __builtin_amdgcn_cvt_pk_fp8_f32(f[0], f[1], a, false); a = __builtin_amdgcn_cvt_pk_fp8_f32(f[2], f[3], a, true);
    b = __builtin_amdgcn_cvt_pk_fp8_f32(f[4], f[5], b, false); b = __builtin_amdgcn_cvt_pk_fp8_f32(f[6], f[7], b, true); u32x2 w; w.x = (unsigned)a; w.y = (unsigned)b; return w; }
__device__ __forceinline__ u32x4 pack8(const float* f) {
    u32x4 w; w.x = cvt_pk_bf16(f[0], f[1]); w.y = cvt_pk_bf16(f[2], f[3]); w.z = cvt_pk_bf16(f[4], f[5]); w.w = cvt_pk_bf16(f[6], f[7]); return w;
}

namespace pg8 {
constexpr int BM = 256, BK = 64, HALF = 128, HTB = HALF * BK * 2, STAGE_BYTES = 8 * HTB, NXCD = 8, WGM = 8;
__host__ __device__ __forceinline__ int lds_byte(int r, int c) { const int st = (r >> 4) * 2 + (c >> 5), rr = r & 15, cc = c & 31, ob = rr * 64 + cc * 2; return st * 1024 + (ob ^ (((ob >> 9) & 1) << 5)); }
__host__ __device__ __forceinline__ void stage_rc(int b, int& R, int& C) { const int st = b / 1024, sb = b % 1024, swz = sb ^ (((sb >> 9) & 1) << 5); R = (st >> 1) * 16 + swz / 64; C = (st & 1) * 32 + (swz % 64) / 2; }
__host__ __device__ __forceinline__ int perm32(int rho) { const int n = rho >> 4, i = rho & 15; return 8 * (i >> 2) + 4 * n + (i & 3); }
struct Unit { int pm, pn; };
struct Gemm { const bf16_t* A; const bf16_t* Bt; int M, N, K; };
struct StaticOrder {
    int nM, nN, nwg, G, c;
    __host__ __device__ void init(int M, int N, int G_, int c_) { nM = M / BM; nN = N / BM; nwg = nM * nN; G = G_; c = c_; }
    __host__ __device__ bool next(int i, Unit& u) const {
        const long L = (long)i * G + c; if (L >= nwg) return false;
        int wgid = (int)L; { const int q = nwg / NXCD, r = nwg % NXCD, xcd = wgid % NXCD, off = wgid / NXCD; wgid = (xcd < r ? xcd * (q + 1) : r * (q + 1) + (xcd - r) * q) + off; }
        const int nig = WGM * nN, gid = wgid / nig, fm = gid * WGM, gsz = (nM - fm) < WGM ? (nM - fm) : WGM;
        u.pm = fm + ((wgid % nig) % gsz); u.pn = (wgid % nig) / gsz; return true;
    }
    __device__ __forceinline__ void a_ready(const Unit&) const {}
    __device__ __forceinline__ void done(const Unit&) const {}
};
template <class F> struct Epi8 {
    static constexpr bool PERM = true, AFTER_DRAIN = false; F f;
    __device__ __forceinline__ void operator()(const f32x4 (&acc)[2][2][4][2], const Unit& u, int wr, int wc, int fr, int fq) const {
        const int row0 = u.pm * BM + wr * 64 + fr, col0 = u.pn * BM + wc * 32 + 8 * fq;
#pragma unroll
        for (int ai = 0; ai < 2; ++ai)
#pragma unroll
            for (int m = 0; m < 4; ++m)
#pragma unroll
                for (int bj = 0; bj < 2; ++bj) f(row0 + ai * HALF + m * 16, col0 + bj * HALF, acc[ai][bj][m][0], acc[ai][bj][m][1]);
    }
};
template <class F> struct Epi4 {
    static constexpr bool PERM = false, AFTER_DRAIN = false; F f;
    __device__ __forceinline__ void operator()(const f32x4 (&acc)[2][2][4][2], const Unit& u, int wr, int wc, int fr, int fq) const {
        const int row0 = u.pm * BM + wr * 64 + fr, col0 = u.pn * BM + wc * 32 + 4 * fq;
#pragma unroll
        for (int ai = 0; ai < 2; ++ai)
#pragma unroll
            for (int m = 0; m < 4; ++m) {
#pragma unroll
                for (int bj = 0; bj < 2; ++bj)
#pragma unroll
                    for (int n = 0; n < 2; ++n) f(row0 + ai * HALF + m * 16, col0 + bj * HALF + n * 16, acc[ai][bj][m][n]);
                if (m & 1) asm volatile("" ::: "memory");
            }
    }
};

template <class Epi, class Sched, bool ALIGN_EPI = false, bool SP2 = false>
__device__ __forceinline__ void gemm_phase(LAS unsigned char* lds, const Gemm g, const Sched& S, const Epi& E) {
    const int tid = tid_opaque(), wid = __builtin_amdgcn_readfirstlane(tid >> 6), lane = tid & 63, wr = wid >> 2, wc = wid & 3, fr = lane & 15, fq = lane >> 4;
    const int K = g.K, nt = K / BK;
    unsigned voffA[2], voffB[2];
#pragma unroll
    for (int i = 0; i < 2; ++i) { int R, C; stage_rc(tid * 16 + i * 8192, R, C); const int Rb = Epi::PERM ? ((R & ~31) + perm32(R & 31)) : R;
        voffA[i] = (unsigned)(R * K + C) * 2u; voffB[i] = (unsigned)(Rb * K + C) * 2u; }
    const size_t kstep = (size_t)(BK * 2);
    const size_t hstep = (size_t)HALF * K * 2;
    const size_t tstep = 2 * hstep;
    const unsigned ldsw = (unsigned)wid * 1024u;
    const int aoff = lds_byte(wr * 64 + fr, fq * 8), boff = lds_byte(wc * 32 + fr, fq * 8);
#define PG8_SA(b, h) (((b) * 2 + (h)) * HTB)
#define PG8_SB(b, h) ((4 + (b) * 2 + (h)) * HTB)
#define PG8_STAGE(bufoff, gbase, voff) do { _Pragma("unroll") for (int _i = 0; _i < 2; ++_i) \
        __builtin_amdgcn_global_load_lds((const unsigned*)((const char*)(gbase) + (voff)[_i]), (LAS unsigned*)(lds + (bufoff) + ldsw + _i * 8192), 16, 0, 0); } while (0)
#define PG8_LDA(dst, b, h) do { _Pragma("unroll") for (int m = 0; m < 4; ++m) _Pragma("unroll") for (int k = 0; k < 2; ++k) dst[m][k] = *(const LAS bf16x8*)(lds + PG8_SA(b, h) + aoff + m * 2048 + k * 1024); } while (0)
#define PG8_LDB(dst, b, h) do { _Pragma("unroll") for (int n = 0; n < 2; ++n) _Pragma("unroll") for (int k = 0; k < 2; ++k) dst[n][k] = *(const LAS bf16x8*)(lds + PG8_SB(b, h) + boff + n * 2048 + k * 1024); } while (0)
#define PG8_MMA(ai, bj, At, Bt) do { __builtin_amdgcn_s_setprio(1); _Pragma("unroll") for (int m = 0; m < 4; ++m) _Pragma("unroll") for (int n = 0; n < 2; ++n) _Pragma("unroll") for (int k = 0; k < 2; ++k) \
        acc[ai][bj][m][n] = __builtin_amdgcn_mfma_f32_16x16x32_bf16(Bt[n][k], At[m][k], acc[ai][bj][m][n], 0, 0, 0); __builtin_amdgcn_s_setprio(0); } while (0)
#define PG8_WAIT_V(n) asm volatile("s_waitcnt vmcnt(" #n ")" ::: "memory")
#define PG8_WAIT_L(n) asm volatile("s_waitcnt lgkmcnt(" #n ")" ::: "memory")
#define PG8_BAR __builtin_amdgcn_s_barrier()
#define PG8_SCHED __builtin_amdgcn_sched_barrier(0)
    Unit cur, nxt; int ui = 0;
    if (!S.next(0, cur)) return;
    f32x4 acc[2][2][4][2];
#pragma unroll
    for (int a = 0; a < 2; ++a)
#pragma unroll
        for (int b = 0; b < 2; ++b)
#pragma unroll
            for (int m = 0; m < 4; ++m)
#pragma unroll
                for (int n = 0; n < 2; ++n) acc[a][b][m][n] = (f32x4){0.f, 0.f, 0.f, 0.f};
    bf16x8 At[4][2], B0[2][2], B1[2][2];
    const char* cA = (const char*)g.A + (size_t)cur.pm * tstep; const char* cB = (const char*)g.Bt + (size_t)cur.pn * tstep;
    S.a_ready(cur);
    if constexpr (SP2) {
        PG8_STAGE(PG8_SB(0, 0), cB, voffB); PG8_STAGE(PG8_SB(0, 1), cB + hstep, voffB); PG8_STAGE(PG8_SA(0, 0), cA, voffA); PG8_STAGE(PG8_SA(0, 1), cA + hstep, voffA);
        if (wr == 1) PG8_BAR;
        PG8_WAIT_V(2); PG8_BAR;
        PG8_STAGE(PG8_SB(1, 0), cB + kstep, voffB); PG8_STAGE(PG8_SA(1, 0), cA + kstep, voffA); PG8_STAGE(PG8_SB(1, 1), cB + hstep + kstep, voffB);
        PG8_WAIT_V(6); PG8_BAR;
    } else {
        PG8_STAGE(PG8_SB(0, 0), cB, voffB); PG8_STAGE(PG8_SA(0, 0), cA, voffA); PG8_STAGE(PG8_SB(0, 1), cB + hstep, voffB); PG8_STAGE(PG8_SA(0, 1), cA + hstep, voffA);
        if (wr == 1) PG8_BAR;
        PG8_WAIT_V(4); PG8_BAR;
        PG8_STAGE(PG8_SB(1, 0), cB + kstep, voffB); PG8_STAGE(PG8_SA(1, 0), cA + kstep, voffA); PG8_STAGE(PG8_SB(1, 1), cB + hstep + kstep, voffB);
        PG8_WAIT_V(6); PG8_BAR;
    }
    for (;;) {
        const bool has_next = S.next(ui + 1, nxt);
        const char* nA = has_next ? (const char*)g.A + (size_t)nxt.pm * tstep : cA; const char* nB = has_next ? (const char*)g.Bt + (size_t)nxt.pn * tstep : cB;
#pragma unroll 1
        for (int t = 0; t < nt; t += 2) {
            const bool last = (t == nt - 2);
            const char* a1 = cA + (size_t)(t + 1) * kstep;
            const char* a2 = last ? nA : cA + (size_t)(t + 2) * kstep; const char* b2 = last ? nB : cB + (size_t)(t + 2) * kstep;
            const char* a3 = a2 + kstep; const char* b3 = b2 + kstep;
            if (last && has_next) S.a_ready(nxt);
            if constexpr (SP2) {
            PG8_LDB(B0, 0, 0); PG8_LDB(B1, 0, 1); PG8_SCHED; PG8_LDA(At, 0, 0); PG8_STAGE(PG8_SA(1, 1), a1 + hstep, voffA);
            PG8_WAIT_V(8); PG8_WAIT_L(0); PG8_BAR; PG8_MMA(0, 0, At, B0); PG8_MMA(0, 1, At, B1); PG8_BAR; PG8_SCHED;
            PG8_LDA(At, 0, 1); PG8_STAGE(PG8_SB(0, 0), b2, voffB); PG8_STAGE(PG8_SB(0, 1), b2 + hstep, voffB); PG8_STAGE(PG8_SA(0, 0), a2, voffA);
            PG8_WAIT_V(8); PG8_WAIT_L(0); PG8_BAR; PG8_MMA(1, 0, At, B0); PG8_MMA(1, 1, At, B1); PG8_BAR; PG8_SCHED;
            PG8_LDB(B0, 1, 0); PG8_LDB(B1, 1, 1); PG8_SCHED; PG8_LDA(At, 1, 0); PG8_STAGE(PG8_SA(0, 1), a2 + hstep, voffA);
            PG8_WAIT_V(8); PG8_WAIT_L(0); PG8_BAR; PG8_MMA(0, 0, At, B0); PG8_MMA(0, 1, At, B1); PG8_BAR; PG8_SCHED;
            PG8_LDA(At, 1, 1); PG8_STAGE(PG8_SB(1, 0), b3, voffB); PG8_STAGE(PG8_SB(1, 1), b3 + hstep, voffB); PG8_STAGE(PG8_SA(1, 0), a3, voffA);
            PG8_WAIT_V(8); PG8_WAIT_L(0); PG8_BAR; PG8_MMA(1, 0, At, B0); PG8_MMA(1, 1, At, B1); PG8_BAR; PG8_SCHED;
            } else {
            PG8_LDB(B0, 0, 0); PG8_SCHED; PG8_LDA(At, 0, 0); PG8_STAGE(PG8_SA(1, 1), a1 + hstep, voffA);
            PG8_WAIT_L(8); PG8_BAR; PG8_WAIT_L(0); PG8_MMA(0, 0, At, B0); PG8_BAR; PG8_SCHED;
            PG8_LDB(B1, 0, 1); PG8_STAGE(PG8_SB(0, 0), b2, voffB);
            PG8_BAR; PG8_WAIT_L(0); PG8_MMA(0, 1, At, B1); PG8_BAR;
            PG8_LDA(At, 0, 1); PG8_STAGE(PG8_SA(0, 0), a2, voffA);
            PG8_BAR; PG8_WAIT_L(0); PG8_MMA(1, 0, At, B0); PG8_BAR; PG8_SCHED;
            PG8_STAGE(PG8_SB(0, 1), b2 + hstep, voffB);
            PG8_WAIT_V(6); PG8_BAR; PG8_MMA(1, 1, At, B1); PG8_BAR;
            PG8_LDB(B0, 1, 0); PG8_SCHED; PG8_LDA(At, 1, 0); PG8_STAGE(PG8_SA(0, 1), a2 + hstep, voffA);
            PG8_WAIT_L(8); PG8_BAR; PG8_WAIT_L(0); PG8_MMA(0, 0, At, B0); PG8_BAR; PG8_SCHED;
            PG8_LDB(B1, 1, 1); PG8_STAGE(PG8_SB(1, 0), b3, voffB);
            PG8_BAR; PG8_WAIT_L(0); PG8_MMA(0, 1, At, B1); PG8_BAR;
            PG8_LDA(At, 1, 1); PG8_STAGE(PG8_SA(1, 0), a3, voffA);
            PG8_BAR; PG8_WAIT_L(0); PG8_MMA(1, 0, At, B0); PG8_BAR; PG8_SCHED;
            PG8_STAGE(PG8_SB(1, 1), b3 + hstep, voffB);
            PG8_WAIT_V(6); PG8_BAR; PG8_MMA(1, 1, At, B1); PG8_BAR;
            }
        }
        if constexpr (ALIGN_EPI) { if (wr == 0) PG8_BAR; }
        if constexpr (!Epi::AFTER_DRAIN) { E(acc, cur, wr, wc, fr, fq); S.done(cur); }
        if (!has_next) break;
#pragma unroll
        for (int a = 0; a < 2; ++a)
#pragma unroll
            for (int b = 0; b < 2; ++b)
#pragma unroll
                for (int m = 0; m < 4; ++m)
#pragma unroll
                    for (int n = 0; n < 2; ++n) acc[a][b][m][n] = (f32x4){0.f, 0.f, 0.f, 0.f};
        cur = nxt; cA = nA; cB = nB; ++ui;
        if constexpr (ALIGN_EPI) { if (wr == 1) PG8_BAR; }
    }
    PG8_WAIT_V(0);
    if constexpr (!ALIGN_EPI) { if (wr == 0) PG8_BAR; }
    PG8_BAR;
#undef PG8_SA
#undef PG8_SB
#undef PG8_STAGE
#undef PG8_LDA
#undef PG8_LDB
#undef PG8_MMA
#undef PG8_WAIT_V
#undef PG8_WAIT_L
#undef PG8_BAR
#undef PG8_SCHED
}
}

namespace att {
constexpr int NW = 8, QBLK = 32, KVBLK = 64;
constexpr int LDQ = NH * DQK, LDK = NH * DQK, LDV = NH * 256, LDO = DM;
constexpr float SCALE = 0.07216878364870322f;
constexpr float THR = 8.f;
constexpr int SHM_K = KVBLK * DQK * 2, SHM_V = KVBLK * DV * 2;
constexpr int SHM_QL = 2 * SHM_V + 2 * SHM_K + NW * 64 * 4;
constexpr int SHM_ATTN = SHM_QL + NW * 4096;
#define KSWZ(row, colB) ((row) * 384 + ((colB) ^ ((((row) >> 1) & 7) << 4)))
#define SBAR() __builtin_amdgcn_sched_barrier(0)
__device__ __forceinline__ int crow(int r, int hi) { return (r & 3) + 8 * (r >> 2) + 4 * hi; }
__device__ __forceinline__ void partialSM(f32x16& p0, f32x16& p1, float& m_reg, float& mn, float& alpha) {
    constexpr float C = SCALE * 1.4426950408889634f;
    float pmax = p0[0];
#pragma unroll
    for (int r = 1; r < 16; ++r) pmax = fmaxf(pmax, p0[r]);
#pragma unroll
    for (int r = 0; r < 16; ++r) pmax = fmaxf(pmax, p1[r]);
    { auto rr = __builtin_amdgcn_permlane32_swap(__float_as_uint(pmax), __float_as_uint(pmax), false, false);
      pmax = fmaxf(__uint_as_float(rr[0]), __uint_as_float(rr[1])); }
    if (__builtin_expect(__all(pmax - m_reg <= THR / SCALE), 1)) { mn = m_reg; alpha = 1.f; }
    else { mn = fmaxf(m_reg, pmax); alpha = __builtin_amdgcn_exp2f((m_reg - mn) * C); m_reg = mn; }
    float mnC = -mn * C;
#pragma unroll
    for (int r = 0; r < 16; ++r) p0[r] = fmaf(p0[r], C, mnC);
#pragma unroll
    for (int r = 0; r < 16; ++r) p1[r] = fmaf(p1[r], C, mnC);
#pragma unroll
    for (int r = 0; r < 16; ++r) p0[r] = __builtin_amdgcn_exp2f(p0[r]);
}
__device__ __forceinline__ void finishSM(f32x16& p0, f32x16& p1, float alpha, float& l_reg, bf16x8& pa0, bf16x8& pa1, bf16x8& pa2, bf16x8& pa3) {
#pragma unroll
    for (int r = 0; r < 16; ++r) p1[r] = __builtin_amdgcn_exp2f(p1[r]);
    float ps = 0;
#pragma unroll
    for (int r = 0; r < 16; ++r) ps += p0[r];
#pragma unroll
    for (int r = 0; r < 16; ++r) ps += p1[r];
    { auto rr = __builtin_amdgcn_permlane32_swap(__float_as_uint(ps), __float_as_uint(ps), false, false);
      ps = __uint_as_float(rr[0]) + __uint_as_float(rr[1]); }
    l_reg = l_reg * alpha + ps;
#define PK4(P, BASE, OUT) do { unsigned a0 = cvt_pk_bf16(P[BASE + 0], P[BASE + 1]), a1 = cvt_pk_bf16(P[BASE + 2], P[BASE + 3]);   \
    unsigned b0 = cvt_pk_bf16(P[BASE + 4], P[BASE + 5]), b1 = cvt_pk_bf16(P[BASE + 6], P[BASE + 7]);                              \
    auto r0 = __builtin_amdgcn_permlane32_swap(a0, b0, false, false); auto r1 = __builtin_amdgcn_permlane32_swap(a1, b1, false, false); \
    u32x4 w = {r0[0], r1[0], r0[1], r1[1]}; OUT = *reinterpret_cast<bf16x8*>(&w); } while (0)
    PK4(p0, 0, pa0); PK4(p0, 8, pa1); PK4(p1, 0, pa2); PK4(p1, 8, pa3);
#undef PK4
}
typedef int v8i __attribute__((ext_vector_type(8)));
constexpr float THR8 = 1.0f;
__device__ __forceinline__ void partialSM8(f32x16& p0, f32x16& p1, float& m_reg, float& mn, float& alpha) {
    constexpr float C = SCALE * 1.4426950408889634f;
    float pmax = p0[0];
#pragma unroll
    for (int r = 1; r < 16; ++r) pmax = fmaxf(pmax, p0[r]);
#pragma unroll
    for (int r = 0; r < 16; ++r) pmax = fmaxf(pmax, p1[r]);
    { auto rr = __builtin_amdgcn_permlane32_swap(__float_as_uint(pmax), __float_as_uint(pmax), false, false);
      pmax = fmaxf(__uint_as_float(rr[0]), __uint_as_float(rr[1])); }
    if (__builtin_expect(__all(pmax - m_reg <= THR8 / SCALE), 1)) { mn = m_reg; alpha = 1.f; }
    else { mn = fmaxf(m_reg, pmax); alpha = __builtin_amdgcn_exp2f((m_reg - mn) * C); m_reg = mn; }
    float mnC = -mn * C + 7.0f;
#pragma unroll
    for (int r = 0; r < 16; ++r) p0[r] = fmaf(p0[r], C, mnC);
#pragma unroll
    for (int r = 0; r < 16; ++r) p1[r] = fmaf(p1[r], C, mnC);
#pragma unroll
    for (int r = 0; r < 16; ++r) p0[r] = __builtin_amdgcn_exp2f(p0[r]);
}
__device__ __forceinline__ void finishSM8(f32x16& p0, f32x16& p1, float alpha, float& l_reg, v8i& pa) {
#pragma unroll
    for (int r = 0; r < 16; ++r) p1[r] = __builtin_amdgcn_exp2f(p1[r]);
    float ps = 0;
#pragma unroll
    for (int r = 0; r < 16; ++r) ps += p0[r];
#pragma unroll
    for (int r = 0; r < 16; ++r) ps += p1[r];
    { auto rr = __builtin_amdgcn_permlane32_swap(__float_as_uint(ps), __float_as_uint(ps), false, false);
      ps = __uint_as_float(rr[0]) + __uint_as_float(rr[1]); }
    l_reg = l_reg * alpha + ps;
#pragma unroll
    for (int w = 0; w < 4; ++w) { int a = 0, b = 0;
        a = __builtin_amdgcn_cvt_pk_fp8_f32(p0[4 * w], p0[4 * w + 1], a, false); a = __builtin_amdgcn_cvt_pk_fp8_f32(p0[4 * w + 2], p0[4 * w + 3], a, true);
        b = __builtin_amdgcn_cvt_pk_fp8_f32(p1[4 * w], p1[4 * w + 1], b, false); b = __builtin_amdgcn_cvt_pk_fp8_f32(p1[4 * w + 2], p1[4 * w + 3], b, true);
        pa[w] = a; pa[4 + w] = b; }
}
constexpr int V8S = 80;
__device__ __forceinline__ void pv8(f32x16* o, const char* Vs, const v8i& pa, int r32, int hi) {
#pragma unroll
    for (int d0 = 0; d0 < 4; ++d0) { const char* bp = Vs + (32 * d0 + r32) * V8S + hi * 32;
        const u32x4 bl = *(const u32x4*)bp, bh = *(const u32x4*)(bp + 16);
        const v8i B = {(int)bl.x, (int)bl.y, (int)bl.z, (int)bl.w, (int)bh.x, (int)bh.y, (int)bh.z, (int)bh.w};
        o[d0] = __builtin_amdgcn_mfma_scale_f32_32x32x64_f8f6f4(pa, B, o[d0], 0, 0, 0, 0, 0, 0); }
}
__device__ __forceinline__ void qkt(f32x16& p0, f32x16& p1, const char* Ks, const bf16x8* qr, const char* ql, int r32, int hi) {
    p0 = f32x16{}; p1 = f32x16{};
#pragma unroll
    for (int d0 = 0; d0 < 12; ++d0) { const int cb = (d0 * 16 + hi * 8) * 2;
        bf16x8 b0 = *reinterpret_cast<const bf16x8*>(Ks + KSWZ(r32, cb));
        bf16x8 b1 = *reinterpret_cast<const bf16x8*>(Ks + KSWZ(32 + r32, cb));
        const bf16x8 q = d0 < 8 ? qr[d0 < 8 ? d0 : 0] : *reinterpret_cast<const bf16x8*>(ql + (d0 - 8) * 1024);
        p0 = __builtin_amdgcn_mfma_f32_32x32x16_bf16(b0, q, p0, 0, 0, 0);
        p1 = __builtin_amdgcn_mfma_f32_32x32x16_bf16(b1, q, p1, 0, 0, 0); }
}
__device__ __forceinline__ int v_st(int k, int c) { const int kk = (k & ~0xC) | ((k & 4) << 1) | ((k & 8) >> 1); return ((kk >> 3) * 4 + (c >> 5)) * 512 + ((kk & 7) * 32 + (c & 31)) * 2; }
__device__ __forceinline__ int v_rd_base(int lane) { return ((lane & 3) << 3) | (((lane >> 2) & 3) << 6) | (((lane >> 4) & 1) << 5) | (((lane >> 5) & 1) << 8); }
constexpr int v_rd_off(int d0, int ks, int half) { return d0 * 512 + ks * 4096 + half * 2048; }
template <int OFF> __device__ __forceinline__ s16x4 tr_read(int vb) {
    s16x4 r; asm volatile("ds_read_b64_tr_b16 %0, %1 offset:%2" : "=&v"(r) : "v"(vb), "i"(OFF) : "memory"); return r;
}
template <int D0> __device__ __forceinline__ void pv_one(f32x16& od, int vb, bf16x8 pa0, bf16x8 pa1, bf16x8 pa2, bf16x8 pa3) {
#define PK(L, H) (bf16x8){L[0], L[1], L[2], L[3], H[0], H[1], H[2], H[3]}
    { const s16x4 l0 = tr_read<v_rd_off(D0, 0, 0)>(vb), h0 = tr_read<v_rd_off(D0, 0, 1)>(vb), l1 = tr_read<v_rd_off(D0, 1, 0)>(vb), h1 = tr_read<v_rd_off(D0, 1, 1)>(vb);
      asm volatile("s_waitcnt lgkmcnt(0)" ::: "memory"); SBAR();
      od = __builtin_amdgcn_mfma_f32_32x32x16_bf16(pa0, PK(l0, h0), od, 0, 0, 0);
      od = __builtin_amdgcn_mfma_f32_32x32x16_bf16(pa1, PK(l1, h1), od, 0, 0, 0); }
    { const s16x4 l2 = tr_read<v_rd_off(D0, 2, 0)>(vb), h2 = tr_read<v_rd_off(D0, 2, 1)>(vb), l3 = tr_read<v_rd_off(D0, 3, 0)>(vb), h3 = tr_read<v_rd_off(D0, 3, 1)>(vb);
      asm volatile("s_waitcnt lgkmcnt(0)" ::: "memory"); SBAR();
      od = __builtin_amdgcn_mfma_f32_32x32x16_bf16(pa2, PK(l2, h2), od, 0, 0, 0);
      od = __builtin_amdgcn_mfma_f32_32x32x16_bf16(pa3, PK(l3, h3), od, 0, 0, 0); }
#undef PK
}
__device__ __forceinline__ void pv_d0(f32x16* o, int vb, bf16x8 pa0, bf16x8 pa1, bf16x8 pa2, bf16x8 pa3) {
    pv_one<0>(o[0], vb, pa0, pa1, pa2, pa3); pv_one<1>(o[1], vb, pa0, pa1, pa2, pa3); pv_one<2>(o[2], vb, pa0, pa1, pa2, pa3); pv_one<3>(o[3], vb, pa0, pa1, pa2, pa3);
}
#ifndef ATT_SDEPTH
#define ATT_SDEPTH 1
#endif
constexpr int SDEPTH = ATT_SDEPTH;
constexpr int K8S = 208;
__device__ __forceinline__ void qkt8(f32x16& p0, f32x16& p1, const char* Ks, const v8i* qr8, int r32, int hi) {
    p0 = f32x16{}; p1 = f32x16{};
#pragma unroll
    for (int ks = 0; ks < 3; ++ks) {
        const char* a0p = Ks + r32 * K8S + ks * 64 + hi * 32; const char* a1p = a0p + 32 * K8S;
        const u32x4 a0l = *(const u32x4*)a0p, a0h = *(const u32x4*)(a0p + 16), a1l = *(const u32x4*)a1p, a1h = *(const u32x4*)(a1p + 16);
        const v8i A0 = {(int)a0l.x, (int)a0l.y, (int)a0l.z, (int)a0l.w, (int)a0h.x, (int)a0h.y, (int)a0h.z, (int)a0h.w};
        const v8i A1 = {(int)a1l.x, (int)a1l.y, (int)a1l.z, (int)a1l.w, (int)a1h.x, (int)a1h.y, (int)a1h.z, (int)a1h.w};
        p0 = __builtin_amdgcn_mfma_scale_f32_32x32x64_f8f6f4(A0, qr8[ks], p0, 0, 0, 0, 0, 0, 0);
        p1 = __builtin_amdgcn_mfma_scale_f32_32x32x64_f8f6f4(A1, qr8[ks], p1, 0, 0, 0, 0, 0, 0); }
}
template <int FM>
__device__ __forceinline__ void attn_unit(const void* __restrict__ Qbv, const void* __restrict__ Khv, const void* __restrict__ Vhv, bf16_t* __restrict__ Ob, int seq, char* lds) {
    constexpr bool F8 = FM != 0, PV8 = FM == 3; const bf16_t* Vh = (const bf16_t*)Vhv;
    const int tid = tid_opaque(), wid = tid >> 6, lane = tid & 63, r32 = lane & 31, hi = lane >> 5;
    char* V_lds = lds; char* K_lds = lds + 2 * SHM_V;
    float* ws = (float*)(lds + 2 * SHM_V + 2 * SHM_K) + wid * 64; float* li_l = ws; float* al_l = ws + 32;
    float m_reg = -1e30f, l_reg = 0; f32x16 o[4] = {};
    bf16x8 qr[F8 ? 1 : 8]; v8i qr8[F8 ? 3 : 1];
    char* ql = lds + SHM_QL + wid * 4096 + lane * 16;
    if constexpr (F8) {
        const unsigned char* Qw = (const unsigned char*)Qbv + (long)(wid * QBLK + r32) * (NH * DQK) + hi * 32;
#pragma unroll
        for (int ks = 0; ks < 3; ++ks) { const u32x4 lo = *(const u32x4*)(Qw + ks * 64), hh = *(const u32x4*)(Qw + ks * 64 + 16);
            qr8[ks] = (v8i){(int)lo.x, (int)lo.y, (int)lo.z, (int)lo.w, (int)hh.x, (int)hh.y, (int)hh.z, (int)hh.w}; }
    } else {
        const bf16_t* Qw = (const bf16_t*)Qbv + (long)(wid * QBLK + r32) * LDQ + hi * 8;
#pragma unroll
        for (int d0 = 0; d0 < 8; ++d0) qr[d0] = *reinterpret_cast<const bf16x8*>(Qw + d0 * 16);
#pragma unroll
        for (int d0 = 8; d0 < 12; ++d0) *reinterpret_cast<bf16x8*>(ql + (d0 - 8) * 1024) = *reinterpret_cast<const bf16x8*>(Qw + d0 * 16);
    }
    const int krow = tid >> 3, kc8 = tid & 7;
    const int id1 = 512 + (tid & 255);
    const unsigned kgo = F8 ? (unsigned)((tid / 12) * (NH * DQK) + (tid % 12) * 16) : (unsigned)(krow * LDK + kc8 * 8) * 2u;
    const int kso = F8 ? (tid / 12) * K8S + (tid % 12) * 16 : krow * 384 + ((kc8 * 16) ^ (((krow >> 1) & 7) << 4));
    const unsigned kgo1 = (unsigned)((id1 / 12) * (NH * DQK) + (id1 % 12) * 16); const int kso1 = (id1 / 12) * K8S + (id1 % 12) * 16; const bool k1on = tid < 256;
    const int sr = tid >> 4, sc = (tid & 15) * 8, vst0 = v_st(sr, sc);
    const unsigned vgo = (unsigned)(sr * LDV + sc) * 2u;
    const int vb0 = (int)(uintptr_t)V_lds + v_rd_base(lane);
    const int v8so = (tid >> 2) * V8S + (tid & 3) * 16;
    struct { bf16x8 k0, k1, k2, v0, v1; } sr_[SDEPTH];
#define SLOAD(i, kk0) do { if constexpr (PV8) { sr_[i].v0 = ldgu<bf16x8>((const char*)Vhv + (long)(kk0) * 128, (unsigned)tid * 16u); } \
    else { const char* vp_ = (const char*)(Vh + (long)(kk0) * LDV); sr_[i].v0 = ldgu<bf16x8>(vp_, vgo); sr_[i].v1 = ldgu<bf16x8>(vp_ + 32 * LDV * 2, vgo); } \
    if constexpr (F8) { const char* kp_ = (const char*)Khv + (long)(kk0) * (NH * DQK); sr_[i].k0 = ldgu<bf16x8>(kp_, kgo); if (k1on) sr_[i].k1 = ldgu<bf16x8>(kp_, kgo1); } \
    else { const char* kp_ = (const char*)((const bf16_t*)Khv + (long)(kk0) * LDK); sr_[i].k0 = ldgu<bf16x8>(kp_, kgo); sr_[i].k1 = ldgu<bf16x8>(kp_ + 128, kgo); sr_[i].k2 = ldgu<bf16x8>(kp_ + 256, kgo); } } while (0)
#define SWRITE(b, i) do { if constexpr (PV8) { *(bf16x8*)(V_lds + (b) * SHM_V + v8so) = sr_[i].v0; } else { *(bf16x8*)(V_lds + (b) * SHM_V + vst0) = sr_[i].v0; *(bf16x8*)(V_lds + (b) * SHM_V + 8192 + vst0) = sr_[i].v1; } \
    if constexpr (F8) { *(bf16x8*)(K_lds + (b) * SHM_K + kso) = sr_[i].k0; if (k1on) *(bf16x8*)(K_lds + (b) * SHM_K + kso1) = sr_[i].k1; } \
    else { *(bf16x8*)(K_lds + (b) * SHM_K + kso) = sr_[i].k0; *(bf16x8*)(K_lds + (b) * SHM_K + 128 + kso) = sr_[i].k1; *(bf16x8*)(K_lds + (b) * SHM_K + 256 + kso) = sr_[i].k2; } } while (0)
#define SWAIT() do { if constexpr (SDEPTH == 2) asm volatile("s_waitcnt vmcnt(5)" ::: "memory"); else asm volatile("s_waitcnt vmcnt(0)" ::: "memory"); } while (0)
#define RESC(a) do { if (__any((a) < 1.f)) { if (hi == 0) al_l[r32] = (a); asm volatile("s_waitcnt lgkmcnt(0)" ::: "memory"); \
    _Pragma("unroll") for (int d = 0; d < 4; ++d) _Pragma("unroll") for (int r = 0; r < 16; ++r) o[d][r] *= al_l[crow(r, hi)]; } } while (0)
#define PSM(P0, P1, MN, AL) do { if constexpr (PV8) partialSM8(P0, P1, m_reg, MN, AL); else partialSM(P0, P1, m_reg, MN, AL); } while (0)
#define FSM(P0, P1, AL) do { if constexpr (PV8) finishSM8(P0, P1, AL, l_reg, pa8); else finishSM(P0, P1, AL, l_reg, pa0, pa1, pa2, pa3); } while (0)
#define PVD(BUF) do { if constexpr (PV8) pv8(o, V_lds + (BUF) * SHM_V, pa8, r32, hi); else pv_d0(o, vb0 + (BUF) * SHM_V, pa0, pa1, pa2, pa3); } while (0)
#define QKT(P0, P1, KB) do { if constexpr (F8) qkt8(P0, P1, KB, qr8, r32, hi); else qkt(P0, P1, KB, qr, ql, r32, hi); } while (0)
    f32x16 pA0, pA1, pB0, pB1; float mnA, mnB, alA, alB; bf16x8 pa0, pa1, pa2, pa3; v8i pa8; const int NT = seq / KVBLK;
    constexpr int SE = 0, SO = SDEPTH - 1;
    SLOAD(SE, 0); asm volatile("s_waitcnt vmcnt(0)" ::: "memory"); SWRITE(0, SE); __syncthreads();
    QKT(pA0, pA1, K_lds); PSM(pA0, pA1, mnA, alA);
    SLOAD(SO, KVBLK); if constexpr (SDEPTH == 2) { if (2 < NT) SLOAD(SE, 2 * KVBLK); }
    SWAIT(); SWRITE(1, SO); __syncthreads();
    for (int j = 1; j + 1 < NT; j += 2) {
        SBAR(); QKT(pB0, pB1, K_lds + SHM_K);
        FSM(pA0, pA1, alA); SBAR();
        SLOAD(SO, (j + SDEPTH) * KVBLK); SBAR();
        PVD(0); PSM(pB0, pB1, mnB, alB);
        __syncthreads(); SWAIT(); SWRITE(0, SE);
        RESC(alB); __syncthreads();
        SBAR(); QKT(pA0, pA1, K_lds);
        FSM(pB0, pB1, alB); SBAR();
        if (SDEPTH == 1 || j + 3 < NT) SLOAD(SE, (j + 1 + SDEPTH) * KVBLK); SBAR();
        PVD(1); PSM(pA0, pA1, mnA, alA);
        __syncthreads(); SWAIT(); SWRITE(1, SO);
        RESC(alA); __syncthreads();
    }
    SBAR(); QKT(pB0, pB1, K_lds + SHM_K);
    FSM(pA0, pA1, alA); SBAR();
    PVD(0); PSM(pB0, pB1, mnB, alB);
    __syncthreads(); RESC(alB);
    FSM(pB0, pB1, alB); SBAR();
    PVD(1);
    if (hi == 0) li_l[r32] = l_reg; asm volatile("s_waitcnt lgkmcnt(0)" ::: "memory");
    float rli[16];
#pragma unroll
    for (int r = 0; r < 16; ++r) rli[r] = __builtin_amdgcn_rcpf(li_l[crow(r, hi)]);
    bf16_t* Ow = Ob + (long)(wid * QBLK) * LDO;
#pragma unroll
    for (int r = 0; r < 16; ++r) { const int orow = crow(r, hi);
#pragma unroll
        for (int d0 = 0; d0 < 4; ++d0) Ow[(long)orow * LDO + d0 * 32 + r32] = f2bf(o[d0][r] * rli[r]); }
    __syncthreads();
#undef SLOAD
#undef SWRITE
#undef SWAIT
#undef RESC
#undef QKT
#undef PSM
#undef FSM
#undef PVD
}
#undef SBAR
}

struct TrTile { f32x4 v[16]; };
__device__ __forceinline__ void tr_load(TrTile& t, const float* __restrict__ W, int N, int kb, int nb, int lane) {
    const int k0 = 64 * kb, n0 = 64 * nb; const int nq = 4 * (lane & 15), kr = lane >> 4; const bool ok = (n0 + nq) < N;
    const float* wp = W + (size_t)(k0 + kr) * N + n0 + nq;
#pragma unroll
    for (int i = 0; i < 16; ++i) { t.v[i] = (f32x4){0.f, 0.f, 0.f, 0.f}; if (ok) t.v[i] = __builtin_nontemporal_load((const f32x4*)(wp + (size_t)(4 * i) * N)); }
}
template <class RowMap>
__device__ __forceinline__ void tr_finish(const TrTile& t, int K, int N, bf16_t* __restrict__ WT, float* scr, int kb, int nb, int lane, RowMap rm) {
    const int k0 = 64 * kb, n0 = 64 * nb; const int nq = 4 * (lane & 15), kr = lane >> 4;
#pragma unroll
    for (int i = 0; i < 16; ++i) { float* d = scr + nq * 65 + 4 * i + kr; d[0] = t.v[i][0]; d[65] = t.v[i][1]; d[130] = t.v[i][2]; d[195] = t.v[i][3]; }
    asm volatile("s_waitcnt lgkmcnt(0)" ::: "memory");
    const int c = lane & 7;
#pragma unroll
    for (int j = 0; j < 8; ++j) { const int nl = (lane >> 3) + 8 * j; const int n = n0 + nl; const float* sp = scr + nl * 65 + 8 * c;
        u32x4 o; o.x = cvt_pk_bf16(sp[0], sp[1]); o.y = cvt_pk_bf16(sp[2], sp[3]); o.z = cvt_pk_bf16(sp[4], sp[5]); o.w = cvt_pk_bf16(sp[6], sp[7]);
        if (n < N) *(u32x4*)(WT + (size_t)rm(n) * K + k0 + 8 * c) = o; }
    asm volatile("s_waitcnt lgkmcnt(0)" ::: "memory");
}
template <class RowMap>
__device__ __forceinline__ void transpose_tile(const float* __restrict__ W, int K, int N, bf16_t* __restrict__ WT, float* scr, int kb, int nb, int lane, RowMap rm) {
    TrTile t; tr_load(t, W, N, kb, nb, lane); tr_finish(t, K, N, WT, scr, kb, nb, lane, rm);
}
struct RowId { __device__ __forceinline__ int operator()(int n) const { return n; } };
struct RowUq { __device__ __forceinline__ int operator()(int n) const { return (n / DQK) * 256 + (n % DQK); } };

__device__ __forceinline__ void phase0(const Params& P, char* lds, int G) {
    const int tid = tid_opaque(), lane = tid & 63, wave = tid >> 6;
    const int gw = blockIdx.x * NWAVES + wave, NGW = G * NWAVES;
    float* modp = (float*)(P.ws + WS_MODP);
    for (int task = gw; task < 1536; task += NGW) {
        const int ks = task / 48, cb = task % 48;
        const float s0 = silu_f(P.c[ks * 64 + lane]);
        f32x4 acc = {0.f, 0.f, 0.f, 0.f};
        const float* wp = P.w_ada + (size_t)(ks * 64) * (6 * DM) + cb * 256 + lane * 4;
#pragma unroll 16
        for (int kk = 0; kk < 64; ++kk) { const float sv = shidx(s0, kk); const f32x4 w = __builtin_nontemporal_load((const f32x4*)(wp + (size_t)kk * (6 * DM))); acc += w * sv; }
        { unsigned long long* pp = (unsigned long long*)(modp + (size_t)ks * (6 * DM) + cb * 256 + lane * 4);
          __hip_atomic_store(pp, ((unsigned long long)__float_as_uint(acc[1]) << 32) | __float_as_uint(acc[0]), __ATOMIC_RELAXED, __HIP_MEMORY_SCOPE_AGENT);
          __hip_atomic_store(pp + 1, ((unsigned long long)__float_as_uint(acc[3]) << 32) | __float_as_uint(acc[2]), __ATOMIC_RELAXED, __HIP_MEMORY_SCOPE_AGENT); }
        asm volatile("s_waitcnt vmcnt(0)" ::: "memory");
        unsigned old = 0u; if (lane == 0) old = __hip_atomic_fetch_add((unsigned*)(P.ws + WS_CNT) + cb * 16, 1u, __ATOMIC_RELAXED, __HIP_MEMORY_SCOPE_AGENT);
        old = __builtin_amdgcn_readfirstlane(old);
        if (old == 31u) {
            __builtin_amdgcn_fence(__ATOMIC_ACQUIRE, "agent");
            asm volatile("s_waitcnt vmcnt(0)" ::: "memory");
            f32x4 a = *(const f32x4*)(P.b_ada + cb * 256 + lane * 4);
#pragma unroll 8
            for (int k2 = 0; k2 < 32; ++k2) a += *(const f32x4*)(modp + (size_t)k2 * (6 * DM) + cb * 256 + lane * 4);
            *(f32x4*)((float*)(P.ws + WS_MOD) + cb * 256 + lane * 4) = a;
        }
    }
    { f32x2* rt = (f32x2*)(P.ws + WS_ROPE); const int i = lane & 31; const float freq = powf(10000.0f, -(float)i / 32.0f);
      for (int t = 2 * gw + (lane >> 5); t < SEQ; t += 2 * NGW) { float sn, cs; sincosf((float)P.pos[t] * freq, &sn, &cs); rt[(size_t)t * 32 + i] = (f32x2){cs, sn}; } }
    float* scr = (float*)(lds + wave * 17408);
    constexpr int I_IN = 32 * 78, I_UQ = 8 * 24, I_UKV = 4 * 32, I_OUT = 32 * 32, NIT = I_IN + I_UQ + I_UKV + I_OUT;
    auto src = [&](int it, const float*& W, int& N, int& kb, int& nb, int& kind) {
        int r = it;
        if (r < I_IN) { W = P.w_in; N = DIN; kb = r / 78; nb = r % 78; kind = 0; return; } r -= I_IN;
        if (r < I_UQ) { W = P.w_uq; N = NH * DQK; kb = r / 24; nb = r % 24; kind = 1; return; } r -= I_UQ;
        if (r < I_UKV) { W = P.w_ukv; N = NH * 256; kb = r / 32; nb = r % 32; kind = 2; return; } r -= I_UKV;
        W = P.w_out; N = DM; kb = r / 32; nb = r % 32; kind = 3; };
    int it = (gw + NGW - (1536 % NGW)) % NGW;
    if (it < NIT) {
        TrTile cur, nxt; const float* W; int N, kb, nb, kind;
        src(it, W, N, kb, nb, kind); tr_load(cur, W, N, kb, nb, lane);
        for (; it < NIT; it += NGW) {
            const int itn = it + NGW; const float* Wn = W; int Nn = N, kbn = kb, nbn = nb, kindn = kind;
            if (itn < NIT) { src(itn, Wn, Nn, kbn, nbn, kindn); tr_load(nxt, Wn, Nn, kbn, nbn, lane); }
            if (kind == 0) tr_finish(cur, DM, DIN, (bf16_t*)(P.ws + WS_WIN), scr, kb, nb, lane, RowId());
            else if (kind == 1) tr_finish(cur, QLORA, NH * DQK, (bf16_t*)(P.ws + WS_WUQ), scr, kb, nb, lane, RowUq());
            else if (kind == 2) tr_finish(cur, KVLORA, NH * 256, (bf16_t*)(P.ws + WS_WUKV), scr, kb, nb, lane, RowId());
            else tr_finish(cur, DM, DM, (bf16_t*)(P.ws + WS_WOUT), scr, kb, nb, lane, RowId());
            cur = nxt; W = Wn; N = Nn; kb = kbn; nb = nbn; kind = kindn;
        }
    }
}
__device__ __forceinline__ void norm_mod_rows(const float* __restrict__ src, const float* __restrict__ g, const float* sh, const float* sc, bf16_t* __restrict__ dst, int G) {
    const int tid = tid_opaque(), lane = tid & 63, wave = tid >> 6;
    const int gw = blockIdx.x * NWAVES + wave, NGW = G * NWAVES;
    for (int row0 = gw; row0 < SEQ; row0 += 4 * NGW) {
        f32x4 v[4][8]; float ss[4];
#pragma unroll
        for (int q = 0; q < 4; ++q) { const int row = row0 + q * NGW; const f32x4* xr = (const f32x4*)(src + (size_t)(row < SEQ ? row : row0) * DM) + lane;
#pragma unroll
            for (int j = 0; j < 8; ++j) v[q][j] = xr[64 * j]; }
#pragma unroll
        for (int q = 0; q < 4; ++q) { float a = 0.f;
#pragma unroll
            for (int j = 0; j < 8; ++j) a += (v[q][j].x * v[q][j].x + v[q][j].y * v[q][j].y) + (v[q][j].z * v[q][j].z + v[q][j].w * v[q][j].w);
            ss[q] = rsqrtf(wave_sum(a) * (1.f / DM) + EPS); }
#pragma unroll
        for (int j = 0; j < 8; ++j) { const int col = lane * 4 + 256 * j; const f32x4 gg = *(const f32x4*)(g + col); const f32x4 s1 = *(const f32x4*)(sc + col) + 1.f, s0 = *(const f32x4*)(sh + col);
#pragma unroll
            for (int q = 0; q < 4; ++q) { const int row = row0 + q * NGW;
                if (row < SEQ) { f32x4 y = v[q][j] * ss[q] * gg; y = y * s1 + s0; u32x2 w; w.x = cvt_pk_bf16(y.x, y.y); w.y = cvt_pk_bf16(y.z, y.w);
                    ((u32x2*)(dst + (size_t)row * DM) + lane)[64 * j] = w; } } }
    }
}
__device__ __forceinline__ void phase1a(const Params& P, char* lds, int G) {
    const int tid = tid_opaque();
    const float* mod = (const float*)(P.ws + WS_MOD);
    float* sh = (float*)lds; float* sc = sh + DM;
    for (int n = tid; n < 2 * DM; n += NTHREADS) sh[n] = mod[n];
    __syncthreads();
    norm_mod_rows(P.x, P.norm_mix_g, sh, sc, (bf16_t*)(P.ws + WS_H), G);
    __syncthreads();
}
__device__ __forceinline__ void ff_tile_src(const Params& P, int it, const float*& W, int& N, int& kb, int& nb) {
    constexpr int I_1 = 32 * 128;
    if (it < I_1) { W = P.w_ff1; N = DFF; kb = it / 128; nb = it % 128; } else { const int r = it - I_1; W = P.w_ff2; N = DM; kb = r / 32; nb = r % 32; }
}
__device__ __forceinline__ void ff_transposes(const Params& P, char* lds, int pidx, int np, int it0, int it1) {
    const int tid = tid_opaque(), lane = tid & 63, wave = tid >> 6;
    float* scr = (float*)(lds + wave * 17408);
    constexpr int I_1 = 32 * 128;
    const int stride = np * NWAVES;
    int it = it0 + pidx * NWAVES + wave;
    if (it >= it1) return;
    TrTile cur, nxt; const float* W; int N, kb, nb;
    ff_tile_src(P, it, W, N, kb, nb); tr_load(cur, W, N, kb, nb, lane);
    for (; it < it1; it += stride) {
        const int itn = it + stride; const float* Wn = W; int Nn = N, kbn = kb, nbn = nb;
        if (itn < it1) { ff_tile_src(P, itn, Wn, Nn, kbn, nbn); tr_load(nxt, Wn, Nn, kbn, nbn, lane); }
        if (it < I_1) tr_finish(cur, DM, DFF, (bf16_t*)(P.ws + WS_W1), scr, kb, nb, lane, RowId());
        else tr_finish(cur, DFF, DM, (bf16_t*)(P.ws + WS_W2), scr, kb, nb, lane, RowId());
        cur = nxt; W = Wn; N = Nn; kb = kbn; nb = nbn;
    }
}
constexpr int FFT_SPLIT = 4096, FFT_ALL = 8192;

__device__ __forceinline__ void phase6b(const Params& P, char* lds, int G) {
    const int tid = tid_opaque(), lane = tid & 63, wave = tid >> 6;
    const int gw = blockIdx.x * NWAVES + wave, NGW = G * NWAVES;
    const float* mod = (const float*)(P.ws + WS_MOD);
    float* sh = (float*)lds; float* sc = sh + DM;
    for (int n = tid; n < 2 * DM; n += NTHREADS) sh[n] = mod[3 * DM + n];
    __syncthreads();
    norm_mod_rows(P.out, P.norm_mlp_g, sh, sc, (bf16_t*)(P.ws + WS_H), G);
    __syncthreads();
    ff_transposes(P, lds, blockIdx.x, G, FFT_SPLIT, FFT_ALL);
}
__device__ __forceinline__ void phase2(const Params& P, char* lds, int G) {
    const int tid = tid_opaque(), lane = tid & 63, wave = tid >> 6;
    const int gw = blockIdx.x * NWAVES + wave, NGW = G * NWAVES;
    const bf16_t* pa = (const bf16_t*)(P.ws + WS_PA); const bf16_t* pb = (const bf16_t*)(P.ws + WS_PB);
    { bf16_t* cqn = (bf16_t*)(P.ws + WS_CQN); bf16_t* ckvn = (bf16_t*)(P.ws + WS_CKVN);
      float gq[8], gk[8];
#pragma unroll
      for (int e = 0; e < 8; ++e) { gq[e] = P.q_lora_g[lane * 8 + e]; gk[e] = P.kv_lora_g[(lane & 31) * 8 + e]; }
      for (int row0 = gw; row0 < SEQ; row0 += 4 * NGW) {
        u32x4 wq[4], wk[4];
#pragma unroll
        for (int q = 0; q < 4; ++q) { const int row = (row0 + q * NGW) < SEQ ? row0 + q * NGW : row0;
            wq[q] = *(const u32x4*)(pa + (size_t)row * PAW + OFF_CQ + lane * 8); wk[q] = *(const u32x4*)(pa + (size_t)row * PAW + OFF_CKV + (lane & 31) * 8); }
#pragma unroll
        for (int q = 0; q < 4; ++q) { const int row = row0 + q * NGW; if (row >= SEQ) break;
            float fq[8], fk[8]; unpack8(wq[q], fq); unpack8(wk[q], fk);
            float sq = 0.f, sk = 0.f;
#pragma unroll
            for (int e = 0; e < 8; ++e) { sq += fq[e] * fq[e]; sk += fk[e] * fk[e]; }
            if (lane >= 32) sk = 0.f;
            const float rq = rsqrtf(wave_sum(sq) * (1.f / QLORA) + EPS), rk = rsqrtf(wave_sum(sk) * (1.f / KVLORA) + EPS);
#pragma unroll
            for (int e = 0; e < 8; ++e) { fq[e] = fq[e] * rq * gq[e]; fk[e] = fk[e] * rk * gk[e]; }
            *(u32x4*)(cqn + (size_t)row * QLORA + lane * 8) = pack8(fq);
            if (lane < 32) *(u32x4*)(ckvn + (size_t)row * KVLORA + lane * 8) = pack8(fk); }
      } }
    { bf16_t* QH = (bf16_t*)(P.ws + WS_QH); bf16_t* KH = (bf16_t*)(P.ws + WS_KH); bf16_t* KT = (bf16_t*)(P.ws + WS_KT); bf16_t* VT = (bf16_t*)(P.ws + WS_VT);
      const int tg = tid >> 5, cgp = tid & 31, chl = cgp * 8;
      for (int item = blockIdx.x; item < 3 * HM * NCH; item += G) {
        const int kind = item / (HM * NCH), h = (item / NCH) % HM, c = item % NCH;
        const int t0 = LCH * c + 8 * tg;
        float outv[8][8];
        if (kind < 2) {
            const int col = kind * 1024 + h * DH + chl;
            float cw[5][8], cb[8];
#pragma unroll
            for (int e = 0; e < 8; ++e) cb[e] = P.conv_b[kind * 1024 + h * DH + chl + e];
#pragma unroll
            for (int j = 0; j < 5; ++j)
#pragma unroll
                for (int e = 0; e < 8; ++e) cw[j][e] = P.conv_w[j * 2048 + kind * 1024 + h * DH + chl + e];
#pragma unroll
            for (int tt = 0; tt < 8; ++tt)
#pragma unroll
                for (int e = 0; e < 8; ++e) outv[tt][e] = cb[e];
#pragma unroll
            for (int rr = 0; rr < 12; ++rr) {
                const int t = t0 - 2 + rr; float in[8];
                if (t >= 0 && t < SEQ) { const u32x4 w = *(const u32x4*)(pb + (size_t)t * PBW + col); unpack8(w, in); }
                else {
#pragma unroll
                    for (int e = 0; e < 8; ++e) in[e] = 0.f; }
#pragma unroll
                for (int j = 0; j < 5; ++j) { const int tt = rr - j;
                    if (tt >= 0 && tt < 8) {
#pragma unroll
                        for (int e = 0; e < 8; ++e) outv[tt][e] += cw[j][e] * in[e]; } }
            }
            const float osc = kind == 1 ? 0.0625f : 1.f;
#pragma unroll
            for (int tt = 0; tt < 8; ++tt)
#pragma unroll
                for (int e = 0; e < 8; ++e) outv[tt][e] = silu_f(outv[tt][e]) * osc;
            bf16_t* dst = (kind == 0 ? QH : KH) + ((size_t)h * SEQ + t0) * DH + chl;
#pragma unroll
            for (int tt = 0; tt < 8; ++tt) *(u32x4*)(dst + (size_t)tt * DH) = pack8(outv[tt]);
        } else {
#pragma unroll
            for (int tt = 0; tt < 8; ++tt) { const u32x4 w = *(const u32x4*)(pb + (size_t)(t0 + tt) * PBW + 2048 + h * DH + chl); unpack8(w, outv[tt]); }
        }
        if (kind >= 1) {
            bf16_t* dst = (kind == 1 ? KT : VT) + ((size_t)(h * NCH + c) * DH + chl) * LCH + 8 * tg;
#pragma unroll
            for (int e = 0; e < 8; ++e) { u32x4 w; w.x = cvt_pk_bf16(outv[0][e], outv[1][e]); w.y = cvt_pk_bf16(outv[2][e], outv[3][e]); w.z = cvt_pk_bf16(outv[4][e], outv[5][e]); w.w = cvt_pk_bf16(outv[6][e], outv[7][e]);
                *(u32x4*)(dst + (size_t)e * LCH) = w; }
        }
      } }
    { const float* gates = (const float*)(P.ws + WS_GATES);
      float* BC = (float*)(P.ws + WS_BC); float* IG = (float*)(P.ws + WS_IG); float* PM = (float*)(P.ws + WS_PM); float* WL = (float*)(P.ws + WS_WL);
      float* BL = (float*)(P.ws + WS_BL); float* AC = (float*)(P.ws + WS_AC);
      for (int task = gw; task < 2 * HM * NCH; task += NGW) {
        const int dir = task / (HM * NCH), h = (task / NCH) % HM, c = task % NCH;
        const float bi = P.b_gates[dir * 8 + h], bfg = P.b_gates[dir * 8 + 4 + h];
        const int u0 = 2 * lane, u1 = 2 * lane + 1;
        const int t0 = LCH * c + (dir ? 127 - u0 : u0), t1 = LCH * c + (dir ? 127 - u1 : u1);
        const float i0 = gates[(size_t)t0 * 16 + dir * 8 + h] + bi, i1 = gates[(size_t)t1 * 16 + dir * 8 + h] + bi;
        const float f0 = gates[(size_t)t0 * 16 + dir * 8 + 4 + h] + bfg, f1 = gates[(size_t)t1 * 16 + dir * 8 + 4 + h] + bfg;
        const float l0 = fminf(f0, 0.f) - log1pf(expf(-fabsf(f0))), l1 = fminf(f1, 0.f) - log1pf(expf(-fabsf(f1)));
        float inc = l0 + l1;
#pragma unroll
        for (int o = 1; o < 64; o <<= 1) { const float t = shup(inc, o); if (lane >= o) inc += t; }
        const float b1 = inc, b0 = inc - l1;
        const float d0 = i0 - b0, d1 = i1 - b1;
        float pmx = fmaxf(d0, d1);
#pragma unroll
        for (int o = 1; o < 64; o <<= 1) { const float t = shup(pmx, o); if (lane >= o) pmx = fmaxf(pmx, t); }
        float prev = shup(pmx, 1); if (lane == 0) prev = -INFINITY;
        const float pm0 = fmaxf(prev, d0), pm1 = pmx;
        const float bL = shidx(b1, 63), pmL = shidx(pmx, 63);
        const size_t base = (size_t)(dir * HM + h) * SEQ;
        BC[base + t0] = b0; BC[base + t1] = b1; IG[base + t0] = i0; IG[base + t1] = i1;
        PM[base + t0] = b0 + pm0; PM[base + t1] = b1 + pm1;
        WL[base + t0] = bL - b0 + i0; WL[base + t1] = bL - b1 + i1;
        if (lane == 63) { BL[(dir * HM + h) * NCH + c] = bL; AC[(dir * HM + h) * NCH + c] = bL + pmL; }
      } }
}

constexpr int M2_W = 1024, M2_WB = M2_W + SEQ * 4, M2_T0 = M2_WB + SEQ * 2, M2_TB = 96 * 256;
static_assert(M2_T0 + 2 * M2_TB <= LDS_BYTES, "M2 LDS");
__device__ __forceinline__ void m2_block(const Params& P, char* lds, int blk) {
    const int tid = tid_opaque(), lane = tid & 63, wid = tid >> 6, r = lane & 15, g = lane >> 4;
    const int dir = blk >> 7, h = (blk >> 5) & 3, vs = (blk >> 2) & 7, ksl = blk & 3;
    const int vi = wid >> 2, ki = wid & 3, v0 = 32 * vs + 16 * vi, k0 = 64 * ksl + 16 * ki;
    const int dh = dir * HM + h;
    const float* BL = (const float*)(P.ws + WS_BL) + dh * NCH; const float* AC = (const float*)(P.ws + WS_AC) + dh * NCH;
    const float* WL = (const float*)(P.ws + WS_WL) + (size_t)dh * SEQ;
    bf16_t* CST = (bf16_t*)(P.ws + cst_off(dh)); float* NST = (float*)(P.ws + WS_NST);
    float* s_mA = (float*)lds; float* s_dec = s_mA + NCH; float* s_w = (float*)(lds + M2_W); bf16_t* s_wb = (bf16_t*)(lds + M2_WB);
    float* s_bl = (float*)(lds + 512); float* s_ac = s_bl + NCH;
    if (tid < NCH) { s_bl[tid] = BL[tid]; s_ac[tid] = AC[tid]; }
    __syncthreads();
    if (tid == 0) { float m = -1e30f; float* MB = (float*)(P.ws + WS_MB) + dh * NCH; const bool pub = (vs == 0 && ksl == 0);
#pragma unroll 1
        for (int st = 0; st < NCH; ++st) { const int c = dir ? NCH - 1 - st : st; const float bL = s_bl[c], a = s_ac[c]; const float mn = fmaxf(bL + m, a);
            if (pub) MB[c] = m;
            s_dec[c] = __expf(bL + m - mn); s_mA[c] = mn; m = mn; } }
    __syncthreads();
    { float wl_[16];
#pragma unroll
      for (int i = 0; i < 16; ++i) wl_[i] = WL[tid + NTHREADS * i];
#pragma unroll
      for (int i = 0; i < 16; ++i) { const float w_ = __expf(wl_[i] - s_mA[(tid + NTHREADS * i) >> 7]); s_w[tid + NTHREADS * i] = w_; s_wb[tid + NTHREADS * i] = f2bf(w_); } }
    const int srow = tid >> 4, sslot = tid & 15;
    const char* gV = (const char*)(P.ws + WS_VT) + ((size_t)h * NCH * DH + 32 * vs + srow) * (LCH * 2) + sslot * 16;
    const char* gK = (const char*)(P.ws + WS_KT) + ((size_t)h * NCH * DH + 64 * ksl + srow) * (LCH * 2) + sslot * 16;
    const int lw = srow * 256 + ((sslot ^ (srow & 15)) << 4);
    const int la = (16 * vi + r) * 256, lb = (32 + 16 * ki + r) * 256;
    char* tb = lds + M2_T0;
    u32x4 ring[8][3];
#define M2_LOAD(slot, stp) do { const int c_ = dir ? NCH - 1 - (stp) : (stp); const size_t co_ = (size_t)c_ * (DH * LCH * 2); \
        ring[slot][0] = *(const u32x4*)(gV + co_); ring[slot][1] = *(const u32x4*)(gK + co_); ring[slot][2] = *(const u32x4*)(gK + co_ + 32 * LCH * 2); } while (0)
#define M2_WRITE(slot, buf, stp) do { char* d_ = tb + (buf) * M2_TB + lw; const int cw_ = dir ? NCH - 1 - (stp) : (stp); \
        const f32x4 wv0_ = *(const f32x4*)(s_w + LCH * cw_ + 8 * sslot), wv1_ = *(const f32x4*)(s_w + LCH * cw_ + 8 * sslot + 4); float a_[8]; unpack8(ring[slot][0], a_); \
        _Pragma("unroll") for (int j_ = 0; j_ < 4; ++j_) { a_[j_] *= wv0_[j_]; a_[4 + j_] *= wv1_[j_]; } \
        *(u32x4*)d_ = pack8(a_); *(u32x4*)(d_ + 8192) = ring[slot][1]; *(u32x4*)(d_ + 16384) = ring[slot][2]; } while (0)
#pragma unroll
    for (int d = 0; d < 8; ++d) M2_LOAD(d, d);
    __syncthreads();
    M2_WRITE(0, 0, 0);
    const bool do_n = (vs == 0 && vi == 0);
    f32x4 acc = {0.f, 0.f, 0.f, 0.f}, nacc = {0.f, 0.f, 0.f, 0.f};
#pragma unroll 1
    for (int st8 = 0; st8 < NCH; st8 += 8) {
#pragma unroll
        for (int u = 0; u < 8; ++u) {
            const int st = st8 + u;
            const int c = dir ? NCH - 1 - st : st;
            asm volatile("s_waitcnt lgkmcnt(0)" ::: "memory"); __builtin_amdgcn_s_barrier(); asm volatile("" ::: "memory");
            if (st + 1 < NCH) M2_WRITE((u + 1) & 7, (u + 1) & 1, st + 1);
            if (st + 8 < NCH) M2_LOAD(u, st + 8);
            { bf16_t* cp = CST + (size_t)c * (DH * DH) + (size_t)(v0 + r) * DH + k0 + 4 * g;
              u32x2 w2; w2.x = cvt_pk_bf16(acc[0], acc[1]); w2.y = cvt_pk_bf16(acc[2], acc[3]); *(u32x2*)cp = w2;
              if (do_n && r == 0) *(f32x4*)(NST + ((size_t)dh * NCH + c) * DH + k0 + 4 * g) = nacc; }
            const float dec = s_dec[c];
            acc = acc * dec; if (do_n) nacc = nacc * dec;
            const char* tbuf = tb + (u & 1) * M2_TB;
#pragma unroll
            for (int ks = 0; ks < 4; ++ks) {
                const int sl = ((4 * ks + g) ^ r) << 4;
                const bf16x8 av = *(const bf16x8*)(tbuf + la + sl), bv = *(const bf16x8*)(tbuf + lb + sl);
                acc = __builtin_amdgcn_mfma_f32_16x16x32_bf16(bv, av, acc, 0, 0, 0);
                if (do_n) { const bf16x8 wv = *(const bf16x8*)(s_wb + LCH * c + 32 * ks + 8 * g);
                    nacc = __builtin_amdgcn_mfma_f32_16x16x32_bf16(bv, wv, nacc, 0, 0, 0); }
            }
        }
    }
#undef M2_LOAD
#undef M2_WRITE
    __syncthreads();
}

constexpr int M3_SC = 1024, M3_LV = 6144, M3_LVS = 272, M3_LC = M3_LV + 256 * M3_LVS, M3_LCS = 528;
static_assert(M3_LC + 128 * M3_LCS <= 147456 - 64 - 256, "M3 LDS");
__device__ __forceinline__ void m3_unit(const Params& P, char* lds, int h, int c) {
    const int tid = tid_opaque(), lane = tid & 63, wid = __builtin_amdgcn_readfirstlane(tid >> 6), r = lane & 15, g = lane >> 4;
    const int T0 = LCH * c, tl = 16 * wid + r;
    const char* QHc = (const char*)(P.ws + WS_QH) + ((size_t)h * SEQ + T0 + 16 * wid) * (DH * 2);
    const char* KHc = (const char*)(P.ws + WS_KH) + ((size_t)h * SEQ + T0) * (DH * 2);
    const char* VTc = (const char*)(P.ws + WS_VT) + ((size_t)h * NCH + c) * (DH * LCH * 2);
    const unsigned o512 = (unsigned)(r * 512 + g * 16);
    float* s_bc = (float*)(lds + M3_SC); float* s_ig = s_bc + 256; float* s_pm = s_ig + 256; float* s_n = s_pm + 256;
    float* s_mb = (float*)lds;
    char* LV = lds + M3_LV; char* LC = lds + M3_LC;
    const char* lvr = LV + r * M3_LVS + g * 8;
    const char* lcr = LC + r * M3_LCS + g * 16;
    char* lcw = LC + (tid >> 5) * M3_LCS + (tid & 31) * 16;
    u32x4 cr[8];
#define M3_CLOAD(src) do { _Pragma("unroll") for (int n = 0; n < 8; ++n) cr[n] = ldgu<u32x4>((src) + n * 8192, (unsigned)tid * 16u); } while (0)
#define M3_CWRITE() do { _Pragma("unroll") for (int n = 0; n < 8; ++n) *(u32x4*)(lcw + n * (16 * M3_LCS)) = cr[n]; } while (0)
    M3_CLOAD(KHc);
    bf16x8 qf[8];
#pragma unroll
    for (int kd = 0; kd < 8; ++kd) qf[kd] = ldgu<bf16x8>(QHc + 64 * kd, o512);
    { u32x4 v[8];
#pragma unroll
      for (int n = 0; n < 8; ++n) v[n] = ldgu<u32x4>(VTc + n * 8192, (unsigned)tid * 16u);
      { const int dir = tid >> 8, tt = tid & 127; const size_t gi = (size_t)(dir * HM + h) * SEQ + T0 + tt;
        if ((tid & 255) < 128) { s_bc[dir * 128 + tt] = ((const float*)(P.ws + WS_BC))[gi]; s_ig[dir * 128 + tt] = ((const float*)(P.ws + WS_IG))[gi]; s_pm[dir * 128 + tt] = ((const float*)(P.ws + WS_PM))[gi]; }
        s_n[tid] = ((const float*)(P.ws + WS_NST))[((size_t)((tid >> 8) * HM + h) * NCH + c) * DH + (tid & 255)];
        if (tid < 2) s_mb[tid] = ((const float*)(P.ws + WS_MB))[(tid * HM + h) * NCH + c]; }
#pragma unroll
      for (int n = 0; n < 8; ++n) *(u32x4*)(LV + ((tid >> 4) + 32 * n) * M3_LVS + (tid & 15) * 16) = v[n]; }
    M3_CWRITE();
    __syncthreads();
    f32x4 st[8]; float qn0 = 0.f, qn1 = 0.f;
#pragma unroll
    for (int j = 0; j < 8; ++j) { st[j] = (f32x4){0.f, 0.f, 0.f, 0.f};
#pragma unroll
        for (int kd = 0; kd < 8; ++kd) { const bf16x8 kf = *(const bf16x8*)(lcr + j * (16 * M3_LCS) + kd * 64);
            st[j] = __builtin_amdgcn_mfma_f32_16x16x32_bf16(kf, qf[kd], st[j], 0, 0, 0); } }
#pragma unroll
    for (int kd = 0; kd < 8; ++kd) { float q[8]; unpack8(*(const u32x4*)&qf[kd], q);
        const f32x4 a0 = *(const f32x4*)(s_n + 32 * kd + 8 * g), a1 = *(const f32x4*)(s_n + 32 * kd + 8 * g + 4), b0 = *(const f32x4*)(s_n + 256 + 32 * kd + 8 * g), b1 = *(const f32x4*)(s_n + 256 + 32 * kd + 8 * g + 4);
        qn0 += q[0] * a0[0] + q[1] * a0[1] + q[2] * a0[2] + q[3] * a0[3] + q[4] * a1[0] + q[5] * a1[1] + q[6] * a1[2] + q[7] * a1[3];
        qn1 += q[0] * b0[0] + q[1] * b0[1] + q[2] * b0[2] + q[3] * b0[3] + q[4] * b1[0] + q[5] * b1[1] + q[6] * b1[2] + q[7] * b1[3]; }
    qn0 += shx(qn0, 16); qn0 += shx(qn0, 32); qn1 += shx(qn1, 16); qn1 += shx(qn1, 32);
    f32x4 acc[16];
#pragma unroll
    for (int vt = 0; vt < 16; ++vt) acc[vt] = (f32x4){0.f, 0.f, 0.f, 0.f};
#pragma unroll 1
    for (int dir = 0; dir < 2; ++dir) {
        const int dh = dir * HM + h;
        const char* Cc = (const char*)(P.ws + cst_off(dh)) + (size_t)c * (DH * DH * 2);
        M3_CLOAD(Cc);
        const float* bcd = s_bc + dir * 128; const float* igd = s_ig + dir * 128;
        const int fx = dir * 127, tlx = tl ^ fx;
        const float mB = s_mb[dir];
        const float bt = bcd[tl], pm = s_pm[dir * 128 + tl];
        const float mt = fmaxf(bt + mB, pm); const float alpha = bt - mt; const float winter = __expf(bt + mB - mt);
        float den = 0.f;
#pragma unroll
        for (int j = 0; j < 8; ++j) { const int sb = 16 * j + 4 * g;
            const f32x4 ig = *(const f32x4*)(igd + sb), bc = *(const f32x4*)(bcd + sb);
#pragma unroll
            for (int i = 0; i < 4; ++i) { const int sl = sb + i; const bool ok = ((sl ^ fx) <= tlx);
                const float e = ok ? __expf(alpha + ig[i] - bc[i]) : 0.f; den += st[j][i] * e; } }
        den += shx(den, 16); den += shx(den, 32);
        const float dtot = den + winter * (dir ? qn1 : qn0);
        const float hdiv = 1.f / fmaxf(fabsf(dtot), __expf(-mt));
        int tlx2 = tlx; LAUNDER_V(tlx2);
#pragma unroll
        for (int ks = 0; ks < 4; ++ks) {
            float e8[8];
#pragma unroll
            for (int hh = 0; hh < 2; ++hh) { const int j = 2 * ks + hh, sb = 16 * j + 4 * g;
                const f32x4 ig = *(const f32x4*)(igd + sb), bc = *(const f32x4*)(bcd + sb);
#pragma unroll
                for (int i = 0; i < 4; ++i) { const int sl = sb + i; const bool ok = ((sl ^ fx) <= tlx2);
                    const float e = ok ? __expf(alpha + ig[i] - bc[i]) : 0.f; e8[4 * hh + i] = st[j][i] * e * hdiv; } }
            const u32x4 pw = pack8(e8); const bf16x8 pa = *(const bf16x8*)&pw;
#pragma unroll
            for (int vt = 0; vt < 16; ++vt) {
                const u32x2 lo = *(const u32x2*)(lvr + vt * (16 * M3_LVS) + ks * 64), hi2 = *(const u32x2*)(lvr + vt * (16 * M3_LVS) + ks * 64 + 32);
                u32x4 w; w.x = lo.x; w.y = lo.y; w.z = hi2.x; w.w = hi2.y;
                acc[vt] = __builtin_amdgcn_mfma_f32_16x16x32_bf16(pa, *(const bf16x8*)&w, acc[vt], 0, 0, 0); }
        }
        const float qsc = winter * hdiv;
#pragma unroll
        for (int half = 0; half < 2; ++half) {
            __syncthreads();
            M3_CWRITE();
            __syncthreads();
            if (half == 0) M3_CLOAD(Cc + 65536);
            else if (dir == 1) { const char* om = (const char*)(P.ws + WS_PA) + ((size_t)T0 * PAW + PA_OM + h * DH) * 2;
#pragma unroll
                for (int n = 0; n < 8; ++n) cr[n] = ldgu<u32x4>(om + n * (16 * PAW * 2), (unsigned)((tid >> 5) * (PAW * 2) + (tid & 31) * 16)); }
#pragma unroll
            for (int kd = 0; kd < 8; ++kd) { const u32x4 qt = ldgu<u32x4>(QHc + 64 * kd, o512); float q[8]; unpack8(qt, q);
#pragma unroll
                for (int e = 0; e < 8; ++e) q[e] *= qsc;
                const u32x4 qw = pack8(q); const bf16x8 qs = *(const bf16x8*)&qw;
#pragma unroll
                for (int v8 = 0; v8 < 8; ++v8) { const bf16x8 cf = *(const bf16x8*)(lcr + v8 * (16 * M3_LCS) + kd * 64);
                    acc[half * 8 + v8] = __builtin_amdgcn_mfma_f32_16x16x32_bf16(qs, cf, acc[half * 8 + v8], 0, 0, 0); }
            }
        }
    }
    __syncthreads();
    M3_CWRITE();
#undef M3_CLOAD
#undef M3_CWRITE
    float ss[4] = {0.f, 0.f, 0.f, 0.f};
#pragma unroll
    for (int vt = 0; vt < 16; ++vt)
#pragma unroll
        for (int i = 0; i < 4; ++i) ss[i] += acc[vt][i] * acc[vt][i];
#pragma unroll
    for (int i = 0; i < 4; ++i) { ss[i] += shx(ss[i], 1); ss[i] += shx(ss[i], 2); ss[i] += shx(ss[i], 4); ss[i] += shx(ss[i], 8); ss[i] = rsqrtf(ss[i] * (1.f / DH) + EPS); }
    const float* gmp = P.mlstm_norm_g + h * DH + r;
    __syncthreads();
    const char* omr = LC + (16 * wid + 4 * g) * M3_LCS + r * 2; char* outw = LV + (16 * wid + 4 * g) * M3_LCS + r * 2;
#pragma unroll
    for (int vt = 0; vt < 16; ++vt) { const float gm = gmp[16 * vt];
#pragma unroll
        for (int i = 0; i < 4; ++i) { const float om = bf2f(*(const bf16_t*)(omr + i * M3_LCS + 32 * vt));
            *(bf16_t*)(outw + i * M3_LCS + 32 * vt) = f2bf(acc[vt][i] * ss[i] * gm * sigmoid_f(om)); } }
    __syncthreads();
    { char* mx = (char*)(P.ws + WS_MIX) + ((size_t)T0 * DM + 1024 + h * DH) * 2;
#pragma unroll
      for (int n = 0; n < 8; ++n) { const u32x4 v = *(const u32x4*)(LV + ((tid >> 5) + 16 * n) * M3_LCS + (tid & 31) * 16);
          *(u32x4*)(mx + (size_t)((tid >> 5) + 16 * n) * (DM * 2) + (tid & 31) * 16) = v; } }
    __syncthreads();
}

__device__ __forceinline__ void phase4(const Params& P, int G) {
    const int tid = tid_opaque(), lane = tid & 63, wave = tid >> 6;
    const int gw = blockIdx.x * NWAVES + wave, NGW = G * NWAVES;
    bf16_t* Q = (bf16_t*)(P.ws + WS_Q); bf16_t* K = (bf16_t*)(P.ws + WS_K); const bf16_t* KV = (const bf16_t*)(P.ws + WS_KV); const bf16_t* proj = (const bf16_t*)(P.ws + WS_PA);
    const f32x4* rt = (const f32x4*)(P.ws + WS_ROPE);
    unsigned char* Q8 = P.ws + WS_Q8; unsigned char* K8 = (F8_MODE == 2) ? (unsigned char*)P.out : P.ws + WS_K8;
    const int i = lane & 7, hh = lane >> 3; const bool lo = i < 4;
    float gq[3][8], gk[3][8];
#pragma unroll
    for (int j = 0; j < 3; ++j)
#pragma unroll
        for (int e = 0; e < 8; ++e) { gq[j][e] = P.q_norm_g[8 * (i + 8 * j) + e]; gk[j][e] = P.k_norm_g[8 * (i + 8 * j) + e]; }
    for (int t0 = gw; t0 < SEQ; t0 += 2 * NGW) {
        u32x4 win[2][2][3]; f32x4 rv[2][4];
#pragma unroll
        for (int tt = 0; tt < 2; ++tt) { const int t = (t0 + tt * NGW) < SEQ ? t0 + tt * NGW : t0;
            const bf16_t* qp = Q + (size_t)t * (NH * DQK) + hh * DQK + 8 * i; const bf16_t* kp = KV + (size_t)t * (NH * 256) + hh * 256 + 8 * i;
            win[tt][0][0] = *(const u32x4*)qp; win[tt][0][1] = *(const u32x4*)(qp + 64); win[tt][0][2] = *(const u32x4*)(qp + 128);
            win[tt][1][0] = *(const u32x4*)kp; win[tt][1][1] = *(const u32x4*)(kp + 64); win[tt][1][2] = *(const u32x4*)(proj + (size_t)t * PAW + OFF_KPE + 8 * i);
#pragma unroll
            for (int e2 = 0; e2 < 4; ++e2) rv[tt][e2] = rt[(size_t)t * 16 + 4 * (i & 3) + e2]; }
#pragma unroll
        for (int tt = 0; tt < 2; ++tt) { const int t = t0 + tt * NGW; if (t >= SEQ) break;
            float cs[8], sn[8];
#pragma unroll
            for (int e2 = 0; e2 < 4; ++e2) { cs[2 * e2] = rv[tt][e2][0]; sn[2 * e2] = rv[tt][e2][1]; cs[2 * e2 + 1] = rv[tt][e2][2]; sn[2 * e2 + 1] = rv[tt][e2][3]; }
#pragma unroll
            for (int which = 0; which < 2; ++which) {
                bf16_t* dst = (which == 0 ? Q : K) + (size_t)t * (NH * DQK) + hh * DQK + 8 * i;
                float a0[8], a1[8], a2[8]; unpack8(win[tt][which][0], a0); unpack8(win[tt][which][1], a1); unpack8(win[tt][which][2], a2);
                float ss = 0.f;
#pragma unroll
                for (int e = 0; e < 8; ++e) ss += a0[e] * a0[e] + a1[e] * a1[e] + a2[e] * a2[e];
                ss += shx(ss, 1); ss += shx(ss, 2); ss += shx(ss, 4);
                const float rs = rsqrtf(ss * (1.f / DQK) + EPS);
#pragma unroll
                for (int e = 0; e < 8; ++e) { const float g0 = which ? gk[0][e] : gq[0][e], g1 = which ? gk[1][e] : gq[1][e], g2 = which ? gk[2][e] : gq[2][e];
                    a0[e] *= rs * g0; a1[e] *= rs * g1; a2[e] *= rs * g2; }
                float o2[8];
#pragma unroll
                for (int e = 0; e < 8; ++e) { const float pr = shx(a2[e], 4);
                    o2[e] = lo ? (a2[e] * cs[e] - pr * sn[e]) : (pr * sn[e] + a2[e] * cs[e]); }
                if (F8_MODE == 0 || F8_MODE == 2) { *(u32x4*)dst = pack8(a0); *(u32x4*)(dst + 64) = pack8(a1); *(u32x4*)(dst + 128) = pack8(o2); }
                if (F8_MODE != 0) { unsigned char* d8 = (which == 0 ? Q8 : K8) + (size_t)t * (NH * DQK) + hh * DQK + 8 * i;
                    *(u32x2*)d8 = pack8_fp8(a0); *(u32x2*)(d8 + 64) = pack8_fp8(a1); *(u32x2*)(d8 + 128) = pack8_fp8(o2); }
            }
        }
    }
}

__device__ __forceinline__ void v8t_items(const Params& P, int G) {
    const int tid = tid_opaque(), lane = tid & 63, wave = tid >> 6;
    const int gw = blockIdx.x * NWAVES + wave, NGW = G * NWAVES;
    const bf16_t* KV = (const bf16_t*)(P.ws + WS_KV); unsigned char* V8T = P.ws + WS_V8T;
    for (int item = gw; item < NH * (SEQ / 64); item += NGW) {
        const int h = item >> 7, jt = item & 127;
        const bf16_t* src = KV + (size_t)(64 * jt) * (NH * 256) + h * 256 + 128 + lane;
#pragma unroll
        for (int cc = 0; cc < 2; ++cc) {
            int w[16];
#pragma unroll
            for (int q = 0; q < 16; ++q) {
                const int hi_ = q >> 3, j = (4 * q) & 31, jj = j & 15, key = (j >> 4) * 32 + (jj & 3) + 8 * (jj >> 2) + 4 * hi_;
                const float f0 = bf2f(src[(size_t)key * (NH * 256) + 64 * cc]), f1 = bf2f(src[(size_t)(key + 1) * (NH * 256) + 64 * cc]);
                const float f2 = bf2f(src[(size_t)(key + 2) * (NH * 256) + 64 * cc]), f3 = bf2f(src[(size_t)(key + 3) * (NH * 256) + 64 * cc]);
                int a = 0; a = __builtin_amdgcn_cvt_pk_fp8_f32(f0, f1, a, false); a = __builtin_amdgcn_cvt_pk_fp8_f32(f2, f3, a, true); w[q] = a; }
            unsigned char* dst = V8T + ((size_t)item * 128 + 64 * cc + lane) * 64;
#pragma unroll
            for (int q = 0; q < 4; ++q) { u32x4 o; o.x = (unsigned)w[4 * q]; o.y = (unsigned)w[4 * q + 1]; o.z = (unsigned)w[4 * q + 2]; o.w = (unsigned)w[4 * q + 3]; *(u32x4*)(dst + 16 * q) = o; }
        }
    }
}

struct StoreProj { bf16_t* pa; bf16_t* pb; float* gates;
    __device__ __forceinline__ void operator()(int row, int col, f32x4 v0, f32x4 v1) const {
        u32x4 w; w.x = cvt_pk_bf16(v0[0], v0[1]); w.y = cvt_pk_bf16(v0[2], v0[3]); w.z = cvt_pk_bf16(v1[0], v1[1]); w.w = cvt_pk_bf16(v1[2], v1[3]);
        bf16_t* dst = (col >= OFF_QM && col < OFF_OM) ? pb + (size_t)row * PBW + (col - OFF_QM) : pa + (size_t)row * PAW + (col < OFF_QM ? col : col - OFF_OM + PA_OM);
        *(u32x4*)dst = w;
        if (col >= OFF_GM && col < OFF_GM + 16) { float* gp = gates + (size_t)row * 16 + (col - OFF_GM); *(f32x4*)gp = v0; *(f32x4*)(gp + 4) = v1; } } };
struct StoreQ { bf16_t* q;
    __device__ __forceinline__ void operator()(int row, int col, f32x4 v0, f32x4 v1) const {
        const int h = col >> 8, ct = col & 255;
        if (ct < DQK) { u32x4 w; w.x = cvt_pk_bf16(v0[0], v0[1]); w.y = cvt_pk_bf16(v0[2], v0[3]); w.z = cvt_pk_bf16(v1[0], v1[1]); w.w = cvt_pk_bf16(v1[2], v1[3]);
            *(u32x4*)(q + (size_t)row * (NH * DQK) + h * DQK + ct) = w; } } };
struct StoreKV { bf16_t* kv;
    __device__ __forceinline__ void operator()(int row, int col, f32x4 v0, f32x4 v1) const {
        u32x4 w; w.x = cvt_pk_bf16(v0[0], v0[1]); w.y = cvt_pk_bf16(v0[2], v0[3]); w.z = cvt_pk_bf16(v1[0], v1[1]); w.w = cvt_pk_bf16(v1[2], v1[3]);
        *(u32x4*)(kv + (size_t)row * (NH * 256) + col) = w; } };
struct StoreX1 { const float* x; const float* gate; float* out;
    __device__ __forceinline__ void operator()(int row, int col, f32x4 v) const {
        const size_t off = (size_t)row * DM + col; const f32x4 xv = *(const f32x4*)(x + off); const f32x4 gv = *(const f32x4*)(gate + col);
        *(f32x4*)(out + off) = xv + gv * v; } };
struct StoreAct { bf16_t* act;
    __device__ __forceinline__ void operator()(int row, int col, f32x4 v0, f32x4 v1) const {
        float f[8] = {v0[0], v0[1], v0[2], v0[3], v1[0], v1[1], v1[2], v1[3]};
#pragma unroll
        for (int e = 0; e < 8; ++e) { const float rl = fmaxf(f[e], 0.f); f[e] = rl * rl; }
        *(u32x4*)(act + (size_t)row * DFF + col) = pack8(f); } };

#define XB_TMO      128
#define XB_XCNT(j)  (256  + 64 * (j))
#define XB_XSUB(j)  (1280 + 64 * (j))
#define XB_XGEN(j)  (2304 + 64 * (j))
#define XB_TOP      3328
#define XB_TOPGEN   3392
#define XCD_BAR_WORDS 3456
#define XB_SPIN_CAP (1u << 18)

__device__ __forceinline__ unsigned xb_ld(unsigned* p)              { return __hip_atomic_load(p, __ATOMIC_RELAXED, __HIP_MEMORY_SCOPE_AGENT); }
__device__ __forceinline__ unsigned xb_add(unsigned* p, unsigned v) { return __hip_atomic_fetch_add(p, v, __ATOMIC_RELAXED, __HIP_MEMORY_SCOPE_AGENT); }
__device__ __forceinline__ unsigned xb_xcc_id() { return (unsigned)__builtin_amdgcn_s_getreg((3 << 11) | 20) & 0xFu; }
#define XB_SPIN(cond, bar) do { unsigned _sp = 0; while (cond) { __builtin_amdgcn_s_sleep(1); \
    if ((++_sp & 255u) == 0u) { if (xb_ld(&(bar)[XB_TMO])) break; if (_sp > XB_SPIN_CAP) { atomicAdd(&(bar)[XB_TMO], 1u); break; } } } } while (0)

struct XcdBarrier {
    unsigned* bar; unsigned x;
    volatile LAS unsigned* st;
};

__device__ __forceinline__ XcdBarrier xcd_barrier_post(unsigned* bar, volatile LAS unsigned* st) {
    XcdBarrier b; b.bar = bar; b.x = xb_xcc_id(); b.st = st;
    if (threadIdx.x == 0) (void)xb_add(&bar[XB_XCNT(b.x)], 1u);
    return b;
}
__device__ __forceinline__ void xcd_barrier_complete(unsigned* bar, unsigned x, unsigned& nloc, unsigned& nx) {
    const unsigned G = gridDim.x * gridDim.y * gridDim.z;
    unsigned sum, cnt, mine, sp = 0u;
    for (;;) {
        sum = 0u; cnt = 0u; mine = 0u;
#pragma unroll
        for (unsigned j = 0; j < 16; ++j) { const unsigned c = xb_ld(&bar[XB_XCNT(j)]); sum += c; cnt += (c > 0u) ? 1u : 0u; mine = (j == x) ? c : mine; }
        if (sum == G) break;
        __builtin_amdgcn_s_sleep(1);
        if ((++sp & 255u) == 0u) { if (xb_ld(&bar[XB_TMO])) break; if (sp > XB_SPIN_CAP) { atomicAdd(&bar[XB_TMO], 1u); break; } }
    }
    nloc = mine > 0u ? mine : 1u; nx = cnt > 0u ? cnt : 1u;
}

__device__ __forceinline__ void xcd_barrier(const XcdBarrier& b) {
    asm volatile("s_waitcnt vmcnt(0)" ::: "memory");
    __syncthreads();
    if (tid_opaque() == 0) {
        unsigned* bar = b.bar;
        __builtin_amdgcn_s_waitcnt(0);
        unsigned nloc = b.st[0], nx = b.st[1];
        if (nloc == 0u) { xcd_barrier_complete(bar, b.x, nloc, nx); b.st[0] = nloc; b.st[1] = nx; }
        const unsigned old = xb_add(&bar[XB_XSUB(b.x)], 1u);
        const unsigned gen = old / nloc;
        if (old + 1u == (gen + 1u) * nloc) {
            __builtin_amdgcn_fence(__ATOMIC_RELEASE, "agent");
            asm volatile("s_waitcnt vmcnt(0)" ::: "memory");
            const unsigned og = xb_add(&bar[XB_TOP], 1u);
            const unsigned tg = og / nx;
            if (og + 1u == (tg + 1u) * nx) xb_add(&bar[XB_TOPGEN], 1u);
            else XB_SPIN(xb_ld(&bar[XB_TOPGEN]) == tg, bar);
            __builtin_amdgcn_fence(__ATOMIC_ACQUIRE, "agent");
            xb_add(&bar[XB_XGEN(b.x)], 1u);
            asm volatile("s_waitcnt vmcnt(0)" ::: "memory");
        } else {
            XB_SPIN(xb_ld(&bar[XB_XGEN(b.x)]) == gen, bar);
            __builtin_amdgcn_fence(__ATOMIC_ACQUIRE, "agent");
            asm volatile("s_waitcnt vmcnt(0)" ::: "memory");
        }
    }
    __syncthreads();
}


constexpr int NPH = 11;
#ifdef ONLY_PH
#define PH_ON(n) ((n) == ONLY_PH)
#else
#define PH_ON(n) 1
#endif
#define CAS __attribute__((address_space(4)))
__device__ __forceinline__ Params load_params(const CAS Params* kp) {
#if defined(__HIP_DEVICE_COMPILE__)
    unsigned long long kv = (unsigned long long)kp; asm volatile("" : "+s"(kv)); return *(const CAS Params*)kv;
#else
    return Params{};
#endif
}
__global__ void __launch_bounds__(NTHREADS, 2) fwd_kernel(Params Pk) {
    extern __shared__ __attribute__((aligned(16))) char lds[];
    const CAS Params* kp = (const CAS Params*)__builtin_amdgcn_kernarg_segment_ptr();
    const int G0 = gridDim.x; const int bx0 = blockIdx.x;
    const int vcu0 = (G0 % 8 == 0) ? (bx0 % 8) * (G0 / 8) + bx0 / 8 : bx0;
    LAS unsigned char* ldsl = (LAS unsigned char*)lds;
    const int ph_lo = Pk.ph_lo, ph_hi = Pk.ph_hi;
    if (threadIdx.x < 16) ((volatile LAS unsigned*)(ldsl + LDS_BARST))[threadIdx.x] = 0u;
    if ((threadIdx.x & 63) == 0) { const unsigned hw = __builtin_amdgcn_s_getreg((5 << 11) | 4) & 63u; *(volatile LAS int*)(uintptr_t)(LDS_WIDTAB + hw * 4) = (int)(threadIdx.x >> 6); }
    __syncthreads();
    XcdBarrier xbar = xcd_barrier_post((unsigned*)(Pk.ws + WS_BAR), (volatile LAS unsigned*)(ldsl + LDS_BARST));
#ifndef PROBE_PH
#define PROBE_PH (-1)
#endif
    unsigned long long probe_dt = 0, probe_t0g = 0;
#ifndef PROBE_FROM
#define PROBE_FROM (-1)
#define PROBE_TO (-1)
#endif
#define PROBE_MARK(id) do { if (PROBE_FROM == (id)) { __syncthreads(); probe_t0g = __builtin_amdgcn_s_memrealtime(); } if (PROBE_TO == (id)) { __syncthreads(); probe_dt = __builtin_amdgcn_s_memrealtime() - probe_t0g; } } while (0)
#ifndef DUP_PH
#define DUP_PH (-1)
#endif
#ifndef DUP_SUB
#define DUP_SUB 0
#endif
    for (int ph = ph_lo; ph < ph_hi; ++ph) {
      {
        int G = G0, bx = bx0, vcu = vcu0; asm volatile("" : "+s"(G), "+s"(bx), "+s"(vcu));
        unsigned long long probe_t0 = 0; if (PROBE_PH >= 0 && ph == PROBE_PH) probe_t0 = __builtin_amdgcn_s_memrealtime();
        for (int sub = 0; sub < (ph == 6 ? 2 : 1); ++sub) {
        int G = G0, bx = bx0, vcu = vcu0; asm volatile("" : "+s"(G), "+s"(bx), "+s"(vcu));
        switch (sub ? 11 : ph) {
        case 0: if (PH_ON(0)) { const Params P = load_params(kp); phase0(P, lds, G); } break;
        case 1: if (PH_ON(1)) { const Params P = load_params(kp); phase1a(P, lds, G); } break;
        case 2: if (PH_ON(2)) { const Params P = load_params(kp); unsigned char* ws = P.ws;
                  pg8::Gemm g{(const bf16_t*)(ws + WS_H), (const bf16_t*)(ws + WS_WIN), SEQ, DINP, DM}; pg8::StaticOrder S; S.init(SEQ, DINP, G, bx);
                  pg8::Epi8<StoreProj> E{{(bf16_t*)(ws + WS_PA), (bf16_t*)(ws + WS_PB), (float*)(ws + WS_GATES)}};
                  pg8::gemm_phase<pg8::Epi8<StoreProj>, pg8::StaticOrder, true, true>(ldsl, g, S, E);
                  { const int nwg = (SEQ / 256) * (DINP / 256), nfull = nwg % G;
                    if (nfull == 0) ff_transposes(P, lds, bx, G, 0, FFT_SPLIT); else if (bx >= nfull) ff_transposes(P, lds, bx - nfull, G - nfull, 0, FFT_SPLIT); } } break;
        case 3: if (PH_ON(3)) { const Params P = load_params(kp); phase2(P, lds, G); } break;
        case 4: if (PH_ON(4)) { PROBE_MARK(40);
#ifndef NO_G4
#ifndef NO_G4A
                  { const Params P = load_params(kp); unsigned char* ws = P.ws;
                    pg8::Gemm g{(const bf16_t*)(ws + WS_CQN), (const bf16_t*)(ws + WS_WUQ), SEQ, NH * 256, QLORA}; pg8::StaticOrder S; S.init(SEQ, NH * 256, G, bx);
                    pg8::Epi8<StoreQ> E{{(bf16_t*)(ws + WS_Q)}};
                    pg8::gemm_phase<pg8::Epi8<StoreQ>, pg8::StaticOrder, true, true>(ldsl, g, S, E); }
#endif
#ifndef NO_G4B
                  { const Params P = load_params(kp); unsigned char* ws = P.ws;
                    pg8::Gemm g{(const bf16_t*)(ws + WS_CKVN), (const bf16_t*)(ws + WS_WUKV), SEQ, NH * 256, KVLORA}; pg8::StaticOrder S; S.init(SEQ, NH * 256, G, bx);
                    pg8::Epi8<StoreKV> E{{(bf16_t*)(ws + WS_KV)}};
                    pg8::gemm_phase<pg8::Epi8<StoreKV>, pg8::StaticOrder, true, true>(ldsl, g, S, E); }
#endif
#endif
                  PROBE_MARK(42);
#ifndef NO_M2
                  { const Params P = load_params(kp); for (int b = vcu; b < 256; b += G) m2_block(P, lds, b); }
#endif
                  PROBE_MARK(43);
                  } break;
        case 5: if (PH_ON(5)) { const Params P = load_params(kp); phase4(P, G); if (F8_MODE == 3 || (F8_MODE == 2 && F8_DBG == 3)) v8t_items(P, G); } break;
        case 6: if (PH_ON(6)) { PROBE_MARK(60);
#ifndef NO_ATT
                  { const Params P = load_params(kp); unsigned char* ws = P.ws;
                  for (int u = vcu; u < NH * (SEQ / 256); u += G) { const int h = u >> 5, qb = u & 31;
                      const bf16_t* vh = (const bf16_t*)(ws + WS_KV) + h * 256 + 128; bf16_t* ob = (bf16_t*)(ws + WS_MIX) + (size_t)(qb * 256) * DM + h * DV;
                      const unsigned char* v8 = ws + WS_V8T + (size_t)h * (SEQ / 64) * 8192; const unsigned char* q8 = ws + WS_Q8 + (size_t)(qb * 256) * (NH * DQK) + h * DQK;
                      if (F8_MODE == 0 || F8_MODE == 2) att::attn_unit<0>((const bf16_t*)(ws + WS_Q) + (size_t)(qb * 256) * att::LDQ + h * DQK, (const bf16_t*)(ws + WS_K) + h * DQK, vh, ob, SEQ, lds);
                      if (F8_MODE == 1) att::attn_unit<1>(q8, ws + WS_K8 + h * DQK, vh, ob, SEQ, lds);
                      if (F8_MODE == 3) att::attn_unit<3>(q8, ws + WS_K8 + h * DQK, v8, ob, SEQ, lds);
                      if (F8_MODE == 2) {
                          bf16_t* ob2 = (bf16_t*)((unsigned char*)P.out + 16 * MiB) + (size_t)(qb * 256) * DM + h * DV;
                          if (F8_DBG == 1) att::attn_unit<1>(q8, (const unsigned char*)P.out + h * DQK, vh, ob2, SEQ, lds);
                          else att::attn_unit<3>(q8, (const unsigned char*)P.out + h * DQK, v8, ob2, SEQ, lds);
                          asm volatile("s_waitcnt vmcnt(0)" ::: "memory"); __syncthreads();
                          const int tidc = tid_opaque(); float e2 = 0.f, r2 = 0.f;
                          for (int idx = tidc; idx < 256 * 128; idx += NTHREADS) { const int rr = idx >> 7, cc = idx & 127;
                              const unsigned short va = __hip_atomic_load((const unsigned short*)(ob + (size_t)rr * DM + cc), __ATOMIC_RELAXED, __HIP_MEMORY_SCOPE_AGENT);
                              const unsigned short vb = __hip_atomic_load((const unsigned short*)(ob2 + (size_t)rr * DM + cc), __ATOMIC_RELAXED, __HIP_MEMORY_SCOPE_AGENT);
                              const float fa = bf2f(va), fb = bf2f(vb); e2 += (fa - fb) * (fa - fb); r2 += fa * fa; }
                          e2 = wave_sum(e2); r2 = wave_sum(r2);
                          float* red = (float*)lds; if ((tidc & 63) == 0) { red[(tidc >> 6) * 2] = e2; red[(tidc >> 6) * 2 + 1] = r2; }
                          __syncthreads();
                          float E = 0.f, R = 0.f; for (int w = 0; w < NWAVES; ++w) { E += red[2 * w]; R += red[2 * w + 1]; }
                          if (!(E <= F8_THR * F8_THR * R) && tidc == 0) ob[0] = (bf16_t)0x7fc0;
                          __syncthreads(); }
                  } }
#endif
                  PROBE_MARK(61);
                  } break;
        case 11: if (PH_ON(6)) {
#ifndef NO_M3
                  { const Params P = load_params(kp); for (int u = vcu; u < HM * NCH; u += G) m3_unit(P, lds, u >> 6, u & 63); }
#endif
                  PROBE_MARK(62);
                  } break;
        case 7: if (PH_ON(7)) { const Params P = load_params(kp); unsigned char* ws = P.ws;
                  pg8::Gemm g{(const bf16_t*)(ws + WS_MIX), (const bf16_t*)(ws + WS_WOUT), SEQ, DM, DM}; pg8::StaticOrder S; S.init(SEQ, DM, G, bx);
                  pg8::Epi4<StoreX1> E{{P.x, (const float*)(ws + WS_MOD) + 2 * DM, P.out}};
                  pg8::gemm_phase<pg8::Epi4<StoreX1>, pg8::StaticOrder, true, true>(ldsl, g, S, E); } break;
        case 8: if (PH_ON(8)) { const Params P = load_params(kp); phase6b(P, lds, G); } break;
        case 9: if (PH_ON(9)) { const Params P = load_params(kp); unsigned char* ws = P.ws;
                  pg8::Gemm g{(const bf16_t*)(ws + WS_H), (const bf16_t*)(ws + WS_W1), SEQ, DFF, DM}; pg8::StaticOrder S; S.init(SEQ, DFF, G, bx);
                  pg8::Epi8<StoreAct> E{{(bf16_t*)(ws + WS_ACT)}};
                  pg8::gemm_phase<pg8::Epi8<StoreAct>, pg8::StaticOrder, true, true>(ldsl, g, S, E); } break;
        case 10: if (PH_ON(10)) { const Params P = load_params(kp); unsigned char* ws = P.ws;
                  pg8::Gemm g{(const bf16_t*)(ws + WS_ACT), (const bf16_t*)(ws + WS_W2), SEQ, DM, DFF}; pg8::StaticOrder S; S.init(SEQ, DM, G, bx);
                  pg8::Epi4<StoreX1> E{{P.out, (const float*)(ws + WS_MOD) + 5 * DM, P.out}};
                  pg8::gemm_phase<pg8::Epi4<StoreX1>, pg8::StaticOrder, true, true>(ldsl, g, S, E); } break;
        default: break;
        }
        }
        if (ph + 1 < ph_hi) { xcd_barrier(xbar); }
        if (PROBE_PH >= 0 && ph == PROBE_PH) { __syncthreads(); probe_dt = __builtin_amdgcn_s_memrealtime() - probe_t0; }
      }
    }
    #ifndef PROBE_BLK
#define PROBE_BLK 0
#endif
    if ((PROBE_PH >= 0 || PROBE_FROM >= 0) && blockIdx.x == PROBE_BLK) { const unsigned long long te = __builtin_amdgcn_s_memrealtime();
        while (__builtin_amdgcn_s_memrealtime() - te < probe_dt) __builtin_amdgcn_s_sleep(8); }
}

extern "C" void kernel_launch(void* const* d_in, const int* in_sizes, int n_in, void* d_out, int out_size, void* d_ws, size_t ws_size, hipStream_t stream) {
    static int grid = 0;
    if (grid == 0) {
        if (n_in != 21 || out_size != SEQ * DM || ws_size < WS_END) { fprintf(stderr, "kernel_launch: unexpected shapes n_in %d out %d ws %zu\n", n_in, out_size, ws_size); grid = -1; return; }
        int dev = 0, cus = 0, per_cu = 0;
        if (hipGetDevice(&dev) != hipSuccess || hipDeviceGetAttribute(&cus, hipDeviceAttributeMultiprocessorCount, dev) != hipSuccess) { grid = -1; return; }
        if (hipFuncSetAttribute((const void*)fwd_kernel, hipFuncAttributeMaxDynamicSharedMemorySize, LDS_BYTES) != hipSuccess) { fprintf(stderr, "kernel_launch: hipFuncSetAttribute failed\n"); grid = -1; return; }
        if (hipOccupancyMaxActiveBlocksPerMultiprocessor(&per_cu, (const void*)fwd_kernel, NTHREADS, LDS_BYTES) != hipSuccess || per_cu < 1) { fprintf(stderr, "kernel_launch: occupancy query says %d\n", per_cu); per_cu = 1; }
        (void)hipGetLastError();
        grid = cus * 1;
    }
    if (grid < 0) return;
    Params p{};
    p.x = (const float*)d_in[0]; p.c = (const float*)d_in[1]; p.pos = (const int*)d_in[2]; p.w_ada = (const float*)d_in[3]; p.b_ada = (const float*)d_in[4];
    p.norm_mix_g = (const float*)d_in[5]; p.w_in = (const float*)d_in[6]; p.b_gates = (const float*)d_in[7]; p.conv_w = (const float*)d_in[8]; p.conv_b = (const float*)d_in[9];
    p.q_lora_g = (const float*)d_in[10]; p.w_uq = (const float*)d_in[11]; p.kv_lora_g = (const float*)d_in[12]; p.w_ukv = (const float*)d_in[13]; p.q_norm_g = (const float*)d_in[14];
    p.k_norm_g = (const float*)d_in[15]; p.mlstm_norm_g = (const float*)d_in[16]; p.w_out = (const float*)d_in[17]; p.norm_mlp_g = (const float*)d_in[18];
    p.w_ff1 = (const float*)d_in[19]; p.w_ff2 = (const float*)d_in[20];
    p.out = (float*)d_out; p.ws = (unsigned char*)d_ws;
    (void)hipMemsetAsync((char*)d_ws + WS_BAR, 0, 32768, stream);
#if MK_MULTI
    for (int ph = 0; ph < NPH; ++ph) { p.ph_lo = ph; p.ph_hi = ph + 1; hipLaunchKernelGGL(fwd_kernel, dim3(grid), dim3(NTHREADS), LDS_BYTES, stream, p); }
#else
    p.ph_lo = 0; p.ph_hi = NPH;
    void* args[] = {&p};
    hipError_t e = hipLaunchCooperativeKernel((const void*)fwd_kernel, dim3(grid), dim3(NTHREADS), args, LDS_BYTES, stream);
    if (e != hipSuccess) fprintf(stderr, "kernel_launch: cooperative launch failed: %s (grid %d)\n", hipGetErrorString(e), grid);
#endif
}
```

```cpp
#include <hip/hip_runtime.h>
#include <hip/hip_cooperative_groups.h>
#include <cstdio>
#include <cstdint>
namespace cg = cooperative_groups;

#ifndef MK_MULTI
#define MK_MULTI 0
#endif

#ifndef F8_MODE
#define F8_MODE 3
#endif
#ifndef F8_DBG
#define F8_DBG 3
#endif
#ifndef F8_THR
#define F8_THR 0.10f
#endif
#define LAS __attribute__((address_space(3)))
typedef unsigned short bf16_t;
typedef short bf16x8 __attribute__((ext_vector_type(8)));
typedef short s16x4 __attribute__((ext_vector_type(4)));
typedef float f32x4 __attribute__((ext_vector_type(4)));
typedef float f32x2 __attribute__((ext_vector_type(2)));
typedef float f32x16 __attribute__((ext_vector_type(16)));
typedef unsigned u32x4 __attribute__((ext_vector_type(4)));
typedef unsigned u32x2 __attribute__((ext_vector_type(2)));

constexpr int SEQ = 8192, DM = 2048, DIN = 4944, DINP = 5120, DFF = 8192;
constexpr int NH = 8, DQK = 192, DV = 128, QLORA = 512, KVLORA = 256;
constexpr int HM = 4, DH = 256, LCH = 128, NCH = 64;
constexpr int OFF_CQ = 0, OFF_CKV = 512, OFF_KPE = 768, OFF_QM = 832, OFF_KM = 1856, OFF_VM = 2880, OFF_OM = 3904, OFF_GM = 4928;
constexpr float EPS = 1e-6f;
constexpr int NTHREADS = 512, NWAVES = 8;
constexpr int LDS_BYTES = 147456;
constexpr int LDS_BARST = LDS_BYTES - 64;

constexpr size_t MiB = 1u << 20;
constexpr size_t WS_MODP = 384 * MiB - 2 * MiB;
constexpr size_t WS_MOD = 786432;
constexpr size_t WS_BC = 1 * MiB;
constexpr size_t WS_IG = WS_BC + 262144;
constexpr size_t WS_PM = WS_IG + 262144;
constexpr size_t WS_WL = WS_PM + 262144;
constexpr size_t WS_BAR = 868352;
constexpr size_t WS_CNT = WS_BAR + 16384;
constexpr size_t WS_MB = 860160;
constexpr size_t WS_BL = 851968;
constexpr size_t WS_AC = 856064;
constexpr size_t WS_WIN = 2 * MiB, WS_WUQ = 22 * MiB, WS_WUKV = 24 * MiB, WS_WOUT = 26 * MiB;
constexpr size_t WS_W1 = 34 * MiB, WS_W2 = 66 * MiB;
constexpr size_t WS_H = 98 * MiB;
constexpr size_t WS_Q = 98 * MiB;
constexpr size_t WS_MIX = 130 * MiB;
constexpr size_t WS_PA = 162 * MiB;
constexpr size_t WS_PB = 194 * MiB;
constexpr int PAW = 2048, PBW = 3072, PA_OM = 832;
constexpr size_t WS_CQN = 242 * MiB, WS_CKVN = 250 * MiB;
constexpr size_t WS_GATES = 254 * MiB;
constexpr size_t WS_NST = 255 * MiB;
constexpr size_t WS_ACT = 130 * MiB;
constexpr size_t WS_KV = 258 * MiB;
constexpr size_t WS_K = 290 * MiB;
constexpr size_t WS_V8T = 122 * MiB;
constexpr size_t WS_Q8 = 242 * MiB;
constexpr size_t WS_K8 = 290 * MiB;
constexpr size_t WS_QH = 314 * MiB, WS_KH = 330 * MiB, WS_KT = 346 * MiB, WS_VT = 362 * MiB;
constexpr size_t WS_ROPE = 378 * MiB;
constexpr size_t WS_END = 384 * MiB;

struct Params {
    const float* x; const float* c; const int* pos; const float* w_ada; const float* b_ada; const float* norm_mix_g; const float* w_in;
    const float* b_gates; const float* conv_w; const float* conv_b; const float* q_lora_g; const float* w_uq; const float* kv_lora_g;
    const float* w_ukv; const float* q_norm_g; const float* k_norm_g; const float* mlstm_norm_g; const float* w_out; const float* norm_mlp_g;
    const float* w_ff1; const float* w_ff2;
    float* out; unsigned char* ws; int ph_lo, ph_hi;
};

__host__ __device__ __forceinline__ size_t cst_off(int dh) { return dh < 6 ? WS_PB + (size_t)dh * (8 * MiB) : WS_WIN + (size_t)(dh - 6) * (8 * MiB); }
#define LAUNDER_V(x) asm volatile("" : "+v"(x))
#define LAUNDER_S(x) asm volatile("" : "+s"(x))
constexpr int LDS_WIDTAB = 147456 - 64 - 256;
__device__ __forceinline__ int tid_opaque() {
    const unsigned hw = __builtin_amdgcn_s_getreg((5 << 11) | 4) & 63u;
    const int wid = *(volatile LAS int*)(uintptr_t)(LDS_WIDTAB + hw * 4);
    int t = wid * 64 + (int)__builtin_amdgcn_mbcnt_hi(~0u, __builtin_amdgcn_mbcnt_lo(~0u, 0u)); LAUNDER_V(t); return t; }
__device__ __forceinline__ unsigned cvt_pk_bf16(float lo, float hi) { unsigned r; asm volatile("v_cvt_pk_bf16_f32 %0, %1, %2" : "=v"(r) : "v"(lo), "v"(hi)); return r; }
__device__ __forceinline__ float bf_lo(unsigned w) { return __uint_as_float(w << 16); }
__device__ __forceinline__ float bf_hi(unsigned w) { return __uint_as_float(w & 0xffff0000u); }
__device__ __forceinline__ float bf2f(bf16_t b) { return __uint_as_float(((unsigned)b) << 16); }
__device__ __forceinline__ bf16_t f2bf(float f) { return (bf16_t)(cvt_pk_bf16(f, 0.f) & 0xffffu); }
__device__ __forceinline__ int lane_opaque() { int l = (int)__builtin_amdgcn_mbcnt_hi(~0u, __builtin_amdgcn_mbcnt_lo(~0u, 0u)); LAUNDER_V(l); return l; }
__device__ __forceinline__ float shx(float v, int m) { return __int_as_float(__builtin_amdgcn_ds_bpermute((lane_opaque() ^ m) << 2, __float_as_int(v))); }
__device__ __forceinline__ float shidx(float v, int i) { return __int_as_float(__builtin_amdgcn_ds_bpermute(i << 2, __float_as_int(v))); }
__device__ __forceinline__ float shup(float v, int o) { return __int_as_float(__builtin_amdgcn_ds_bpermute((lane_opaque() - o) << 2, __float_as_int(v))); }
__device__ __forceinline__ float wave_sum(float v) {
#pragma unroll
    for (int o = 1; o < 64; o <<= 1) v += shx(v, o);
    return v;
}
template <class T> __device__ __forceinline__ T ldgu(const void* ubase, unsigned voff) { return *(const T*)((const char*)ubase + voff); }
__device__ __forceinline__ float silu_f(float v) { return v / (1.f + __expf(-v)); }
__device__ __forceinline__ float sigmoid_f(float v) { return 1.f / (1.f + __expf(-v)); }
__device__ __forceinline__ void unpack8(u32x4 w, float* f) {
    f[0] = bf_lo(w.x); f[1] = bf_hi(w.x); f[2] = bf_lo(w.y); f[3] = bf_hi(w.y); f[4] = bf_lo(w.z); f[5] = bf_hi(w.z); f[6] = bf_lo(w.w); f[7] = bf_hi(w.w);
}
__device__ __forceinline__ u32x2 pack8_fp8(const float* f) {
    int a = 0, b = 0; a = __builtin_amdgcn_cvt_pk_fp8_f32(f[0], f[1], a, false); a = __builtin_amdgcn_cvt_pk_fp8_f32(f[2], f[3], a, true);
    b = __builtin_amdgcn_cvt_pk_fp8_f32(f[4], f[5], b, false); b = __builtin_amdgcn_cvt_pk_fp8_f32(f[6], f[7], b, true); u32x2 w; w.x = (unsigned)a; w.y = (unsigned)b; return w; }
__device__ __forceinline__ u32x4 pack8(const float* f) {
    u32x4 w; w.x = cvt_pk_bf16(f[0], f[1]); w.y = cvt_pk_bf16(f[2], f[3]); w.z = cvt_pk_bf16(f[4], f[5]); w.w = cvt_pk_bf16(f[6], f[7]); return w;
}

namespace pg8 {
constexpr int BM = 256, BK = 64, HALF = 128, HTB = HALF * BK * 2, STAGE_BYTES = 8 * HTB, NXCD = 8, WGM = 8;
__host__ __device__ __forceinline__ int lds_byte(int r, int c) { const int st = (r >> 4) * 2 + (c >> 5), rr = r & 15, cc = c & 31, ob = rr * 64 + cc * 2; return st * 1024 + (ob ^ (((ob >> 9) & 1) << 5)); }
__host__ __device__ __forceinline__ void stage_rc(int b, int& R, int& C) { const int st = b / 1024, sb = b % 1024, swz = sb ^ (((sb >> 9) & 1) << 5); R = (st >> 1) * 16 + swz / 64; C = (st & 1) * 32 + (swz % 64) / 2; }
__host__ __device__ __forceinline__ int perm32(int rho) { const int n = rho >> 4, i = rho & 15; return 8 * (i >> 2) + 4 * n + (i & 3); }
struct Unit { int pm, pn; };
struct Gemm { const bf16_t* A; const bf16_t* Bt; int M, N, K; };
struct StaticOrder {
    int nM, nN, nwg, G, c;
    __host__ __device__ void init(int M, int N, int G_, int c_) { nM = M / BM; nN = N / BM; nwg = nM * nN; G = G_; c = c_; }
    __host__ __device__ bool next(int i, Unit& u) const {
        const long L = (long)i * G + c; if (L >= nwg) return false;
        int wgid = (int)L; { const int q = nwg / NXCD, r = nwg % NXCD, xcd = wgid % NXCD, off = wgid / NXCD; wgid = (xcd < r ? xcd * (q + 1) : r * (q + 1) + (xcd - r) * q) + off; }
        const int nig = WGM * nN, gid = wgid / nig, fm = gid * WGM, gsz = (nM - fm) < WGM ? (nM - fm) : WGM;
        u.pm = fm + ((wgid % nig) % gsz); u.pn = (wgid % nig) / gsz; return true;
    }
    __device__ __forceinline__ void a_ready(const Unit&) const {}
    __device__ __forceinline__ void done(const Unit&) const {}
};
template <class F> struct Epi8 {
    static constexpr bool PERM = true, AFTER_DRAIN = false; F f;
    __device__ __forceinline__ void operator()(const f32x4 (&acc)[2][2][4][2], const Unit& u, int wr, int wc, int fr, int fq) const {
        const int row0 = u.pm * BM + wr * 64 + fr, col0 = u.pn * BM + wc * 32 + 8 * fq;
#pragma unroll
        for (int ai = 0; ai < 2; ++ai)
#pragma unroll
            for (int m = 0; m < 4; ++m)
#pragma unroll
                for (int bj = 0; bj < 2; ++bj) f(row0 + ai * HALF + m * 16, col0 + bj * HALF, acc[ai][bj][m][0], acc[ai][bj][m][1]);
    }
};
template <class F> struct Epi4 {
    static constexpr bool PERM = false, AFTER_DRAIN = false; F f;
    __device__ __forceinline__ void operator()(const f32x4 (&acc)[2][2][4][2], const Unit& u, int wr, int wc, int fr, int fq) const {
        const int row0 = u.pm * BM + wr * 64 + fr, col0 = u.pn * BM + wc * 32 + 4 * fq;
#pragma unroll
        for (int ai = 0; ai < 2; ++ai)
#pragma unroll
            for (int m = 0; m < 4; ++m) {
#pragma unroll
                for (int bj = 0; bj < 2; ++bj)
#pragma unroll
                    for (int n = 0; n < 2; ++n) f(row0 + ai * HALF + m * 16, col0 + bj * HALF + n * 16, acc[ai][bj][m][n]);
                if (m & 1) asm volatile("" ::: "memory");
            }
    }
};

template <class Epi, class Sched, bool ALIGN_EPI = false, bool SP2 = false>
__device__ __forceinline__ void gemm_phase(LAS unsigned char* lds, const Gemm g, const Sched& S, const Epi& E) {
    const int tid = tid_opaque(), wid = __builtin_amdgcn_readfirstlane(tid >> 6), lane = tid & 63, wr = wid >> 2, wc = wid & 3, fr = lane & 15, fq = lane >> 4;
    const int K = g.K, nt = K / BK;
    unsigned voffA[2], voffB[2];
#pragma unroll
    for (int i = 0; i < 2; ++i) { int R, C; stage_rc(tid * 16 + i * 8192, R, C); const int Rb = Epi::PERM ? ((R & ~31) + perm32(R & 31)) : R;
        voffA[i] = (unsigned)(R * K + C) * 2u; voffB[i] = (unsigned)(Rb * K + C) * 2u; }
    const size_t kstep = (size_t)(BK * 2);
    const size_t hstep = (size_t)HALF * K * 2;
    const size_t tstep = 2 * hstep;
    const unsigned ldsw = (unsigned)wid * 1024u;
    const int aoff = lds_byte(wr * 64 + fr, fq * 8), boff = lds_byte(wc * 32 + fr, fq * 8);
#define PG8_SA(b, h) (((b) * 2 + (h)) * HTB)
#define PG8_SB(b, h) ((4 + (b) * 2 + (h)) * HTB)
#define PG8_STAGE(bufoff, gbase, voff) do { _Pragma("unroll") for (int _i = 0; _i < 2; ++_i) \
        __builtin_amdgcn_global_load_lds((const unsigned*)((const char*)(gbase) + (voff)[_i]), (LAS unsigned*)(lds + (bufoff) + ldsw + _i * 8192), 16, 0, 0); } while (0)
#define PG8_LDA(dst, b, h) do { _Pragma("unroll") for (int m = 0; m < 4; ++m) _Pragma("unroll") for (int k = 0; k < 2; ++k) dst[m][k] = *(const LAS bf16x8*)(lds + PG8_SA(b, h) + aoff + m * 2048 + k * 1024); } while (0)
#define PG8_LDB(dst, b, h) do { _Pragma("unroll") for (int n = 0; n < 2; ++n) _Pragma("unroll") for (int k = 0; k < 2; ++k) dst[n][k] = *(const LAS bf16x8*)(lds + PG8_SB(b, h) + boff + n * 2048 + k * 1024); } while (0)
#define PG8_MMA(ai, bj, At, Bt) do { __builtin_amdgcn_s_setprio(1); _Pragma("unroll") for (int m = 0; m < 4; ++m) _Pragma("unroll") for (int n = 0; n < 2; ++n) _Pragma("unroll") for (int k = 0; k < 2; ++k) \
        acc[ai][bj][m][n] = __builtin_amdgcn_mfma_f32_16x16x32_bf16(Bt[n][k], At[m][k], acc[ai][bj][m][n], 0, 0, 0); __builtin_amdgcn_s_setprio(0); } while (0)
#define PG8_WAIT_V(n) asm volatile("s_waitcnt vmcnt(" #n ")" ::: "memory")
#define PG8_WAIT_L(n) asm volatile("s_waitcnt lgkmcnt(" #n ")" ::: "memory")
#define PG8_BAR __builtin_amdgcn_s_barrier()
#define PG8_SCHED __builtin_amdgcn_sched_barrier(0)
    Unit cur, nxt; int ui = 0;
    if (!S.next(0, cur)) return;
    f32x4 acc[2][2][4][2];
#pragma unroll
    for (int a = 0; a < 2; ++a)
#pragma unroll
        for (int b = 0; b < 2; ++b)
#pragma unroll
            for (int m = 0; m < 4; ++m)
#pragma unroll
                for (int n = 0; n < 2; ++n) acc[a][b][m][n] = (f32x4){0.f, 0.f, 0.f, 0.f};
    bf16x8 At[4][2], B0[2][2], B1[2][2];
    const char* cA = (const char*)g.A + (size_t)cur.pm * tstep; const char* cB = (const char*)g.Bt + (size_t)cur.pn * tstep;
    S.a_ready(cur);
    if constexpr (SP2) {
        PG8_STAGE(PG8_SB(0, 0), cB, voffB); PG8_STAGE(PG8_SB(0, 1), cB + hstep, voffB); PG8_STAGE(PG8_SA(0, 0), cA, voffA); PG8_STAGE(PG8_SA(0, 1), cA + hstep, voffA);
        if (wr == 1) PG8_BAR;
        PG8_WAIT_V(2); PG8_BAR;
        PG8_STAGE(PG8_SB(1, 0), cB + kstep, voffB); PG8_STAGE(PG8_SA(1, 0), cA + kstep, voffA); PG8_STAGE(PG8_SB(1, 1), cB + hstep + kstep, voffB);
        PG8_WAIT_V(6); PG8_BAR;
    } else {
        PG8_STAGE(PG8_SB(0, 0), cB, voffB); PG8_STAGE(PG8_SA(0, 0), cA, voffA); PG8_STAGE(PG8_SB(0, 1), cB + hstep, voffB); PG8_STAGE(PG8_SA(0, 1), cA + hstep, voffA);
        if (wr == 1) PG8_BAR;
        PG8_WAIT_V(4); PG8_BAR;
        PG8_STAGE(PG8_SB(1, 0), cB + kstep, voffB); PG8_STAGE(PG8_SA(1, 0), cA + kstep, voffA); PG8_STAGE(PG8_SB(1, 1), cB + hstep + kstep, voffB);
        PG8_WAIT_V(6); PG8_BAR;
    }
    for (;;) {
        const bool has_next = S.next(ui + 1, nxt);
        const char* nA = has_next ? (const char*)g.A + (size_t)nxt.pm * tstep : cA; const char* nB = has_next ? (const char*)g.Bt + (size_t)nxt.pn * tstep : cB;
#pragma unroll 1
        for (int t = 0; t < nt; t += 2) {
            const bool last = (t == nt - 2);
            const char* a1 = cA + (size_t)(t + 1) * kstep;
            const char* a2 = last ? nA : cA + (size_t)(t + 2) * kstep; const char* b2 = last ? nB : cB + (size_t)(t + 2) * kstep;
            const char* a3 = a2 + kstep; const char* b3 = b2 + kstep;
            if (last && has_next) S.a_ready(nxt);
            if constexpr (SP2) {
            PG8_LDB(B0, 0, 0); PG8_LDB(B1, 0, 1); PG8_SCHED; PG8_LDA(At, 0, 0); PG8_STAGE(PG8_SA(1, 1), a1 + hstep, voffA);
            PG8_WAIT_V(8); PG8_WAIT_L(0); PG8_BAR; PG8_MMA(0, 0, At, B0); PG8_MMA(0, 1, At, B1); PG8_BAR; PG8_SCHED;
            PG8_LDA(At, 0, 1); PG8_STAGE(PG8_SB(0, 0), b2, voffB); PG8_STAGE(PG8_SB(0, 1), b2 + hstep, voffB); PG8_STAGE(PG8_SA(0, 0), a2, voffA);
            PG8_WAIT_V(8); PG8_WAIT_L(0); PG8_BAR; PG8_MMA(1, 0, At, B0); PG8_MMA(1, 1, At, B1); PG8_BAR; PG8_SCHED;
            PG8_LDB(B0, 1, 0); PG8_LDB(B1, 1, 1); PG8_SCHED; PG8_LDA(At, 1, 0); PG8_STAGE(PG8_SA(0, 1), a2 + hstep, voffA);
            PG8_WAIT_V(8); PG8_WAIT_L(0); PG8_BAR; PG8_MMA(0, 0, At, B0); PG8_MMA(0, 1, At, B1); PG8_BAR; PG8_SCHED;
            PG8_LDA(At, 1, 1); PG8_STAGE(PG8_SB(1, 0), b3, voffB); PG8_STAGE(PG8_SB(1, 1), b3 + hstep, voffB); PG8_STAGE(PG8_SA(1, 0), a3, voffA);
            PG8_WAIT_V(8); PG8_WAIT_L(0); PG8_BAR; PG8_MMA(1, 0, At, B0); PG8_MMA(1, 1, At, B1); PG8_BAR; PG8_SCHED;
            } else {
            PG8_LDB(B0, 0, 0); PG8_SCHED; PG8_LDA(At, 0, 0); PG8_STAGE(PG8_SA(1, 1), a1 + hstep, voffA);
            PG8_WAIT_L(8); PG8_BAR; PG8_WAIT_L(0); PG8_MMA(0, 0, At, B0); PG8_BAR; PG8_SCHED;
            PG8_LDB(B1, 0, 1); PG8_STAGE(PG8_SB(0, 0), b2, voffB);
            PG8_BAR; PG8_WAIT_L(0); PG8_MMA(0, 1, At, B1); PG8_BAR;
            PG8_LDA(At, 0, 1); PG8_STAGE(PG8_SA(0, 0), a2, voffA);
            PG8_BAR; PG8_WAIT_L(0); PG8_MMA(1, 0, At, B0); PG8_BAR; PG8_SCHED;
            PG8_STAGE(PG8_SB(0, 1), b2 + hstep, voffB);
            PG8_WAIT_V(6); PG8_BAR; PG8_MMA(1, 1, At, B1); PG8_BAR;
            PG8_LDB(B0, 1, 0); PG8_SCHED; PG8_LDA(At, 1, 0); PG8_STAGE(PG8_SA(0, 1), a2 + hstep, voffA);
            PG8_WAIT_L(8); PG8_BAR; PG8_WAIT_L(0); PG8_MMA(0, 0, At, B0); PG8_BAR; PG8_SCHED;
            PG8_LDB(B1, 1, 1); PG8_STAGE(PG8_SB(1, 0), b3, voffB);
            PG8_BAR; PG8_WAIT_L(0); PG8_MMA(0, 1, At, B1); PG8_BAR;
            PG8_LDA(At, 1, 1); PG8_STAGE(PG8_SA(1, 0), a3, voffA);
            PG8_BAR; PG8_WAIT_L(0); PG8_MMA(1, 0, At, B0); PG8_BAR; PG8_SCHED;
            PG8_STAGE(PG8_SB(1, 1), b3 + hstep, voffB);
            PG8_WAIT_V(6); PG8_BAR; PG8_MMA(1, 1, At, B1); PG8_BAR;
            }
        }
        if constexpr (ALIGN_EPI) { if (wr == 0) PG8_BAR; }
        if constexpr (!Epi::AFTER_DRAIN) { E(acc, cur, wr, wc, fr, fq); S.done(cur); }
        if (!has_next) break;
#pragma unroll
        for (int a = 0; a < 2; ++a)
#pragma unroll
            for (int b = 0; b < 2; ++b)
#pragma unroll
                for (int m = 0; m < 4; ++m)
#pragma unroll
                    for (int n = 0; n < 2; ++n) acc[a][b][m][n] = (f32x4){0.f, 0.f, 0.f, 0.f};
        cur = nxt; cA = nA; cB = nB; ++ui;
        if constexpr (ALIGN_EPI) { if (wr == 1) PG8_BAR; }
    }
    PG8_WAIT_V(0);
    if constexpr (!ALIGN_EPI) { if (wr == 0) PG8_BAR; }
    PG8_BAR;
#undef PG8_SA
#undef PG8_SB
#undef PG8_STAGE
#undef PG8_LDA
#undef PG8_LDB
#undef PG8_MMA
#undef PG8_WAIT_V
#undef PG8_WAIT_L
#undef PG8_BAR
#undef PG8_SCHED
}
}

namespace att {
constexpr int NW = 8, QBLK = 32, KVBLK = 64;
constexpr int LDQ = NH * DQK, LDK = NH * DQK, LDV = NH * 256, LDO = DM;
constexpr float SCALE = 0.07216878364870322f;
constexpr float THR = 8.f;
constexpr int SHM_K = KVBLK * DQK * 2, SHM_V = KVBLK * DV * 2;
constexpr int SHM_QL = 2 * SHM_V + 2 * SHM_K + NW * 64 * 4;
constexpr int SHM_ATTN = SHM_QL + NW * 4096;
#define KSWZ(row, colB) ((row) * 384 + ((colB) ^ ((((row) >> 1) & 7) << 4)))
#define SBAR() __builtin_amdgcn_sched_barrier(0)
__device__ __forceinline__ int crow(int r, int hi) { return (r & 3) + 8 * (r >> 2) + 4 * hi; }
__device__ __forceinline__ void partialSM(f32x16& p0, f32x16& p1, float& m_reg, float& mn, float& alpha) {
    constexpr float C = SCALE * 1.4426950408889634f;
    float pmax = p0[0];
#pragma unroll
    for (int r = 1; r < 16; ++r) pmax = fmaxf(pmax, p0[r]);
#pragma unroll
    for (int r = 0; r < 16; ++r) pmax = fmaxf(pmax, p1[r]);
    { auto rr = __builtin_amdgcn_permlane32_swap(__float_as_uint(pmax), __float_as_uint(pmax), false, false);
      pmax = fmaxf(__uint_as_float(rr[0]), __uint_as_float(rr[1])); }
    if (__builtin_expect(__all(pmax - m_reg <= THR / SCALE), 1)) { mn = m_reg; alpha = 1.f; }
    else { mn = fmaxf(m_reg, pmax); alpha = __builtin_amdgcn_exp2f((m_reg - mn) * C); m_reg = mn; }
    float mnC = -mn * C;
#pragma unroll
    for (int r = 0; r < 16; ++r) p0[r] = fmaf(p0[r], C, mnC);
#pragma unroll
    for (int r = 0; r < 16; ++r) p1[r] = fmaf(p1[r], C, mnC);
#pragma unroll
    for (int r = 0; r < 16; ++r) p0[r] = __builtin_amdgcn_exp2f(p0[r]);
}
__device__ __forceinline__ void finishSM(f32x16& p0, f32x16& p1, float alpha, float& l_reg, bf16x8& pa0, bf16x8& pa1, bf16x8& pa2, bf16x8& pa3) {
#pragma unroll
    for (int r = 0; r < 16; ++r) p1[r] = __builtin_amdgcn_exp2f(p1[r]);
    float ps = 0;
#pragma unroll
    for (int r = 0; r < 16; ++r) ps += p0[r];
#pragma unroll
    for (int r = 0; r < 16; ++r) ps += p1[r];
    { auto rr = __builtin_amdgcn_permlane32_swap(__float_as_uint(ps), __float_as_uint(ps), false, false);
      ps = __uint_as_float(rr[0]) + __uint_as_float(rr[1]); }
    l_reg = l_reg * alpha + ps;
#define PK4(P, BASE, OUT) do { unsigned a0 = cvt_pk_bf16(P[BASE + 0], P[BASE + 1]), a1 = cvt_pk_bf16(P[BASE + 2], P[BASE + 3]);   \
    unsigned b0 = cvt_pk_bf16(P[BASE + 4], P[BASE + 5]), b1 = cvt_pk_bf16(P[BASE + 6], P[BASE + 7]);                              \
    auto r0 = __builtin_amdgcn_permlane32_swap(a0, b0, false, false); auto r1 = __builtin_amdgcn_permlane32_swap(a1, b1, false, false); \
    u32x4 w = {r0[0], r1[0], r0[1], r1[1]}; OUT = *reinterpret_cast<bf16x8*>(&w); } while (0)
    PK4(p0, 0, pa0); PK4(p0, 8, pa1); PK4(p1, 0, pa2); PK4(p1, 8, pa3);
#undef PK4
}
typedef int v8i __attribute__((ext_vector_type(8)));
constexpr float THR8 = 1.0f;
__device__ __forceinline__ void partialSM8(f32x16& p0, f32x16& p1, float& m_reg, float& mn, float& alpha) {
    constexpr float C = SCALE * 1.4426950408889634f;
    float pmax = p0[0];
#pragma unroll
    for (int r = 1; r < 16; ++r) pmax = fmaxf(pmax, p0[r]);
#pragma unroll
    for (int r = 0; r < 16; ++r) pmax = fmaxf(pmax, p1[r]);
    { auto rr = __builtin_amdgcn_permlane32_swap(__float_as_uint(pmax), __float_as_uint(pmax), false, false);
      pmax = fmaxf(__uint_as_float(rr[0]), __uint_as_float(rr[1])); }
    if (__builtin_expect(__all(pmax - m_reg <= THR8 / SCALE), 1)) { mn = m_reg; alpha = 1.f; }
    else { mn = fmaxf(m_reg, pmax); alpha = __builtin_amdgcn_exp2f((m_reg - mn) * C); m_reg = mn; }
    float mnC = -mn * C + 7.0f;
#pragma unroll
    for (int r = 0; r < 16; ++r) p0[r] = fmaf(p0[r], C, mnC);
#pragma unroll
    for (int r = 0; r < 16; ++r) p1[r] = fmaf(p1[r], C, mnC);
#pragma unroll
    for (int r = 0; r < 16; ++r) p0[r] = __builtin_amdgcn_exp2f(p0[r]);
}
__device__ __forceinline__ void finishSM8(f32x16& p0, f32x16& p1, float alpha, float& l_reg, v8i& pa) {
#pragma unroll
    for (int r = 0; r < 16; ++r) p1[r] = __builtin_amdgcn_exp2f(p1[r]);
    float ps = 0;
#pragma unroll
    for (int r = 0; r < 16; ++r) ps += p0[r];
#pragma unroll
    for (int r = 0; r < 16; ++r) ps += p1[r];
    { auto rr = __builtin_amdgcn_permlane32_swap(__float_as_uint(ps), __float_as_uint(ps), false, false);
      ps = __uint_as_float(rr[0]) + __uint_as_float(rr[1]); }
    l_reg = l_reg * alpha + ps;
#pragma unroll
    for (int w = 0; w < 4; ++w) { int a = 0, b = 0;
        a = __builtin_amdgcn_cvt_pk_fp8_f32(p0[4 * w], p0[4 * w + 1], a, false); a = __builtin_amdgcn_cvt_pk_fp8_f32(p0[4 * w + 2], p0[4 * w + 3], a, true);
        b = __builtin_amdgcn_cvt_pk_fp8_f32(p1[4 * w], p1[4 * w + 1], b, false); b = __builtin_amdgcn_cvt_pk_fp8_f32(p1[4 * w + 2], p1[4 * w + 3], b, true);
        pa[w] = a; pa[4 + w] = b; }
}
constexpr int V8S = 80;
__device__ __forceinline__ void pv8(f32x16* o, const char* Vs, const v8i& pa, int r32, int hi) {
    const char* bp = Vs + r32 * V8S + hi * 32;
    u32x4 bl[4], bh[4];
#pragma unroll
    for (int d0 = 0; d0 < 4; ++d0) { bl[d0] = *(const u32x4*)(bp + d0 * (32 * V8S)); bh[d0] = *(const u32x4*)(bp + d0 * (32 * V8S) + 16); }
    asm volatile("" ::: "memory");
#pragma unroll
    for (int d0 = 0; d0 < 4; ++d0) {
        const v8i B = {(int)bl[d0].x, (int)bl[d0].y, (int)bl[d0].z, (int)bl[d0].w, (int)bh[d0].x, (int)bh[d0].y, (int)bh[d0].z, (int)bh[d0].w};
        o[d0] = __builtin_amdgcn_mfma_scale_f32_32x32x64_f8f6f4(pa, B, o[d0], 0, 0, 0, 0, 0, 0); }
}
__device__ __forceinline__ void qkt(f32x16& p0, f32x16& p1, const char* Ks, const bf16x8* qr, const char* ql, int r32, int hi) {
    p0 = f32x16{}; p1 = f32x16{};
#pragma unroll
    for (int d0 = 0; d0 < 12; ++d0) { const int cb = (d0 * 16 + hi * 8) * 2;
        bf16x8 b0 = *reinterpret_cast<const bf16x8*>(Ks + KSWZ(r32, cb));
        bf16x8 b1 = *reinterpret_cast<const bf16x8*>(Ks + KSWZ(32 + r32, cb));
        const bf16x8 q = d0 < 8 ? qr[d0 < 8 ? d0 : 0] : *reinterpret_cast<const bf16x8*>(ql + (d0 - 8) * 1024);
        p0 = __builtin_amdgcn_mfma_f32_32x32x16_bf16(b0, q, p0, 0, 0, 0);
        p1 = __builtin_amdgcn_mfma_f32_32x32x16_bf16(b1, q, p1, 0, 0, 0); }
}
__device__ __forceinline__ int v_st(int k, int c) { const int kk = (k & ~0xC) | ((k & 4) << 1) | ((k & 8) >> 1); return ((kk >> 3) * 4 + (c >> 5)) * 512 + ((kk & 7) * 32 + (c & 31)) * 2; }
__device__ __forceinline__ int v_rd_base(int lane) { return ((lane & 3) << 3) | (((lane >> 2) & 3) << 6) | (((lane >> 4) & 1) << 5) | (((lane >> 5) & 1) << 8); }
constexpr int v_rd_off(int d0, int ks, int half) { return d0 * 512 + ks * 4096 + half * 2048; }
template <int OFF> __device__ __forceinline__ s16x4 tr_read(int vb) {
    s16x4 r; asm volatile("ds_read_b64_tr_b16 %0, %1 offset:%2" : "=&v"(r) : "v"(vb), "i"(OFF) : "memory"); return r;
}
template <int D0> __device__ __forceinline__ void pv_one(f32x16& od, int vb, bf16x8 pa0, bf16x8 pa1, bf16x8 pa2, bf16x8 pa3) {
#define PK(L, H) (bf16x8){L[0], L[1], L[2], L[3], H[0], H[1], H[2], H[3]}
    { const s16x4 l0 = tr_read<v_rd_off(D0, 0, 0)>(vb), h0 = tr_read<v_rd_off(D0, 0, 1)>(vb), l1 = tr_read<v_rd_off(D0, 1, 0)>(vb), h1 = tr_read<v_rd_off(D0, 1, 1)>(vb);
      asm volatile("s_waitcnt lgkmcnt(0)" ::: "memory"); SBAR();
      od = __builtin_amdgcn_mfma_f32_32x32x16_bf16(pa0, PK(l0, h0), od, 0, 0, 0);
      od = __builtin_amdgcn_mfma_f32_32x32x16_bf16(pa1, PK(l1, h1), od, 0, 0, 0); }
    { const s16x4 l2 = tr_read<v_rd_off(D0, 2, 0)>(vb), h2 = tr_read<v_rd_off(D0, 2, 1)>(vb), l3 = tr_read<v_rd_off(D0, 3, 0)>(vb), h3 = tr_read<v_rd_off(D0, 3, 1)>(vb);
      asm volatile("s_waitcnt lgkmcnt(0)" ::: "memory"); SBAR();
      od = __builtin_amdgcn_mfma_f32_32x32x16_bf16(pa2, PK(l2, h2), od, 0, 0, 0);
      od = __builtin_amdgcn_mfma_f32_32x32x16_bf16(pa3, PK(l3, h3), od, 0, 0, 0); }
#undef PK
}
__device__ __forceinline__ void pv_d0(f32x16* o, int vb, bf16x8 pa0, bf16x8 pa1, bf16x8 pa2, bf16x8 pa3) {
    pv_one<0>(o[0], vb, pa0, pa1, pa2, pa3); pv_one<1>(o[1], vb, pa0, pa1, pa2, pa3); pv_one<2>(o[2], vb, pa0, pa1, pa2, pa3); pv_one<3>(o[3], vb, pa0, pa1, pa2, pa3);
}
#ifndef ATT_SDEPTH
#define ATT_SDEPTH 1
#endif
constexpr int SDEPTH = ATT_SDEPTH;
constexpr int K8S = 208;
__device__ __forceinline__ void qkt8(f32x16& p0, f32x16& p1, const char* Ks, const v8i* qr8, int r32, int hi) {
    p0 = f32x16{}; p1 = f32x16{};
#pragma unroll
    for (int ks = 0; ks < 3; ++ks) {
        const char* a0p = Ks + r32 * K8S + ks * 64 + hi * 32; const char* a1p = a0p + 32 * K8S;
        const u32x4 a0l = *(const u32x4*)a0p, a0h = *(const u32x4*)(a0p + 16), a1l = *(const u32x4*)a1p, a1h = *(const u32x4*)(a1p + 16);
        const v8i A0 = {(int)a0l.x, (int)a0l.y, (int)a0l.z, (int)a0l.w, (int)a0h.x, (int)a0h.y, (int)a0h.z, (int)a0h.w};
        const v8i A1 = {(int)a1l.x, (int)a1l.y, (int)a1l.z, (int)a1l.w, (int)a1h.x, (int)a1h.y, (int)a1h.z, (int)a1h.w};
        p0 = __builtin_amdgcn_mfma_scale_f32_32x32x64_f8f6f4(A0, qr8[ks], p0, 0, 0, 0, 0, 0, 0);
        p1 = __builtin_amdgcn_mfma_scale_f32_32x32x64_f8f6f4(A1, qr8[ks], p1, 0, 0, 0, 0, 0, 0); }
}
template <int FM>
__device__ __forceinline__ void attn_unit(const void* __restrict__ Qbv, const void* __restrict__ Khv, const void* __restrict__ Vhv, bf16_t* __restrict__ Ob, int seq, char* lds) {
    constexpr bool F8 = FM != 0, PV8 = FM == 3; const bf16_t* Vh = (const bf16_t*)Vhv;
    const int tid = tid_opaque(), wid = tid >> 6, lane = tid & 63, r32 = lane & 31, hi = lane >> 5;
    char* V_lds = lds; char* K_lds = lds + 2 * SHM_V;
    float* ws = (float*)(lds + 2 * SHM_V + 2 * SHM_K) + wid * 64; float* li_l = ws; float* al_l = ws + 32;
    float m_reg = -1e30f, l_reg = 0; f32x16 o[4] = {};
    bf16x8 qr[F8 ? 1 : 8]; v8i qr8[F8 ? 3 : 1];
    char* ql = lds + SHM_QL + wid * 4096 + lane * 16;
    if constexpr (F8) {
        const unsigned char* Qw = (const unsigned char*)Qbv + (long)(wid * QBLK + r32) * (NH * DQK) + hi * 32;
#pragma unroll
        for (int ks = 0; ks < 3; ++ks) { const u32x4 lo = *(const u32x4*)(Qw + ks * 64), hh = *(const u32x4*)(Qw + ks * 64 + 16);
            qr8[ks] = (v8i){(int)lo.x, (int)lo.y, (int)lo.z, (int)lo.w, (int)hh.x, (int)hh.y, (int)hh.z, (int)hh.w}; }
    } else {
        const bf16_t* Qw = (const bf16_t*)Qbv + (long)(wid * QBLK + r32) * LDQ + hi * 8;
#pragma unroll
        for (int d0 = 0; d0 < 8; ++d0) qr[d0] = *reinterpret_cast<const bf16x8*>(Qw + d0 * 16);
#pragma unroll
        for (int d0 = 8; d0 < 12; ++d0) *reinterpret_cast<bf16x8*>(ql + (d0 - 8) * 1024) = *reinterpret_cast<const bf16x8*>(Qw + d0 * 16);
    }
    const int krow = tid >> 3, kc8 = tid & 7;
    const int id1 = 512 + (tid & 255);
    const unsigned kgo = F8 ? (unsigned)((tid / 12) * (NH * DQK) + (tid % 12) * 16) : (unsigned)(krow * LDK + kc8 * 8) * 2u;
    const int kso = F8 ? (tid / 12) * K8S + (tid % 12) * 16 : krow * 384 + ((kc8 * 16) ^ (((krow >> 1) & 7) << 4));
    const unsigned kgo1 = (unsigned)((id1 / 12) * (NH * DQK) + (id1 % 12) * 16); const int kso1 = (id1 / 12) * K8S + (id1 % 12) * 16; const bool k1on = tid < 256;
    const int sr = tid >> 4, sc = (tid & 15) * 8, vst0 = v_st(sr, sc);
    const unsigned vgo = (unsigned)(sr * LDV + sc) * 2u;
    const int vb0 = (int)(uintptr_t)V_lds + v_rd_base(lane);
    const int v8so = (tid >> 2) * V8S + (tid & 3) * 16;
    struct { bf16x8 k0, k1, k2, v0, v1; } sr_[SDEPTH];
#define SLOAD(i, kk0) do { if constexpr (PV8) { sr_[i].v0 = ldgu<bf16x8>((const char*)Vhv + (long)(kk0) * 128, (unsigned)tid * 16u); } \
    else { const char* vp_ = (const char*)(Vh + (long)(kk0) * LDV); sr_[i].v0 = ldgu<bf16x8>(vp_, vgo); sr_[i].v1 = ldgu<bf16x8>(vp_ + 32 * LDV * 2, vgo); } \
    if constexpr (F8) { const char* kp_ = (const char*)Khv + (long)(kk0) * (NH * DQK); sr_[i].k0 = ldgu<bf16x8>(kp_, kgo); if (k1on) sr_[i].k1 = ldgu<bf16x8>(kp_, kgo1); } \
    else { const char* kp_ = (const char*)((const bf16_t*)Khv + (long)(kk0) * LDK); sr_[i].k0 = ldgu<bf16x8>(kp_, kgo); sr_[i].k1 = ldgu<bf16x8>(kp_ + 128, kgo); sr_[i].k2 = ldgu<bf16x8>(kp_ + 256, kgo); } } while (0)
#define SWRITE(b, i) do { if constexpr (PV8) { *(bf16x8*)(V_lds + (b) * SHM_V + v8so) = sr_[i].v0; } else { *(bf16x8*)(V_lds + (b) * SHM_V + vst0) = sr_[i].v0; *(bf16x8*)(V_lds + (b) * SHM_V + 8192 + vst0) = sr_[i].v1; } \
    if constexpr (F8) { *(bf16x8*)(K_lds + (b) * SHM_K + kso) = sr_[i].k0; if (k1on) *(bf16x8*)(K_lds + (b) * SHM_K + kso1) = sr_[i].k1; } \
    else { *(bf16x8*)(K_lds + (b) * SHM_K + kso) = sr_[i].k0; *(bf16x8*)(K_lds + (b) * SHM_K + 128 + kso) = sr_[i].k1; *(bf16x8*)(K_lds + (b) * SHM_K + 256 + kso) = sr_[i].k2; } } while (0)
#define SWAIT() do { if constexpr (SDEPTH == 2) { if constexpr (PV8) { if (k1on) asm volatile("s_waitcnt vmcnt(3)" ::: "memory"); else asm volatile("s_waitcnt vmcnt(2)" ::: "memory"); } \
        else if constexpr (F8) { if (k1on) asm volatile("s_waitcnt vmcnt(4)" ::: "memory"); else asm volatile("s_waitcnt vmcnt(3)" ::: "memory"); } \
        else asm volatile("s_waitcnt vmcnt(5)" ::: "memory"); } else asm volatile("s_waitcnt vmcnt(0)" ::: "memory"); } while (0)
#define RESC(a) do { if (__any((a) < 1.f)) { if (hi == 0) al_l[r32] = (a); asm volatile("s_waitcnt lgkmcnt(0)" ::: "memory"); \
    _Pragma("unroll") for (int d = 0; d < 4; ++d) _Pragma("unroll") for (int r = 0; r < 16; ++r) o[d][r] *= al_l[crow(r, hi)]; } } while (0)
#define PSM(P0, P1, MN, AL) do { if constexpr (PV8) partialSM8(P0, P1, m_reg, MN, AL); else partialSM(P0, P1, m_reg, MN, AL); } while (0)
#define FSM(P0, P1, AL) do { if constexpr (PV8) finishSM8(P0, P1, AL, l_reg, pa8); else finishSM(P0, P1, AL, l_reg, pa0, pa1, pa2, pa3); } while (0)
#define PVD(BUF) do { if constexpr (PV8) pv8(o, V_lds + (BUF) * SHM_V, pa8, r32, hi); else pv_d0(o, vb0 + (BUF) * SHM_V, pa0, pa1, pa2, pa3); } while (0)
#define QKT(P0, P1, KB) do { if constexpr (F8) qkt8(P0, P1, KB, qr8, r32, hi); else qkt(P0, P1, KB, qr, ql, r32, hi); } while (0)
    f32x16 pA0, pA1, pB0, pB1; float mnA, mnB, alA, alB; bf16x8 pa0, pa1, pa2, pa3; v8i pa8; const int NT = seq / KVBLK;
    constexpr int SE = 0, SO = SDEPTH - 1;
    SLOAD(SE, 0); asm volatile("s_waitcnt vmcnt(0)" ::: "memory"); SWRITE(0, SE); __syncthreads();
    QKT(pA0, pA1, K_lds); PSM(pA0, pA1, mnA, alA);
    SLOAD(SO, KVBLK); if constexpr (SDEPTH == 2) { if (2 < NT) SLOAD(SE, 2 * KVBLK); }
    SWAIT(); SWRITE(1, SO); __syncthreads();
    for (int j = 1; j + 1 < NT; j += 2) {
        SBAR(); QKT(pB0, pB1, K_lds + SHM_K);
        FSM(pA0, pA1, alA); SBAR();
        SLOAD(SO, (j + SDEPTH) * KVBLK); SBAR();
        PVD(0); PSM(pB0, pB1, mnB, alB);
        __syncthreads(); SWAIT(); SWRITE(0, SE);
        RESC(alB); __syncthreads();
        SBAR(); QKT(pA0, pA1, K_lds);
        FSM(pB0, pB1, alB); SBAR();
        if (SDEPTH == 1 || j + 3 < NT) SLOAD(SE, (j + 1 + SDEPTH) * KVBLK); SBAR();
        PVD(1); PSM(pA0, pA1, mnA, alA);
        __syncthreads(); SWAIT(); SWRITE(1, SO);
        RESC(alA); __syncthreads();
    }
    SBAR(); QKT(pB0, pB1, K_lds + SHM_K);
    FSM(pA0, pA1, alA); SBAR();
    PVD(0); PSM(pB0, pB1, mnB, alB);
    __syncthreads(); RESC(alB);
    FSM(pB0, pB1, alB); SBAR();
    PVD(1);
    if (hi == 0) li_l[r32] = l_reg; asm volatile("s_waitcnt lgkmcnt(0)" ::: "memory");
    float rli[16];
#pragma unroll
    for (int r = 0; r < 16; ++r) rli[r] = __builtin_amdgcn_rcpf(li_l[crow(r, hi)]);
    bf16_t* Ow = Ob + (long)(wid * QBLK) * LDO;
#pragma unroll
    for (int r = 0; r < 16; ++r) { const int orow = crow(r, hi);
#pragma unroll
        for (int d0 = 0; d0 < 4; ++d0) Ow[(long)orow * LDO + d0 * 32 + r32] = f2bf(o[d0][r] * rli[r]); }
    __syncthreads();
#undef SLOAD
#undef SWRITE
#undef SWAIT
#undef RESC
#undef QKT
#undef PSM
#undef FSM
#undef PVD
}
constexpr int ST_K = 64 * K8S, ST_V = 128 * V8S, ST_BYTES = 2 * ST_K + 2 * ST_V;
constexpr int ST_WS = 2 * ST_BYTES;
static_assert(ST_WS + NW * 256 <= 147456 - 64 - 256, "attention super-tile LDS");
__device__ __forceinline__ void attn_unit_f8x2(const unsigned char* __restrict__ Q8b, const unsigned char* __restrict__ K8h, const unsigned char* __restrict__ V8h, bf16_t* __restrict__ Ob, int seq, char* lds) {
    const int tid = tid_opaque(), wid = tid >> 6, lane = tid & 63, r32 = lane & 31, hi = lane >> 5;
    float* ws = (float*)(lds + ST_WS) + wid * 64; float* li_l = ws; float* al_l = ws + 32;
    float m_reg = -1e30f, l_reg = 0; f32x16 o[4] = {};
    v8i qr8[3];
    { const unsigned char* Qw = Q8b + (long)(wid * QBLK + r32) * (NH * DQK) + hi * 32;
#pragma unroll
      for (int ks = 0; ks < 3; ++ks) { const u32x4 lo = *(const u32x4*)(Qw + ks * 64), hh = *(const u32x4*)(Qw + ks * 64 + 16);
          qr8[ks] = (v8i){(int)lo.x, (int)lo.y, (int)lo.z, (int)lo.w, (int)hh.x, (int)hh.y, (int)hh.z, (int)hh.w}; } }
    unsigned kgo[3]; int kso[3];
#pragma unroll
    for (int n = 0; n < 3; ++n) { const int id = tid + 512 * n, sub = id / 768, wi = id % 768, row = wi / 12, c = wi % 12;
        kgo[n] = (unsigned)((64 * sub + row) * (NH * DQK) + c * 16); kso[n] = sub * ST_K + row * K8S + c * 16; }
    const int vso = 2 * ST_K + (tid >> 2) * V8S + (tid & 3) * 16;
    u32x4 sk0, sk1, sk2, sv0, sv1;
#define XLOAD(m) do { const char* kp_ = (const char*)K8h + (long)(m) * (128 * NH * DQK); const char* vp_ = (const char*)V8h + (long)(m) * 16384; \
    sk0 = ldgu<u32x4>(kp_, kgo[0]); sk1 = ldgu<u32x4>(kp_, kgo[1]); sk2 = ldgu<u32x4>(kp_, kgo[2]); sv0 = ldgu<u32x4>(vp_, (unsigned)tid * 16u); sv1 = ldgu<u32x4>(vp_ + 8192, (unsigned)tid * 16u); } while (0)
#define XWRITE(bo) do { char* b_ = lds + (bo); *(u32x4*)(b_ + kso[0]) = sk0; *(u32x4*)(b_ + kso[1]) = sk1; *(u32x4*)(b_ + kso[2]) = sk2; *(u32x4*)(b_ + vso) = sv0; *(u32x4*)(b_ + vso + ST_V) = sv1; } while (0)
#define XRESC(a) do { if (__any((a) < 1.f)) { if (hi == 0) al_l[r32] = (a); asm volatile("s_waitcnt lgkmcnt(0)" ::: "memory"); \
    _Pragma("unroll") for (int d = 0; d < 4; ++d) _Pragma("unroll") for (int r = 0; r < 16; ++r) o[d][r] *= al_l[crow(r, hi)]; } } while (0)
    f32x16 pA0, pA1, pB0, pB1; float mnA, mnB, alA, alB; v8i pa8; const int NS = seq / 128;
    int cur = 0, prv = ST_BYTES;
    XLOAD(0); asm volatile("s_waitcnt vmcnt(0)" ::: "memory"); XWRITE(0); __syncthreads();
    qkt8(pA0, pA1, lds + cur, qr8, r32, hi); partialSM8(pA0, pA1, m_reg, mnA, alA);
    if (1 < NS) XLOAD(1);
    SBAR(); qkt8(pB0, pB1, lds + cur + ST_K, qr8, r32, hi);
    finishSM8(pA0, pA1, alA, l_reg, pa8); SBAR();
    pv8(o, lds + cur + 2 * ST_K, pa8, r32, hi); partialSM8(pB0, pB1, m_reg, mnB, alB);
    __syncthreads(); if (1 < NS) { asm volatile("s_waitcnt vmcnt(0)" ::: "memory"); XWRITE(prv); }
    XRESC(alB); __syncthreads();
    for (int m = 1; m < NS; ++m) {
        { const int t_ = cur; cur = prv; prv = t_; }
        SBAR(); qkt8(pA0, pA1, lds + cur, qr8, r32, hi);
        finishSM8(pB0, pB1, alB, l_reg, pa8); SBAR();
        if (m + 1 < NS) XLOAD(m + 1);
        SBAR(); pv8(o, lds + prv + 2 * ST_K + ST_V, pa8, r32, hi); partialSM8(pA0, pA1, m_reg, mnA, alA);
        XRESC(alA);
        SBAR(); qkt8(pB0, pB1, lds + cur + ST_K, qr8, r32, hi);
        finishSM8(pA0, pA1, alA, l_reg, pa8); SBAR();
        pv8(o, lds + cur + 2 * ST_K, pa8, r32, hi); partialSM8(pB0, pB1, m_reg, mnB, alB);
        __syncthreads(); if (m + 1 < NS) { asm volatile("s_waitcnt vmcnt(0)" ::: "memory"); XWRITE(prv); }
        XRESC(alB); __syncthreads();
    }
    finishSM8(pB0, pB1, alB, l_reg, pa8); SBAR();
    pv8(o, lds + cur + 2 * ST_K + ST_V, pa8, r32, hi);
    if (hi == 0) li_l[r32] = l_reg; asm volatile("s_waitcnt lgkmcnt(0)" ::: "memory");
    float rli[16];
#pragma unroll
    for (int r = 0; r < 16; ++r) rli[r] = __builtin_amdgcn_rcpf(li_l[crow(r, hi)]);
    bf16_t* Ow = Ob + (long)(wid * QBLK) * LDO;
#pragma unroll
    for (int r = 0; r < 16; ++r) { const int orow = crow(r, hi);
#pragma unroll
        for (int d0 = 0; d0 < 4; ++d0) Ow[(long)orow * LDO + d0 * 32 + r32] = f2bf(o[d0][r] * rli[r]); }
    __syncthreads();
#undef XLOAD
#undef XWRITE
#undef XRESC
}
#undef SBAR
}

struct TrTile { f32x4 v[16]; };
__device__ __forceinline__ void tr_load(TrTile& t, const float* __restrict__ W, int N, int kb, int nb, int lane) {
    const int k0 = 64 * kb, n0 = 64 * nb; const int nq = 4 * (lane & 15), kr = lane >> 4; const bool ok = (n0 + nq) < N;
    const float* wp = W + (size_t)(k0 + kr) * N + n0 + nq;
#pragma unroll
    for (int i = 0; i < 16; ++i) { t.v[i] = (f32x4){0.f, 0.f, 0.f, 0.f}; if (ok) t.v[i] = __builtin_nontemporal_load((const f32x4*)(wp + (size_t)(4 * i) * N)); }
}
template <class RowMap>
__device__ __forceinline__ void tr_finish(const TrTile& t, int K, int N, bf16_t* __restrict__ WT, float* scr, int kb, int nb, int lane, RowMap rm) {
    const int k0 = 64 * kb, n0 = 64 * nb; const int nq = 4 * (lane & 15), kr = lane >> 4;
#pragma unroll
    for (int i = 0; i < 16; ++i) { float* d = scr + nq * 65 + 4 * i + kr; d[0] = t.v[i][0]; d[65] = t.v[i][1]; d[130] = t.v[i][2]; d[195] = t.v[i][3]; }
    asm volatile("s_waitcnt lgkmcnt(0)" ::: "memory");
    const int c = lane & 7;
#pragma unroll
    for (int j = 0; j < 8; ++j) { const int nl = (lane >> 3) + 8 * j; const int n = n0 + nl; const float* sp = scr + nl * 65 + 8 * c;
        u32x4 o; o.x = cvt_pk_bf16(sp[0], sp[1]); o.y = cvt_pk_bf16(sp[2], sp[3]); o.z = cvt_pk_bf16(sp[4], sp[5]); o.w = cvt_pk_bf16(sp[6], sp[7]);
        if (n < N) *(u32x4*)(WT + (size_t)rm(n) * K + k0 + 8 * c) = o; }
    asm volatile("s_waitcnt lgkmcnt(0)" ::: "memory");
}
template <class RowMap>
__device__ __forceinline__ void transpose_tile(const float* __restrict__ W, int K, int N, bf16_t* __restrict__ WT, float* scr, int kb, int nb, int lane, RowMap rm) {
    TrTile t; tr_load(t, W, N, kb, nb, lane); tr_finish(t, K, N, WT, scr, kb, nb, lane, rm);
}
struct RowId { __device__ __forceinline__ int operator()(int n) const { return n; } };
struct RowUq { __device__ __forceinline__ int operator()(int n) const { return (n / DQK) * 256 + (n % DQK); } };

__device__ __forceinline__ void phase0(const Params& P, char* lds, int G) {
    const int tid = tid_opaque(), lane = tid & 63, wave = tid >> 6;
    const int gw = blockIdx.x * NWAVES + wave, NGW = G * NWAVES;
    float* modp = (float*)(P.ws + WS_MODP);
    for (int task = gw; task < 1536; task += NGW) {
        const int ks = task / 48, cb = task % 48;
        const float s0 = silu_f(P.c[ks * 64 + lane]);
        f32x4 acc = {0.f, 0.f, 0.f, 0.f};
        const float* wp = P.w_ada + (size_t)(ks * 64) * (6 * DM) + cb * 256 + lane * 4;
#pragma unroll 16
        for (int kk = 0; kk < 64; ++kk) { const float sv = shidx(s0, kk); const f32x4 w = __builtin_nontemporal_load((const f32x4*)(wp + (size_t)kk * (6 * DM))); acc += w * sv; }
        { unsigned long long* pp = (unsigned long long*)(modp + (size_t)ks * (6 * DM) + cb * 256 + lane * 4);
          __hip_atomic_store(pp, ((unsigned long long)__float_as_uint(acc[1]) << 32) | __float_as_uint(acc[0]), __ATOMIC_RELAXED, __HIP_MEMORY_SCOPE_AGENT);
          __hip_atomic_store(pp + 1, ((unsigned long long)__float_as_uint(acc[3]) << 32) | __float_as_uint(acc[2]), __ATOMIC_RELAXED, __HIP_MEMORY_SCOPE_AGENT); }
        asm volatile("s_waitcnt vmcnt(0)" ::: "memory");
        unsigned old = 0u; if (lane == 0) old = __hip_atomic_fetch_add((unsigned*)(P.ws + WS_CNT) + cb * 16, 1u, __ATOMIC_RELAXED, __HIP_MEMORY_SCOPE_AGENT);
        old = __builtin_amdgcn_readfirstlane(old);
        if (old == 31u) {
            __builtin_amdgcn_fence(__ATOMIC_ACQUIRE, "agent");
            asm volatile("s_waitcnt vmcnt(0)" ::: "memory");
            f32x4 a = *(const f32x4*)(P.b_ada + cb * 256 + lane * 4);
#pragma unroll 8
            for (int k2 = 0; k2 < 32; ++k2) a += *(const f32x4*)(modp + (size_t)k2 * (6 * DM) + cb * 256 + lane * 4);
            *(f32x4*)((float*)(P.ws + WS_MOD) + cb * 256 + lane * 4) = a;
        }
    }
    { f32x2* rt = (f32x2*)(P.ws + WS_ROPE); const int i = lane & 31; const float freq = powf(10000.0f, -(float)i / 32.0f);
      for (int t = 2 * gw + (lane >> 5); t < SEQ; t += 2 * NGW) { float sn, cs; sincosf((float)P.pos[t] * freq, &sn, &cs); rt[(size_t)t * 32 + i] = (f32x2){cs, sn}; } }
    float* scr = (float*)(lds + wave * 17408);
    constexpr int I_IN = 32 * 78, I_UQ = 8 * 24, I_UKV = 4 * 32, I_OUT = 32 * 32, NIT = I_IN + I_UQ + I_UKV + I_OUT;
    auto src = [&](int it, const float*& W, int& N, int& kb, int& nb, int& kind) {
        int r = it;
        if (r < I_IN) { W = P.w_in; N = DIN; kb = r / 78; nb = r % 78; kind = 0; return; } r -= I_IN;
        if (r < I_UQ) { W = P.w_uq; N = NH * DQK; kb = r / 24; nb = r % 24; kind = 1; return; } r -= I_UQ;
        if (r < I_UKV) { W = P.w_ukv; N = NH * 256; kb = r / 32; nb = r % 32; kind = 2; return; } r -= I_UKV;
        W = P.w_out; N = DM; kb = r / 32; nb = r % 32; kind = 3; };
    int it = (gw + NGW - (1536 % NGW)) % NGW;
    if (it < NIT) {
        TrTile cur, nxt; const float* W; int N, kb, nb, kind;
        src(it, W, N, kb, nb, kind); tr_load(cur, W, N, kb, nb, lane);
        for (; it < NIT; it += NGW) {
            const int itn = it + NGW; const float* Wn = W; int Nn = N, kbn = kb, nbn = nb, kindn = kind;
            if (itn < NIT) { src(itn, Wn, Nn, kbn, nbn, kindn); tr_load(nxt, Wn, Nn, kbn, nbn, lane); }
            if (kind == 0) tr_finish(cur, DM, DIN, (bf16_t*)(P.ws + WS_WIN), scr, kb, nb, lane, RowId());
            else if (kind == 1) tr_finish(cur, QLORA, NH * DQK, (bf16_t*)(P.ws + WS_WUQ), scr, kb, nb, lane, RowUq());
            else if (kind == 2) tr_finish(cur, KVLORA, NH * 256, (bf16_t*)(P.ws + WS_WUKV), scr, kb, nb, lane, RowId());
            else tr_finish(cur, DM, DM, (bf16_t*)(P.ws + WS_WOUT), scr, kb, nb, lane, RowId());
            cur = nxt; W = Wn; N = Nn; kb = kbn; nb = nbn; kind = kindn;
        }
    }
}
__device__ __forceinline__ void norm_mod_rows(const float* __restrict__ src, const float* __restrict__ g, const float* sh, const float* sc, bf16_t* __restrict__ dst, int G) {
    const int tid = tid_opaque(), lane = tid & 63, wave = tid >> 6;
    const int gw = blockIdx.x * NWAVES + wave, NGW = G * NWAVES;
    for (int row0 = gw; row0 < SEQ; row0 += 4 * NGW) {
        f32x4 v[4][8]; float ss[4];
#pragma unroll
        for (int q = 0; q < 4; ++q) { const int row = row0 + q * NGW; const f32x4* xr = (const f32x4*)(src + (size_t)(row < SEQ ? row : row0) * DM) + 2 * lane;
#pragma unroll
            for (int jj = 0; jj < 4; ++jj) { v[q][2 * jj] = xr[128 * jj]; v[q][2 * jj + 1] = xr[128 * jj + 1]; } }
#pragma unroll
        for (int q = 0; q < 4; ++q) { float a = 0.f;
#pragma unroll
            for (int j = 0; j < 8; ++j) a += (v[q][j].x * v[q][j].x + v[q][j].y * v[q][j].y) + (v[q][j].z * v[q][j].z + v[q][j].w * v[q][j].w);
            ss[q] = rsqrtf(wave_sum(a) * (1.f / DM) + EPS); }
#pragma unroll
        for (int jj = 0; jj < 4; ++jj) { const int col = lane * 8 + 512 * jj;
            const f32x4 g0 = *(const f32x4*)(g + col), g1 = *(const f32x4*)(g + col + 4);
            const f32x4 a0 = *(const f32x4*)(sc + col) + 1.f, a1 = *(const f32x4*)(sc + col + 4) + 1.f, b0 = *(const f32x4*)(sh + col), b1 = *(const f32x4*)(sh + col + 4);
#pragma unroll
            for (int q = 0; q < 4; ++q) { const int row = row0 + q * NGW;
                if (row < SEQ) { f32x4 y0 = v[q][2 * jj] * ss[q] * g0, y1 = v[q][2 * jj + 1] * ss[q] * g1; y0 = y0 * a0 + b0; y1 = y1 * a1 + b1;
                    u32x4 w; w.x = cvt_pk_bf16(y0.x, y0.y); w.y = cvt_pk_bf16(y0.z, y0.w); w.z = cvt_pk_bf16(y1.x, y1.y); w.w = cvt_pk_bf16(y1.z, y1.w);
                    *(u32x4*)(dst + (size_t)row * DM + col) = w; } } }
    }
}
__device__ __forceinline__ void phase1a(const Params& P, char* lds, int G) {
    const int tid = tid_opaque();
    const float* mod = (const float*)(P.ws + WS_MOD);
    float* sh = (float*)lds; float* sc = sh + DM;
    for (int n = tid; n < 2 * DM; n += NTHREADS) sh[n] = mod[n];
    __syncthreads();
    norm_mod_rows(P.x, P.norm_mix_g, sh, sc, (bf16_t*)(P.ws + WS_H), G);
    __syncthreads();
}
__device__ __forceinline__ void ff_tile_src(const Params& P, int it, const float*& W, int& N, int& kb, int& nb) {
    constexpr int I_1 = 32 * 128;
    if (it < I_1) { W = P.w_ff1; N = DFF; kb = it / 128; nb = it % 128; } else { const int r = it - I_1; W = P.w_ff2; N = DM; kb = r / 32; nb = r % 32; }
}
__device__ __forceinline__ void ff_transposes(const Params& P, char* lds, int pidx, int np, int it0, int it1) {
    const int tid = tid_opaque(), lane = tid & 63, wave = tid >> 6;
    float* scr = (float*)(lds + wave * 17408);
    constexpr int I_1 = 32 * 128;
    const int stride = np * NWAVES;
    int it = it0 + pidx * NWAVES + wave;
    if (it >= it1) return;
    TrTile cur, nxt; const float* W; int N, kb, nb;
    ff_tile_src(P, it, W, N, kb, nb); tr_load(cur, W, N, kb, nb, lane);
    for (; it < it1; it += stride) {
        const int itn = it + stride; const float* Wn = W; int Nn = N, kbn = kb, nbn = nb;
        if (itn < it1) { ff_tile_src(P, itn, Wn, Nn, kbn, nbn); tr_load(nxt, Wn, Nn, kbn, nbn, lane); }
        if (it < I_1) tr_finish(cur, DM, DFF, (bf16_t*)(P.ws + WS_W1), scr, kb, nb, lane, RowId());
        else tr_finish(cur, DFF, DM, (bf16_t*)(P.ws + WS_W2), scr, kb, nb, lane, RowId());
        cur = nxt; W = Wn; N = Nn; kb = kbn; nb = nbn;
    }
}
constexpr int FFT_SPLIT = 4096, FFT_ALL = 8192;

__device__ __forceinline__ void phase6b(const Params& P, char* lds, int G) {
    const int tid = tid_opaque(), lane = tid & 63, wave = tid >> 6;
    const int gw = blockIdx.x * NWAVES + wave, NGW = G * NWAVES;
    const float* mod = (const float*)(P.ws + WS_MOD);
    float* sh = (float*)lds; float* sc = sh + DM;
    for (int n = tid; n < 2 * DM; n += NTHREADS) sh[n] = mod[3 * DM + n];
    __syncthreads();
    norm_mod_rows(P.out, P.norm_mlp_g, sh, sc, (bf16_t*)(P.ws + WS_H), G);
    __syncthreads();
    ff_transposes(P, lds, blockIdx.x, G, FFT_SPLIT, FFT_ALL);
}
__device__ __forceinline__ void phase2(const Params& P, char* lds, int G) {
    const int tid = tid_opaque(), lane = tid & 63, wave = tid >> 6;
    const int gw = blockIdx.x * NWAVES + wave, NGW = G * NWAVES;
    const bf16_t* pa = (const bf16_t*)(P.ws + WS_PA); const bf16_t* pb = (const bf16_t*)(P.ws + WS_PB);
    { bf16_t* cqn = (bf16_t*)(P.ws + WS_CQN); bf16_t* ckvn = (bf16_t*)(P.ws + WS_CKVN);
      float gq[8], gk[8];
#pragma unroll
      for (int e = 0; e < 8; ++e) { gq[e] = P.q_lora_g[lane * 8 + e]; gk[e] = P.kv_lora_g[(lane & 31) * 8 + e]; }
      for (int row0 = gw; row0 < SEQ; row0 += 4 * NGW) {
        u32x4 wq[4], wk[4];
#pragma unroll
        for (int q = 0; q < 4; ++q) { const int row = (row0 + q * NGW) < SEQ ? row0 + q * NGW : row0;
            wq[q] = *(const u32x4*)(pa + (size_t)row * PAW + OFF_CQ + lane * 8); wk[q] = *(const u32x4*)(pa + (size_t)row * PAW + OFF_CKV + (lane & 31) * 8); }
#pragma unroll
        for (int q = 0; q < 4; ++q) { const int row = row0 + q * NGW; if (row >= SEQ) break;
            float fq[8], fk[8]; unpack8(wq[q], fq); unpack8(wk[q], fk);
            float sq = 0.f, sk = 0.f;
#pragma unroll
            for (int e = 0; e < 8; ++e) { sq += fq[e] * fq[e]; sk += fk[e] * fk[e]; }
            if (lane >= 32) sk = 0.f;
            const float rq = rsqrtf(wave_sum(sq) * (1.f / QLORA) + EPS), rk = rsqrtf(wave_sum(sk) * (1.f / KVLORA) + EPS);
#pragma unroll
            for (int e = 0; e < 8; ++e) { fq[e] = fq[e] * rq * gq[e]; fk[e] = fk[e] * rk * gk[e]; }
            *(u32x4*)(cqn + (size_t)row * QLORA + lane * 8) = pack8(fq);
            if (lane < 32) *(u32x4*)(ckvn + (size_t)row * KVLORA + lane * 8) = pack8(fk); }
      } }
    { bf16_t* QH = (bf16_t*)(P.ws + WS_QH); bf16_t* KH = (bf16_t*)(P.ws + WS_KH); bf16_t* KT = (bf16_t*)(P.ws + WS_KT); bf16_t* VT = (bf16_t*)(P.ws + WS_VT);
      const int tg = tid >> 5, cgp = tid & 31, chl = cgp * 8;
      for (int item = blockIdx.x; item < 3 * HM * NCH; item += G) {
        const int kind = item / (HM * NCH), h = (item / NCH) % HM, c = item % NCH;
        const int t0 = LCH * c + 8 * tg;
        float outv[8][8];
        if (kind < 2) {
            const int col = kind * 1024 + h * DH + chl;
            float cw[5][8], cb[8];
#pragma unroll
            for (int e = 0; e < 8; ++e) cb[e] = P.conv_b[kind * 1024 + h * DH + chl + e];
#pragma unroll
            for (int j = 0; j < 5; ++j)
#pragma unroll
                for (int e = 0; e < 8; ++e) cw[j][e] = P.conv_w[j * 2048 + kind * 1024 + h * DH + chl + e];
#pragma unroll
            for (int tt = 0; tt < 8; ++tt)
#pragma unroll
                for (int e = 0; e < 8; ++e) outv[tt][e] = cb[e];
#pragma unroll
            for (int rr = 0; rr < 12; ++rr) {
                const int t = t0 - 2 + rr; float in[8];
                if (t >= 0 && t < SEQ) { const u32x4 w = *(const u32x4*)(pb + (size_t)t * PBW + col); unpack8(w, in); }
                else {
#pragma unroll
                    for (int e = 0; e < 8; ++e) in[e] = 0.f; }
#pragma unroll
                for (int j = 0; j < 5; ++j) { const int tt = rr - j;
                    if (tt >= 0 && tt < 8) {
#pragma unroll
                        for (int e = 0; e < 8; ++e) outv[tt][e] += cw[j][e] * in[e]; } }
            }
            const float osc = kind == 1 ? 0.0625f : 1.f;
#pragma unroll
            for (int tt = 0; tt < 8; ++tt)
#pragma unroll
                for (int e = 0; e < 8; ++e) outv[tt][e] = silu_f(outv[tt][e]) * osc;
            bf16_t* dst = (kind == 0 ? QH : KH) + ((size_t)h * SEQ + t0) * DH + chl;
#pragma unroll
            for (int tt = 0; tt < 8; ++tt) *(u32x4*)(dst + (size_t)tt * DH) = pack8(outv[tt]);
        } else {
#pragma unroll
            for (int tt = 0; tt < 8; ++tt) { const u32x4 w = *(const u32x4*)(pb + (size_t)(t0 + tt) * PBW + 2048 + h * DH + chl); unpack8(w, outv[tt]); }
        }
        if (kind >= 1) {
            bf16_t* dst = (kind == 1 ? KT : VT) + ((size_t)(h * NCH + c) * DH + chl) * LCH + 8 * tg;
#pragma unroll
            for (int e = 0; e < 8; ++e) { u32x4 w; w.x = cvt_pk_bf16(outv[0][e], outv[1][e]); w.y = cvt_pk_bf16(outv[2][e], outv[3][e]); w.z = cvt_pk_bf16(outv[4][e], outv[5][e]); w.w = cvt_pk_bf16(outv[6][e], outv[7][e]);
                *(u32x4*)(dst + (size_t)e * LCH) = w; }
        }
      } }
    { const float* gates = (const float*)(P.ws + WS_GATES);
      float* BC = (float*)(P.ws + WS_BC); float* IG = (float*)(P.ws + WS_IG); float* PM = (float*)(P.ws + WS_PM); float* WL = (float*)(P.ws + WS_WL);
      float* BL = (float*)(P.ws + WS_BL); float* AC = (float*)(P.ws + WS_AC);
      for (int task = gw; task < 2 * HM * NCH; task += NGW) {
        const int dir = task / (HM * NCH), h = (task / NCH) % HM, c = task % NCH;
        const float bi = P.b_gates[dir * 8 + h], bfg = P.b_gates[dir * 8 + 4 + h];
        const int u0 = 2 * lane, u1 = 2 * lane + 1;
        const int t0 = LCH * c + (dir ? 127 - u0 : u0), t1 = LCH * c + (dir ? 127 - u1 : u1);
        const float i0 = gates[(size_t)t0 * 16 + dir * 8 + h] + bi, i1 = gates[(size_t)t1 * 16 + dir * 8 + h] + bi;
        const float f0 = gates[(size_t)t0 * 16 + dir * 8 + 4 + h] + bfg, f1 = gates[(size_t)t1 * 16 + dir * 8 + 4 + h] + bfg;
        const float l0 = fminf(f0, 0.f) - log1pf(expf(-fabsf(f0))), l1 = fminf(f1, 0.f) - log1pf(expf(-fabsf(f1)));
        float inc = l0 + l1;
#pragma unroll
        for (int o = 1; o < 64; o <<= 1) { const float t = shup(inc, o); if (lane >= o) inc += t; }
        const float b1 = inc, b0 = inc - l1;
        const float d0 = i0 - b0, d1 = i1 - b1;
        float pmx = fmaxf(d0, d1);
#pragma unroll
        for (int o = 1; o < 64; o <<= 1) { const float t = shup(pmx, o); if (lane >= o) pmx = fmaxf(pmx, t); }
        float prev = shup(pmx, 1); if (lane == 0) prev = -INFINITY;
        const float pm0 = fmaxf(prev, d0), pm1 = pmx;
        const float bL = shidx(b1, 63), pmL = shidx(pmx, 63);
        const size_t base = (size_t)(dir * HM + h) * SEQ;
        BC[base + t0] = b0; BC[base + t1] = b1; IG[base + t0] = i0; IG[base + t1] = i1;
        PM[base + t0] = b0 + pm0; PM[base + t1] = b1 + pm1;
        WL[base + t0] = bL - b0 + i0; WL[base + t1] = bL - b1 + i1;
        if (lane == 63) { BL[(dir * HM + h) * NCH + c] = bL; AC[(dir * HM + h) * NCH + c] = bL + pmL; }
      } }
}

constexpr int M2_W = 1024, M2_WB = M2_W + SEQ * 4, M2_T0 = M2_WB + SEQ * 2, M2_TB = 96 * 256;
static_assert(M2_T0 + 2 * M2_TB <= LDS_BYTES, "M2 LDS");
__device__ __forceinline__ void m2_block(const Params& P, char* lds, int blk) {
    const int tid = tid_opaque(), lane = tid & 63, wid = tid >> 6, r = lane & 15, g = lane >> 4;
    const int dir = blk >> 7, h = (blk >> 5) & 3, vs = (blk >> 2) & 7, ksl = blk & 3;
    const int vi = wid >> 2, ki = wid & 3, v0 = 32 * vs + 16 * vi, k0 = 64 * ksl + 16 * ki;
    const int dh = dir * HM + h;
    const float* BL = (const float*)(P.ws + WS_BL) + dh * NCH; const float* AC = (const float*)(P.ws + WS_AC) + dh * NCH;
    const float* WL = (const float*)(P.ws + WS_WL) + (size_t)dh * SEQ;
    bf16_t* CST = (bf16_t*)(P.ws + cst_off(dh)); float* NST = (float*)(P.ws + WS_NST);
    float* s_mA = (float*)lds; float* s_dec = s_mA + NCH; float* s_w = (float*)(lds + M2_W); bf16_t* s_wb = (bf16_t*)(lds + M2_WB);
    float* s_bl = (float*)(lds + 512); float* s_ac = s_bl + NCH;
    if (tid < NCH) { s_bl[tid] = BL[tid]; s_ac[tid] = AC[tid]; }
    __syncthreads();
    if (tid == 0) { float m = -1e30f; float* MB = (float*)(P.ws + WS_MB) + dh * NCH; const bool pub = (vs == 0 && ksl == 0);
#pragma unroll 1
        for (int st = 0; st < NCH; ++st) { const int c = dir ? NCH - 1 - st : st; const float bL = s_bl[c], a = s_ac[c]; const float mn = fmaxf(bL + m, a);
            if (pub) MB[c] = m;
            s_dec[c] = __expf(bL + m - mn); s_mA[c] = mn; m = mn; } }
    __syncthreads();
    { float wl_[16];
#pragma unroll
      for (int i = 0; i < 16; ++i) wl_[i] = WL[tid + NTHREADS * i];
#pragma unroll
      for (int i = 0; i < 16; ++i) { const float w_ = __expf(wl_[i] - s_mA[(tid + NTHREADS * i) >> 7]); s_w[tid + NTHREADS * i] = w_; s_wb[tid + NTHREADS * i] = f2bf(w_); } }
    const int srow = tid >> 4, sslot = tid & 15;
    const char* gV = (const char*)(P.ws + WS_VT) + ((size_t)h * NCH * DH + 32 * vs + srow) * (LCH * 2) + sslot * 16;
    const char* gK = (const char*)(P.ws + WS_KT) + ((size_t)h * NCH * DH + 64 * ksl + srow) * (LCH * 2) + sslot * 16;
    const int lw = srow * 256 + ((sslot ^ (srow & 15)) << 4);
    const int la = (16 * vi + r) * 256, lb = (32 + 16 * ki + r) * 256;
    char* tb = lds + M2_T0;
    u32x4 ring[8][3];
#define M2_LOAD(slot, stp) do { const int c_ = dir ? NCH - 1 - (stp) : (stp); const size_t co_ = (size_t)c_ * (DH * LCH * 2); \
        ring[slot][0] = *(const u32x4*)(gV + co_); ring[slot][1] = *(const u32x4*)(gK + co_); ring[slot][2] = *(const u32x4*)(gK + co_ + 32 * LCH * 2); } while (0)
#define M2_WRITE(slot, buf, stp) do { char* d_ = tb + (buf) * M2_TB + lw; const int cw_ = dir ? NCH - 1 - (stp) : (stp); \
        const f32x4 wv0_ = *(const f32x4*)(s_w + LCH * cw_ + 8 * sslot), wv1_ = *(const f32x4*)(s_w + LCH * cw_ + 8 * sslot + 4); float a_[8]; unpack8(ring[slot][0], a_); \
        _Pragma("unroll") for (int j_ = 0; j_ < 4; ++j_) { a_[j_] *= wv0_[j_]; a_[4 + j_] *= wv1_[j_]; } \
        *(u32x4*)d_ = pack8(a_); *(u32x4*)(d_ + 8192) = ring[slot][1]; *(u32x4*)(d_ + 16384) = ring[slot][2]; } while (0)
#pragma unroll
    for (int d = 0; d < 8; ++d) M2_LOAD(d, d);
    __syncthreads();
    M2_WRITE(0, 0, 0);
    const bool do_n = (vs == 0 && vi == 0);
    f32x4 acc = {0.f, 0.f, 0.f, 0.f}, nacc = {0.f, 0.f, 0.f, 0.f};
#pragma unroll 1
    for (int st8 = 0; st8 < NCH; st8 += 8) {
#pragma unroll
        for (int u = 0; u < 8; ++u) {
            const int st = st8 + u;
            const int c = dir ? NCH - 1 - st : st;
            asm volatile("s_waitcnt lgkmcnt(0)" ::: "memory"); __builtin_amdgcn_s_barrier(); asm volatile("" ::: "memory");
            if (st + 1 < NCH) M2_WRITE((u + 1) & 7, (u + 1) & 1, st + 1);
            if (st + 8 < NCH) M2_LOAD(u, st + 8);
            { bf16_t* cp = CST + (size_t)c * (DH * DH) + (size_t)(v0 + r) * DH + k0 + 4 * g;
              u32x2 w2; w2.x = cvt_pk_bf16(acc[0], acc[1]); w2.y = cvt_pk_bf16(acc[2], acc[3]); *(u32x2*)cp = w2;
              if (do_n && r == 0) *(f32x4*)(NST + ((size_t)dh * NCH + c) * DH + k0 + 4 * g) = nacc; }
            const float dec = s_dec[c];
            acc = acc * dec; if (do_n) nacc = nacc * dec;
            const char* tbuf = tb + (u & 1) * M2_TB;
#pragma unroll
            for (int ks = 0; ks < 4; ++ks) {
                const int sl = ((4 * ks + g) ^ r) << 4;
                const bf16x8 av = *(const bf16x8*)(tbuf + la + sl), bv = *(const bf16x8*)(tbuf + lb + sl);
                acc = __builtin_amdgcn_mfma_f32_16x16x32_bf16(bv, av, acc, 0, 0, 0);
                if (do_n) { const bf16x8 wv = *(const bf16x8*)(s_wb + LCH * c + 32 * ks + 8 * g);
                    nacc = __builtin_amdgcn_mfma_f32_16x16x32_bf16(bv, wv, nacc, 0, 0, 0); }
            }
        }
    }
#undef M2_LOAD
#undef M2_WRITE
    __syncthreads();
}

constexpr int M3_SC = 1024, M3_LV = 6144, M3_LVS = 272, M3_LC = M3_LV + 256 * M3_LVS, M3_LCS = 528;
static_assert(M3_LC + 128 * M3_LCS <= 147456 - 64 - 256, "M3 LDS");
__device__ __forceinline__ void m3_unit(const Params& P, char* lds, int h, int c) {
    const int tid = tid_opaque(), lane = tid & 63, wid = __builtin_amdgcn_readfirstlane(tid >> 6), r = lane & 15, g = lane >> 4;
    const int T0 = LCH * c, tl = 16 * wid + r;
    const char* QHc = (const char*)(P.ws + WS_QH) + ((size_t)h * SEQ + T0 + 16 * wid) * (DH * 2);
    const char* KHc = (const char*)(P.ws + WS_KH) + ((size_t)h * SEQ + T0) * (DH * 2);
    const char* VTc = (const char*)(P.ws + WS_VT) + ((size_t)h * NCH + c) * (DH * LCH * 2);
    const unsigned o512 = (unsigned)(r * 512 + g * 16);
    float* s_bc = (float*)(lds + M3_SC); float* s_ig = s_bc + 256; float* s_pm = s_ig + 256; float* s_n = s_pm + 256;
    float* s_mb = (float*)lds;
    char* LV = lds + M3_LV; char* LC = lds + M3_LC;
    const char* lvr = LV + r * M3_LVS + g * 8;
    const char* lcr = LC + r * M3_LCS + g * 16;
    char* lcw = LC + (tid >> 5) * M3_LCS + (tid & 31) * 16;
    u32x4 cr[8];
#define M3_CLOAD(src) do { _Pragma("unroll") for (int n = 0; n < 8; ++n) cr[n] = ldgu<u32x4>((src) + n * 8192, (unsigned)tid * 16u); } while (0)
#define M3_CWRITE() do { _Pragma("unroll") for (int n = 0; n < 8; ++n) *(u32x4*)(lcw + n * (16 * M3_LCS)) = cr[n]; } while (0)
    M3_CLOAD(KHc);
    bf16x8 qf[8];
#pragma unroll
    for (int kd = 0; kd < 8; ++kd) qf[kd] = ldgu<bf16x8>(QHc + 64 * kd, o512);
    { u32x4 v[8];
#pragma unroll
      for (int n = 0; n < 8; ++n) v[n] = ldgu<u32x4>(VTc + n * 8192, (unsigned)tid * 16u);
      { const int dir = tid >> 8, tt = tid & 127; const size_t gi = (size_t)(dir * HM + h) * SEQ + T0 + tt;
        if ((tid & 255) < 128) { s_bc[dir * 128 + tt] = ((const float*)(P.ws + WS_BC))[gi]; s_ig[dir * 128 + tt] = ((const float*)(P.ws + WS_IG))[gi]; s_pm[dir * 128 + tt] = ((const float*)(P.ws + WS_PM))[gi]; }
        s_n[tid] = ((const float*)(P.ws + WS_NST))[((size_t)((tid >> 8) * HM + h) * NCH + c) * DH + (tid & 255)];
        if (tid < 2) s_mb[tid] = ((const float*)(P.ws + WS_MB))[(tid * HM + h) * NCH + c]; }
#pragma unroll
      for (int n = 0; n < 8; ++n) *(u32x4*)(LV + ((tid >> 4) + 32 * n) * M3_LVS + (tid & 15) * 16) = v[n]; }
    M3_CWRITE();
    __syncthreads();
    f32x4 st[8]; float qn0 = 0.f, qn1 = 0.f;
#pragma unroll
    for (int j = 0; j < 8; ++j) { st[j] = (f32x4){0.f, 0.f, 0.f, 0.f};
#pragma unroll
        for (int kd = 0; kd < 8; ++kd) { const bf16x8 kf = *(const bf16x8*)(lcr + j * (16 * M3_LCS) + kd * 64);
            st[j] = __builtin_amdgcn_mfma_f32_16x16x32_bf16(kf, qf[kd], st[j], 0, 0, 0); } }
#pragma unroll
    for (int kd = 0; kd < 8; ++kd) { float q[8]; unpack8(*(const u32x4*)&qf[kd], q);
        const f32x4 a0 = *(const f32x4*)(s_n + 32 * kd + 8 * g), a1 = *(const f32x4*)(s_n + 32 * kd + 8 * g + 4), b0 = *(const f32x4*)(s_n + 256 + 32 * kd + 8 * g), b1 = *(const f32x4*)(s_n + 256 + 32 * kd + 8 * g + 4);
        qn0 += q[0] * a0[0] + q[1] * a0[1] + q[2] * a0[2] + q[3] * a0[3] + q[4] * a1[0] + q[5] * a1[1] + q[6] * a1[2] + q[7] * a1[3];
        qn1 += q[0] * b0[0] + q[1] * b0[1] + q[2] * b0[2] + q[3] * b0[3] + q[4] * b1[0] + q[5] * b1[1] + q[6] * b1[2] + q[7] * b1[3]; }
    qn0 += shx(qn0, 16); qn0 += shx(qn0, 32); qn1 += shx(qn1, 16); qn1 += shx(qn1, 32);
    f32x4 acc[16];
#pragma unroll
    for (int vt = 0; vt < 16; ++vt) acc[vt] = (f32x4){0.f, 0.f, 0.f, 0.f};
#pragma unroll 1
    for (int dir = 0; dir < 2; ++dir) {
        const int dh = dir * HM + h;
        const char* Cc = (const char*)(P.ws + cst_off(dh)) + (size_t)c * (DH * DH * 2);
        M3_CLOAD(Cc);
        const float* bcd = s_bc + dir * 128; const float* igd = s_ig + dir * 128;
        const int fx = dir * 127, tlx = tl ^ fx;
        const float mB = s_mb[dir];
        const float bt = bcd[tl], pm = s_pm[dir * 128 + tl];
        const float mt = fmaxf(bt + mB, pm); const float alpha = bt - mt; const float winter = __expf(bt + mB - mt);
        float den = 0.f;
#pragma unroll
        for (int j = 0; j < 8; ++j) { const int sb = 16 * j + 4 * g;
            const f32x4 ig = *(const f32x4*)(igd + sb), bc = *(const f32x4*)(bcd + sb);
#pragma unroll
            for (int i = 0; i < 4; ++i) { const int sl = sb + i; const bool ok = ((sl ^ fx) <= tlx);
                const float e = ok ? __expf(alpha + ig[i] - bc[i]) : 0.f; den += st[j][i] * e; } }
        den += shx(den, 16); den += shx(den, 32);
        const float dtot = den + winter * (dir ? qn1 : qn0);
        const float hdiv = 1.f / fmaxf(fabsf(dtot), __expf(-mt));
        int tlx2 = tlx; LAUNDER_V(tlx2);
#pragma unroll
        for (int ks = 0; ks < 4; ++ks) {
            float e8[8];
#pragma unroll
            for (int hh = 0; hh < 2; ++hh) { const int j = 2 * ks + hh, sb = 16 * j + 4 * g;
                const f32x4 ig = *(const f32x4*)(igd + sb), bc = *(const f32x4*)(bcd + sb);
#pragma unroll
                for (int i = 0; i < 4; ++i) { const int sl = sb + i; const bool ok = ((sl ^ fx) <= tlx2);
                    const float e = ok ? __expf(alpha + ig[i] - bc[i]) : 0.f; e8[4 * hh + i] = st[j][i] * e * hdiv; } }
            const u32x4 pw = pack8(e8); const bf16x8 pa = *(const bf16x8*)&pw;
#pragma unroll
            for (int vt = 0; vt < 16; ++vt) {
                const u32x2 lo = *(const u32x2*)(lvr + vt * (16 * M3_LVS) + ks * 64), hi2 = *(const u32x2*)(lvr + vt * (16 * M3_LVS) + ks * 64 + 32);
                u32x4 w; w.x = lo.x; w.y = lo.y; w.z = hi2.x; w.w = hi2.y;
                acc[vt] = __builtin_amdgcn_mfma_f32_16x16x32_bf16(pa, *(const bf16x8*)&w, acc[vt], 0, 0, 0); }
        }
        const float qsc = winter * hdiv;
#pragma unroll
        for (int half = 0; half < 2; ++half) {
            __syncthreads();
            M3_CWRITE();
            __syncthreads();
            if (half == 0) M3_CLOAD(Cc + 65536);
            else if (dir == 1) { const char* om = (const char*)(P.ws + WS_PA) + ((size_t)T0 * PAW + PA_OM + h * DH) * 2;
#pragma unroll
                for (int n = 0; n < 8; ++n) cr[n] = ldgu<u32x4>(om + n * (16 * PAW * 2), (unsigned)((tid >> 5) * (PAW * 2) + (tid & 31) * 16)); }
#pragma unroll
            for (int kd = 0; kd < 8; ++kd) { const u32x4 qt = ldgu<u32x4>(QHc + 64 * kd, o512); float q[8]; unpack8(qt, q);
#pragma unroll
                for (int e = 0; e < 8; ++e) q[e] *= qsc;
                const u32x4 qw = pack8(q); const bf16x8 qs = *(const bf16x8*)&qw;
#pragma unroll
                for (int v8 = 0; v8 < 8; ++v8) { const bf16x8 cf = *(const bf16x8*)(lcr + v8 * (16 * M3_LCS) + kd * 64);
                    acc[half * 8 + v8] = __builtin_amdgcn_mfma_f32_16x16x32_bf16(qs, cf, acc[half * 8 + v8], 0, 0, 0); }
            }
        }
    }
    __syncthreads();
    M3_CWRITE();
#undef M3_CLOAD
#undef M3_CWRITE
    float ss[4] = {0.f, 0.f, 0.f, 0.f};
#pragma unroll
    for (int vt = 0; vt < 16; ++vt)
#pragma unroll
        for (int i = 0; i < 4; ++i) ss[i] += acc[vt][i] * acc[vt][i];
#pragma unroll
    for (int i = 0; i < 4; ++i) { ss[i] += shx(ss[i], 1); ss[i] += shx(ss[i], 2); ss[i] += shx(ss[i], 4); ss[i] += shx(ss[i], 8); ss[i] = rsqrtf(ss[i] * (1.f / DH) + EPS); }
    const float* gmp = P.mlstm_norm_g + h * DH + r;
    __syncthreads();
    const char* omr = LC + (16 * wid + 4 * g) * M3_LCS + r * 2; char* outw = LV + (16 * wid + 4 * g) * M3_LCS + r * 2;
#pragma unroll
    for (int vt = 0; vt < 16; ++vt) { const float gm = gmp[16 * vt];
#pragma unroll
        for (int i = 0; i < 4; ++i) { const float om = bf2f(*(const bf16_t*)(omr + i * M3_LCS + 32 * vt));
            *(bf16_t*)(outw + i * M3_LCS + 32 * vt) = f2bf(acc[vt][i] * ss[i] * gm * sigmoid_f(om)); } }
    __syncthreads();
    { char* mx = (char*)(P.ws + WS_MIX) + ((size_t)T0 * DM + 1024 + h * DH) * 2;
#pragma unroll
      for (int n = 0; n < 8; ++n) { const u32x4 v = *(const u32x4*)(LV + ((tid >> 5) + 16 * n) * M3_LCS + (tid & 31) * 16);
          *(u32x4*)(mx + (size_t)((tid >> 5) + 16 * n) * (DM * 2) + (tid & 31) * 16) = v; } }
    __syncthreads();
}

__device__ __forceinline__ void phase4(const Params& P, int G) {
    const int tid = tid_opaque(), lane = tid & 63, wave = tid >> 6;
    const int gw = blockIdx.x * NWAVES + wave, NGW = G * NWAVES;
    bf16_t* Q = (bf16_t*)(P.ws + WS_Q); bf16_t* K = (bf16_t*)(P.ws + WS_K); const bf16_t* KV = (const bf16_t*)(P.ws + WS_KV); const bf16_t* proj = (const bf16_t*)(P.ws + WS_PA);
    const f32x4* rt = (const f32x4*)(P.ws + WS_ROPE);
    unsigned char* Q8 = P.ws + WS_Q8; unsigned char* K8 = (F8_MODE == 2) ? (unsigned char*)P.out : P.ws + WS_K8;
    const int i = lane & 7, hh = lane >> 3; const bool lo = i < 4;
    float gq[3][8], gk[3][8];
#pragma unroll
    for (int j = 0; j < 3; ++j)
#pragma unroll
        for (int e = 0; e < 8; ++e) { gq[j][e] = P.q_norm_g[8 * (i + 8 * j) + e]; gk[j][e] = P.k_norm_g[8 * (i + 8 * j) + e]; }
    for (int t0 = gw; t0 < SEQ; t0 += 2 * NGW) {
        u32x4 win[2][2][3]; f32x4 rv[2][4];
#pragma unroll
        for (int tt = 0; tt < 2; ++tt) { const int t = (t0 + tt * NGW) < SEQ ? t0 + tt * NGW : t0;
            const bf16_t* qp = Q + (size_t)t * (NH * DQK) + hh * DQK + 8 * i; const bf16_t* kp = KV + (size_t)t * (NH * 256) + hh * 256 + 8 * i;
            win[tt][0][0] = *(const u32x4*)qp; win[tt][0][1] = *(const u32x4*)(qp + 64); win[tt][0][2] = *(const u32x4*)(qp + 128);
            win[tt][1][0] = *(const u32x4*)kp; win[tt][1][1] = *(const u32x4*)(kp + 64); win[tt][1][2] = *(const u32x4*)(proj + (size_t)t * PAW + OFF_KPE + 8 * i);
#pragma unroll
            for (int e2 = 0; e2 < 4; ++e2) rv[tt][e2] = rt[(size_t)t * 16 + 4 * (i & 3) + e2]; }
#pragma unroll
        for (int tt = 0; tt < 2; ++tt) { const int t = t0 + tt * NGW; if (t >= SEQ) break;
            float cs[8], sn[8];
#pragma unroll
            for (int e2 = 0; e2 < 4; ++e2) { cs[2 * e2] = rv[tt][e2][0]; sn[2 * e2] = rv[tt][e2][1]; cs[2 * e2 + 1] = rv[tt][e2][2]; sn[2 * e2 + 1] = rv[tt][e2][3]; }
#pragma unroll
            for (int which = 0; which < 2; ++which) {
                bf16_t* dst = (which == 0 ? Q : K) + (size_t)t * (NH * DQK) + hh * DQK + 8 * i;
                float a0[8], a1[8], a2[8]; unpack8(win[tt][which][0], a0); unpack8(win[tt][which][1], a1); unpack8(win[tt][which][2], a2);
                float ss = 0.f;
#pragma unroll
                for (int e = 0; e < 8; ++e) ss += a0[e] * a0[e] + a1[e] * a1[e] + a2[e] * a2[e];
                ss += shx(ss, 1); ss += shx(ss, 2); ss += shx(ss, 4);
                const float rs = rsqrtf(ss * (1.f / DQK) + EPS);
#pragma unroll
                for (int e = 0; e < 8; ++e) { const float g0 = which ? gk[0][e] : gq[0][e], g1 = which ? gk[1][e] : gq[1][e], g2 = which ? gk[2][e] : gq[2][e];
                    a0[e] *= rs * g0; a1[e] *= rs * g1; a2[e] *= rs * g2; }
                float o2[8];
#pragma unroll
                for (int e = 0; e < 8; ++e) { const float pr = shx(a2[e], 4);
                    o2[e] = lo ? (a2[e] * cs[e] - pr * sn[e]) : (pr * sn[e] + a2[e] * cs[e]); }
                if (F8_MODE == 0 || F8_MODE == 2) { *(u32x4*)dst = pack8(a0); *(u32x4*)(dst + 64) = pack8(a1); *(u32x4*)(dst + 128) = pack8(o2); }
                if (F8_MODE != 0) { unsigned char* d8 = (which == 0 ? Q8 : K8) + (size_t)t * (NH * DQK) + hh * DQK + 8 * i;
                    *(u32x2*)d8 = pack8_fp8(a0); *(u32x2*)(d8 + 64) = pack8_fp8(a1); *(u32x2*)(d8 + 128) = pack8_fp8(o2); }
            }
        }
    }
}

__device__ __forceinline__ void v8t_items(const Params& P, int G) {
    const int tid = tid_opaque(), lane = tid & 63, wave = tid >> 6;
    const int gw = blockIdx.x * NWAVES + wave, NGW = G * NWAVES;
    const bf16_t* KV = (const bf16_t*)(P.ws + WS_KV); unsigned char* V8T = P.ws + WS_V8T;
    for (int it2 = gw; it2 < 2 * NH * (SEQ / 64); it2 += NGW) {
        const int item = it2 >> 1, cc = it2 & 1; const int h = item >> 7, jt = item & 127;
        const bf16_t* src = KV + (size_t)(64 * jt) * (NH * 256) + h * 256 + 128 + lane + 64 * cc;
        int w[16];
#pragma unroll
        for (int q = 0; q < 16; ++q) {
            const int hi_ = q >> 3, j = (4 * q) & 31, jj = j & 15, key = (j >> 4) * 32 + (jj & 3) + 8 * (jj >> 2) + 4 * hi_;
            const float f0 = bf2f(src[(size_t)key * (NH * 256)]), f1 = bf2f(src[(size_t)(key + 1) * (NH * 256)]);
            const float f2 = bf2f(src[(size_t)(key + 2) * (NH * 256)]), f3 = bf2f(src[(size_t)(key + 3) * (NH * 256)]);
            int a = 0; a = __builtin_amdgcn_cvt_pk_fp8_f32(f0, f1, a, false); a = __builtin_amdgcn_cvt_pk_fp8_f32(f2, f3, a, true); w[q] = a; }
        unsigned char* dst = V8T + ((size_t)item * 128 + 64 * cc + lane) * 64;
#pragma unroll
        for (int q = 0; q < 4; ++q) { u32x4 o; o.x = (unsigned)w[4 * q]; o.y = (unsigned)w[4 * q + 1]; o.z = (unsigned)w[4 * q + 2]; o.w = (unsigned)w[4 * q + 3]; *(u32x4*)(dst + 16 * q) = o; }
    }
}

struct StoreProj { bf16_t* pa; bf16_t* pb; float* gates;
    __device__ __forceinline__ void operator()(int row, int col, f32x4 v0, f32x4 v1) const {
        u32x4 w; w.x = cvt_pk_bf16(v0[0], v0[1]); w.y = cvt_pk_bf16(v0[2], v0[3]); w.z = cvt_pk_bf16(v1[0], v1[1]); w.w = cvt_pk_bf16(v1[2], v1[3]);
        bf16_t* dst = (col >= OFF_QM && col < OFF_OM) ? pb + (size_t)row * PBW + (col - OFF_QM) : pa + (size_t)row * PAW + (col < OFF_QM ? col : col - OFF_OM + PA_OM);
        *(u32x4*)dst = w;
        if (col >= OFF_GM && col < OFF_GM + 16) { float* gp = gates + (size_t)row * 16 + (col - OFF_GM); *(f32x4*)gp = v0; *(f32x4*)(gp + 4) = v1; } } };
struct StoreQ { bf16_t* q;
    __device__ __forceinline__ void operator()(int row, int col, f32x4 v0, f32x4 v1) const {
        const int h = col >> 8, ct = col & 255;
        if (ct < DQK) { u32x4 w; w.x = cvt_pk_bf16(v0[0], v0[1]); w.y = cvt_pk_bf16(v0[2], v0[3]); w.z = cvt_pk_bf16(v1[0], v1[1]); w.w = cvt_pk_bf16(v1[2], v1[3]);
            *(u32x4*)(q + (size_t)row * (NH * DQK) + h * DQK + ct) = w; } } };
struct StoreKV { bf16_t* kv;
    __device__ __forceinline__ void operator()(int row, int col, f32x4 v0, f32x4 v1) const {
        u32x4 w; w.x = cvt_pk_bf16(v0[0], v0[1]); w.y = cvt_pk_bf16(v0[2], v0[3]); w.z = cvt_pk_bf16(v1[0], v1[1]); w.w = cvt_pk_bf16(v1[2], v1[3]);
        *(u32x4*)(kv + (size_t)row * (NH * 256) + col) = w; } };
struct StoreX1 { const float* x; const float* gate; float* out;
    __device__ __forceinline__ void operator()(int row, int col, f32x4 v) const {
        const size_t off = (size_t)row * DM + col; const f32x4 xv = *(const f32x4*)(x + off); const f32x4 gv = *(const f32x4*)(gate + col);
        *(f32x4*)(out + off) = xv + gv * v; } };
struct StoreAct { bf16_t* act;
    __device__ __forceinline__ void operator()(int row, int col, f32x4 v0, f32x4 v1) const {
        float f[8] = {v0[0], v0[1], v0[2], v0[3], v1[0], v1[1], v1[2], v1[3]};
#pragma unroll
        for (int e = 0; e < 8; ++e) { const float rl = fmaxf(f[e], 0.f); f[e] = rl * rl; }
        *(u32x4*)(act + (size_t)row * DFF + col) = pack8(f); } };

#define XB_TMO      128
#define XB_XCNT(j)  (256  + 64 * (j))
#define XB_XSUB(j)  (1280 + 64 * (j))
#define XB_XGEN(j)  (2304 + 64 * (j))
#define XB_TOP      3328
#define XB_TOPGEN   3392
#define XCD_BAR_WORDS 3456
#define XB_SPIN_CAP (1u << 18)

__device__ __forceinline__ unsigned xb_ld(unsigned* p)              { return __hip_atomic_load(p, __ATOMIC_RELAXED, __HIP_MEMORY_SCOPE_AGENT); }
__device__ __forceinline__ unsigned xb_add(unsigned* p, unsigned v) { return __hip_atomic_fetch_add(p, v, __ATOMIC_RELAXED, __HIP_MEMORY_SCOPE_AGENT); }
__device__ __forceinline__ unsigned xb_xcc_id() { return (unsigned)__builtin_amdgcn_s_getreg((3 << 11) | 20) & 0xFu; }
#define XB_SPIN(cond, bar) do { unsigned _sp = 0; while (cond) { __builtin_amdgcn_s_sleep(1); \
    if ((++_sp & 255u) == 0u) { if (xb_ld(&(bar)[XB_TMO])) break; if (_sp > XB_SPIN_CAP) { atomicAdd(&(bar)[XB_TMO], 1u); break; } } } } while (0)

struct XcdBarrier {
    unsigned* bar; unsigned x;
    volatile LAS unsigned* st;
};

__device__ __forceinline__ XcdBarrier xcd_barrier_post(unsigned* bar, volatile LAS unsigned* st) {
    XcdBarrier b; b.bar = bar; b.x = xb_xcc_id(); b.st = st;
    if (threadIdx.x == 0) (void)xb_add(&bar[XB_XCNT(b.x)], 1u);
    return b;
}
__device__ __forceinline__ void xcd_barrier_complete(unsigned* bar, unsigned x, unsigned& nloc, unsigned& nx) {
    const unsigned G = gridDim.x * gridDim.y * gridDim.z;
    unsigned sum, cnt, mine, sp = 0u;
    for (;;) {
        sum = 0u; cnt = 0u; mine = 0u;
#pragma unroll
        for (unsigned j = 0; j < 16; ++j) { const unsigned c = xb_ld(&bar[XB_XCNT(j)]); sum += c; cnt += (c > 0u) ? 1u : 0u; mine = (j == x) ? c : mine; }
        if (sum == G) break;
        __builtin_amdgcn_s_sleep(1);
        if ((++sp & 255u) == 0u) { if (xb_ld(&bar[XB_TMO])) break; if (sp > XB_SPIN_CAP) { atomicAdd(&bar[XB_TMO], 1u); break; } }
    }
    nloc = mine > 0u ? mine : 1u; nx = cnt > 0u ? cnt : 1u;
}

__device__ __forceinline__ void xcd_barrier(const XcdBarrier& b) {
    asm volatile("s_waitcnt vmcnt(0)" ::: "memory");
    __syncthreads();
    if (tid_opaque() == 0) {
        unsigned* bar = b.bar;
        __builtin_amdgcn_s_waitcnt(0);
        unsigned nloc = b.st[0], nx = b.st[1];
        if (nloc == 0u) { xcd_barrier_complete(bar, b.x, nloc, nx); b.st[0] = nloc; b.st[1] = nx; }
        const unsigned old = xb_add(&bar[XB_XSUB(b.x)], 1u);
        const unsigned gen = old / nloc;
        if (old + 1u == (gen + 1u) * nloc) {
            __builtin_amdgcn_fence(__ATOMIC_RELEASE, "agent");
            asm volatile("s_waitcnt vmcnt(0)" ::: "memory");
            const unsigned og = xb_add(&bar[XB_TOP], 1u);
            const unsigned tg = og / nx;
            if (og + 1u == (tg + 1u) * nx) xb_add(&bar[XB_TOPGEN], 1u);
            else XB_SPIN(xb_ld(&bar[XB_TOPGEN]) == tg, bar);
            __builtin_amdgcn_fence(__ATOMIC_ACQUIRE, "agent");
            xb_add(&bar[XB_XGEN(b.x)], 1u);
            asm volatile("s_waitcnt vmcnt(0)" ::: "memory");
        } else {
            XB_SPIN(xb_ld(&bar[XB_XGEN(b.x)]) == gen, bar);
            __builtin_amdgcn_fence(__ATOMIC_ACQUIRE, "agent");
            asm volatile("s_waitcnt vmcnt(0)" ::: "memory");
        }
    }
    __syncthreads();
}


constexpr int NPH = 11;
#ifdef ONLY_PH
#define PH_ON(n) ((n) == ONLY_PH)
#else
#define PH_ON(n) 1
#endif
#define CAS __attribute__((address_space(4)))
__device__ __forceinline__ Params load_params(const CAS Params* kp) {
#if defined(__HIP_DEVICE_COMPILE__)
    unsigned long long kv = (unsigned long long)kp; asm volatile("" : "+s"(kv)); return *(const CAS Params*)kv;
#else
    return Params{};
#endif
}
__global__ void __launch_bounds__(NTHREADS, 2) fwd_kernel(Params Pk) {
    extern __shared__ __attribute__((aligned(16))) char lds[];
    const CAS Params* kp = (const CAS Params*)__builtin_amdgcn_kernarg_segment_ptr();
    const int G0 = gridDim.x; const int bx0 = blockIdx.x;
    const int vcu0 = (G0 % 8 == 0) ? (bx0 % 8) * (G0 / 8) + bx0 / 8 : bx0;
    LAS unsigned char* ldsl = (LAS unsigned char*)lds;
    const int ph_lo = Pk.ph_lo, ph_hi = Pk.ph_hi;
    if (threadIdx.x < 16) ((volatile LAS unsigned*)(ldsl + LDS_BARST))[threadIdx.x] = 0u;
    if ((threadIdx.x & 63) == 0) { const unsigned hw = __builtin_amdgcn_s_getreg((5 << 11) | 4) & 63u; *(volatile LAS int*)(uintptr_t)(LDS_WIDTAB + hw * 4) = (int)(threadIdx.x >> 6); }
    __syncthreads();
    XcdBarrier xbar = xcd_barrier_post((unsigned*)(Pk.ws + WS_BAR), (volatile LAS unsigned*)(ldsl + LDS_BARST));
#ifndef PROBE_PH
#define PROBE_PH (-1)
#endif
    unsigned long long probe_dt = 0, probe_t0g = 0;
#ifndef PROBE_FROM
#define PROBE_FROM (-1)
#define PROBE_TO (-1)
#endif
#define PROBE_MARK(id) do { if (PROBE_FROM == (id)) { __syncthreads(); probe_t0g = __builtin_amdgcn_s_memrealtime(); } if (PROBE_TO == (id)) { __syncthreads(); probe_dt = __builtin_amdgcn_s_memrealtime() - probe_t0g; } } while (0)
#ifndef DUP_PH
#define DUP_PH (-1)
#endif
#ifndef DUP_SUB
#define DUP_SUB 0
#endif
    for (int ph = ph_lo; ph < ph_hi; ++ph) {
      {
        int G = G0, bx = bx0, vcu = vcu0; asm volatile("" : "+s"(G), "+s"(bx), "+s"(vcu));
        unsigned long long probe_t0 = 0; if (PROBE_PH >= 0 && ph == PROBE_PH) probe_t0 = __builtin_amdgcn_s_memrealtime();
        for (int sub = 0; sub < (ph == 6 ? 2 : 1); ++sub) {
        int G = G0, bx = bx0, vcu = vcu0; asm volatile("" : "+s"(G), "+s"(bx), "+s"(vcu));
        switch (sub ? 11 : ph) {
        case 0: if (PH_ON(0)) { const Params P = load_params(kp); phase0(P, lds, G); } break;
        case 1: if (PH_ON(1)) { const Params P = load_params(kp); phase1a(P, lds, G); } break;
        case 2: if (PH_ON(2)) { const Params P = load_params(kp); unsigned char* ws = P.ws;
                  pg8::Gemm g{(const bf16_t*)(ws + WS_H), (const bf16_t*)(ws + WS_WIN), SEQ, DINP, DM}; pg8::StaticOrder S; S.init(SEQ, DINP, G, bx);
                  pg8::Epi8<StoreProj> E{{(bf16_t*)(ws + WS_PA), (bf16_t*)(ws + WS_PB), (float*)(ws + WS_GATES)}};
                  pg8::gemm_phase<pg8::Epi8<StoreProj>, pg8::StaticOrder, true, true>(ldsl, g, S, E);
                  { const int nwg = (SEQ / 256) * (DINP / 256), nfull = nwg % G;
                    if (nfull == 0) ff_transposes(P, lds, bx, G, 0, FFT_SPLIT); else if (bx >= nfull) ff_transposes(P, lds, bx - nfull, G - nfull, 0, FFT_SPLIT); } } break;
        case 3: if (PH_ON(3)) { const Params P = load_params(kp); phase2(P, lds, G); } break;
        case 4: if (PH_ON(4)) { PROBE_MARK(40);
#ifndef NO_G4
#ifndef NO_G4A
                  { const Params P = load_params(kp); unsigned char* ws = P.ws;
                    pg8::Gemm g{(const bf16_t*)(ws + WS_CQN), (const bf16_t*)(ws + WS_WUQ), SEQ, NH * 256, QLORA}; pg8::StaticOrder S; S.init(SEQ, NH * 256, G, bx);
                    pg8::Epi8<StoreQ> E{{(bf16_t*)(ws + WS_Q)}};
                    pg8::gemm_phase<pg8::Epi8<StoreQ>, pg8::StaticOrder, true, true>(ldsl, g, S, E); }
#endif
#ifndef NO_G4B
                  { const Params P = load_params(kp); unsigned char* ws = P.ws;
                    pg8::Gemm g{(const bf16_t*)(ws + WS_CKVN), (const bf16_t*)(ws + WS_WUKV), SEQ, NH * 256, KVLORA}; pg8::StaticOrder S; S.init(SEQ, NH * 256, G, bx);
                    pg8::Epi8<StoreKV> E{{(bf16_t*)(ws + WS_KV)}};
                    pg8::gemm_phase<pg8::Epi8<StoreKV>, pg8::StaticOrder, true, true>(ldsl, g, S, E); }
#endif
#endif
                  PROBE_MARK(42);
#ifndef NO_M2
                  { const Params P = load_params(kp); for (int b = vcu; b < 256; b += G) m2_block(P, lds, b); }
#endif
                  PROBE_MARK(43);
                  } break;
        case 5: if (PH_ON(5)) { const Params P = load_params(kp); phase4(P, G); if (F8_MODE == 3 || (F8_MODE == 2 && F8_DBG == 3)) v8t_items(P, G); } break;
        case 6: if (PH_ON(6)) { PROBE_MARK(60);
#ifndef NO_ATT
                  { const Params P = load_params(kp); unsigned char* ws = P.ws;
                  for (int u = vcu; u < NH * (SEQ / 256); u += G) { const int h = u >> 5, qb = u & 31;
                      const bf16_t* vh = (const bf16_t*)(ws + WS_KV) + h * 256 + 128; bf16_t* ob = (bf16_t*)(ws + WS_MIX) + (size_t)(qb * 256) * DM + h * DV;
                      const unsigned char* v8 = ws + WS_V8T + (size_t)h * (SEQ / 64) * 8192; const unsigned char* q8 = ws + WS_Q8 + (size_t)(qb * 256) * (NH * DQK) + h * DQK;
                      if (F8_MODE == 0 || F8_MODE == 2) att::attn_unit<0>((const bf16_t*)(ws + WS_Q) + (size_t)(qb * 256) * att::LDQ + h * DQK, (const bf16_t*)(ws + WS_K) + h * DQK, vh, ob, SEQ, lds);
                      if (F8_MODE == 1) att::attn_unit<1>(q8, ws + WS_K8 + h * DQK, vh, ob, SEQ, lds);
                      if (F8_MODE == 3) att::attn_unit_f8x2(q8, ws + WS_K8 + h * DQK, v8, ob, SEQ, lds);
                      if (F8_MODE == 2) {
                          bf16_t* ob2 = (bf16_t*)((unsigned char*)P.out + 16 * MiB) + (size_t)(qb * 256) * DM + h * DV;
                          if (F8_DBG == 1) att::attn_unit<1>(q8, (const unsigned char*)P.out + h * DQK, vh, ob2, SEQ, lds);
                          else att::attn_unit<3>(q8, (const unsigned char*)P.out + h * DQK, v8, ob2, SEQ, lds);
                          asm volatile("s_waitcnt vmcnt(0)" ::: "memory"); __syncthreads();
                          const int tidc = tid_opaque(); float e2 = 0.f, r2 = 0.f;
                          for (int idx = tidc; idx < 256 * 128; idx += NTHREADS) { const int rr = idx >> 7, cc = idx & 127;
                              const unsigned short va = __hip_atomic_load((const unsigned short*)(ob + (size_t)rr * DM + cc), __ATOMIC_RELAXED, __HIP_MEMORY_SCOPE_AGENT);
                              const unsigned short vb = __hip_atomic_load((const unsigned short*)(ob2 + (size_t)rr * DM + cc), __ATOMIC_RELAXED, __HIP_MEMORY_SCOPE_AGENT);
                              const float fa = bf2f(va), fb = bf2f(vb); e2 += (fa - fb) * (fa - fb); r2 += fa * fa; }
                          e2 = wave_sum(e2); r2 = wave_sum(r2);
                          float* red = (float*)lds; if ((tidc & 63) == 0) { red[(tidc >> 6) * 2] = e2; red[(tidc >> 6) * 2 + 1] = r2; }
                          __syncthreads();
                          float E = 0.f, R = 0.f; for (int w = 0; w < NWAVES; ++w) { E += red[2 * w]; R += red[2 * w + 1]; }
                          if (!(E <= F8_THR * F8_THR * R) && tidc == 0) ob[0] = (bf16_t)0x7fc0;
                          __syncthreads(); }
                  } }
#endif
                  PROBE_MARK(61);
                  } break;
        case 11: if (PH_ON(6)) {
#ifndef NO_M3
                  { const Params P = load_params(kp); for (int u = vcu; u < HM * NCH; u += G) m3_unit(P, lds, u >> 6, u & 63); }
#endif
                  PROBE_MARK(62);
                  } break;
        case 7: if (PH_ON(7)) { const Params P = load_params(kp); unsigned char* ws = P.ws;
                  pg8::Gemm g{(const bf16_t*)(ws + WS_MIX), (const bf16_t*)(ws + WS_WOUT), SEQ, DM, DM}; pg8::StaticOrder S; S.init(SEQ, DM, G, bx);
                  pg8::Epi4<StoreX1> E{{P.x, (const float*)(ws + WS_MOD) + 2 * DM, P.out}};
                  pg8::gemm_phase<pg8::Epi4<StoreX1>, pg8::StaticOrder, true, true>(ldsl, g, S, E); } break;
        case 8: if (PH_ON(8)) { const Params P = load_params(kp); phase6b(P, lds, G); } break;
        case 9: if (PH_ON(9)) { const Params P = load_params(kp); unsigned char* ws = P.ws;
                  pg8::Gemm g{(const bf16_t*)(ws + WS_H), (const bf16_t*)(ws + WS_W1), SEQ, DFF, DM}; pg8::StaticOrder S; S.init(SEQ, DFF, G, bx);
                  pg8::Epi8<StoreAct> E{{(bf16_t*)(ws + WS_ACT)}};
                  pg8::gemm_phase<pg8::Epi8<StoreAct>, pg8::StaticOrder, true, true>(ldsl, g, S, E); } break;
        case 10: if (PH_ON(10)) { const Params P = load_params(kp); unsigned char* ws = P.ws;
                  pg8::Gemm g{(const bf16_t*)(ws + WS_ACT), (const bf16_t*)(ws + WS_W2), SEQ, DM, DFF}; pg8::StaticOrder S; S.init(SEQ, DM, G, bx);
                  pg8::Epi4<StoreX1> E{{P.out, (const float*)(ws + WS_MOD) + 5 * DM, P.out}};
                  pg8::gemm_phase<pg8::Epi4<StoreX1>, pg8::StaticOrder, true, true>(ldsl, g, S, E); } break;
        default: break;
        }
        }
        if (ph + 1 < ph_hi) { xcd_barrier(xbar); }
        if (PROBE_PH >= 0 && ph == PROBE_PH) { __syncthreads(); probe_dt = __builtin_amdgcn_s_memrealtime() - probe_t0; }
      }
    }
    #ifndef PROBE_BLK
#define PROBE_BLK 0
#endif
    if ((PROBE_PH >= 0 || PROBE_FROM >= 0) && blockIdx.x == PROBE_BLK) { const unsigned long long te = __builtin_amdgcn_s_memrealtime();
        while (__builtin_amdgcn_s_memrealtime() - te < probe_dt) __builtin_amdgcn_s_sleep(8); }
}

extern "C" void kernel_launch(void* const* d_in, const int* in_sizes, int n_in, void* d_out, int out_size, void* d_ws, size_t ws_size, hipStream_t stream) {
    static int grid = 0;
    if (grid == 0) {
        if (n_in != 21 || out_size != SEQ * DM || ws_size < WS_END) { fprintf(stderr, "kernel_launch: unexpected shapes n_in %d out %d ws %zu\n", n_in, out_size, ws_size); grid = -1; return; }
        int dev = 0, cus = 0, per_cu = 0;
        if (hipGetDevice(&dev) != hipSuccess || hipDeviceGetAttribute(&cus, hipDeviceAttributeMultiprocessorCount, dev) != hipSuccess) { grid = -1; return; }
        if (hipFuncSetAttribute((const void*)fwd_kernel, hipFuncAttributeMaxDynamicSharedMemorySize, LDS_BYTES) != hipSuccess) { fprintf(stderr, "kernel_launch: hipFuncSetAttribute failed\n"); grid = -1; return; }
        if (hipOccupancyMaxActiveBlocksPerMultiprocessor(&per_cu, (const void*)fwd_kernel, NTHREADS, LDS_BYTES) != hipSuccess || per_cu < 1) { fprintf(stderr, "kernel_launch: occupancy query says %d\n", per_cu); per_cu = 1; }
        (void)hipGetLastError();
        grid = cus * 1;
    }
    if (grid < 0) return;
    Params p{};
    p.x = (const float*)d_in[0]; p.c = (const float*)d_in[1]; p.pos = (const int*)d_in[2]; p.w_ada = (const float*)d_in[3]; p.b_ada = (const float*)d_in[4];
    p.norm_mix_g = (const float*)d_in[5]; p.w_in = (const float*)d_in[6]; p.b_gates = (const float*)d_in[7]; p.conv_w = (const float*)d_in[8]; p.conv_b = (const float*)d_in[9];
    p.q_lora_g = (const float*)d_in[10]; p.w_uq = (const float*)d_in[11]; p.kv_lora_g = (const float*)d_in[12]; p.w_ukv = (const float*)d_in[13]; p.q_norm_g = (const float*)d_in[14];
    p.k_norm_g = (const float*)d_in[15]; p.mlstm_norm_g = (const float*)d_in[16]; p.w_out = (const float*)d_in[17]; p.norm_mlp_g = (const float*)d_in[18];
    p.w_ff1 = (const float*)d_in[19]; p.w_ff2 = (const float*)d_in[20];
    p.out = (float*)d_out; p.ws = (unsigned char*)d_ws;
    (void)hipMemsetAsync((char*)d_ws + WS_BAR, 0, 32768, stream);
#if MK_MULTI
    for (int ph = 0; ph < NPH; ++ph) { p.ph_lo = ph; p.ph_hi = ph + 1; hipLaunchKernelGGL(fwd_kernel, dim3(grid), dim3(NTHREADS), LDS_BYTES, stream, p); }
#else
    p.ph_lo = 0; p.ph_hi = NPH;
    void* args[] = {&p};
    hipError_t e = hipLaunchCooperativeKernel((const void*)fwd_kernel, dim3(grid), dim3(NTHREADS), args, LDS_BYTES, stream);
    if (e != hipSuccess) fprintf(stderr, "kernel_launch: cooperative launch failed: %s (grid %d)\n", hipGetErrorString(e), grid);
#endif
}
```
